# Optimizing an MI355X kernel written in HIP

```python
import math
import jax, jax.numpy as jnp
from jax import lax
import numpy as np

D_MODEL = 1024
BATCH = 4
SEQ = 4096
DEPTH = 4

CHUNK = 64
N_A_LAYERS = DEPTH // 2
N_B_LAYERS = DEPTH - N_A_LAYERS
SSM_GROUP = 16
SSM_GROUPS = D_MODEL // SSM_GROUP
SSM_STATE = 64
N_HEADS = 16
HEAD_DIM = D_MODEL // N_HEADS
Q_BLOCK = 128
PEER_HEADS = 8
PEER_NKEYS = 128
PEER_EXPERTS = PEER_NKEYS * PEER_NKEYS
PEER_TOPK = 16
PEER_QDIM = 256
PEER_TOK_BLOCK = 128
PLE_DIM = 256
ALPHA = (2 * DEPTH) ** 0.25
BETA = (8 * DEPTH) ** -0.25
LN_EPS = 1e-5

kernel_name = "yoco_s5_stickbreak_peer_trunk"


def layer_norm(h, g, b):
    hf = h.astype(jnp.float32)
    mu = jnp.mean(hf, axis=-1, keepdims=True)
    var = jnp.mean(jnp.square(hf - mu), axis=-1, keepdims=True)
    y = (hf - mu) * lax.rsqrt(var + LN_EPS)
    return (y * g.astype(jnp.float32) + b.astype(jnp.float32)).astype(h.dtype)


def s5_mixer(h, w_in, lam_re, lam_im, log_dt, b_re, b_im, c_re, c_im, d_skip, w_glu):
    bsz, seq, _ = h.shape
    f32 = jnp.float32
    u = (h @ w_in).astype(f32)
    ug = u.reshape(bsz, seq, SSM_GROUPS, SSM_GROUP)
    lam = lax.complex(lam_re.astype(f32), lam_im.astype(f32))
    dt = jnp.exp(log_dt.astype(f32))[:, None]
    a_bar = jnp.exp(lam * dt)
    b_cplx = lax.complex(b_re.astype(f32), b_im.astype(f32))
    b_bar = ((a_bar - 1.0) / lam)[..., None] * b_cplx
    bu = lax.complex(jnp.einsum('bsgc,gpc->bsgp', ug, jnp.real(b_bar)),
                     jnp.einsum('bsgc,gpc->bsgp', ug, jnp.imag(b_bar)))
    a_seq = jnp.broadcast_to(a_bar[None, None], (1, seq, SSM_GROUPS, SSM_STATE))

    def combine(left, right):
        a_l, b_l = left
        a_r, b_r = right
        return a_l * a_r, a_r * b_l + b_r

    _, states = lax.associative_scan(combine, (a_seq, bu), axis=1)
    y = (jnp.einsum('bsgp,gcp->bsgc', jnp.real(states), c_re.astype(f32))
         - jnp.einsum('bsgp,gcp->bsgc', jnp.imag(states), c_im.astype(f32)))
    y = y.reshape(bsz, seq, D_MODEL) + d_skip.astype(f32) * u
    y = jax.nn.gelu(y).astype(h.dtype)
    val, gate = jnp.split(y @ w_glu, 2, axis=-1)
    return val * jax.nn.sigmoid(gate)


def shared_kv(h, g, b, w_kv):
    bsz, seq, _ = h.shape
    k, v = jnp.split(layer_norm(h, g, b) @ w_kv, 2, axis=-1)
    return (k.reshape(bsz, seq, N_HEADS, HEAD_DIM), v.reshape(bsz, seq, N_HEADS, HEAD_DIM))


def stick_breaking_mixer(h, w_q, w_o, k, v):
    bsz, seq, _ = h.shape
    q = (h @ w_q).reshape(bsz, seq, N_HEADS, HEAD_DIM)
    scale = HEAD_DIM ** -0.5
    outs = []
    for blk in range(seq // Q_BLOCK):
        t0 = blk * Q_BLOCK
        t1 = t0 + Q_BLOCK
        qb, kb, vb = q[:, t0:t1], k[:, :t1], v[:, :t1]
        z = jnp.einsum('bqhd,bkhd->bhqk', qb, kb).astype(jnp.float32) * scale
        mask = jnp.arange(t1)[None, :] < jnp.arange(t0, t1)[:, None]
        log_keep = jnp.where(mask, jax.nn.log_sigmoid(-z), 0.0)
        later = lax.cumsum(log_keep, axis=3, reverse=True) - log_keep
        w = jnp.where(mask, jnp.exp(jax.nn.log_sigmoid(z) + later), 0.0)
        outs.append(jnp.einsum('bhqk,bkhd->bqhd', w.astype(vb.dtype), vb))
    o = jnp.concatenate(outs, axis=1).reshape(bsz, seq, D_MODEL)
    return o @ w_o


def peer_ffn(h, w_q, k1, k2, u_tab, v_tab):
    bsz, seq, _ = h.shape
    n_tok = bsz * seq
    xt = h.reshape(n_tok, D_MODEL)
    q = (xt @ w_q).reshape(n_tok, PEER_HEADS, PEER_QDIM).astype(jnp.float32)
    q1, q2 = jnp.split(q, 2, axis=-1)
    s1 = jnp.einsum('thd,nd->thn', q1, k1.astype(jnp.float32))
    s2 = jnp.einsum('thd,nd->thn', q2, k2.astype(jnp.float32))
    v1, i1 = lax.top_k(s1, PEER_TOPK)
    v2, i2 = lax.top_k(s2, PEER_TOPK)
    cand = (v1[..., :, None] + v2[..., None, :]).reshape(n_tok, PEER_HEADS, PEER_TOPK * PEER_TOPK)
    sc, ci = lax.top_k(cand, PEER_TOPK)
    e1 = jnp.take_along_axis(i1, ci // PEER_TOPK, axis=-1)
    e2 = jnp.take_along_axis(i2, ci % PEER_TOPK, axis=-1)
    idx = e1 * PEER_NKEYS + e2
    gates = jax.nn.softmax(sc, axis=-1)
    n_blk = n_tok // PEER_TOK_BLOCK

    def block(args):
        xb, ib, gb = args
        act = jnp.einsum('td,thkd->thk', xb, u_tab[ib]).astype(jnp.float32)
        wgt = (gb * jax.nn.gelu(act)).astype(xb.dtype)
        return jnp.einsum('thk,thkd->td', wgt, v_tab[ib])

    out = lax.map(block, (xt.reshape(n_blk, PEER_TOK_BLOCK, D_MODEL),
                          idx.reshape(n_blk, PEER_TOK_BLOCK, PEER_HEADS, PEER_TOPK),
                          gates.reshape(n_blk, PEER_TOK_BLOCK, PEER_HEADS, PEER_TOPK)))
    return out.reshape(bsz, seq, D_MODEL).astype(h.dtype)


def setup_inputs(seed: int = 0) -> dict:
    key = jax.random.key(seed)
    ks = jax.random.split(key, 32)
    f32 = jnp.float32

    def nrm(k, shape, std):
        return std * jax.random.normal(k, shape, f32)

    D, G, P = D_MODEL, SSM_GROUPS, SSM_STATE
    x = nrm(ks[0], (BATCH, SEQ, D), 1.0)
    p = nrm(ks[1], (DEPTH, BATCH, SEQ, PLE_DIM), 1.0)
    ln_mix_g = 1.0 + nrm(ks[2], (DEPTH, D), 0.02)
    ln_mix_b = nrm(ks[3], (DEPTH, D), 0.02)
    ln_ffn_g = 1.0 + nrm(ks[4], (DEPTH, D), 0.02)
    ln_ffn_b = nrm(ks[5], (DEPTH, D), 0.02)
    ssm_w_in = nrm(ks[6], (N_A_LAYERS, D, D), D ** -0.5)
    ssm_lam_re = -0.5 * jnp.exp(nrm(ks[7], (N_A_LAYERS, G, P), 0.01))
    ssm_lam_im = math.pi * jnp.arange(P, dtype=f32)[None, None, :] + nrm(ks[8], (N_A_LAYERS, G, P), 0.01)
    ssm_log_dt = jax.random.uniform(ks[9], (N_A_LAYERS, G), f32, math.log(1e-3), math.log(1e-1))
    ssm_b_re = nrm(ks[10], (N_A_LAYERS, G, P, SSM_GROUP), (2 * SSM_GROUP) ** -0.5)
    ssm_b_im = nrm(ks[11], (N_A_LAYERS, G, P, SSM_GROUP), (2 * SSM_GROUP) ** -0.5)
    ssm_c_re = nrm(ks[12], (N_A_LAYERS, G, SSM_GROUP, P), P ** -0.5)
    ssm_c_im = nrm(ks[13], (N_A_LAYERS, G, SSM_GROUP, P), P ** -0.5)
    ssm_d = nrm(ks[14], (N_A_LAYERS, D), 1.0)
    ssm_w_glu = jnp.concatenate([nrm(ks[15], (N_A_LAYERS, D, D), BETA * D ** -0.5),
                                 nrm(ks[16], (N_A_LAYERS, D, D), D ** -0.5)], axis=-1)
    kv_ln_g = 1.0 + nrm(ks[17], (D,), 0.02)
    kv_ln_b = nrm(ks[18], (D,), 0.02)
    w_kv = jnp.concatenate([nrm(ks[19], (D, D), D ** -0.5),
                            nrm(ks[20], (D, D), BETA * D ** -0.5)], axis=-1)
    sb_w_q = nrm(ks[21], (N_B_LAYERS, D, D), D ** -0.5)
    sb_w_o = nrm(ks[22], (N_B_LAYERS, D, D), BETA * D ** -0.5)
    peer_w_q = nrm(ks[23], (DEPTH, D, PEER_HEADS * PEER_QDIM), D ** -0.5)
    peer_k1 = nrm(ks[24], (DEPTH, PEER_NKEYS, PEER_QDIM // 2), (PEER_QDIM // 2) ** -0.5)
    peer_k2 = nrm(ks[25], (DEPTH, PEER_NKEYS, PEER_QDIM // 2), (PEER_QDIM // 2) ** -0.5)
    peer_u = nrm(ks[26], (DEPTH, PEER_EXPERTS, D), D ** -0.5)
    peer_v = nrm(ks[27], (DEPTH, PEER_EXPERTS, D), BETA)
    ple_w = nrm(ks[28], (DEPTH, PLE_DIM, D), PLE_DIM ** -0.5)
    ple_gate = nrm(ks[29], (DEPTH, D, D), D ** -0.5)
    return {"x": x, "p": p, "ln_mix_g": ln_mix_g, "ln_mix_b": ln_mix_b,
            "ln_ffn_g": ln_ffn_g, "ln_ffn_b": ln_ffn_b, "ssm_w_in": ssm_w_in,
            "ssm_lam_re": ssm_lam_re, "ssm_lam_im": ssm_lam_im, "ssm_log_dt": ssm_log_dt,
            "ssm_b_re": ssm_b_re, "ssm_b_im": ssm_b_im, "ssm_c_re": ssm_c_re,
            "ssm_c_im": ssm_c_im, "ssm_d": ssm_d, "ssm_w_glu": ssm_w_glu,
            "kv_ln_g": kv_ln_g, "kv_ln_b": kv_ln_b, "w_kv": w_kv,
            "sb_w_q": sb_w_q, "sb_w_o": sb_w_o, "peer_w_q": peer_w_q,
            "peer_k1": peer_k1, "peer_k2": peer_k2, "peer_u": peer_u, "peer_v": peer_v,
            "ple_w": ple_w, "ple_gate": ple_gate}


def reference(x, p, ln_mix_g, ln_mix_b, ln_ffn_g, ln_ffn_b, ssm_w_in, ssm_lam_re, ssm_lam_im,
              ssm_log_dt, ssm_b_re, ssm_b_im, ssm_c_re, ssm_c_im, ssm_d, ssm_w_glu,
              kv_ln_g, kv_ln_b, w_kv, sb_w_q, sb_w_o, peer_w_q, peer_k1, peer_k2,
              peer_u, peer_v, ple_w, ple_gate):
    h = x
    k_sh = None
    v_sh = None
    for i in range(DEPTH):
        if i < N_A_LAYERS:
            mix = s5_mixer(h, ssm_w_in[i], ssm_lam_re[i], ssm_lam_im[i], ssm_log_dt[i],
                           ssm_b_re[i], ssm_b_im[i], ssm_c_re[i], ssm_c_im[i],
                           ssm_d[i], ssm_w_glu[i])
        else:
            if i == N_A_LAYERS:
                k_sh, v_sh = shared_kv(h, kv_ln_g, kv_ln_b, w_kv)
            j = i - N_A_LAYERS
            mix = stick_breaking_mixer(h, sb_w_q[j], sb_w_o[j], k_sh, v_sh)
        h = layer_norm(ALPHA * h + mix, ln_mix_g[i], ln_mix_b[i])
        ffn = peer_ffn(h, peer_w_q[i], peer_k1[i], peer_k2[i], peer_u[i], peer_v[i])
        h = layer_norm(ALPHA * h + ffn, ln_ffn_g[i], ln_ffn_b[i])
        h = h + jax.nn.sigmoid(h @ ple_gate[i]) * (p[i] @ ple_w[i])
    return h
```

```cpp
#include <hip/hip_runtime.h>
#include <cstdio>
#include <cstdint>
#include <cmath>
namespace pg8 {
#define PG8_LAS __attribute__((address_space(3)))
typedef unsigned short bf16_t;
typedef short bf16x8 __attribute__((ext_vector_type(8)));
typedef float f32x4 __attribute__((ext_vector_type(4)));
typedef unsigned u32x4 __attribute__((ext_vector_type(4)));
constexpr int BM = 256, BK = 64, HALF = 128, HTB = HALF * BK * 2  , STAGE_BYTES = 8 * HTB, NXCD = 8, WGM = 8;

__host__ __device__ __forceinline__ int lds_byte(int r, int c) { const int st = (r >> 4) * 2 + (c >> 5), rr = r & 15, cc = c & 31, ob = rr * 64 + cc * 2; return st * 1024 + (ob ^ (((ob >> 9) & 1) << 5)); }
__host__ __device__ __forceinline__ void stage_rc(int b, int& R, int& C) { const int st = b / 1024, sb = b % 1024, swz = sb ^ (((sb >> 9) & 1) << 5); R = (st >> 1) * 16 + swz / 64; C = (st & 1) * 32 + (swz % 64) / 2; }
__host__ __device__ __forceinline__ int perm32(int rho) { const int n = rho >> 4, i = rho & 15; return 8 * (i >> 2) + 4 * n + (i & 3); }

struct Unit { int pm, pn; };
struct Gemm { const bf16_t* A; const bf16_t* Bt; int M, N, K; };

struct StaticOrder {
    int nM, nN, nwg, G, c;
    __host__ __device__ void init(int M, int N, int G_, int c_) { nM = M / BM; nN = N / BM; nwg = nM * nN; G = G_; c = c_; pw = 0; }
    int pw;
    __host__ __device__ bool next(int i, Unit& u) const {
        const long L = (long)i * G + c; if (L >= nwg) return false;
        if (pw) { const int l = (int)L >> 8, rem = (int)L & 255; u.pm = l * 64 + (rem >> 2); u.pn = l * 4 + (rem & 3); return true; }
        int wgid = (int)L; { const int q = nwg / NXCD, r = nwg % NXCD, xcd = wgid % NXCD, off = wgid / NXCD; wgid = (xcd < r ? xcd * (q + 1) : r * (q + 1) + (xcd - r) * q) + off; }
        const int nig = WGM * nN, gid = wgid / nig, fm = gid * WGM, gsz = (nM - fm) < WGM ? (nM - fm) : WGM;
        u.pm = fm + ((wgid % nig) % gsz); u.pn = (wgid % nig) / gsz; return true;
    }
    __device__ __forceinline__ void a_ready(const Unit&) const {}
    __device__ __forceinline__ void done(const Unit&) const {}
};

typedef float f32x2c_t __attribute__((ext_vector_type(2))); typedef __bf16 bf16x2c_t __attribute__((ext_vector_type(2)));
__device__ __forceinline__ unsigned cvt_pk_bf16(float lo, float hi) { f32x2c_t v = {lo, hi}; bf16x2c_t b = __builtin_convertvector(v, bf16x2c_t); return __builtin_bit_cast(unsigned, b); }
typedef float f32x2 __attribute__((ext_vector_type(2)));
typedef int v8i32_t __attribute__((ext_vector_type(8)));
typedef unsigned u32x8_t __attribute__((ext_vector_type(8)));
template <bool F8> struct Frag { bf16x8 k[2]; };
template <> struct Frag<true> { v8i32_t v; };
template <class Epi, class Sched, bool ALIGN_EPI = false, bool SP2 = false, bool F8 = false>
__device__ __forceinline__ void gemm_phase(PG8_LAS unsigned char* lds, const Gemm g, const Sched& S, const Epi& E, const int tid) {
    const int wid = __builtin_amdgcn_readfirstlane(tid >> 6), lane = tid & 63, wr = wid >> 2, wc = wid & 3, fr = lane & 15, fq = lane >> 4;
    const int K = g.K, nt = K / BK;
    unsigned voffA[1], voffB[1];
    { int R, C; stage_rc(tid * 16, R, C); const int Rb = Epi::PERM ? ((R & ~31) + perm32(R & 31)) : R;
        voffA[0] = (unsigned)(R * K + C) * 2u; voffB[0] = (unsigned)(Rb * K + C) * 2u; }
    const size_t r64 = (size_t)128 * K;
    const size_t kstep = (size_t)(BK * 2);
    const size_t hstep = (size_t)HALF * K * 2;
    const size_t tstep = 2 * hstep;
    const unsigned ldsw = (unsigned)wid * 1024u;
    const int aoff = lds_byte(wr * 64 + fr, F8 ? fq * 16 : fq * 8), boff = lds_byte(wc * 32 + fr, F8 ? fq * 16 : fq * 8);
#define PG8_SA(b, h) (((b) * 2 + (h)) * HTB)
#define PG8_SB(b, h) ((4 + (b) * 2 + (h)) * HTB)
#define PG8_STAGE(bufoff, gbase, voff) do { _Pragma("unroll") for (int _i = 0; _i < 2; ++_i) \
        __builtin_amdgcn_global_load_lds((const unsigned*)((const char*)(gbase) + _i * r64 + (voff)[0]), (PG8_LAS unsigned*)(lds + (bufoff) + ldsw + _i * 8192), 16, 0, 0); } while (0)
#define PG8_LDF(d, addr) do { if constexpr (F8) { const u32x4 lo_ = *(const PG8_LAS u32x4*)(addr), hi_ = *(const PG8_LAS u32x4*)((addr) + 16); d.v = __builtin_bit_cast(v8i32_t, (u32x8_t){lo_[0], lo_[1], lo_[2], lo_[3], hi_[0], hi_[1], hi_[2], hi_[3]}); } \
        else { d.k[0] = *(const PG8_LAS bf16x8*)(addr); d.k[1] = *(const PG8_LAS bf16x8*)((addr) + 1024); } } while (0)
#define PG8_LDA(dst, b, h) do { _Pragma("unroll") for (int m = 0; m < 4; ++m) PG8_LDF(dst[m], lds + PG8_SA(b, h) + aoff + m * 2048); } while (0)
#define PG8_LDB(dst, b, h) do { _Pragma("unroll") for (int n = 0; n < 2; ++n) PG8_LDF(dst[n], lds + PG8_SB(b, h) + boff + n * 2048); } while (0)
#define PG8_MMA(ai, bj, At, Bt) do { __builtin_amdgcn_s_setprio(1); _Pragma("unroll") for (int m = 0; m < 4; ++m) _Pragma("unroll") for (int n = 0; n < 2; ++n) { \
        if constexpr (F8) asm volatile("v_mfma_f32_16x16x128_f8f6f4 %0, %1, %2, %0" : "+v"(acc[ai][bj][m][n]) : "v"(Bt[n].v), "v"(At[m].v));   \
        else { _Pragma("unroll") for (int k = 0; k < 2; ++k) acc[ai][bj][m][n] = __builtin_amdgcn_mfma_f32_16x16x32_bf16(Bt[n].k[k], At[m].k[k], acc[ai][bj][m][n], 0, 0, 0); } } __builtin_amdgcn_s_setprio(0); } while (0)
#define PG8_WAIT_V(n) asm volatile("s_waitcnt vmcnt(" #n ")" ::: "memory")
#define PG8_WAIT_L(n) asm volatile("s_waitcnt lgkmcnt(" #n ")" ::: "memory")
#define PG8_BAR __builtin_amdgcn_s_barrier()
#define PG8_SCHED __builtin_amdgcn_sched_barrier(0)
    Unit cur, nxt; int ui = 0;
    if (!S.next(0, cur)) return;
    f32x4 acc[2][2][4][2];
#pragma unroll
    for (int a = 0; a < 2; ++a)
#pragma unroll
        for (int b = 0; b < 2; ++b)
#pragma unroll
            for (int m = 0; m < 4; ++m)
#pragma unroll
                for (int n = 0; n < 2; ++n) acc[a][b][m][n] = (f32x4){0.f, 0.f, 0.f, 0.f};
    Frag<F8> At[4], B0[2], B1[2];
    const char* cA = (const char*)g.A + (size_t)cur.pm * tstep; const char* cB = (const char*)g.Bt + (size_t)cur.pn * tstep;
    S.a_ready(cur);
    if constexpr (SP2) {
        PG8_STAGE(PG8_SB(0, 0), cB, voffB); PG8_STAGE(PG8_SB(0, 1), cB + hstep, voffB); PG8_STAGE(PG8_SA(0, 0), cA, voffA); PG8_STAGE(PG8_SA(0, 1), cA + hstep, voffA);
        if (wr == 1) PG8_BAR;
        PG8_WAIT_V(2); PG8_BAR;
        PG8_STAGE(PG8_SB(1, 0), cB + kstep, voffB); PG8_STAGE(PG8_SA(1, 0), cA + kstep, voffA); PG8_STAGE(PG8_SB(1, 1), cB + hstep + kstep, voffB);
        PG8_WAIT_V(6); PG8_BAR;
    } else {
        PG8_STAGE(PG8_SB(0, 0), cB, voffB); PG8_STAGE(PG8_SA(0, 0), cA, voffA); PG8_STAGE(PG8_SB(0, 1), cB + hstep, voffB); PG8_STAGE(PG8_SA(0, 1), cA + hstep, voffA);
        if (wr == 1) PG8_BAR;
        PG8_WAIT_V(4); PG8_BAR;
        PG8_STAGE(PG8_SB(1, 0), cB + kstep, voffB); PG8_STAGE(PG8_SA(1, 0), cA + kstep, voffA); PG8_STAGE(PG8_SB(1, 1), cB + hstep + kstep, voffB);
        PG8_WAIT_V(6); PG8_BAR;
    }
    for (;;) {
        const bool has_next = S.next(ui + 1, nxt);
        const char* nA = has_next ? (const char*)g.A + (size_t)nxt.pm * tstep : cA; const char* nB = has_next ? (const char*)g.Bt + (size_t)nxt.pn * tstep : cB;
#pragma unroll 1
        for (int t = 0; t < nt; t += 2) {
            const bool last = (t == nt - 2);
            const char* a1 = cA + (size_t)(t + 1) * kstep;
            const char* a2 = last ? nA : cA + (size_t)(t + 2) * kstep; const char* b2 = last ? nB : cB + (size_t)(t + 2) * kstep;
            const char* a3 = a2 + kstep; const char* b3 = b2 + kstep;
            if (last && has_next) S.a_ready(nxt);
            if constexpr (SP2) {
            PG8_LDB(B0, 0, 0); PG8_LDB(B1, 0, 1); PG8_SCHED; PG8_LDA(At, 0, 0); PG8_STAGE(PG8_SA(1, 1), a1 + hstep, voffA);
            PG8_WAIT_V(8); PG8_WAIT_L(0); PG8_BAR; PG8_MMA(0, 0, At, B0); PG8_MMA(0, 1, At, B1); PG8_BAR; PG8_SCHED;
            PG8_LDA(At, 0, 1); PG8_STAGE(PG8_SB(0, 0), b2, voffB); PG8_STAGE(PG8_SB(0, 1), b2 + hstep, voffB); PG8_STAGE(PG8_SA(0, 0), a2, voffA);
            PG8_WAIT_V(8); PG8_WAIT_L(0); PG8_BAR; PG8_MMA(1, 0, At, B0); PG8_MMA(1, 1, At, B1); PG8_BAR; PG8_SCHED;
            PG8_LDB(B0, 1, 0); PG8_LDB(B1, 1, 1); PG8_SCHED; PG8_LDA(At, 1, 0); PG8_STAGE(PG8_SA(0, 1), a2 + hstep, voffA);
            PG8_WAIT_V(8); PG8_WAIT_L(0); PG8_BAR; PG8_MMA(0, 0, At, B0); PG8_MMA(0, 1, At, B1); PG8_BAR; PG8_SCHED;
            PG8_LDA(At, 1, 1); PG8_STAGE(PG8_SB(1, 0), b3, voffB); PG8_STAGE(PG8_SB(1, 1), b3 + hstep, voffB); PG8_STAGE(PG8_SA(1, 0), a3, voffA);
            PG8_WAIT_V(8); PG8_WAIT_L(0); PG8_BAR; PG8_MMA(1, 0, At, B0); PG8_MMA(1, 1, At, B1); PG8_BAR; PG8_SCHED;
            } else {
            PG8_LDB(B0, 0, 0); PG8_SCHED; PG8_LDA(At, 0, 0); PG8_STAGE(PG8_SA(1, 1), a1 + hstep, voffA);
            PG8_WAIT_L(8); PG8_BAR; PG8_WAIT_L(0); PG8_MMA(0, 0, At, B0); PG8_BAR; PG8_SCHED;
            PG8_LDB(B1, 0, 1); PG8_STAGE(PG8_SB(0, 0), b2, voffB);
            PG8_BAR; PG8_WAIT_L(0); PG8_MMA(0, 1, At, B1); PG8_BAR;
            PG8_LDA(At, 0, 1); PG8_STAGE(PG8_SA(0, 0), a2, voffA);
            PG8_BAR; PG8_WAIT_L(0); PG8_MMA(1, 0, At, B0); PG8_BAR; PG8_SCHED;
            PG8_STAGE(PG8_SB(0, 1), b2 + hstep, voffB);
            PG8_WAIT_V(6); PG8_BAR; PG8_MMA(1, 1, At, B1); PG8_BAR;
            PG8_LDB(B0, 1, 0); PG8_SCHED; PG8_LDA(At, 1, 0); PG8_STAGE(PG8_SA(0, 1), a2 + hstep, voffA);
            PG8_WAIT_L(8); PG8_BAR; PG8_WAIT_L(0); PG8_MMA(0, 0, At, B0); PG8_BAR; PG8_SCHED;
            PG8_LDB(B1, 1, 1); PG8_STAGE(PG8_SB(1, 0), b3, voffB);
            PG8_BAR; PG8_WAIT_L(0); PG8_MMA(0, 1, At, B1); PG8_BAR;
            PG8_LDA(At, 1, 1); PG8_STAGE(PG8_SA(1, 0), a3, voffA);
            PG8_BAR; PG8_WAIT_L(0); PG8_MMA(1, 0, At, B0); PG8_BAR; PG8_SCHED;
            PG8_STAGE(PG8_SB(1, 1), b3 + hstep, voffB);
            PG8_WAIT_V(6); PG8_BAR; PG8_MMA(1, 1, At, B1); PG8_BAR;
            }
        }
        if constexpr (F8) asm volatile("s_nop 15\n\ts_nop 15" ::: "memory");
        if constexpr (ALIGN_EPI) { if (wr == 0) PG8_BAR; }
        if constexpr (!Epi::AFTER_DRAIN) { E(acc, cur, wr, wc, fr, fq); S.done(cur); }
        if (!has_next) break;
#pragma unroll
        for (int a = 0; a < 2; ++a)
#pragma unroll
            for (int b = 0; b < 2; ++b)
#pragma unroll
                for (int m = 0; m < 4; ++m)
#pragma unroll
                    for (int n = 0; n < 2; ++n) acc[a][b][m][n] = (f32x4){0.f, 0.f, 0.f, 0.f};
        cur = nxt; cA = nA; cB = nB; ++ui;
        if constexpr (ALIGN_EPI) { if (wr == 1) PG8_BAR; }
    }
    PG8_WAIT_V(0);
    if constexpr (!ALIGN_EPI) { if (wr == 0) PG8_BAR; }
    PG8_BAR;
    if constexpr (Epi::AFTER_DRAIN) { E.fused(acc, cur, wr, wc, fr, fq, lds, wid, lane); S.done(cur); }
#undef PG8_SA
#undef PG8_SB
#undef PG8_STAGE
#undef PG8_LDA
#undef PG8_LDB
#undef PG8_MMA
#undef PG8_LDF
#undef PG8_WAIT_V
#undef PG8_WAIT_L
#undef PG8_BAR
#undef PG8_SCHED
}
}
namespace pg8 {
__device__ __forceinline__ float bf_lo(unsigned w) { return __uint_as_float(w << 16); }
__device__ __forceinline__ float bf_hi(unsigned w) { return __uint_as_float(w & 0xffff0000u); }
__device__ __forceinline__ float fast_sigmoid(float x) { return __builtin_amdgcn_rcpf(1.0f + __builtin_amdgcn_exp2f(-1.4426950408889634f * x)); }
__device__ __forceinline__ float gelu_tanh(float x) { const float t = x * (1.5957691216057308f + 0.07135481627260025f * x * x); return x * __builtin_amdgcn_rcpf(1.0f + __builtin_amdgcn_exp2f(-1.4426950408889634f * t)); }
constexpr float ALPHA_F = 1.681792830507429f;
constexpr float WSC = 1.0f / 32.0f;

struct EpiStore {
    static constexpr bool PERM = true, AFTER_DRAIN = false;
    bf16_t* O; int ldc; float scale; int pnmask;
    __device__ __forceinline__ void operator()(const f32x4 (&acc)[2][2][4][2], const Unit& u, int wr, int wc, int fr, int fq) const {
        const int row0 = u.pm * BM + wr * 64 + fr, col0 = (u.pn & pnmask) * BM + wc * 32 + 8 * fq;
#pragma unroll
        for (int ai = 0; ai < 2; ++ai)
#pragma unroll
            for (int m = 0; m < 4; ++m) { bf16_t* rowp = O + (size_t)(row0 + ai * HALF + m * 16) * ldc + col0;
#pragma unroll
                for (int bj = 0; bj < 2; ++bj) { const f32x4 v0 = acc[ai][bj][m][0] * scale, v1 = acc[ai][bj][m][1] * scale;
                    if (pnmask >= 0) {
                        int w0 = 0, w1 = 0; w0 = __builtin_amdgcn_cvt_pk_fp8_f32(v0[0], v0[1], w0, false); w0 = __builtin_amdgcn_cvt_pk_fp8_f32(v0[2], v0[3], w0, true);
                        w1 = __builtin_amdgcn_cvt_pk_fp8_f32(v1[0], v1[1], w1, false); w1 = __builtin_amdgcn_cvt_pk_fp8_f32(v1[2], v1[3], w1, true);
                        *(unsigned long long*)((unsigned char*)O + (size_t)(row0 + ai * HALF + m * 16) * ldc + col0 + bj * HALF) = (unsigned long long)(unsigned)w0 | ((unsigned long long)(unsigned)w1 << 32);
                    } else {
                    u32x4 w; w.x = cvt_pk_bf16(v0[0], v0[1]); w.y = cvt_pk_bf16(v0[2], v0[3]); w.z = cvt_pk_bf16(v1[0], v1[1]); w.w = cvt_pk_bf16(v1[2], v1[3]);
                    *(u32x4*)(rowp + bj * HALF) = w; } } }
    }
};
struct EpiGlu {
    static constexpr bool PERM = true, AFTER_DRAIN = false;
    const bf16_t* Hin; bf16_t* X1;
    __device__ __forceinline__ void operator()(const f32x4 (&acc)[2][2][4][2], const Unit& u, int wr, int wc, int fr, int fq) const {
        const int row0 = u.pm * BM + wr * 64 + fr, col0 = u.pn * HALF + wc * 32 + 8 * fq;
        u32x4 hvv[2][4];
#pragma unroll
        for (int ai = 0; ai < 2; ++ai)
#pragma unroll
            for (int m = 0; m < 4; ++m) hvv[ai][m] = *(const u32x4*)(Hin + (size_t)(row0 + ai * HALF + m * 16) * 1024 + col0);
#pragma unroll
        for (int ai = 0; ai < 2; ++ai)
#pragma unroll
            for (int m = 0; m < 4; ++m) { const size_t off = (size_t)(row0 + ai * HALF + m * 16) * 1024 + col0;
                const u32x4 hv = hvv[ai][m];
                const f32x4 v0 = acc[ai][0][m][0] * WSC, v1 = acc[ai][0][m][1] * WSC, g0 = acc[ai][1][m][0] * WSC, g1 = acc[ai][1][m][1] * WSC;
                float o[8];
                o[0] = ALPHA_F * bf_lo(hv.x) + v0[0] * fast_sigmoid(g0[0]); o[1] = ALPHA_F * bf_hi(hv.x) + v0[1] * fast_sigmoid(g0[1]);
                o[2] = ALPHA_F * bf_lo(hv.y) + v0[2] * fast_sigmoid(g0[2]); o[3] = ALPHA_F * bf_hi(hv.y) + v0[3] * fast_sigmoid(g0[3]);
                o[4] = ALPHA_F * bf_lo(hv.z) + v1[0] * fast_sigmoid(g1[0]); o[5] = ALPHA_F * bf_hi(hv.z) + v1[1] * fast_sigmoid(g1[1]);
                o[6] = ALPHA_F * bf_lo(hv.w) + v1[2] * fast_sigmoid(g1[2]); o[7] = ALPHA_F * bf_hi(hv.w) + v1[3] * fast_sigmoid(g1[3]);
                u32x4 w; w.x = cvt_pk_bf16(o[0], o[1]); w.y = cvt_pk_bf16(o[2], o[3]); w.z = cvt_pk_bf16(o[4], o[5]); w.w = cvt_pk_bf16(o[6], o[7]);
                *(u32x4*)(X1 + off) = w; }
    }
};
struct EpiRes {
    static constexpr bool PERM = true, AFTER_DRAIN = false;
    const bf16_t* Hin; bf16_t* X1;
    __device__ __forceinline__ void operator()(const f32x4 (&acc)[2][2][4][2], const Unit& u, int wr, int wc, int fr, int fq) const {
        const int row0 = u.pm * BM + wr * 64 + fr, col0 = u.pn * BM + wc * 32 + 8 * fq;
        u32x4 hvv[2][4][2];
#pragma unroll
        for (int ai = 0; ai < 2; ++ai)
#pragma unroll
            for (int m = 0; m < 4; ++m)
#pragma unroll
                for (int bj = 0; bj < 2; ++bj) hvv[ai][m][bj] = *(const u32x4*)(Hin + (size_t)(row0 + ai * HALF + m * 16) * 1024 + col0 + bj * HALF);
#pragma unroll
        for (int ai = 0; ai < 2; ++ai)
#pragma unroll
            for (int m = 0; m < 4; ++m)
#pragma unroll
                for (int bj = 0; bj < 2; ++bj) { const size_t off = (size_t)(row0 + ai * HALF + m * 16) * 1024 + col0 + bj * HALF;
                    const u32x4 hv = hvv[ai][m][bj]; const f32x4 v0 = acc[ai][bj][m][0] * WSC, v1 = acc[ai][bj][m][1] * WSC;
                    u32x4 w; w.x = cvt_pk_bf16(ALPHA_F * bf_lo(hv.x) + v0[0], ALPHA_F * bf_hi(hv.x) + v0[1]); w.y = cvt_pk_bf16(ALPHA_F * bf_lo(hv.y) + v0[2], ALPHA_F * bf_hi(hv.y) + v0[3]);
                    w.z = cvt_pk_bf16(ALPHA_F * bf_lo(hv.z) + v1[0], ALPHA_F * bf_hi(hv.z) + v1[1]); w.w = cvt_pk_bf16(ALPHA_F * bf_lo(hv.w) + v1[2], ALPHA_F * bf_hi(hv.w) + v1[3]);
                    *(u32x4*)(X1 + off) = w; }
    }
};
struct EpiPle {
    static constexpr bool PERM = true, AFTER_DRAIN = false;
    const bf16_t* H2; const unsigned char* PW; bf16_t* Hout; float* Fout; unsigned char* H8out;
    __device__ __forceinline__ void operator()(const f32x4 (&acc)[2][2][4][2], const Unit& u, int wr, int wc, int fr, int fq) const {
        const int row0 = u.pm * BM + wr * 64 + fr, col0 = u.pn * BM + wc * 32 + 8 * fq;
#pragma unroll
        for (int ai = 0; ai < 2; ++ai) {
            u32x4 hvv[4][2]; unsigned long long pvv[4][2];
#pragma unroll
            for (int m = 0; m < 4; ++m)
#pragma unroll
                for (int bj = 0; bj < 2; ++bj) { const size_t off = (size_t)(row0 + ai * HALF + m * 16) * 1024 + col0 + bj * HALF; hvv[m][bj] = *(const u32x4*)(H2 + off); pvv[m][bj] = *(const unsigned long long*)(PW + off); }
#pragma unroll
            for (int m = 0; m < 4; ++m)
#pragma unroll
                for (int bj = 0; bj < 2; ++bj) { const size_t off = (size_t)(row0 + ai * HALF + m * 16) * 1024 + col0 + bj * HALF;
                    const u32x4 hv = hvv[m][bj]; const int pl = (int)(unsigned)pvv[m][bj], ph = (int)(unsigned)(pvv[m][bj] >> 32); const f32x4 v0 = acc[ai][bj][m][0] * WSC, v1 = acc[ai][bj][m][1] * WSC;
                    const auto p01 = __builtin_amdgcn_cvt_pk_f32_fp8(pl, false), p23 = __builtin_amdgcn_cvt_pk_f32_fp8(pl, true), p45 = __builtin_amdgcn_cvt_pk_f32_fp8(ph, false), p67 = __builtin_amdgcn_cvt_pk_f32_fp8(ph, true);
                    float o[8];
                    o[0] = bf_lo(hv.x) + fast_sigmoid(v0[0]) * p01[0]; o[1] = bf_hi(hv.x) + fast_sigmoid(v0[1]) * p01[1];
                    o[2] = bf_lo(hv.y) + fast_sigmoid(v0[2]) * p23[0]; o[3] = bf_hi(hv.y) + fast_sigmoid(v0[3]) * p23[1];
                    o[4] = bf_lo(hv.z) + fast_sigmoid(v1[0]) * p45[0]; o[5] = bf_hi(hv.z) + fast_sigmoid(v1[1]) * p45[1];
                    o[6] = bf_lo(hv.w) + fast_sigmoid(v1[2]) * p67[0]; o[7] = bf_hi(hv.w) + fast_sigmoid(v1[3]) * p67[1];
                    if (Fout) { *(f32x4*)(Fout + off) = (f32x4){o[0], o[1], o[2], o[3]}; *(f32x4*)(Fout + off + 4) = (f32x4){o[4], o[5], o[6], o[7]}; }
                    else { u32x4 w; w.x = cvt_pk_bf16(o[0], o[1]); w.y = cvt_pk_bf16(o[2], o[3]); w.z = cvt_pk_bf16(o[4], o[5]); w.w = cvt_pk_bf16(o[6], o[7]); *(u32x4*)(Hout + off) = w;
                        int w0 = 0, w1 = 0; w0 = __builtin_amdgcn_cvt_pk_fp8_f32(o[0], o[1], w0, false); w0 = __builtin_amdgcn_cvt_pk_fp8_f32(o[2], o[3], w0, true); w1 = __builtin_amdgcn_cvt_pk_fp8_f32(o[4], o[5], w1, false); w1 = __builtin_amdgcn_cvt_pk_fp8_f32(o[6], o[7], w1, true);
                        *(unsigned long long*)(H8out + off) = (unsigned long long)(unsigned)w0 | ((unsigned long long)(unsigned)w1 << 32); } }
        }
    }
};

__device__ __forceinline__ int imax_(int a, int b) { return a > b ? a : b; }
__device__ __forceinline__ int imin_(int a, int b) { return a < b ? a : b; }
__device__ __forceinline__ float csum(float a, float b) { float s = a + b; asm volatile("" : "+v"(s)); return s; }
__device__ __forceinline__ int f2key(float v) { int s = __float_as_int(v); return s ^ ((s >> 31) & 0x7fffffff); }
__device__ __forceinline__ float key2f(int k) { return __int_as_float(k ^ ((k >> 31) & 0x7fffffff)); }
template <bool DESC> __device__ __forceinline__ void bitonic_sort16(int (&x)[16]) {
#pragma unroll
    for (int k = 2; k <= 16; k <<= 1)
#pragma unroll
        for (int j = k >> 1; j > 0; j >>= 1)
#pragma unroll
            for (int i = 0; i < 16; ++i) { const int l = i ^ j; if (l > i) { const bool up = ((i & k) == 0) || (k == 16); const bool asc = DESC ? !up : up;
                const int lo = imin_(x[i], x[l]), hi = imax_(x[i], x[l]); x[i] = asc ? lo : hi; x[l] = asc ? hi : lo; } }
}
__device__ __forceinline__ void bitonic_merge_desc16(int (&x)[16]) {
#pragma unroll
    for (int j = 8; j > 0; j >>= 1)
#pragma unroll
        for (int i = 0; i < 16; ++i) { const int l = i ^ j; if (l > i) { const int lo = imin_(x[i], x[l]), hi = imax_(x[i], x[l]); x[i] = hi; x[l] = lo; } }
}
__device__ __forceinline__ void topk_absorb16(int (&L)[16], int (&N)[16]) {
    bitonic_sort16<false>(N);
#pragma unroll
    for (int i = 0; i < 16; ++i) L[i] = imax_(L[i], N[i]);
    bitonic_merge_desc16(L);
}
__device__ __forceinline__ void topk_insert1(int (&L)[16], int v) {
#pragma unroll
    for (int i = 0; i < 16; ++i) { const int hi = imax_(L[i], v); v = imin_(L[i], v); L[i] = hi; }
}

template <bool DESC> __device__ __forceinline__ void bitonic_sort16f(float (&x)[16]) {
#pragma unroll
    for (int k = 2; k <= 16; k <<= 1)
#pragma unroll
        for (int j = k >> 1; j > 0; j >>= 1)
#pragma unroll
            for (int i = 0; i < 16; ++i) { const int l = i ^ j; if (l > i) { const bool up = ((i & k) == 0) || (k == 16); const bool asc = DESC ? !up : up;
                const float lo = __builtin_fminf(x[i], x[l]), hi = __builtin_fmaxf(x[i], x[l]); x[i] = asc ? lo : hi; x[l] = asc ? hi : lo; } }
}
__device__ __forceinline__ void bitonic_merge_desc16f(float (&x)[16]) {
#pragma unroll
    for (int j = 8; j > 0; j >>= 1)
#pragma unroll
        for (int i = 0; i < 16; ++i) { const int l = i ^ j; if (l > i) { const float lo = __builtin_fminf(x[i], x[l]), hi = __builtin_fmaxf(x[i], x[l]); x[i] = hi; x[l] = lo; } }
}
__device__ __forceinline__ void topk_absorb16f(float (&L)[16], float (&N)[16]) {
    bitonic_sort16f<false>(N);
#pragma unroll
    for (int i = 0; i < 16; ++i) L[i] = __builtin_fmaxf(L[i], N[i]);
    bitonic_merge_desc16f(L);
}

struct EpiTopk {
    static constexpr bool PERM = true, AFTER_DRAIN = true;
    int* IDX; float* GATE;
    __device__ __forceinline__ void fused(f32x4 (&acc)[2][2][4][2], const Unit& u, int wr, int wc, int fr, int fq, PG8_LAS unsigned char* lds, int wid, int lane) const {
        const int tid = wid * 64 + lane;
        PG8_LAS float* S = (PG8_LAS float*)lds;
        PG8_LAS int* X = (PG8_LAS int*)lds;
        const int row = tid & 255, part = tid >> 8;
        int KK[2][16];
#pragma unroll
        for (int bj = 0; bj < 2; ++bj) {
#pragma unroll
            for (int ai = 0; ai < 2; ++ai)
#pragma unroll
                for (int m = 0; m < 4; ++m)
#pragma unroll
                    for (int n = 0; n < 2; ++n) *(PG8_LAS f32x4*)(S + (ai * HALF + wr * 64 + m * 16 + fr) * 132 + wc * 32 + 8 * fq + 4 * n) = acc[ai][bj][m][n] * WSC;
            asm volatile("s_waitcnt lgkmcnt(0)" ::: "memory"); __builtin_amdgcn_s_barrier(); asm volatile("" ::: "memory");
            float L[16];
#pragma unroll
            for (int c = 0; c < 4; ++c) {
                float N[16];
#pragma unroll
                for (int i = 0; i < 4; ++i) { const f32x4 v = *(const PG8_LAS f32x4*)(S + row * 132 + 64 * part + 16 * c + 4 * i);
#pragma unroll
                    for (int e = 0; e < 4; ++e) N[4 * i + e] = __int_as_float((__float_as_int(v[e]) & ~127) | (127 - (64 * part + 16 * c + 4 * i + e))); }
                if (c == 0) { bitonic_sort16f<true>(N);
#pragma unroll
                    for (int i = 0; i < 16; ++i) L[i] = N[i]; }
                else topk_absorb16f(L, N);
            }
            asm volatile("s_waitcnt lgkmcnt(0)" ::: "memory"); __builtin_amdgcn_s_barrier(); asm volatile("" ::: "memory");
#pragma unroll
            for (int i = 0; i < 4; ++i) *(PG8_LAS u32x4*)(X + tid * 20 + 4 * i) = (u32x4){(unsigned)__float_as_int(L[4 * i]), (unsigned)__float_as_int(L[4 * i + 1]), (unsigned)__float_as_int(L[4 * i + 2]), (unsigned)__float_as_int(L[4 * i + 3])};
            asm volatile("s_waitcnt lgkmcnt(0)" ::: "memory"); __builtin_amdgcn_s_barrier(); asm volatile("" ::: "memory");
            { float P[16]; const int pt = tid ^ 256;
#pragma unroll
              for (int i = 0; i < 4; ++i) { const u32x4 v = *(const PG8_LAS u32x4*)(X + pt * 20 + 4 * i); P[4 * i] = __int_as_float((int)v.x); P[4 * i + 1] = __int_as_float((int)v.y); P[4 * i + 2] = __int_as_float((int)v.z); P[4 * i + 3] = __int_as_float((int)v.w); }
#pragma unroll
              for (int i = 0; i < 16; ++i) L[i] = __builtin_fmaxf(L[i], P[15 - i]);
              bitonic_merge_desc16f(L); }
#pragma unroll
            for (int i = 0; i < 16; ++i) KK[bj][i] = __float_as_int(L[i]);
            asm volatile("s_waitcnt lgkmcnt(0)" ::: "memory"); __builtin_amdgcn_s_barrier(); asm volatile("" ::: "memory");
        }
        float v1[16], v2[16];
#pragma unroll
        for (int i = 0; i < 16; ++i) { v1[i] = __int_as_float(KK[0][i] & ~127); v2[i] = __int_as_float(KK[1][i] & ~127); }
#define CKEY(a, b) ((f2key(csum(v1[a], v2[b])) & ~255) | (255 - (((a) << 4) | (b))))
        int L[16];
#pragma unroll
        for (int b = 0; b < 16; ++b) L[b] = CKEY(0, b);
        { int N[16] = {CKEY(1, 0), CKEY(1, 1), CKEY(1, 2), CKEY(1, 3), CKEY(1, 4), CKEY(1, 5), CKEY(1, 6), CKEY(1, 7), CKEY(2, 0), CKEY(2, 1), CKEY(2, 2), CKEY(2, 3), CKEY(2, 4), CKEY(4, 0), CKEY(4, 1), CKEY(4, 2)};
          topk_absorb16(L, N); }
        { int N[16] = {CKEY(3, 0), CKEY(3, 1), CKEY(3, 2), CKEY(3, 3), CKEY(5, 0), CKEY(5, 1), CKEY(6, 0), CKEY(6, 1), CKEY(7, 0), CKEY(7, 1), CKEY(8, 0), CKEY(9, 0), CKEY(10, 0), CKEY(11, 0), CKEY(12, 0), CKEY(13, 0)};
          topk_absorb16(L, N); }
        topk_insert1(L, CKEY(14, 0)); topk_insert1(L, CKEY(15, 0));
#undef CKEY
#pragma unroll
        for (int i = 0; i < 4; ++i) { *(PG8_LAS u32x4*)(X + tid * 36 + 4 * i) = (u32x4){(unsigned)KK[0][4 * i], (unsigned)KK[0][4 * i + 1], (unsigned)KK[0][4 * i + 2], (unsigned)KK[0][4 * i + 3]};
                                      *(PG8_LAS u32x4*)(X + tid * 36 + 16 + 4 * i) = (u32x4){(unsigned)KK[1][4 * i], (unsigned)KK[1][4 * i + 1], (unsigned)KK[1][4 * i + 2], (unsigned)KK[1][4 * i + 3]}; }
        asm volatile("s_waitcnt lgkmcnt(0)" ::: "memory");
        float sc[16]; int ex[16];
#pragma unroll
        for (int i = 0; i < 16; ++i) { const int code = 255 - (L[i] & 255); const int ka = X[tid * 36 + (code >> 4)], kb = X[tid * 36 + 16 + (code & 15)];
            sc[i] = __int_as_float(ka & ~127) + __int_as_float(kb & ~127); ex[i] = (127 - (ka & 127)) * 128 + (127 - (kb & 127)); }
        float mx = sc[0];
#pragma unroll
        for (int i = 1; i < 16; ++i) mx = fmaxf(mx, sc[i]);
        float den = 0.f;
#pragma unroll
        for (int i = 0; i < 16; ++i) { sc[i] = __builtin_amdgcn_exp2f((sc[i] - mx) * 1.4426950408889634f); den += sc[i]; }
        const float rden = 1.0f / den;
        const size_t o = ((size_t)(u.pm * BM + row) * 8 + u.pn) * 16;
        if (part == 0) {
#pragma unroll
            for (int i = 0; i < 4; ++i) *(u32x4*)(IDX + o + 4 * i) = (u32x4){(unsigned)ex[4 * i], (unsigned)ex[4 * i + 1], (unsigned)ex[4 * i + 2], (unsigned)ex[4 * i + 3]};
        } else {
#pragma unroll
            for (int i = 0; i < 4; ++i) *(f32x4*)(GATE + o + 4 * i) = (f32x4){sc[4 * i] * rden, sc[4 * i + 1] * rden, sc[4 * i + 2] * rden, sc[4 * i + 3] * rden};
        }
        asm volatile("s_waitcnt lgkmcnt(0)" ::: "memory"); __builtin_amdgcn_s_barrier(); asm volatile("" ::: "memory");
    }
};
struct OneUnitOrder {
    StaticOrder base; int round;
    __device__ __forceinline__ bool next(int i, Unit& u) const { return i == 0 && base.next(round, u); }
    __device__ __forceinline__ void a_ready(const Unit&) const {}
    __device__ __forceinline__ void done(const Unit&) const {}
};
}
constexpr int NWAVES = 8;
constexpr int BATCH = 4, SEQ = 4096, DM = 1024, TOK = BATCH * SEQ, DEPTH = 4;
constexpr float LN_EPS = 1e-5f;
constexpr size_t MiB = 1u << 20;
constexpr size_t WS_CTL = 0, CTL_ZERO_BYTES = 32 * 1024;
constexpr size_t WS_W_IN = 2 * MiB;
constexpr size_t WS_W_GLU = 6 * MiB;
constexpr size_t WS_W_KV = 14 * MiB;
constexpr size_t WS_W_SQ = 18 * MiB;
constexpr size_t WS_W_SO = 22 * MiB;
constexpr size_t WS_W_EFF = 26 * MiB;
constexpr size_t WS_W_PG = 42 * MiB;
constexpr size_t WS_W_PW = 50 * MiB;
constexpr size_t WS_PB = 52 * MiB;
constexpr size_t WS_IDX = 84 * MiB;
constexpr size_t WS_GATE = 92 * MiB;
constexpr size_t WS_TABU = 100 * MiB;
constexpr size_t WS_TABV = 228 * MiB;
constexpr size_t WS_PW = 356 * MiB;
constexpr size_t WS_H = 484 * MiB, WS_U = 516 * MiB, WS_Y = 548 * MiB, WS_X1 = 580 * MiB, WS_H1 = 612 * MiB, WS_H2 = 644 * MiB, WS_KB = 676 * MiB, WS_VT = 708 * MiB, WS_HKV = 740 * MiB;
constexpr size_t WS_H8 = 772 * MiB, WS_H28 = 788 * MiB;
constexpr size_t WS_W8 = 804 * MiB;
constexpr size_t W8_IN = WS_W8, W8_GLU = WS_W8 + 2 * MiB, W8_KV = WS_W8 + 6 * MiB, W8_SQ = WS_W8 + 8 * MiB, W8_SO = WS_W8 + 10 * MiB, W8_PG = WS_W8 + 12 * MiB;
constexpr float W8_SCALE = 32.0f;
constexpr size_t WS_H18 = 820 * MiB;
constexpr size_t W8_EFF = 836 * MiB;
constexpr size_t WS_END = 844 * MiB;
constexpr int CW_BAR = 4096;
constexpr float PEER_SU = 91.0f, PEER_SV = 4.75f;

constexpr int LDS_BYTES = 163840;
constexpr int RING_BYTES = 131072;
constexpr int MISC_OFF = 163840 - 256;

#define GAS __attribute__((address_space(1)))
#define LAS __attribute__((address_space(3)))
typedef unsigned short bf16;
typedef unsigned v4u __attribute__((ext_vector_type(4)));
typedef unsigned v2u __attribute__((ext_vector_type(2)));
typedef float f32x4 __attribute__((ext_vector_type(4)));
typedef float f32x16 __attribute__((ext_vector_type(16)));
typedef short bf16x8 __attribute__((ext_vector_type(8)));
typedef __bf16 bf16x2_t __attribute__((ext_vector_type(2)));
#define LDS_WAIT() asm volatile("s_waitcnt lgkmcnt(0)" ::: "memory")
#define VM_WAIT() asm volatile("s_waitcnt vmcnt(0)" ::: "memory")
using pg8::cvt_pk_bf16; using pg8::bf_lo; using pg8::bf_hi; using pg8::gelu_tanh;

#define XB_TMO      128
#define XB_XCNT(j)  (256  + 64 * (j))
#define XB_XSUB(j)  (1280 + 64 * (j))
#define XB_XGEN(j)  (2304 + 64 * (j))
#define XB_TOP      3328
#define XB_TOPGEN   3392
#define XCD_BAR_WORDS 3456
#define XB_SPIN_CAP (1u << 24)
__device__ __forceinline__ unsigned xb_ld(unsigned* p)              { return __hip_atomic_load(p, __ATOMIC_RELAXED, __HIP_MEMORY_SCOPE_AGENT); }
__device__ __forceinline__ unsigned xb_add(unsigned* p, unsigned v) { return __hip_atomic_fetch_add(p, v, __ATOMIC_RELAXED, __HIP_MEMORY_SCOPE_AGENT); }
__device__ __forceinline__ unsigned xb_xcc_id() { return (unsigned)__builtin_amdgcn_s_getreg((3 << 11) | 20) & 0xFu; }
#define XB_SPIN(cond, bar) do { unsigned _sp = 0; while (cond) { __builtin_amdgcn_s_sleep(1); \
    if ((++_sp & 255u) == 0u) { if (xb_ld(&(bar)[XB_TMO])) break; if (_sp > XB_SPIN_CAP) { atomicAdd(&(bar)[XB_TMO], 1u); break; } } } } while (0)
struct XcdBarrier { unsigned* bar; unsigned x; volatile LAS unsigned* st; };
__device__ __forceinline__ XcdBarrier xcd_barrier_post(unsigned* bar, volatile LAS unsigned* st) {
    XcdBarrier b; b.bar = bar; b.x = xb_xcc_id(); b.st = st;
    if (threadIdx.x == 0) (void)xb_add(&bar[XB_XCNT(b.x)], 1u);
    return b;
}
__device__ __forceinline__ void xcd_barrier_complete(unsigned* bar, unsigned x, unsigned& nloc, unsigned& nx) {
    const unsigned G = gridDim.x * gridDim.y * gridDim.z;
    unsigned sum, cnt, mine, sp = 0u;
    for (;;) {
        sum = 0u; cnt = 0u; mine = 0u;
#pragma unroll
        for (unsigned j = 0; j < 16; ++j) { const unsigned c = xb_ld(&bar[XB_XCNT(j)]); sum += c; cnt += (c > 0u) ? 1u : 0u; mine = (j == x) ? c : mine; }
        if (sum == G) break;
        __builtin_amdgcn_s_sleep(1);
        if ((++sp & 255u) == 0u) { if (xb_ld(&bar[XB_TMO])) break; if (sp > XB_SPIN_CAP) { atomicAdd(&bar[XB_TMO], 1u); break; } }
    }
    nloc = mine > 0u ? mine : 1u; nx = cnt > 0u ? cnt : 1u;
}
__device__ __forceinline__ void xcd_barrier(const XcdBarrier& b) {
    asm volatile("s_waitcnt vmcnt(0)" ::: "memory");
    __syncthreads();
    if (threadIdx.x == 0) {
        unsigned* bar = b.bar;
        __builtin_amdgcn_s_waitcnt(0);
        unsigned nloc = b.st[0], nx = b.st[1];
        if (nloc == 0u) { xcd_barrier_complete(bar, b.x, nloc, nx); b.st[0] = nloc; b.st[1] = nx; }
        const unsigned old = xb_add(&bar[XB_XSUB(b.x)], 1u);
        const unsigned gen = old / nloc;
        if (old + 1u == (gen + 1u) * nloc) {
            __builtin_amdgcn_fence(__ATOMIC_RELEASE, "agent");
            asm volatile("s_waitcnt vmcnt(0)" ::: "memory");
            const unsigned og = xb_add(&bar[XB_TOP], 1u);
            const unsigned tg = og / nx;
            if (og + 1u == (tg + 1u) * nx) xb_add(&bar[XB_TOPGEN], 1u);
            else XB_SPIN(xb_ld(&bar[XB_TOPGEN]) == tg, bar);
            __builtin_amdgcn_fence(__ATOMIC_ACQUIRE, "agent");
            xb_add(&bar[XB_XGEN(b.x)], 1u);
            asm volatile("s_waitcnt vmcnt(0)" ::: "memory");
        } else {
            XB_SPIN(xb_ld(&bar[XB_XGEN(b.x)]) == gen, bar);
            __builtin_amdgcn_fence(__ATOMIC_ACQUIRE, "agent");
            asm volatile("s_waitcnt vmcnt(0)" ::: "memory");
        }
    }
    __syncthreads();
}

enum PhaseType { P_PROLOGUE = 0, P_STORE = 1, P_SSM = 2, P_GLU = 3, P_LNMIX = 4, P_TOPK = 5, P_PEER = 6, P_PLE = 7, P_LNKV = 8, P_ATTN = 9, P_RES = 10 };
constexpr int MAX_PH = 48;
struct Args { const float* in[28]; float* out; unsigned char* ws; int ph_lo, ph_hi, use_bar, nph; unsigned char ph_type[MAX_PH]; unsigned char ph_arg[MAX_PH]; };
struct Frame {
    LAS unsigned char* lds;
    int tid, lane, wave, vcu, G, z, bx;
    const struct Args* A;
    float* out; unsigned char* ws;
};
__device__ __forceinline__ float wave_sum(float v) {
#pragma unroll
    for (int o = 1; o < 64; o <<= 1) v += __shfl_xor(v, o);
    return v;
}
template <int CTRL, int BANK> __device__ __forceinline__ float dpp_movf(float old, float v) {
    return __builtin_bit_cast(float, __builtin_amdgcn_update_dpp(__builtin_bit_cast(int, old), __builtin_bit_cast(int, v), CTRL, 0xF, BANK, true));
}
__device__ __forceinline__ float wave_sum_dpp(float v) {
    v += dpp_movf<0xB1, 0xF>(0.f, v);
    v += dpp_movf<0x4E, 0xF>(0.f, v);
    { float r = dpp_movf<0x104, 0x5>(0.f, v); r = dpp_movf<0x114, 0xA>(r, v); v += r; }
    v += dpp_movf<0x128, 0xF>(0.f, v);
    { const auto t = __builtin_amdgcn_permlane16_swap(__builtin_bit_cast(unsigned, v), __builtin_bit_cast(unsigned, v), false, false); const unsigned ta = t[0], tb = t[1]; v = __builtin_bit_cast(float, ta) + __builtin_bit_cast(float, tb); }
    { const auto t = __builtin_amdgcn_permlane32_swap(__builtin_bit_cast(unsigned, v), __builtin_bit_cast(unsigned, v), false, false); const unsigned ta = t[0], tb = t[1]; v = __builtin_bit_cast(float, ta) + __builtin_bit_cast(float, tb); }
    return v;
}
__device__ __forceinline__ unsigned f2bf(float f) { unsigned u = __builtin_bit_cast(unsigned, f); return (u + 0x7fffu + ((u >> 16) & 1u)) >> 16; }
__device__ __forceinline__ unsigned pk2(float lo, float hi) { return f2bf(lo) | (f2bf(hi) << 16); }

__device__ __forceinline__ unsigned pk4_fp8(float a, float b, float c, float d) { int w = 0; w = __builtin_amdgcn_cvt_pk_fp8_f32(a, b, w, false); w = __builtin_amdgcn_cvt_pk_fp8_f32(c, d, w, true); return (unsigned)w; }
__device__ __forceinline__ void p0_transpose_item(const float* W, int K, int N, bf16* WT, int glu, LAS float* scr, int item, int lane, unsigned char* WT8 = nullptr) {
    const int nblk = N / 32, kb = item / nblk, nb = item % nblk, k0 = 64 * kb, n0 = 32 * nb;
    int r0 = n0;
    if (glu) { const int bj = n0 >> 10, rem = n0 & 1023; r0 = 256 * (rem >> 7) + 128 * bj + (rem & 127); }
#pragma unroll 8
    for (int i = 0; i < 32; ++i) { const int kk = 2 * i + (lane >> 5); scr[kk * 33 + (lane & 31)] = W[(size_t)(k0 + kk) * N + n0 + (lane & 31)]; }
    LDS_WAIT(); asm volatile("" ::: "memory");
    const int c = lane & 7;
#pragma unroll
    for (int j = 0; j < 4; ++j) { const int n = (lane >> 3) + 8 * j; const LAS float* s = scr + (8 * c) * 33 + n;
        v4u o; o.x = pk2(s[0 * 33], s[1 * 33]); o.y = pk2(s[2 * 33], s[3 * 33]); o.z = pk2(s[4 * 33], s[5 * 33]); o.w = pk2(s[6 * 33], s[7 * 33]);
        if (WT) *(GAS v4u*)(WT + (size_t)(r0 + n) * K + k0 + 8 * c) = o;
        if (WT8) *(GAS v2u*)(WT8 + (size_t)(r0 + n) * K + k0 + 8 * c) = (v2u){pk4_fp8(s[0 * 33] * W8_SCALE, s[1 * 33] * W8_SCALE, s[2 * 33] * W8_SCALE, s[3 * 33] * W8_SCALE), pk4_fp8(s[4 * 33] * W8_SCALE, s[5 * 33] * W8_SCALE, s[6 * 33] * W8_SCALE, s[7 * 33] * W8_SCALE)}; }
    LDS_WAIT(); asm volatile("" ::: "memory");
}
__device__ __forceinline__ void cvt_stream_dual(Frame& F, const float* src, bf16* dst, unsigned char* dst8, size_t n) {
    const size_t nthr = (size_t)F.G * 512, gt = (size_t)F.bx * 512 + F.tid;
    for (size_t i = gt; i < n / 8; i += nthr) {
        const f32x4 a = *(const GAS f32x4*)(src + i * 8), b = *(const GAS f32x4*)(src + i * 8 + 4);
        v4u o; o.x = pk2(a.x, a.y); o.y = pk2(a.z, a.w); o.z = pk2(b.x, b.y); o.w = pk2(b.z, b.w);
        *(GAS v4u*)(dst + i * 8) = o;
        *(GAS v2u*)(dst8 + i * 8) = (v2u){pk4_fp8(a.x, a.y, a.z, a.w), pk4_fp8(b.x, b.y, b.z, b.w)};
    }
}
__device__ __forceinline__ void cvt_stream(Frame& F, const float* src, bf16* dst, size_t n) {
    const size_t nthr = (size_t)F.G * 512, gt = (size_t)F.bx * 512 + F.tid;
    for (size_t i = gt; i < n / 8; i += nthr) {
        const f32x4 a = *(const GAS f32x4*)(src + i * 8), b = *(const GAS f32x4*)(src + i * 8 + 4);
        v4u o; o.x = pk2(a.x, a.y); o.y = pk2(a.z, a.w); o.z = pk2(b.x, b.y); o.w = pk2(b.z, b.w);
        *(GAS v4u*)(dst + i * 8) = o;
    }
}
__device__ __forceinline__ void cvt_stream_fp4(Frame& F, const float* src, unsigned char* dst, size_t n, float scale) {
    const size_t nthr = (size_t)F.G * 512, gt = (size_t)F.bx * 512 + F.tid;
    for (size_t i = gt; i < n / 32; i += nthr) {
        unsigned w[4];
#pragma unroll
        for (int q = 0; q < 4; ++q) {
            const f32x4 a = *(const GAS f32x4*)(src + i * 32 + 8 * q) * scale, b = *(const GAS f32x4*)(src + i * 32 + 8 * q + 4) * scale;
            unsigned t = 0u;
            t = __builtin_amdgcn_cvt_scalef32_pk_fp4_f32(t, a.x, a.y, 1.0f, 0); t = __builtin_amdgcn_cvt_scalef32_pk_fp4_f32(t, a.z, a.w, 1.0f, 1);
            t = __builtin_amdgcn_cvt_scalef32_pk_fp4_f32(t, b.x, b.y, 1.0f, 2); t = __builtin_amdgcn_cvt_scalef32_pk_fp4_f32(t, b.z, b.w, 1.0f, 3);
            w[q] = t;
        }
        *(GAS v4u*)(dst + i * 16) = (v4u){w[0], w[1], w[2], w[3]};
    }
}
__device__ __forceinline__ unsigned pkbf2(float lo, float hi) { return cvt_pk_bf16(lo, hi); }
__device__ __forceinline__ void p0_weff_item(Frame& F, int item) {
    const int jb = item & 1, kb = (item >> 1) & 15, hh = (item >> 5) & 15, l = item >> 9;
    const int lane = F.lane, r32 = lane & 31, h = lane >> 5;
    const float* wq = F.A->in[21 + F.z] + (size_t)l * 1024 * 2048 + (size_t)(64 * kb + r32) * 2048 + 128 * hh + 8 * h;
    const float* ky = F.A->in[22 + (hh & 1) + F.z] + (size_t)l * 128 * 128 + (size_t)(64 * jb + r32) * 128 + 8 * h;
    f32x16 acc[2][2] = {};
#pragma unroll
    for (int ks = 0; ks < 8; ++ks) {
        bf16x8 af[2], bf[2];
#pragma unroll
        for (int a = 0; a < 2; ++a) { const f32x4 a0 = *(const GAS f32x4*)(wq + (size_t)a * 32 * 2048 + 16 * ks), a1 = *(const GAS f32x4*)(wq + (size_t)a * 32 * 2048 + 16 * ks + 4);
            af[a] = __builtin_bit_cast(bf16x8, (v4u){pkbf2(a0.x, a0.y), pkbf2(a0.z, a0.w), pkbf2(a1.x, a1.y), pkbf2(a1.z, a1.w)}); }
#pragma unroll
        for (int b = 0; b < 2; ++b) { const f32x4 b0 = *(const GAS f32x4*)(ky + (size_t)b * 32 * 128 + 16 * ks), b1 = *(const GAS f32x4*)(ky + (size_t)b * 32 * 128 + 16 * ks + 4);
            bf[b] = __builtin_bit_cast(bf16x8, (v4u){pkbf2(b0.x, b0.y), pkbf2(b0.z, b0.w), pkbf2(b1.x, b1.y), pkbf2(b1.z, b1.w)}); }
#pragma unroll
        for (int a = 0; a < 2; ++a)
#pragma unroll
            for (int b = 0; b < 2; ++b) acc[a][b] = __builtin_amdgcn_mfma_f32_32x32x16_bf16(af[a], bf[b], acc[a][b], 0, 0, 0);
    }
#pragma unroll
    for (int a = 0; a < 2; ++a)
#pragma unroll
        for (int b = 0; b < 2; ++b) {
            unsigned char* dst = (unsigned char*)(F.ws + W8_EFF) + (size_t)l * 2048 * 1024 + (size_t)(128 * hh + 64 * jb + 32 * b + r32) * 1024 + 64 * kb + 32 * a + 4 * h;
#pragma unroll
            for (int q = 0; q < 4; ++q) *(GAS unsigned*)(dst + 8 * q) = pk4_fp8(acc[a][b][4 * q] * W8_SCALE, acc[a][b][4 * q + 1] * W8_SCALE, acc[a][b][4 * q + 2] * W8_SCALE, acc[a][b][4 * q + 3] * W8_SCALE); }
}
__device__ __forceinline__ void p0_prologue(Frame& F) {
#ifndef PROBE_PRO
#define PROBE_PRO 0
#endif
    for (int rp = 0; rp < (PROBE_PRO == 4 ? 2 : 1); ++rp) {
    cvt_stream_dual(F, F.A->in[0 + F.z], (bf16*)(F.ws + WS_H), (unsigned char*)(F.ws + WS_H8), (size_t)TOK * DM);
    cvt_stream(F, F.A->in[1 + F.z], (bf16*)(F.ws + WS_PB), (size_t)DEPTH * TOK * 256); }
    LAS float* scr = (LAS float*)(F.lds + F.wave * 8704);
    const int gw = F.vcu * NWAVES + F.wave, NGW = F.G * NWAVES;
    constexpr int I_SQ = 16 * 32, I_GLU = 16 * 64, I_PW = 4 * 32;
    constexpr int NITEMS = 2 * I_SQ + 2 * I_GLU + I_GLU + 2 * I_SQ + 2 * I_SQ + 4 * I_SQ + 4 * I_PW;
    for (int rp = 0; rp < (PROBE_PRO == 2 ? 2 : 1); ++rp)
    for (int it = gw; it < NITEMS; it += NGW) {
        int r = it;
        if (r < 2 * I_SQ) { const int l = r / I_SQ; p0_transpose_item(F.A->in[6 + F.z] + (size_t)l * 1024 * 1024, 1024, 1024, nullptr, 0, scr, r % I_SQ, F.lane, (unsigned char*)(F.ws + W8_IN) + (size_t)l * 1024 * 1024); continue; } r -= 2 * I_SQ;
        if (r < 2 * I_GLU) { const int l = r / I_GLU; p0_transpose_item(F.A->in[15 + F.z] + (size_t)l * 1024 * 2048, 1024, 2048, nullptr, 1, scr, r % I_GLU, F.lane, (unsigned char*)(F.ws + W8_GLU) + (size_t)l * 2048 * 1024); continue; } r -= 2 * I_GLU;
        if (r < I_GLU) { p0_transpose_item(F.A->in[18 + F.z], 1024, 2048, nullptr, 0, scr, r, F.lane, (unsigned char*)(F.ws + W8_KV)); continue; } r -= I_GLU;
        if (r < 2 * I_SQ) { const int l = r / I_SQ; p0_transpose_item(F.A->in[19 + F.z] + (size_t)l * 1024 * 1024, 1024, 1024, nullptr, 0, scr, r % I_SQ, F.lane, (unsigned char*)(F.ws + W8_SQ) + (size_t)l * 1024 * 1024); continue; } r -= 2 * I_SQ;
        if (r < 2 * I_SQ) { const int l = r / I_SQ; p0_transpose_item(F.A->in[20 + F.z] + (size_t)l * 1024 * 1024, 1024, 1024, nullptr, 0, scr, r % I_SQ, F.lane, (unsigned char*)(F.ws + W8_SO) + (size_t)l * 1024 * 1024); continue; } r -= 2 * I_SQ;
        if (r < 4 * I_SQ) { const int l = r / I_SQ; p0_transpose_item(F.A->in[27 + F.z] + (size_t)l * 1024 * 1024, 1024, 1024, nullptr, 0, scr, r % I_SQ, F.lane, (unsigned char*)(F.ws + W8_PG) + (size_t)l * 1024 * 1024); continue; } r -= 4 * I_SQ;
        { const int l = r / I_PW; p0_transpose_item(F.A->in[26 + F.z] + (size_t)l * 256 * 1024, 256, 1024, (bf16*)(F.ws + WS_W_PW) + (size_t)l * 1024 * 256, 0, scr, r % I_PW, F.lane); }
    }
    for (int rp = 0; rp < (PROBE_PRO == 3 ? 2 : 1); ++rp)
    for (int it = gw; it < 2048; it += NGW) p0_weff_item(F, it);
}

__device__ __forceinline__ void ln_rows(Frame& F, const bf16* X, const float* g, const float* bb, bf16* O, unsigned char* O8 = nullptr) {
    const int gw = F.vcu * NWAVES + F.wave, NGW = F.G * NWAVES;
    float gg[16], bv[16];
    { const f32x4 a = *(const GAS f32x4*)(g + 8 * F.lane), b = *(const GAS f32x4*)(g + 8 * F.lane + 4), c = *(const GAS f32x4*)(g + 512 + 8 * F.lane), d = *(const GAS f32x4*)(g + 512 + 8 * F.lane + 4);
      gg[0] = a.x; gg[1] = a.y; gg[2] = a.z; gg[3] = a.w; gg[4] = b.x; gg[5] = b.y; gg[6] = b.z; gg[7] = b.w; gg[8] = c.x; gg[9] = c.y; gg[10] = c.z; gg[11] = c.w; gg[12] = d.x; gg[13] = d.y; gg[14] = d.z; gg[15] = d.w; }
    { const f32x4 a = *(const GAS f32x4*)(bb + 8 * F.lane), b = *(const GAS f32x4*)(bb + 8 * F.lane + 4), c = *(const GAS f32x4*)(bb + 512 + 8 * F.lane), d = *(const GAS f32x4*)(bb + 512 + 8 * F.lane + 4);
      bv[0] = a.x; bv[1] = a.y; bv[2] = a.z; bv[3] = a.w; bv[4] = b.x; bv[5] = b.y; bv[6] = b.z; bv[7] = b.w; bv[8] = c.x; bv[9] = c.y; bv[10] = c.z; bv[11] = c.w; bv[12] = d.x; bv[13] = d.y; bv[14] = d.z; bv[15] = d.w; }
    for (int m = gw; m < TOK; m += NGW) {
        const v4u xa = *(const GAS v4u*)(X + (size_t)m * DM + 8 * F.lane), xb = *(const GAS v4u*)(X + (size_t)m * DM + 512 + 8 * F.lane);
        float x[16] = {bf_lo(xa.x), bf_hi(xa.x), bf_lo(xa.y), bf_hi(xa.y), bf_lo(xa.z), bf_hi(xa.z), bf_lo(xa.w), bf_hi(xa.w), bf_lo(xb.x), bf_hi(xb.x), bf_lo(xb.y), bf_hi(xb.y), bf_lo(xb.z), bf_hi(xb.z), bf_lo(xb.w), bf_hi(xb.w)};
        float s = 0.f;
#pragma unroll
        for (int i = 0; i < 16; ++i) s += x[i];
        const float mean = wave_sum_dpp(s) * (1.f / DM); float q = 0.f;
#pragma unroll
        for (int i = 0; i < 16; ++i) { x[i] -= mean; q += x[i] * x[i]; }
        const float rstd = 1.0f / sqrtf(wave_sum_dpp(q) * (1.f / DM) + LN_EPS);
#pragma unroll
        for (int i = 0; i < 16; ++i) x[i] = x[i] * rstd * gg[i] + bv[i];
        v4u oa, ob; oa.x = pk2(x[0], x[1]); oa.y = pk2(x[2], x[3]); oa.z = pk2(x[4], x[5]); oa.w = pk2(x[6], x[7]); ob.x = pk2(x[8], x[9]); ob.y = pk2(x[10], x[11]); ob.z = pk2(x[12], x[13]); ob.w = pk2(x[14], x[15]);
        if (O) { *(GAS v4u*)(O + (size_t)m * DM + 8 * F.lane) = oa; *(GAS v4u*)(O + (size_t)m * DM + 512 + 8 * F.lane) = ob; }
        if (O8) { *(GAS v2u*)(O8 + (size_t)m * DM + 8 * F.lane) = (v2u){pk4_fp8(x[0], x[1], x[2], x[3]), pk4_fp8(x[4], x[5], x[6], x[7])};
                  *(GAS v2u*)(O8 + (size_t)m * DM + 512 + 8 * F.lane) = (v2u){pk4_fp8(x[8], x[9], x[10], x[11]), pk4_fp8(x[12], x[13], x[14], x[15])}; }
    }
}
struct TabCvt { const float* su; const float* sv; unsigned char* du; unsigned char* dv; int c, cf, stride, n; };
__device__ __forceinline__ void tabcvt_issue(TabCvt& T, int lane, f32x4 (&cv)[4]) {
    const bool live = T.c < T.n;
    if (live) { const int half = T.n >> 1; const float* src = (T.c < half ? T.su + (size_t)T.c * 1024 : T.sv + (size_t)(T.c - half) * 1024) + 16 * lane;
#pragma unroll
        for (int q = 0; q < 4; ++q) cv[q] = *(const GAS f32x4*)(src + 4 * q); }
    T.c += T.stride;
}
__device__ __forceinline__ unsigned i4q(float v) { float t = __builtin_fminf(__builtin_fmaxf(v * PEER_SU, -7.f), 7.f) + 12582912.0f; asm volatile("" : "+v"(t)); return __builtin_bit_cast(unsigned, t) & 15u; }
__device__ __forceinline__ unsigned pack8_i4(const f32x4& a, const f32x4& b) {
    return i4q(a.x) | (i4q(a.y) << 4) | (i4q(a.z) << 8) | (i4q(a.w) << 12) | (i4q(b.x) << 16) | (i4q(b.y) << 20) | (i4q(b.z) << 24) | (i4q(b.w) << 28);
}
__device__ __forceinline__ void tabcvt_finish(TabCvt& T, int lane, const f32x4 (&cv)[4]) {
    const bool live = T.cf < T.n;
    if (live) { const int half = T.n >> 1;
        unsigned w0 = 0u, w1 = 0u;
        if (T.cf < half) { w0 = pack8_i4(cv[0], cv[1]); w1 = pack8_i4(cv[2], cv[3]); }
        else { const float sc = PEER_SV;
            w0 = __builtin_amdgcn_cvt_scalef32_pk_fp4_f32(w0, cv[0].x * sc, cv[0].y * sc, 1.0f, 0); w0 = __builtin_amdgcn_cvt_scalef32_pk_fp4_f32(w0, cv[0].z * sc, cv[0].w * sc, 1.0f, 1);
            w0 = __builtin_amdgcn_cvt_scalef32_pk_fp4_f32(w0, cv[1].x * sc, cv[1].y * sc, 1.0f, 2); w0 = __builtin_amdgcn_cvt_scalef32_pk_fp4_f32(w0, cv[1].z * sc, cv[1].w * sc, 1.0f, 3);
            w1 = __builtin_amdgcn_cvt_scalef32_pk_fp4_f32(w1, cv[2].x * sc, cv[2].y * sc, 1.0f, 0); w1 = __builtin_amdgcn_cvt_scalef32_pk_fp4_f32(w1, cv[2].z * sc, cv[2].w * sc, 1.0f, 1);
            w1 = __builtin_amdgcn_cvt_scalef32_pk_fp4_f32(w1, cv[3].x * sc, cv[3].y * sc, 1.0f, 2); w1 = __builtin_amdgcn_cvt_scalef32_pk_fp4_f32(w1, cv[3].z * sc, cv[3].w * sc, 1.0f, 3); }
        unsigned char* dst = (T.cf < half ? T.du + (size_t)T.cf * 512 : T.dv + (size_t)(T.cf - half) * 512) + 8 * lane;
        *(GAS v2u*)dst = (v2u){w0, w1}; }
    T.cf += T.stride;
}
template <bool PASS1> __device__ __forceinline__ void ssm_pass(const bf16* U, bf16* Y, LAS unsigned char* stl, const float* dskip, size_t tok0, int g, int lane, int n, int hh, int i_row,
                                                                  const float (&a_re)[2], const float (&a_im)[2], const bf16x8 (&Bf)[4], const LAS unsigned char* CFL, float (&s_re)[2], float (&s_im)[2]) {
    const int c0 = 16 * g + 4 * hh;
    bf16x8 ua_n = *(const GAS bf16x8*)(U + tok0 * DM + 16 * g + 8 * hh);
    v2u u0_n = {}, u1_n = {};
    if (PASS1) { u0_n = *(const GAS v2u*)(U + tok0 * DM + c0); u1_n = *(const GAS v2u*)(U + tok0 * DM + c0 + 8); }
#pragma unroll 1
    for (int tile = 0; tile < 16; ++tile) {
        const size_t tok = tok0 + tile * 16;
        const bf16x8 ua = ua_n; const v2u u0 = u0_n, u1 = u1_n;
        { const size_t tokn = tok0 + ((tile + 1) & 15) * 16;
          ua_n = *(const GAS bf16x8*)(U + tokn * DM + 16 * g + 8 * hh);
          if (PASS1) { u0_n = *(const GAS v2u*)(U + tokn * DM + c0); u1_n = *(const GAS v2u*)(U + tokn * DM + c0 + 8); } }
        f32x16 acc[4];
#pragma unroll
        for (int nb = 0; nb < 4; ++nb) { f32x16 z = {}; acc[nb] = __builtin_amdgcn_mfma_f32_32x32x16_bf16(ua, Bf[nb], z, 0, 0, 0); }
#pragma unroll
        for (int pb = 0; pb < 2; ++pb) {
#pragma unroll
            for (int r = 0; r < 16; ++r) {
                float t0 = fmaf(-a_im[pb], s_im[pb], acc[2 * pb][r]); asm volatile("" : "+v"(t0));
                float t1 = fmaf(a_im[pb], s_re[pb], acc[2 * pb + 1][r]); asm volatile("" : "+v"(t1));
                float nre = fmaf(a_re[pb], s_re[pb], t0); asm volatile("" : "+v"(nre));
                float nim = fmaf(a_re[pb], s_im[pb], t1); asm volatile("" : "+v"(nim));
                s_re[pb] = nre; s_im[pb] = nim;
                if (PASS1) { const int irow = (r & 3) + 8 * (r >> 2) + 4 * hh; *(LAS unsigned*)(stl + irow * 272 + (32 * pb + n) * 4) = cvt_pk_bf16(nre, nim); }
            }
        }
        if (PASS1) {
            LDS_WAIT();
            f32x16 yv = {};
#pragma unroll
            for (int ks = 0; ks < 8; ++ks) { const bf16x8 sb = *(const LAS bf16x8*)(stl + i_row * 272 + (16 * ks + 8 * hh) * 2); const bf16x8 cf = *(const LAS bf16x8*)(CFL + (ks * 64 + lane) * 16); yv = __builtin_amdgcn_mfma_f32_32x32x16_bf16(cf, sb, yv, 0, 0, 0); }
            const f32x4 d0 = *(const GAS f32x4*)(dskip + c0), d1 = *(const GAS f32x4*)(dskip + c0 + 8);
            float o[8];
            o[0] = gelu_tanh(yv[0] + d0.x * bf_lo(u0.x)); o[1] = gelu_tanh(yv[1] + d0.y * bf_hi(u0.x)); o[2] = gelu_tanh(yv[2] + d0.z * bf_lo(u0.y)); o[3] = gelu_tanh(yv[3] + d0.w * bf_hi(u0.y));
            o[4] = gelu_tanh(yv[4] + d1.x * bf_lo(u1.x)); o[5] = gelu_tanh(yv[5] + d1.y * bf_hi(u1.x)); o[6] = gelu_tanh(yv[6] + d1.z * bf_lo(u1.y)); o[7] = gelu_tanh(yv[7] + d1.w * bf_hi(u1.y));
            *(GAS unsigned*)((unsigned char*)Y + tok * DM + c0) = pk4_fp8(o[0], o[1], o[2], o[3]);
            *(GAS unsigned*)((unsigned char*)Y + tok * DM + c0 + 8) = pk4_fp8(o[4], o[5], o[6], o[7]);
            LDS_WAIT();
        }
    }
}
__device__ __forceinline__ void ssm_phase(Frame& F, int layer) {
    if (layer == 0) {
        TabCvt TC; TC.su = F.A->in[24 + F.z]; TC.sv = F.A->in[25 + F.z]; TC.du = (unsigned char*)(F.ws + WS_TABU); TC.dv = (unsigned char*)(F.ws + WS_TABV);
        TC.c = F.vcu * NWAVES + F.wave; TC.cf = TC.c; TC.stride = F.G * NWAVES; TC.n = 2 * 16384;
        f32x4 cvA[4], cvB[4];
        tabcvt_issue(TC, F.lane, cvA);
        while (TC.cf < TC.n) { tabcvt_issue(TC, F.lane, cvB); tabcvt_finish(TC, F.lane, cvA); tabcvt_issue(TC, F.lane, cvA); tabcvt_finish(TC, F.lane, cvB); }
    }
    const bf16* U = (const bf16*)(F.ws + WS_U); bf16* Y = (bf16*)(F.ws + WS_Y);
    const int lane = F.lane, n = lane & 31, hh = lane >> 5, wave = F.wave;
    LAS unsigned char* stl = F.lds + wave * 8704;
    LAS float* E = (LAS float*)(F.lds + 8 * 8704);
    for (int bg = F.vcu; bg < BATCH * 64; bg += F.G) {
        const int b = bg >> 6, g = bg & 63, lg = layer * 64 + g;
        const float dt = expf(F.A->in[9 + F.z][lg]);
        float a_re[2], a_im[2]; bf16x8 Bf[4];
#pragma unroll
        for (int pb = 0; pb < 2; ++pb) {
            const int p = 32 * pb + n;
            const float lre = F.A->in[7 + F.z][lg * 64 + p], lim = F.A->in[8 + F.z][lg * 64 + p];
            const float mag = expf(lre * dt); float sn, cs; sincosf(lim * dt, &sn, &cs);
            a_re[pb] = mag * cs; a_im[pb] = mag * sn;
            const float nr = a_re[pb] - 1.0f, ni = a_im[pb], den = 1.0f / (lre * lre + lim * lim);
            const float cr = (nr * lre + ni * lim) * den, ci = (ni * lre - nr * lim) * den;
            const float* br = F.A->in[10 + F.z] + ((size_t)lg * 64 + p) * 16 + 8 * hh; const float* bi = F.A->in[11 + F.z] + ((size_t)lg * 64 + p) * 16 + 8 * hh;
            const f32x4 br0 = *(const GAS f32x4*)br, br1 = *(const GAS f32x4*)(br + 4), bi0 = *(const GAS f32x4*)bi, bi1 = *(const GAS f32x4*)(bi + 4);
            const float rr[8] = {br0.x, br0.y, br0.z, br0.w, br1.x, br1.y, br1.z, br1.w}, ii[8] = {bi0.x, bi0.y, bi0.z, bi0.w, bi1.x, bi1.y, bi1.z, bi1.w};
            unsigned wre[4], wim[4];
#pragma unroll
            for (int j = 0; j < 4; ++j) { const float r0 = rr[2 * j], i0 = ii[2 * j], r1 = rr[2 * j + 1], i1 = ii[2 * j + 1];
                wre[j] = pk2(cr * r0 - ci * i0, cr * r1 - ci * i1); wim[j] = pk2(cr * i0 + ci * r0, cr * i1 + ci * r1); }
            Bf[2 * pb] = __builtin_bit_cast(bf16x8, (v4u){wre[0], wre[1], wre[2], wre[3]});
            Bf[2 * pb + 1] = __builtin_bit_cast(bf16x8, (v4u){wim[0], wim[1], wim[2], wim[3]});
        }
        LAS unsigned char* CFL = F.lds + 8 * 8704 + 8192;
        if (wave == 0) { const int cr_ = n & 15; const float zm = (n < 16) ? 1.0f : 0.0f;
          const float* cre = F.A->in[12 + F.z] + ((size_t)lg * 16 + cr_) * 64 + 4 * hh; const float* cim = F.A->in[13 + F.z] + ((size_t)lg * 16 + cr_) * 64 + 4 * hh;
          f32x4 cr4[8], ci4[8];
#pragma unroll
          for (int ks = 0; ks < 8; ++ks) { cr4[ks] = *(const GAS f32x4*)(cre + 8 * ks); ci4[ks] = *(const GAS f32x4*)(cim + 8 * ks); }
#pragma unroll
          for (int ks = 0; ks < 8; ++ks) { const f32x4 a = cr4[ks] * zm, c = ci4[ks] * (-zm);
              *(LAS v4u*)(CFL + (ks * 64 + lane) * 16) = (v4u){pk2(a.x, c.x), pk2(a.y, c.y), pk2(a.z, c.z), pk2(a.w, c.w)}; } }
        const int seg_own = 2 * wave + hh;
        const int i_row = n, seg_ld = 2 * wave + ((i_row >> 2) & 1), tau_ld = (i_row & 3) + 4 * (i_row >> 3);
        const size_t tok0 = (size_t)b * SEQ + seg_ld * 256 + tau_ld;
        const float* dskip = F.A->in[14 + F.z] + layer * 1024;
        float s_re[2] = {0.f, 0.f}, s_im[2] = {0.f, 0.f};
        ssm_pass<false>(U, Y, stl, dskip, tok0, g, lane, n, hh, i_row, a_re, a_im, Bf, CFL, s_re, s_im);
#pragma unroll
        for (int pb = 0; pb < 2; ++pb) { E[(seg_own * 64 + 32 * pb + n) * 2] = s_re[pb]; E[(seg_own * 64 + 32 * pb + n) * 2 + 1] = s_im[pb]; }
        LDS_WAIT(); __syncthreads();
#pragma unroll
        for (int pb = 0; pb < 2; ++pb) {
            float Ar = a_re[pb], Ai = a_im[pb];
#pragma unroll
            for (int q = 0; q < 8; ++q) { float t = Ar * Ar - Ai * Ai; asm volatile("" : "+v"(t)); Ai = 2.0f * Ar * Ai; asm volatile("" : "+v"(Ai)); Ar = t; }
            float sr = 0.f, si = 0.f;
            for (int j = 0; j < 15; ++j) {
                const float er = E[(j * 64 + 32 * pb + n) * 2], ei = E[(j * 64 + 32 * pb + n) * 2 + 1];
                float tr = Ar * sr - Ai * si + er; asm volatile("" : "+v"(tr)); float ti = Ar * si + Ai * sr + ei; asm volatile("" : "+v"(ti));
                if (j < seg_own) { sr = tr; si = ti; }
            }
            s_re[pb] = sr; s_im[pb] = si;
        }
        __syncthreads();
        ssm_pass<true>(U, Y, stl, dskip, tok0, g, lane, n, hh, i_row, a_re, a_im, Bf, CFL, s_re, s_im);
        __syncthreads();
    }
}

__device__ __forceinline__ void attn_wave_unit(Frame& F, int b, int hd, int qt) {
    const bf16* Q = (const bf16*)(F.ws + WS_U); const bf16* K = (const bf16*)(F.ws + WS_KB); const bf16* Vt = (const bf16*)(F.ws + WS_VT); bf16* O = (bf16*)(F.ws + WS_Y);
    constexpr float ATT_EXIT = 28.0f;
    const int lane = F.lane, n = lane & 31, hh = lane >> 5;
    const size_t qrow = (size_t)b * SEQ + 32 * qt + n;
    bf16x8 qf[4];
#pragma unroll
    for (int ks = 0; ks < 4; ++ks) qf[ks] = *(const GAS bf16x8*)(Q + qrow * DM + 64 * hd + 16 * ks + 8 * hh);
    f32x16 o[2]; o[0] = f32x16{}; o[1] = f32x16{};
    float racc = 0.f;
    const int qrel = 32 * qt, myq = qrel + n;
    const int keyi = (n & 3) + 4 * (n >> 3) + 16 * ((n >> 2) & 1);
    const bf16* kbase = K + ((size_t)b * SEQ + keyi) * DM + 64 * hd + 8 * hh;
    const bf16* vbase = Vt + (size_t)(64 * hd + n) * TOK + (size_t)b * SEQ + 16 * hh;
    int T = (qrel + 30) >> 6;
    bf16x8 kf[2][4];
#pragma unroll
    for (int u = 0; u < 2; ++u)
#pragma unroll
        for (int ks = 0; ks < 4; ++ks) kf[u][ks] = *(const GAS bf16x8*)(kbase + (size_t)(64 * T + 32 * u) * DM + 16 * ks);
    for (; T >= 0; --T) {
        const int k0 = 64 * T;
        f32x16 s0 = {}, s1 = {};
#pragma unroll
        for (int ks = 0; ks < 4; ++ks) { s0 = __builtin_amdgcn_mfma_f32_32x32x16_bf16(kf[0][ks], qf[ks], s0, 0, 0, 0); s1 = __builtin_amdgcn_mfma_f32_32x32x16_bf16(kf[1][ks], qf[ks], s1, 0, 0, 0); }
        bf16x8 vf[2][2][2];
#pragma unroll
        for (int u = 0; u < 2; ++u)
#pragma unroll
            for (int sx = 0; sx < 2; ++sx)
#pragma unroll
                for (int db = 0; db < 2; ++db) vf[u][sx][db] = *(const GAS bf16x8*)(vbase + (size_t)(32 * db) * TOK + k0 + 32 * u + 8 * sx);
        { const int Tn = T > 0 ? T - 1 : 0;
#pragma unroll
          for (int u = 0; u < 2; ++u)
#pragma unroll
              for (int ks = 0; ks < 4; ++ks) kf[u][ks] = *(const GAS bf16x8*)(kbase + (size_t)(64 * Tn + 32 * u) * DM + 16 * ks); }
        const bool need_mask = (k0 + 63 >= qrel);
        float sp[2][16], z[2][16];
#pragma unroll
        for (int r = 0; r < 16; ++r) { const float za = fminf(s0[r], 60.0f), zb = fminf(s1[r], 60.0f); z[0][r] = za; z[1][r] = zb;
            sp[0][r] = __builtin_amdgcn_logf(1.0f + __builtin_amdgcn_exp2f(za)); sp[1][r] = __builtin_amdgcn_logf(1.0f + __builtin_amdgcn_exp2f(zb)); }
        if (need_mask) {
#pragma unroll
            for (int u = 0; u < 2; ++u)
#pragma unroll
                for (int r = 0; r < 16; ++r) { const int key = k0 + 32 * u + 16 * hh + r; if (key >= myq) { sp[u][r] = 0.f; z[u][r] = -1e30f; } }
        }
        float T0 = 0.f, T1 = 0.f;
#pragma unroll
        for (int r = 0; r < 16; ++r) { T0 += sp[0][r]; T1 += sp[1][r]; }
        const float oT0 = __shfl_xor(T0, 32), oT1 = __shfl_xor(T1, 32);
        const float off1 = racc + (hh ? 0.f : oT1);
        const float off0 = racc + T1 + oT1 + (hh ? 0.f : oT0);
        racc += T0 + T1 + oT0 + oT1;
        unsigned pw[2][8];
        { float run = off1;
#pragma unroll
          for (int r = 15; r >= 0; --r) { run += sp[1][r]; z[1][r] = __builtin_amdgcn_exp2f(z[1][r] - run); }
          run = off0;
#pragma unroll
          for (int r = 15; r >= 0; --r) { run += sp[0][r]; z[0][r] = __builtin_amdgcn_exp2f(z[0][r] - run); } }
#pragma unroll
        for (int u = 0; u < 2; ++u)
#pragma unroll
            for (int q = 0; q < 8; ++q) pw[u][q] = cvt_pk_bf16(z[u][2 * q], z[u][2 * q + 1]);
#pragma unroll
        for (int u = 0; u < 2; ++u)
#pragma unroll
            for (int sx = 0; sx < 2; ++sx) { const bf16x8 af = __builtin_bit_cast(bf16x8, (v4u){pw[u][4 * sx], pw[u][4 * sx + 1], pw[u][4 * sx + 2], pw[u][4 * sx + 3]});
#pragma unroll
                for (int db = 0; db < 2; ++db) o[db] = __builtin_amdgcn_mfma_f32_32x32x16_bf16(af, vf[u][sx][db], o[db], 0, 0, 0); }
        if (__all(racc >= ATT_EXIT)) break;
    }
#pragma unroll
    for (int db = 0; db < 2; ++db)
#pragma unroll
        for (int r = 0; r < 16; ++r) { const int qr = (r & 3) + 8 * (r >> 2) + 4 * hh;
            ((unsigned char*)O)[((size_t)b * SEQ + 32 * qt + qr) * DM + 64 * hd + 32 * db + n] = (unsigned char)(pk4_fp8(o[db][r], 0.f, 0.f, 0.f) & 0xffu); }
}
__device__ __forceinline__ void attn_phase(Frame& F) {
    const int gw = F.vcu * NWAVES + F.wave, NGW = F.G * NWAVES;
#pragma unroll 1
    for (int uidx = gw; uidx < 64 * 128; uidx += NGW) { const int bh = uidx >> 7; attn_wave_unit(F, bh >> 4, bh & 15, uidx & 127); }
}

typedef float f32x2 __attribute__((ext_vector_type(2)));
typedef _Float16 h16x2 __attribute__((ext_vector_type(2)));
template <int K, class T> __device__ __forceinline__ T xcomb(T a, T b, int lane) {
    const bool hi = (lane >> K) & 1; const T keep = hi ? b : a, send = hi ? a : b;
    return keep + __shfl_xor(send, 1 << K);
}
__device__ __forceinline__ void fp4x16_to_f32(const v2u& r, f32x2 (&f)[8]) {
    const unsigned w0 = r.x, w1 = r.y;
    f[0] = __builtin_amdgcn_cvt_scalef32_pk_f32_fp4(w0, 1.0f, 0); f[1] = __builtin_amdgcn_cvt_scalef32_pk_f32_fp4(w0, 1.0f, 1);
    f[2] = __builtin_amdgcn_cvt_scalef32_pk_f32_fp4(w0, 1.0f, 2); f[3] = __builtin_amdgcn_cvt_scalef32_pk_f32_fp4(w0, 1.0f, 3);
    f[4] = __builtin_amdgcn_cvt_scalef32_pk_f32_fp4(w1, 1.0f, 0); f[5] = __builtin_amdgcn_cvt_scalef32_pk_f32_fp4(w1, 1.0f, 1);
    f[6] = __builtin_amdgcn_cvt_scalef32_pk_f32_fp4(w1, 1.0f, 2); f[7] = __builtin_amdgcn_cvt_scalef32_pk_f32_fp4(w1, 1.0f, 3);
}
typedef unsigned bl_v2u __attribute__((__vector_size__(8)));
__device__ __forceinline__ void peer_load8(__amdgpu_buffer_rsrc_t tab, int idv, int e0, int lane, v2u (&R)[8]) {
    int so[8];
#pragma unroll
    for (int i = 0; i < 8; ++i) so[i] = __builtin_amdgcn_readlane(idv, e0 + i) << 9;
    __builtin_amdgcn_sched_barrier(0);
#pragma unroll
    for (int i = 0; i < 8; ++i) { const bl_v2u t = __builtin_amdgcn_raw_buffer_load_b64(tab, 8 * lane, so[i], 0); R[i] = (v2u){t[0], t[1]}; }
    __builtin_amdgcn_sched_barrier(0);
}
template <int K> __device__ __forceinline__ int xcomb_dpp(int a, int b, int lane) {
    const bool hi = (lane >> K) & 1; const int keep = hi ? b : a, send = hi ? a : b; int recv;
    if (K == 0) recv = __builtin_amdgcn_update_dpp(0, send, 0xB1, 0xF, 0xF, true);
    else if (K == 1) recv = __builtin_amdgcn_update_dpp(0, send, 0x4E, 0xF, 0xF, true);
    else { recv = __builtin_amdgcn_update_dpp(0, send, 0x104, 0xF, 0x5, true);
           recv = __builtin_amdgcn_update_dpp(recv, send, 0x114, 0xF, 0xA, true); }
    return keep + recv;
}
__device__ __forceinline__ float peer_dot8(const v2u (&R)[8], const v2u& xhi, const v2u& xlo, int lane) {
    int p[8];
#pragma unroll
    for (int i = 0; i < 8; ++i) { const int r0 = (int)R[i].x, r1 = (int)R[i].y;
        int h = __builtin_amdgcn_sdot8(r0, (int)xhi.x, 0, false); h = __builtin_amdgcn_sdot8(r1, (int)xhi.y, h, false);
        int l = __builtin_amdgcn_sdot8(r0, (int)xlo.x, 0, false); l = __builtin_amdgcn_sdot8(r1, (int)xlo.y, l, false);
        p[i] = (h << 4) + l; __builtin_amdgcn_sched_barrier(0); }
    int q[4];
#pragma unroll
    for (int i = 0; i < 4; ++i) q[i] = xcomb_dpp<0>(p[2 * i], p[2 * i + 1], lane);
    const int r0 = xcomb_dpp<1>(q[0], q[1], lane), r1 = xcomb_dpp<1>(q[2], q[3], lane);
    int v = xcomb_dpp<2>(r0, r1, lane);
    v += __builtin_amdgcn_update_dpp(0, v, 0x128, 0xF, 0xF, true);
    { const auto t = __builtin_amdgcn_permlane16_swap((unsigned)v, (unsigned)v, false, false); v = (int)(t[0] + t[1]); }
    { const auto t = __builtin_amdgcn_permlane32_swap((unsigned)v, (unsigned)v, false, false); v = (int)(t[0] + t[1]); }
    return (float)v;
}
__device__ __forceinline__ void peer_fma8(const v2u (&R)[8], unsigned wvh, int e0, h16x2 (&o)[8]) {
#pragma unroll
    for (int i = 0; i < 8; ++i) { const unsigned wt = (unsigned)__builtin_amdgcn_readlane((int)wvh, e0 + i); const h16x2 w2 = __builtin_bit_cast(h16x2, wt);
        const unsigned w0 = R[i].x, w1 = R[i].y; h16x2 f[8];
        f[0] = __builtin_amdgcn_cvt_scalef32_pk_f16_fp4(w0, 1.0f, 0); f[1] = __builtin_amdgcn_cvt_scalef32_pk_f16_fp4(w0, 1.0f, 1);
        f[2] = __builtin_amdgcn_cvt_scalef32_pk_f16_fp4(w0, 1.0f, 2); f[3] = __builtin_amdgcn_cvt_scalef32_pk_f16_fp4(w0, 1.0f, 3);
        f[4] = __builtin_amdgcn_cvt_scalef32_pk_f16_fp4(w1, 1.0f, 0); f[5] = __builtin_amdgcn_cvt_scalef32_pk_f16_fp4(w1, 1.0f, 1);
        f[6] = __builtin_amdgcn_cvt_scalef32_pk_f16_fp4(w1, 1.0f, 2); f[7] = __builtin_amdgcn_cvt_scalef32_pk_f16_fp4(w1, 1.0f, 3);
#pragma unroll
        for (int k = 0; k < 8; ++k) o[k] = __builtin_elementwise_fma(w2, f[k], o[k]);
        __builtin_amdgcn_sched_barrier(0); }
}
__device__ __forceinline__ void peer_phase(Frame& F, int layer) {
    const bf16* H1 = (const bf16*)(F.ws + WS_H1); bf16* H2 = (bf16*)(F.ws + WS_H2);
    const __amdgpu_buffer_rsrc_t TU = __builtin_amdgcn_make_buffer_rsrc((void*)(F.ws + WS_TABU + (size_t)layer * 16384 * 512), (short)0, 16384 * 512, 0x00020000);
    const __amdgpu_buffer_rsrc_t TV = __builtin_amdgcn_make_buffer_rsrc((void*)(F.ws + WS_TABV + (size_t)layer * 16384 * 512), (short)0, 16384 * 512, 0x00020000);
    const int* IDX = (const int*)(F.ws + WS_IDX); const float* GATE = (const float*)(F.ws + WS_GATE);
    const float* g = F.A->in[4 + F.z] + layer * 1024; const float* bb = F.A->in[5 + F.z] + layer * 1024;
    const int lane = F.lane, gw = F.vcu * NWAVES + F.wave, NGW = F.G * NWAVES;
    v2u B0[8], B1[8], B2[8], B3[8];
    TabCvt TC; { const size_t lo = (size_t)(layer + 1) * 16384 * 1024;
        TC.su = F.A->in[24 + F.z] + lo; TC.sv = F.A->in[25 + F.z] + lo; TC.du = (unsigned char*)(F.ws + WS_TABU) + lo / 2; TC.dv = (unsigned char*)(F.ws + WS_TABV) + lo / 2;
        TC.c = gw; TC.cf = gw; TC.stride = NGW; TC.n = (layer + 1 < DEPTH) ? 2 * 16384 : 0; }
    f32x4 cvA[4], cvB[4];
    int id0 = 0, id1 = 0;
    if (gw < TOK) { id0 = IDX[(size_t)gw * 128 + lane]; id1 = IDX[(size_t)gw * 128 + 64 + lane];
        peer_load8(TU, id0, 0, lane, B0); peer_load8(TU, id0, 8, lane, B1); peer_load8(TU, id0, 16, lane, B2); }
    tabcvt_issue(TC, lane, cvA); tabcvt_issue(TC, lane, cvB);
    for (int t = gw; t < TOK; t += NGW) {
        const int tn = (t + NGW < TOK) ? t + NGW : t;
        const int nid0 = IDX[(size_t)tn * 128 + lane], nid1 = IDX[(size_t)tn * 128 + 64 + lane];
        const float g0 = GATE[(size_t)t * 128 + lane], g1 = GATE[(size_t)t * 128 + 64 + lane];
        const v4u xa = *(const GAS v4u*)(H1 + (size_t)t * DM + 16 * lane), xb = *(const GAS v4u*)(H1 + (size_t)t * DM + 16 * lane + 8);
        f32x2 x[8] = {{bf_lo(xa.x), bf_hi(xa.x)}, {bf_lo(xa.y), bf_hi(xa.y)}, {bf_lo(xa.z), bf_hi(xa.z)}, {bf_lo(xa.w), bf_hi(xa.w)}, {bf_lo(xb.x), bf_hi(xb.x)}, {bf_lo(xb.y), bf_hi(xb.y)}, {bf_lo(xb.z), bf_hi(xb.z)}, {bf_lo(xb.w), bf_hi(xb.w)}};
        v2u xqh = {0u, 0u}, xql = {0u, 0u};
#pragma unroll
        for (int i = 0; i < 16; ++i) { const float xv = (i & 1) ? x[i >> 1].y : x[i >> 1].x;
            float qf = __builtin_fminf(__builtin_fmaxf(xv * 16.f, -120.f), 119.f) + 12582912.0f; asm volatile("" : "+v"(qf)); const unsigned q = __builtin_bit_cast(unsigned, qf);
            const unsigned lo = q & 15u, hi = ((q + 8u) >> 4) & 15u;
            if (i < 8) { xql.x |= lo << (4 * i); xqh.x |= hi << (4 * i); } else { xql.y |= lo << (4 * (i - 8)); xqh.y |= hi << (4 * (i - 8)); } }
#define PEER_LOADB(buf, b) do { const int b_ = (b); if (b_ < 32) peer_load8((b_ & 16) ? TV : TU, (b_ & 8) ? id1 : id0, 8 * (b_ & 7), lane, buf); else peer_load8(TU, nid0, 8 * (b_ & 7), lane, buf); } while (0)
#define PEER_DOTB(buf, b) do { const int b_ = (b); const float r_ = peer_dot8(buf, xqh, xql, lane); const bool mine_ = (lane >> 3) == (b_ & 7); if (b_ & 8) act1 = mine_ ? r_ : act1; else act0 = mine_ ? r_ : act0; } while (0)
#define PEER_FMAB(buf, b) do { const int b_ = (b); peer_fma8(buf, (b_ & 8) ? w1h : w0h, 8 * (b_ & 7), o); } while (0)
        float act0 = 0.f, act1 = 0.f;
#pragma unroll 1
        for (int j = 0; j < 16; j += 4) {
            PEER_LOADB(B3, j + 3); PEER_DOTB(B0, j);
            PEER_LOADB(B0, j + 4); PEER_DOTB(B1, j + 1);
            PEER_LOADB(B1, j + 5); PEER_DOTB(B2, j + 2);
            PEER_LOADB(B2, j + 6); PEER_DOTB(B3, j + 3);
        }
        const float w0 = g0 * gelu_tanh(act0 * (1.0f / (16.f * PEER_SU))) * (1.0f / PEER_SV), w1 = g1 * gelu_tanh(act1 * (1.0f / (16.f * PEER_SU))) * (1.0f / PEER_SV);
        unsigned w0h, w1h; { const _Float16 a = (_Float16)w0, b = (_Float16)w1; const h16x2 pa = {a, a}, pb = {b, b}; w0h = __builtin_bit_cast(unsigned, pa); w1h = __builtin_bit_cast(unsigned, pb); }
        h16x2 o[8];
#pragma unroll
        for (int i = 0; i < 8; ++i) o[i] = (h16x2){(_Float16)0.f, (_Float16)0.f};
#pragma unroll 1
        for (int j = 16; j < 32; j += 4) {
            PEER_LOADB(B3, j + 3); PEER_FMAB(B0, j);
            PEER_LOADB(B0, j + 4); PEER_FMAB(B1, j + 1);
            PEER_LOADB(B1, j + 5); PEER_FMAB(B2, j + 2);
            PEER_LOADB(B2, j + 6); PEER_FMAB(B3, j + 3);
        }
#undef PEER_LOADB
#undef PEER_DOTB
#undef PEER_FMAB
        id0 = nid0; id1 = nid1;
        tabcvt_finish(TC, lane, cvA); tabcvt_finish(TC, lane, cvB);
        tabcvt_issue(TC, lane, cvA); tabcvt_issue(TC, lane, cvB);
        float y[16]; float sm = 0.f;
#pragma unroll
        for (int i = 0; i < 8; ++i) { y[2 * i] = pg8::ALPHA_F * x[i].x + (float)o[i].x; y[2 * i + 1] = pg8::ALPHA_F * x[i].y + (float)o[i].y; sm += y[2 * i] + y[2 * i + 1]; }
        const float mean = wave_sum(sm) * (1.f / DM); float q = 0.f;
#pragma unroll
        for (int i = 0; i < 16; ++i) { y[i] -= mean; q += y[i] * y[i]; }
        const float rstd = 1.0f / sqrtf(wave_sum(q) * (1.f / DM) + LN_EPS);
#pragma unroll
        for (int c = 0; c < 4; ++c) { const f32x4 gv = *(const GAS f32x4*)(g + 16 * lane + 4 * c), bv = *(const GAS f32x4*)(bb + 16 * lane + 4 * c);
            y[4 * c] = y[4 * c] * rstd * gv.x + bv.x; y[4 * c + 1] = y[4 * c + 1] * rstd * gv.y + bv.y; y[4 * c + 2] = y[4 * c + 2] * rstd * gv.z + bv.z; y[4 * c + 3] = y[4 * c + 3] * rstd * gv.w + bv.w; }
        v4u oa, ob; oa.x = pk2(y[0], y[1]); oa.y = pk2(y[2], y[3]); oa.z = pk2(y[4], y[5]); oa.w = pk2(y[6], y[7]); ob.x = pk2(y[8], y[9]); ob.y = pk2(y[10], y[11]); ob.z = pk2(y[12], y[13]); ob.w = pk2(y[14], y[15]);
        *(GAS v4u*)(H2 + (size_t)t * DM + 16 * lane) = oa; *(GAS v4u*)(H2 + (size_t)t * DM + 16 * lane + 8) = ob;
        *(GAS v4u*)((unsigned char*)(F.ws + WS_H28) + (size_t)t * DM + 16 * lane) = (v4u){pk4_fp8(y[0], y[1], y[2], y[3]), pk4_fp8(y[4], y[5], y[6], y[7]), pk4_fp8(y[8], y[9], y[10], y[11]), pk4_fp8(y[12], y[13], y[14], y[15])};
    }
    tabcvt_finish(TC, lane, cvA); tabcvt_finish(TC, lane, cvB);
    while (TC.cf < TC.n) { tabcvt_issue(TC, lane, cvA); tabcvt_finish(TC, lane, cvA); }
}

template <class Epi> __device__ __forceinline__ void run_gemm(Frame& F, const bf16* A, const bf16* Bt, int M, int N, int K, const Epi& E, int pw = 0) {
    pg8::Gemm g{A, Bt, M, N, K}; pg8::StaticOrder S; S.init(M, N, F.G, pw ? F.vcu : F.bx); S.pw = pw; if (pw) S.nwg = 1024;
    int t = F.tid; asm volatile("" : "+v"(t));
    pg8::gemm_phase<Epi, pg8::StaticOrder, true, true>(F.lds, g, S, E, t);
}

template <class Epi> __device__ __forceinline__ void run_gemm8(Frame& F, const unsigned char* A8, const unsigned char* Bt8, int M, int N, int Kbytes, const Epi& E) {
    pg8::Gemm g{(const bf16*)A8, (const bf16*)Bt8, M, N, Kbytes / 2 + F.z  }; pg8::StaticOrder S; S.init(M, N, F.G, F.bx);
    int t = F.tid; asm volatile("" : "+v"(t));
    pg8::gemm_phase<Epi, pg8::StaticOrder, true, true, true>(F.lds, g, S, E, t);
}

__global__ void __launch_bounds__(NWAVES * 64, 2) mega_fwd(Args args) {
    extern __shared__ __attribute__((aligned(16))) unsigned char lds[];
    Frame F;
    F.lds = (LAS unsigned char*)lds;
    F.tid = threadIdx.x; F.lane = F.tid & 63; F.wave = 0; F.G = gridDim.x; F.bx = blockIdx.x; F.vcu = 0;
    F.A = &args; F.z = 0; F.out = args.out; F.ws = args.ws;
    const int wave_s = __builtin_amdgcn_readfirstlane((int)threadIdx.x >> 6);
    volatile LAS unsigned* MISC = (volatile LAS unsigned*)(F.lds + MISC_OFF);
    if (F.tid < 64) MISC[F.tid] = 0u;
    __syncthreads();
    XcdBarrier bar; bar.bar = (unsigned*)(F.ws + WS_CTL) + CW_BAR; bar.x = 0; bar.st = nullptr;
    if (args.use_bar) bar = xcd_barrier_post((unsigned*)(F.ws + WS_CTL) + CW_BAR, MISC + 8);

    for (int pc = args.ph_lo; pc < args.ph_hi; ++pc) {
        { int z = 0; asm volatile("" : "+s"(z)); int t = wave_s * 64 + (int)__builtin_amdgcn_mbcnt_hi(~0u, __builtin_amdgcn_mbcnt_lo(~0u, (unsigned)z)); asm volatile("" : "+v"(t));
          F.z = z; F.ws = args.ws + z; F.tid = t; F.lane = t & 63; F.wave = __builtin_amdgcn_readfirstlane(t >> 6);
          F.G = (int)gridDim.x + z; F.bx = (int)blockIdx.x + z; F.vcu = (F.G % 8 == 0) ? (F.bx % 8) * (F.G / 8) + F.bx / 8 : F.bx; }
        bf16* const H = (bf16*)(F.ws + WS_H); bf16* const U = (bf16*)(F.ws + WS_U); bf16* const Y = (bf16*)(F.ws + WS_Y); bf16* const X1 = (bf16*)(F.ws + WS_X1);
        bf16* const H1 = (bf16*)(F.ws + WS_H1); bf16* const H2 = (bf16*)(F.ws + WS_H2); bf16* const KB = (bf16*)(F.ws + WS_KB); bf16* const VT = (bf16*)(F.ws + WS_VT); bf16* const HKV = (bf16*)(F.ws + WS_HKV);
        const int ty = args.ph_type[pc], la = args.ph_arg[pc];
#ifndef PHMASK
#define PHMASK 0xFFFF
#endif
#define EN(x) ((PHMASK >> (x)) & 1)
        switch (ty) {
        case P_PROLOGUE: if (EN(P_PROLOGUE)) p0_prologue(F); break;
        case P_STORE: if (EN(P_STORE)) {
            const int njobs = (la == 0) ? 2 : (la == 2) ? 3 : 1;
            for (int j = 0; j < njobs; ++j) {
                const bf16* A; const bf16* Bt; int M = TOK, N = 1024, K = 1024, ldc = 1024, pw = 0; bf16* O; float sc = 1.0f;
                if (la == 0 && j == 0) { A = (const bf16*)(F.ws + WS_PB); Bt = (const bf16*)(F.ws + WS_W_PW); K = 256; O = (bf16*)(F.ws + WS_PW); pw = 1; }
                else if (la == 0) { A = H; Bt = (const bf16*)(F.ws + WS_W_IN); O = U; }
                else if (la == 1) { A = H; Bt = (const bf16*)(F.ws + WS_W_IN) + (size_t)1024 * 1024; O = U; }
                else if (la == 2 && j == 1) { A = HKV; Bt = (const bf16*)(F.ws + WS_W_KV); O = KB; }
                else if (la == 2 && j == 2) { A = (const bf16*)(F.ws + WS_W_KV) + (size_t)1024 * 1024; Bt = HKV; M = 1024; N = TOK; ldc = TOK; O = VT; }
                else { A = H; Bt = (const bf16*)(F.ws + WS_W_SQ) + (size_t)(la - 2) * 1024 * 1024; O = U; sc = 0.125f * 1.4426950408889634f; }
                if (!pw) {
                    const unsigned char* A8; const unsigned char* B8;
                    if (la <= 1) { A8 = (const unsigned char*)(F.ws + WS_H8); B8 = (const unsigned char*)(F.ws + W8_IN) + (size_t)la * 1024 * 1024; }
                    else if (la == 2 && j == 1) { A8 = (const unsigned char*)(F.ws + WS_HKV); B8 = (const unsigned char*)(F.ws + W8_KV); }
                    else if (la == 2 && j == 2) { A8 = (const unsigned char*)(F.ws + W8_KV) + (size_t)1024 * 1024; B8 = (const unsigned char*)(F.ws + WS_HKV); }
                    else { A8 = (const unsigned char*)(F.ws + WS_H8); B8 = (const unsigned char*)(F.ws + W8_SQ) + (size_t)(la - 2) * 1024 * 1024; }
                    pg8::EpiStore E{O, ldc, sc * (1.0f / W8_SCALE), -1};
                    run_gemm8(F, A8, B8, M, N, 1024, E);
                } else {
                    pg8::EpiStore E{O, ldc, sc, pw ? 3 : -1};
                    run_gemm(F, A, Bt, M, N, K, E, pw);
                }
            }
        } break;
        case P_SSM: if (EN(P_SSM)) ssm_phase(F, la); break;
        case P_GLU: if (EN(P_GLU)) { pg8::EpiGlu E{H, X1}; run_gemm8(F, (const unsigned char*)Y, (const unsigned char*)(F.ws + W8_GLU) + (size_t)la * 2048 * 1024, TOK, 2048, 1024, E); } break;
        case P_LNMIX: if (EN(P_LNMIX)) ln_rows(F, X1, F.A->in[2 + F.z] + la * 1024, F.A->in[3 + F.z] + la * 1024, H1, (unsigned char*)(F.ws + WS_H18)); break;
        case P_TOPK: if (EN(P_TOPK)) {
            pg8::EpiTopk E{(int*)(F.ws + WS_IDX), (float*)(F.ws + WS_GATE)};
            pg8::Gemm g{(const bf16*)(F.ws + WS_H18), (const bf16*)((const unsigned char*)(F.ws + W8_EFF) + (size_t)la * 2048 * 1024), TOK, 2048, 512 + F.z};
            for (int r = 0; r < 2; ++r) { pg8::OneUnitOrder S; S.base.init(TOK, 2048, F.G, F.bx); S.round = r;
                int t = F.tid; asm volatile("" : "+v"(t)); pg8::gemm_phase<pg8::EpiTopk, pg8::OneUnitOrder, false, true, true>(F.lds, g, S, E, t); }
        } break;
        case P_PEER: if (EN(P_PEER)) peer_phase(F, la); break;
        case P_PLE: if (EN(P_PLE)) { pg8::EpiPle E{H2, (const unsigned char*)(F.ws + WS_PW) + (size_t)la * TOK * 1024, H, (la == DEPTH - 1) ? F.out : nullptr, (unsigned char*)(F.ws + WS_H8)};
            run_gemm8(F, (const unsigned char*)(F.ws + WS_H28), (const unsigned char*)(F.ws + W8_PG) + (size_t)la * 1024 * 1024, TOK, 1024, 1024, E); } break;
        case P_LNKV: if (EN(P_LNKV)) ln_rows(F, H, F.A->in[16 + F.z], F.A->in[17 + F.z], nullptr, (unsigned char*)HKV); break;
        case P_ATTN: if (EN(P_ATTN)) attn_phase(F); break;
        case P_RES: if (EN(P_RES)) { pg8::EpiRes E{H, X1}; run_gemm8(F, (const unsigned char*)Y, (const unsigned char*)(F.ws + W8_SO) + (size_t)(la - 2) * 1024 * 1024, TOK, 1024, 1024, E); } break;
        default: break;
        }
        if (pc + 1 < args.ph_hi) xcd_barrier(bar);
    }
}

#ifndef N_LAUNCH_MODE
#define N_LAUNCH_MODE 1
#endif
extern "C" void kernel_launch(void* const* d_in, const int* in_sizes, int n_in, void* d_out, int out_size, void* d_ws, size_t ws_size, hipStream_t stream) {
    static int grid = 0;
    if (grid == 0) {
        if (n_in != 28 || out_size != TOK * DM || ws_size < WS_END) { fprintf(stderr, "kernel_launch: unexpected shapes/workspace (n_in %d, out %d, ws %zu)\n", n_in, out_size, ws_size); grid = -1; return; }
        int dev = 0, cus = 0;
        if (hipGetDevice(&dev) != hipSuccess || hipDeviceGetAttribute(&cus, hipDeviceAttributeMultiprocessorCount, dev) != hipSuccess) { grid = -1; return; }
        if (hipFuncSetAttribute((const void*)mega_fwd, hipFuncAttributeMaxDynamicSharedMemorySize, LDS_BYTES) != hipSuccess) { fprintf(stderr, "kernel_launch: hipFuncSetAttribute failed\n"); grid = -1; return; }
        (void)hipGetLastError();
        grid = cus;
    }
    if (grid < 0) return;
    hipMemsetAsync((char*)d_ws + WS_CTL, 0, CTL_ZERO_BYTES, stream);
    Args a{};
    for (int i = 0; i < 28; ++i) a.in[i] = (const float*)d_in[i];
    a.out = (float*)d_out; a.ws = (unsigned char*)d_ws;
    int n = 0;
#ifndef REP_TYPE
#define REP_TYPE -1
#endif
    auto add = [&](int t, int l) { for (int r = 0; r < ((t == REP_TYPE) ? 2 : 1); ++r) { a.ph_type[n] = (unsigned char)t; a.ph_arg[n] = (unsigned char)l; ++n; } };
    add(P_PROLOGUE, 0); add(P_STORE, 0);
    for (int l = 0; l < DEPTH; ++l) {
        if (l < 2) { if (l == 1) add(P_STORE, 1); add(P_SSM, l); add(P_GLU, l); }
        else { if (l == 2) add(P_LNKV, 0); add(P_STORE, l); add(P_ATTN, l); add(P_RES, l); }
        add(P_LNMIX, l); add(P_TOPK, l); add(P_PEER, l); add(P_PLE, l);
    }
    a.nph = n;
    if (N_LAUNCH_MODE == 1) {
        a.ph_lo = 0; a.ph_hi = n; a.use_bar = 1;
        hipLaunchKernelGGL(mega_fwd, dim3(grid), dim3(NWAVES * 64), LDS_BYTES, stream, a);
    } else {
        a.use_bar = 0;
        for (int i = 0; i < n; ++i) { a.ph_lo = i; a.ph_hi = i + 1; hipLaunchKernelGGL(mega_fwd, dim3(grid), dim3(NWAVES * 64), LDS_BYTES, stream, a); }
    }
}
```

```cpp
#include <hip/hip_runtime.h>
#include <cstdio>
#include <cstdint>
#include <cmath>
namespace pg8 {
#define PG8_LAS __attribute__((address_space(3)))
typedef unsigned short bf16_t;
typedef short bf16x8 __attribute__((ext_vector_type(8)));
typedef float f32x4 __attribute__((ext_vector_type(4)));
typedef unsigned u32x4 __attribute__((ext_vector_type(4)));
constexpr int BM = 256, BK = 64, HALF = 128, HTB = HALF * BK * 2  , STAGE_BYTES = 8 * HTB, NXCD = 8, WGM = 8;

__host__ __device__ __forceinline__ int lds_byte(int r, int c) { const int st = (r >> 4) * 2 + (c >> 5), rr = r & 15, cc = c & 31, ob = rr * 64 + cc * 2; return st * 1024 + (ob ^ (((ob >> 9) & 1) << 5)); }
__host__ __device__ __forceinline__ void stage_rc(int b, int& R, int& C) { const int st = b / 1024, sb = b % 1024, swz = sb ^ (((sb >> 9) & 1) << 5); R = (st >> 1) * 16 + swz / 64; C = (st & 1) * 32 + (swz % 64) / 2; }
__host__ __device__ __forceinline__ int perm32(int rho) { const int n = rho >> 4, i = rho & 15; return 8 * (i >> 2) + 4 * n + (i & 3); }

struct Unit { int pm, pn; };
struct Gemm { const bf16_t* A; const bf16_t* Bt; int M, N, K; };

struct StaticOrder {
    int nM, nN, nwg, G, c;
    __host__ __device__ void init(int M, int N, int G_, int c_) { nM = M / BM; nN = N / BM; nwg = nM * nN; G = G_; c = c_; pw = 0; }
    int pw;
    __host__ __device__ bool next(int i, Unit& u) const {
        const long L = (long)i * G + c; if (L >= nwg) return false;
        if (pw) { const int l = (int)L >> 8, rem = (int)L & 255; u.pm = l * 64 + (rem >> 2); u.pn = l * 4 + (rem & 3); return true; }
        int wgid = (int)L; { const int q = nwg / NXCD, r = nwg % NXCD, xcd = wgid % NXCD, off = wgid / NXCD; wgid = (xcd < r ? xcd * (q + 1) : r * (q + 1) + (xcd - r) * q) + off; }
        const int nig = WGM * nN, gid = wgid / nig, fm = gid * WGM, gsz = (nM - fm) < WGM ? (nM - fm) : WGM;
        u.pm = fm + ((wgid % nig) % gsz); u.pn = (wgid % nig) / gsz; return true;
    }
    __device__ __forceinline__ void a_ready(const Unit&) const {}
    __device__ __forceinline__ void done(const Unit&) const {}
};

typedef float f32x2c_t __attribute__((ext_vector_type(2))); typedef __bf16 bf16x2c_t __attribute__((ext_vector_type(2)));
__device__ __forceinline__ unsigned cvt_pk_bf16(float lo, float hi) { f32x2c_t v = {lo, hi}; bf16x2c_t b = __builtin_convertvector(v, bf16x2c_t); return __builtin_bit_cast(unsigned, b); }
typedef float f32x2 __attribute__((ext_vector_type(2)));
typedef int v8i32_t __attribute__((ext_vector_type(8)));
typedef unsigned u32x8_t __attribute__((ext_vector_type(8)));
template <bool F8> struct Frag { bf16x8 k[2]; };
template <> struct Frag<true> { v8i32_t v; };
template <class Epi, class Sched, bool ALIGN_EPI = false, bool SP2 = false, bool F8 = false>
__device__ __forceinline__ void gemm_phase(PG8_LAS unsigned char* lds, const Gemm g, const Sched& S, const Epi& E, const int tid) {
    const int wid = __builtin_amdgcn_readfirstlane(tid >> 6), lane = tid & 63, wr = wid >> 2, wc = wid & 3, fr = lane & 15, fq = lane >> 4;
    const int K = g.K, nt = K / BK;
    unsigned voffA[1], voffB[1];
    { int R, C; stage_rc(tid * 16, R, C); const int Rb = Epi::PERM ? ((R & ~31) + perm32(R & 31)) : R;
        voffA[0] = (unsigned)(R * K + C) * 2u; voffB[0] = (unsigned)(Rb * K + C) * 2u; }
    const size_t r64 = (size_t)128 * K;
    const size_t kstep = (size_t)(BK * 2);
    const size_t hstep = (size_t)HALF * K * 2;
    const size_t tstep = 2 * hstep;
    const unsigned ldsw = (unsigned)wid * 1024u;
    const int aoff = lds_byte(wr * 64 + fr, F8 ? fq * 16 : fq * 8), boff = lds_byte(wc * 32 + fr, F8 ? fq * 16 : fq * 8);
#define PG8_SA(b, h) (((b) * 2 + (h)) * HTB)
#define PG8_SB(b, h) ((4 + (b) * 2 + (h)) * HTB)
#define PG8_STAGE(bufoff, gbase, voff) do { _Pragma("unroll") for (int _i = 0; _i < 2; ++_i) \
        __builtin_amdgcn_global_load_lds((const unsigned*)((const char*)(gbase) + _i * r64 + (voff)[0]), (PG8_LAS unsigned*)(lds + (bufoff) + ldsw + _i * 8192), 16, 0, 0); } while (0)
#define PG8_LDF(d, addr) do { if constexpr (F8) { const u32x4 lo_ = *(const PG8_LAS u32x4*)(addr), hi_ = *(const PG8_LAS u32x4*)((addr) + 16); d.v = __builtin_bit_cast(v8i32_t, (u32x8_t){lo_[0], lo_[1], lo_[2], lo_[3], hi_[0], hi_[1], hi_[2], hi_[3]}); } \
        else { d.k[0] = *(const PG8_LAS bf16x8*)(addr); d.k[1] = *(const PG8_LAS bf16x8*)((addr) + 1024); } } while (0)
#define PG8_LDA(dst, b, h) do { _Pragma("unroll") for (int m = 0; m < 4; ++m) PG8_LDF(dst[m], lds + PG8_SA(b, h) + aoff + m * 2048); } while (0)
#define PG8_LDB(dst, b, h) do { _Pragma("unroll") for (int n = 0; n < 2; ++n) PG8_LDF(dst[n], lds + PG8_SB(b, h) + boff + n * 2048); } while (0)
#define PG8_MMA(ai, bj, At, Bt) do { __builtin_amdgcn_s_setprio(1); _Pragma("unroll") for (int m = 0; m < 4; ++m) _Pragma("unroll") for (int n = 0; n < 2; ++n) { \
        if constexpr (F8) asm volatile("v_mfma_f32_16x16x128_f8f6f4 %0, %1, %2, %0" : "+v"(acc[ai][bj][m][n]) : "v"(Bt[n].v), "v"(At[m].v));   \
        else { _Pragma("unroll") for (int k = 0; k < 2; ++k) acc[ai][bj][m][n] = __builtin_amdgcn_mfma_f32_16x16x32_bf16(Bt[n].k[k], At[m].k[k], acc[ai][bj][m][n], 0, 0, 0); } } __builtin_amdgcn_s_setprio(0); } while (0)
#define PG8_WAIT_V(n) asm volatile("s_waitcnt vmcnt(" #n ")" ::: "memory")
#define PG8_WAIT_L(n) asm volatile("s_waitcnt lgkmcnt(" #n ")" ::: "memory")
#define PG8_BAR __builtin_amdgcn_s_barrier()
#define PG8_SCHED __builtin_amdgcn_sched_barrier(0)
    Unit cur, nxt; int ui = 0;
    if (!S.next(0, cur)) return;
    f32x4 acc[2][2][4][2];
#pragma unroll
    for (int a = 0; a < 2; ++a)
#pragma unroll
        for (int b = 0; b < 2; ++b)
#pragma unroll
            for (int m = 0; m < 4; ++m)
#pragma unroll
                for (int n = 0; n < 2; ++n) acc[a][b][m][n] = (f32x4){0.f, 0.f, 0.f, 0.f};
    Frag<F8> At[4], B0[2], B1[2];
    const char* cA = (const char*)g.A + (size_t)cur.pm * tstep; const char* cB = (const char*)g.Bt + (size_t)cur.pn * tstep;
    S.a_ready(cur);
    if constexpr (SP2) {
        PG8_STAGE(PG8_SB(0, 0), cB, voffB); PG8_STAGE(PG8_SB(0, 1), cB + hstep, voffB); PG8_STAGE(PG8_SA(0, 0), cA, voffA); PG8_STAGE(PG8_SA(0, 1), cA + hstep, voffA);
        if (wr == 1) PG8_BAR;
        PG8_WAIT_V(2); PG8_BAR;
        PG8_STAGE(PG8_SB(1, 0), cB + kstep, voffB); PG8_STAGE(PG8_SA(1, 0), cA + kstep, voffA); PG8_STAGE(PG8_SB(1, 1), cB + hstep + kstep, voffB);
        PG8_WAIT_V(6); PG8_BAR;
    } else {
        PG8_STAGE(PG8_SB(0, 0), cB, voffB); PG8_STAGE(PG8_SA(0, 0), cA, voffA); PG8_STAGE(PG8_SB(0, 1), cB + hstep, voffB); PG8_STAGE(PG8_SA(0, 1), cA + hstep, voffA);
        if (wr == 1) PG8_BAR;
        PG8_WAIT_V(4); PG8_BAR;
        PG8_STAGE(PG8_SB(1, 0), cB + kstep, voffB); PG8_STAGE(PG8_SA(1, 0), cA + kstep, voffA); PG8_STAGE(PG8_SB(1, 1), cB + hstep + kstep, voffB);
        PG8_WAIT_V(6); PG8_BAR;
    }
    for (;;) {
        const bool has_next = S.next(ui + 1, nxt);
        const char* nA = has_next ? (const char*)g.A + (size_t)nxt.pm * tstep : cA; const char* nB = has_next ? (const char*)g.Bt + (size_t)nxt.pn * tstep : cB;
#pragma unroll 1
        for (int t = 0; t < nt; t += 2) {
            const bool last = (t == nt - 2);
            const char* a1 = cA + (size_t)(t + 1) * kstep;
            const char* a2 = last ? nA : cA + (size_t)(t + 2) * kstep; const char* b2 = last ? nB : cB + (size_t)(t + 2) * kstep;
            const char* a3 = a2 + kstep; const char* b3 = b2 + kstep;
            if (last && has_next) S.a_ready(nxt);
            if constexpr (SP2) {
            PG8_LDB(B0, 0, 0); PG8_LDB(B1, 0, 1); PG8_SCHED; PG8_LDA(At, 0, 0); PG8_STAGE(PG8_SA(1, 1), a1 + hstep, voffA);
            PG8_WAIT_V(8); PG8_WAIT_L(0); PG8_BAR; PG8_MMA(0, 0, At, B0); PG8_MMA(0, 1, At, B1); PG8_BAR; PG8_SCHED;
            PG8_LDA(At, 0, 1); PG8_STAGE(PG8_SB(0, 0), b2, voffB); PG8_STAGE(PG8_SB(0, 1), b2 + hstep, voffB); PG8_STAGE(PG8_SA(0, 0), a2, voffA);
            PG8_WAIT_V(8); PG8_WAIT_L(0); PG8_BAR; PG8_MMA(1, 0, At, B0); PG8_MMA(1, 1, At, B1); PG8_BAR; PG8_SCHED;
            PG8_LDB(B0, 1, 0); PG8_LDB(B1, 1, 1); PG8_SCHED; PG8_LDA(At, 1, 0); PG8_STAGE(PG8_SA(0, 1), a2 + hstep, voffA);
            PG8_WAIT_V(8); PG8_WAIT_L(0); PG8_BAR; PG8_MMA(0, 0, At, B0); PG8_MMA(0, 1, At, B1); PG8_BAR; PG8_SCHED;
            PG8_LDA(At, 1, 1); PG8_STAGE(PG8_SB(1, 0), b3, voffB); PG8_STAGE(PG8_SB(1, 1), b3 + hstep, voffB); PG8_STAGE(PG8_SA(1, 0), a3, voffA);
            PG8_WAIT_V(8); PG8_WAIT_L(0); PG8_BAR; PG8_MMA(1, 0, At, B0); PG8_MMA(1, 1, At, B1); PG8_BAR; PG8_SCHED;
            } else {
            PG8_LDB(B0, 0, 0); PG8_SCHED; PG8_LDA(At, 0, 0); PG8_STAGE(PG8_SA(1, 1), a1 + hstep, voffA);
            PG8_WAIT_L(8); PG8_BAR; PG8_WAIT_L(0); PG8_MMA(0, 0, At, B0); PG8_BAR; PG8_SCHED;
            PG8_LDB(B1, 0, 1); PG8_STAGE(PG8_SB(0, 0), b2, voffB);
            PG8_BAR; PG8_WAIT_L(0); PG8_MMA(0, 1, At, B1); PG8_BAR;
            PG8_LDA(At, 0, 1); PG8_STAGE(PG8_SA(0, 0), a2, voffA);
            PG8_BAR; PG8_WAIT_L(0); PG8_MMA(1, 0, At, B0); PG8_BAR; PG8_SCHED;
            PG8_STAGE(PG8_SB(0, 1), b2 + hstep, voffB);
            PG8_WAIT_V(6); PG8_BAR; PG8_MMA(1, 1, At, B1); PG8_BAR;
            PG8_LDB(B0, 1, 0); PG8_SCHED; PG8_LDA(At, 1, 0); PG8_STAGE(PG8_SA(0, 1), a2 + hstep, voffA);
            PG8_WAIT_L(8); PG8_BAR; PG8_WAIT_L(0); PG8_MMA(0, 0, At, B0); PG8_BAR; PG8_SCHED;
            PG8_LDB(B1, 1, 1); PG8_STAGE(PG8_SB(1, 0), b3, voffB);
            PG8_BAR; PG8_WAIT_L(0); PG8_MMA(0, 1, At, B1); PG8_BAR;
            PG8_LDA(At, 1, 1); PG8_STAGE(PG8_SA(1, 0), a3, voffA);
            PG8_BAR; PG8_WAIT_L(0); PG8_MMA(1, 0, At, B0); PG8_BAR; PG8_SCHED;
            PG8_STAGE(PG8_SB(1, 1), b3 + hstep, voffB);
            PG8_WAIT_V(6); PG8_BAR; PG8_MMA(1, 1, At, B1); PG8_BAR;
            }
        }
        if constexpr (F8) asm volatile("s_nop 15\n\ts_nop 15" ::: "memory");
        if constexpr (ALIGN_EPI) { if (wr == 0) PG8_BAR; }
        if constexpr (!Epi::AFTER_DRAIN) { E(acc, cur, wr, wc, fr, fq); S.done(cur); }
        if (!has_next) break;
#pragma unroll
        for (int a = 0; a < 2; ++a)
#pragma unroll
            for (int b = 0; b < 2; ++b)
#pragma unroll
                for (int m = 0; m < 4; ++m)
#pragma unroll
                    for (int n = 0; n < 2; ++n) acc[a][b][m][n] = (f32x4){0.f, 0.f, 0.f, 0.f};
        cur = nxt; cA = nA; cB = nB; ++ui;
        if constexpr (ALIGN_EPI) { if (wr == 1) PG8_BAR; }
    }
    PG8_WAIT_V(0);
    if constexpr (!ALIGN_EPI) { if (wr == 0) PG8_BAR; }
    PG8_BAR;
    if constexpr (Epi::AFTER_DRAIN) { E.fused(acc, cur, wr, wc, fr, fq, lds, wid, lane); S.done(cur); }
#undef PG8_SA
#undef PG8_SB
#undef PG8_STAGE
#undef PG8_LDA
#undef PG8_LDB
#undef PG8_MMA
#undef PG8_LDF
#undef PG8_WAIT_V
#undef PG8_WAIT_L
#undef PG8_BAR
#undef PG8_SCHED
}
}
namespace pg8 {
__device__ __forceinline__ float bf_lo(unsigned w) { return __uint_as_float(w << 16); }
__device__ __forceinline__ float bf_hi(unsigned w) { return __uint_as_float(w & 0xffff0000u); }
__device__ __forceinline__ float fast_sigmoid(float x) { return __builtin_amdgcn_rcpf(1.0f + __builtin_amdgcn_exp2f(-1.4426950408889634f * x)); }
__device__ __forceinline__ float gelu_tanh(float x) { const float t = x * (1.5957691216057308f + 0.07135481627260025f * x * x); return x * __builtin_amdgcn_rcpf(1.0f + __builtin_amdgcn_exp2f(-1.4426950408889634f * t)); }
constexpr float ALPHA_F = 1.681792830507429f;
constexpr float WSC = 1.0f / 32.0f;

struct EpiStore {
    static constexpr bool PERM = true, AFTER_DRAIN = false;
    bf16_t* O; int ldc; float scale; int pnmask;
    __device__ __forceinline__ void operator()(const f32x4 (&acc)[2][2][4][2], const Unit& u, int wr, int wc, int fr, int fq) const {
        const int row0 = u.pm * BM + wr * 64 + fr, col0 = (u.pn & pnmask) * BM + wc * 32 + 8 * fq;
#pragma unroll
        for (int ai = 0; ai < 2; ++ai)
#pragma unroll
            for (int m = 0; m < 4; ++m) { bf16_t* rowp = O + (size_t)(row0 + ai * HALF + m * 16) * ldc + col0;
#pragma unroll
                for (int bj = 0; bj < 2; ++bj) { const f32x4 v0 = acc[ai][bj][m][0] * scale, v1 = acc[ai][bj][m][1] * scale;
                    if (pnmask >= 0) {
                        int w0 = 0, w1 = 0; w0 = __builtin_amdgcn_cvt_pk_fp8_f32(v0[0], v0[1], w0, false); w0 = __builtin_amdgcn_cvt_pk_fp8_f32(v0[2], v0[3], w0, true);
                        w1 = __builtin_amdgcn_cvt_pk_fp8_f32(v1[0], v1[1], w1, false); w1 = __builtin_amdgcn_cvt_pk_fp8_f32(v1[2], v1[3], w1, true);
                        *(unsigned long long*)((unsigned char*)O + (size_t)(row0 + ai * HALF + m * 16) * ldc + col0 + bj * HALF) = (unsigned long long)(unsigned)w0 | ((unsigned long long)(unsigned)w1 << 32);
                    } else {
                    u32x4 w; w.x = cvt_pk_bf16(v0[0], v0[1]); w.y = cvt_pk_bf16(v0[2], v0[3]); w.z = cvt_pk_bf16(v1[0], v1[1]); w.w = cvt_pk_bf16(v1[2], v1[3]);
                    *(u32x4*)(rowp + bj * HALF) = w; } } }
    }
};
struct EpiGlu {
    static constexpr bool PERM = true, AFTER_DRAIN = false;
    const bf16_t* Hin; bf16_t* X1;
    __device__ __forceinline__ void operator()(const f32x4 (&acc)[2][2][4][2], const Unit& u, int wr, int wc, int fr, int fq) const {
        const int row0 = u.pm * BM + wr * 64 + fr, col0 = u.pn * HALF + wc * 32 + 8 * fq;
        u32x4 hvv[2][4];
#pragma unroll
        for (int ai = 0; ai < 2; ++ai)
#pragma unroll
            for (int m = 0; m < 4; ++m) hvv[ai][m] = *(const u32x4*)(Hin + (size_t)(row0 + ai * HALF + m * 16) * 1024 + col0);
#pragma unroll
        for (int ai = 0; ai < 2; ++ai)
#pragma unroll
            for (int m = 0; m < 4; ++m) { const size_t off = (size_t)(row0 + ai * HALF + m * 16) * 1024 + col0;
                const u32x4 hv = hvv[ai][m];
                const f32x4 v0 = acc[ai][0][m][0] * WSC, v1 = acc[ai][0][m][1] * WSC, g0 = acc[ai][1][m][0] * WSC, g1 = acc[ai][1][m][1] * WSC;
                float o[8];
                o[0] = ALPHA_F * bf_lo(hv.x) + v0[0] * fast_sigmoid(g0[0]); o[1] = ALPHA_F * bf_hi(hv.x) + v0[1] * fast_sigmoid(g0[1]);
                o[2] = ALPHA_F * bf_lo(hv.y) + v0[2] * fast_sigmoid(g0[2]); o[3] = ALPHA_F * bf_hi(hv.y) + v0[3] * fast_sigmoid(g0[3]);
                o[4] = ALPHA_F * bf_lo(hv.z) + v1[0] * fast_sigmoid(g1[0]); o[5] = ALPHA_F * bf_hi(hv.z) + v1[1] * fast_sigmoid(g1[1]);
                o[6] = ALPHA_F * bf_lo(hv.w) + v1[2] * fast_sigmoid(g1[2]); o[7] = ALPHA_F * bf_hi(hv.w) + v1[3] * fast_sigmoid(g1[3]);
                u32x4 w; w.x = cvt_pk_bf16(o[0], o[1]); w.y = cvt_pk_bf16(o[2], o[3]); w.z = cvt_pk_bf16(o[4], o[5]); w.w = cvt_pk_bf16(o[6], o[7]);
                *(u32x4*)(X1 + off) = w; }
    }
};
struct EpiRes {
    static constexpr bool PERM = true, AFTER_DRAIN = false;
    const bf16_t* Hin; bf16_t* X1;
    __device__ __forceinline__ void operator()(const f32x4 (&acc)[2][2][4][2], const Unit& u, int wr, int wc, int fr, int fq) const {
        const int row0 = u.pm * BM + wr * 64 + fr, col0 = u.pn * BM + wc * 32 + 8 * fq;
        u32x4 hvv[2][4][2];
#pragma unroll
        for (int ai = 0; ai < 2; ++ai)
#pragma unroll
            for (int m = 0; m < 4; ++m)
#pragma unroll
                for (int bj = 0; bj < 2; ++bj) hvv[ai][m][bj] = *(const u32x4*)(Hin + (size_t)(row0 + ai * HALF + m * 16) * 1024 + col0 + bj * HALF);
#pragma unroll
        for (int ai = 0; ai < 2; ++ai)
#pragma unroll
            for (int m = 0; m < 4; ++m)
#pragma unroll
                for (int bj = 0; bj < 2; ++bj) { const size_t off = (size_t)(row0 + ai * HALF + m * 16) * 1024 + col0 + bj * HALF;
                    const u32x4 hv = hvv[ai][m][bj]; const f32x4 v0 = acc[ai][bj][m][0] * WSC, v1 = acc[ai][bj][m][1] * WSC;
                    u32x4 w; w.x = cvt_pk_bf16(ALPHA_F * bf_lo(hv.x) + v0[0], ALPHA_F * bf_hi(hv.x) + v0[1]); w.y = cvt_pk_bf16(ALPHA_F * bf_lo(hv.y) + v0[2], ALPHA_F * bf_hi(hv.y) + v0[3]);
                    w.z = cvt_pk_bf16(ALPHA_F * bf_lo(hv.z) + v1[0], ALPHA_F * bf_hi(hv.z) + v1[1]); w.w = cvt_pk_bf16(ALPHA_F * bf_lo(hv.w) + v1[2], ALPHA_F * bf_hi(hv.w) + v1[3]);
                    *(u32x4*)(X1 + off) = w; }
    }
};
struct EpiPle {
    static constexpr bool PERM = true, AFTER_DRAIN = false;
    const bf16_t* H2; const unsigned char* PW; bf16_t* Hout; float* Fout; unsigned char* H8out;
    __device__ __forceinline__ void operator()(const f32x4 (&acc)[2][2][4][2], const Unit& u, int wr, int wc, int fr, int fq) const {
        const int row0 = u.pm * BM + wr * 64 + fr, col0 = u.pn * BM + wc * 32 + 8 * fq;
#pragma unroll
        for (int ai = 0; ai < 2; ++ai) {
            u32x4 hvv[4][2]; unsigned long long pvv[4][2];
#pragma unroll
            for (int m = 0; m < 4; ++m)
#pragma unroll
                for (int bj = 0; bj < 2; ++bj) { const size_t off = (size_t)(row0 + ai * HALF + m * 16) * 1024 + col0 + bj * HALF; hvv[m][bj] = *(const u32x4*)(H2 + off); pvv[m][bj] = *(const unsigned long long*)(PW + off); }
#pragma unroll
            for (int m = 0; m < 4; ++m)
#pragma unroll
                for (int bj = 0; bj < 2; ++bj) { const size_t off = (size_t)(row0 + ai * HALF + m * 16) * 1024 + col0 + bj * HALF;
                    const u32x4 hv = hvv[m][bj]; const int pl = (int)(unsigned)pvv[m][bj], ph = (int)(unsigned)(pvv[m][bj] >> 32); const f32x4 v0 = acc[ai][bj][m][0] * WSC, v1 = acc[ai][bj][m][1] * WSC;
                    const auto p01 = __builtin_amdgcn_cvt_pk_f32_fp8(pl, false), p23 = __builtin_amdgcn_cvt_pk_f32_fp8(pl, true), p45 = __builtin_amdgcn_cvt_pk_f32_fp8(ph, false), p67 = __builtin_amdgcn_cvt_pk_f32_fp8(ph, true);
                    float o[8];
                    o[0] = bf_lo(hv.x) + fast_sigmoid(v0[0]) * p01[0]; o[1] = bf_hi(hv.x) + fast_sigmoid(v0[1]) * p01[1];
                    o[2] = bf_lo(hv.y) + fast_sigmoid(v0[2]) * p23[0]; o[3] = bf_hi(hv.y) + fast_sigmoid(v0[3]) * p23[1];
                    o[4] = bf_lo(hv.z) + fast_sigmoid(v1[0]) * p45[0]; o[5] = bf_hi(hv.z) + fast_sigmoid(v1[1]) * p45[1];
                    o[6] = bf_lo(hv.w) + fast_sigmoid(v1[2]) * p67[0]; o[7] = bf_hi(hv.w) + fast_sigmoid(v1[3]) * p67[1];
                    if (Fout) { *(f32x4*)(Fout + off) = (f32x4){o[0], o[1], o[2], o[3]}; *(f32x4*)(Fout + off + 4) = (f32x4){o[4], o[5], o[6], o[7]}; }
                    else { u32x4 w; w.x = cvt_pk_bf16(o[0], o[1]); w.y = cvt_pk_bf16(o[2], o[3]); w.z = cvt_pk_bf16(o[4], o[5]); w.w = cvt_pk_bf16(o[6], o[7]); *(u32x4*)(Hout + off) = w;
                        int w0 = 0, w1 = 0; w0 = __builtin_amdgcn_cvt_pk_fp8_f32(o[0], o[1], w0, false); w0 = __builtin_amdgcn_cvt_pk_fp8_f32(o[2], o[3], w0, true); w1 = __builtin_amdgcn_cvt_pk_fp8_f32(o[4], o[5], w1, false); w1 = __builtin_amdgcn_cvt_pk_fp8_f32(o[6], o[7], w1, true);
                        *(unsigned long long*)(H8out + off) = (unsigned long long)(unsigned)w0 | ((unsigned long long)(unsigned)w1 << 32); } }
        }
    }
};

__device__ __forceinline__ int imax_(int a, int b) { return a > b ? a : b; }
__device__ __forceinline__ int imin_(int a, int b) { return a < b ? a : b; }
__device__ __forceinline__ float csum(float a, float b) { float s = a + b; asm volatile("" : "+v"(s)); return s; }
__device__ __forceinline__ int f2key(float v) { int s = __float_as_int(v); return s ^ ((s >> 31) & 0x7fffffff); }
__device__ __forceinline__ float key2f(int k) { return __int_as_float(k ^ ((k >> 31) & 0x7fffffff)); }
template <bool DESC> __device__ __forceinline__ void bitonic_sort16(int (&x)[16]) {
#pragma unroll
    for (int k = 2; k <= 16; k <<= 1)
#pragma unroll
        for (int j = k >> 1; j > 0; j >>= 1)
#pragma unroll
            for (int i = 0; i < 16; ++i) { const int l = i ^ j; if (l > i) { const bool up = ((i & k) == 0) || (k == 16); const bool asc = DESC ? !up : up;
                const int lo = imin_(x[i], x[l]), hi = imax_(x[i], x[l]); x[i] = asc ? lo : hi; x[l] = asc ? hi : lo; } }
}
__device__ __forceinline__ void bitonic_merge_desc16(int (&x)[16]) {
#pragma unroll
    for (int j = 8; j > 0; j >>= 1)
#pragma unroll
        for (int i = 0; i < 16; ++i) { const int l = i ^ j; if (l > i) { const int lo = imin_(x[i], x[l]), hi = imax_(x[i], x[l]); x[i] = hi; x[l] = lo; } }
}
__device__ __forceinline__ void topk_absorb16(int (&L)[16], int (&N)[16]) {
    bitonic_sort16<false>(N);
#pragma unroll
    for (int i = 0; i < 16; ++i) L[i] = imax_(L[i], N[i]);
    bitonic_merge_desc16(L);
}
__device__ __forceinline__ void topk_insert1(int (&L)[16], int v) {
#pragma unroll
    for (int i = 0; i < 16; ++i) { const int hi = imax_(L[i], v); v = imin_(L[i], v); L[i] = hi; }
}

template <bool DESC> __device__ __forceinline__ void bitonic_sort16f(float (&x)[16]) {
#pragma unroll
    for (int k = 2; k <= 16; k <<= 1)
#pragma unroll
        for (int j = k >> 1; j > 0; j >>= 1)
#pragma unroll
            for (int i = 0; i < 16; ++i) { const int l = i ^ j; if (l > i) { const bool up = ((i & k) == 0) || (k == 16); const bool asc = DESC ? !up : up;
                const float lo = __builtin_fminf(x[i], x[l]), hi = __builtin_fmaxf(x[i], x[l]); x[i] = asc ? lo : hi; x[l] = asc ? hi : lo; } }
}
__device__ __forceinline__ void bitonic_merge_desc16f(float (&x)[16]) {
#pragma unroll
    for (int j = 8; j > 0; j >>= 1)
#pragma unroll
        for (int i = 0; i < 16; ++i) { const int l = i ^ j; if (l > i) { const float lo = __builtin_fminf(x[i], x[l]), hi = __builtin_fmaxf(x[i], x[l]); x[i] = hi; x[l] = lo; } }
}
__device__ __forceinline__ void topk_absorb16f(float (&L)[16], float (&N)[16]) {
    bitonic_sort16f<false>(N);
#pragma unroll
    for (int i = 0; i < 16; ++i) L[i] = __builtin_fmaxf(L[i], N[i]);
    bitonic_merge_desc16f(L);
}

__device__ __forceinline__ void topk_insert1f(float (&L)[16], float v) {
#pragma unroll
    for (int i = 0; i < 16; ++i) { const float hi = __builtin_fmaxf(L[i], v); v = __builtin_fminf(L[i], v); L[i] = hi; }
}
struct EpiTopk {
    static constexpr bool PERM = true, AFTER_DRAIN = true;
    int* IDX; float* GATE;
    __device__ __forceinline__ void fused(f32x4 (&acc)[2][2][4][2], const Unit& u, int wr, int wc, int fr, int fq, PG8_LAS unsigned char* lds, int wid, int lane) const {
        const int tid = wid * 64 + lane;
        PG8_LAS float* S = (PG8_LAS float*)lds;
        PG8_LAS int* X = (PG8_LAS int*)lds;
        const int row = tid & 255, part = tid >> 8;
        int KK[2][16];
#pragma unroll
        for (int bj = 0; bj < 2; ++bj) {
#pragma unroll
            for (int ai = 0; ai < 2; ++ai)
#pragma unroll
                for (int m = 0; m < 4; ++m)
#pragma unroll
                    for (int n = 0; n < 2; ++n) *(PG8_LAS f32x4*)(S + (ai * HALF + wr * 64 + m * 16 + fr) * 132 + wc * 32 + 8 * fq + 4 * n) = acc[ai][bj][m][n] * WSC;
            asm volatile("s_waitcnt lgkmcnt(0)" ::: "memory"); __builtin_amdgcn_s_barrier(); asm volatile("" ::: "memory");
            float L[16];
#pragma unroll
            for (int c = 0; c < 4; ++c) {
                float N[16];
#pragma unroll
                for (int i = 0; i < 4; ++i) { const f32x4 v = *(const PG8_LAS f32x4*)(S + row * 132 + 64 * part + 16 * c + 4 * i);
#pragma unroll
                    for (int e = 0; e < 4; ++e) N[4 * i + e] = __int_as_float((__float_as_int(v[e]) & ~127) | (127 - (64 * part + 16 * c + 4 * i + e))); }
                if (c == 0) { bitonic_sort16f<true>(N);
#pragma unroll
                    for (int i = 0; i < 16; ++i) L[i] = N[i]; }
                else topk_absorb16f(L, N);
            }
            asm volatile("s_waitcnt lgkmcnt(0)" ::: "memory"); __builtin_amdgcn_s_barrier(); asm volatile("" ::: "memory");
#pragma unroll
            for (int i = 0; i < 4; ++i) *(PG8_LAS u32x4*)(X + tid * 20 + 4 * i) = (u32x4){(unsigned)__float_as_int(L[4 * i]), (unsigned)__float_as_int(L[4 * i + 1]), (unsigned)__float_as_int(L[4 * i + 2]), (unsigned)__float_as_int(L[4 * i + 3])};
            asm volatile("s_waitcnt lgkmcnt(0)" ::: "memory"); __builtin_amdgcn_s_barrier(); asm volatile("" ::: "memory");
            { float P[16]; const int pt = tid ^ 256;
#pragma unroll
              for (int i = 0; i < 4; ++i) { const u32x4 v = *(const PG8_LAS u32x4*)(X + pt * 20 + 4 * i); P[4 * i] = __int_as_float((int)v.x); P[4 * i + 1] = __int_as_float((int)v.y); P[4 * i + 2] = __int_as_float((int)v.z); P[4 * i + 3] = __int_as_float((int)v.w); }
#pragma unroll
              for (int i = 0; i < 16; ++i) L[i] = __builtin_fmaxf(L[i], P[15 - i]);
              bitonic_merge_desc16f(L); }
#pragma unroll
            for (int i = 0; i < 16; ++i) KK[bj][i] = __float_as_int(L[i]);
            asm volatile("s_waitcnt lgkmcnt(0)" ::: "memory"); __builtin_amdgcn_s_barrier(); asm volatile("" ::: "memory");
        }
        float v1[16], v2[16];
#pragma unroll
        for (int i = 0; i < 16; ++i) { v1[i] = __int_as_float(KK[0][i] & ~127); v2[i] = __int_as_float(KK[1][i] & ~127); }
#define CKEY(a, b) __int_as_float((__float_as_int(csum(v1[a], v2[b])) & ~255) | (255 - (((a) << 4) | (b))))
        float L[16];
#pragma unroll
        for (int b = 0; b < 16; ++b) L[b] = CKEY(0, b);
        { float N[16] = {CKEY(1, 0), CKEY(1, 1), CKEY(1, 2), CKEY(1, 3), CKEY(1, 4), CKEY(1, 5), CKEY(1, 6), CKEY(1, 7), CKEY(2, 0), CKEY(2, 1), CKEY(2, 2), CKEY(2, 3), CKEY(2, 4), CKEY(4, 0), CKEY(4, 1), CKEY(4, 2)};
          topk_absorb16f(L, N); }
        { float N[16] = {CKEY(3, 0), CKEY(3, 1), CKEY(3, 2), CKEY(3, 3), CKEY(5, 0), CKEY(5, 1), CKEY(6, 0), CKEY(6, 1), CKEY(7, 0), CKEY(7, 1), CKEY(8, 0), CKEY(9, 0), CKEY(10, 0), CKEY(11, 0), CKEY(12, 0), CKEY(13, 0)};
          topk_absorb16f(L, N); }
        topk_insert1f(L, CKEY(14, 0)); topk_insert1f(L, CKEY(15, 0));
#undef CKEY
#pragma unroll
        for (int i = 0; i < 4; ++i) { *(PG8_LAS u32x4*)(X + tid * 36 + 4 * i) = (u32x4){(unsigned)KK[0][4 * i], (unsigned)KK[0][4 * i + 1], (unsigned)KK[0][4 * i + 2], (unsigned)KK[0][4 * i + 3]};
                                      *(PG8_LAS u32x4*)(X + tid * 36 + 16 + 4 * i) = (u32x4){(unsigned)KK[1][4 * i], (unsigned)KK[1][4 * i + 1], (unsigned)KK[1][4 * i + 2], (unsigned)KK[1][4 * i + 3]}; }
        asm volatile("s_waitcnt lgkmcnt(0)" ::: "memory");
        float sc[16]; int ex[16];
#pragma unroll
        for (int i = 0; i < 16; ++i) { const int code = 255 - (__float_as_int(L[i]) & 255); const int ka = X[tid * 36 + (code >> 4)], kb = X[tid * 36 + 16 + (code & 15)];
            sc[i] = __int_as_float(ka & ~127) + __int_as_float(kb & ~127); ex[i] = (127 - (ka & 127)) * 128 + (127 - (kb & 127)); }
        float mx = sc[0];
#pragma unroll
        for (int i = 1; i < 16; ++i) mx = fmaxf(mx, sc[i]);
        float den = 0.f;
#pragma unroll
        for (int i = 0; i < 16; ++i) { sc[i] = __builtin_amdgcn_exp2f((sc[i] - mx) * 1.4426950408889634f); den += sc[i]; }
        const float rden = 1.0f / den;
        const size_t o = ((size_t)(u.pm * BM + row) * 8 + u.pn) * 16;
        if (part == 0) {
#pragma unroll
            for (int i = 0; i < 4; ++i) *(u32x4*)(IDX + o + 4 * i) = (u32x4){(unsigned)ex[4 * i], (unsigned)ex[4 * i + 1], (unsigned)ex[4 * i + 2], (unsigned)ex[4 * i + 3]};
        } else {
#pragma unroll
            for (int i = 0; i < 4; ++i) *(f32x4*)(GATE + o + 4 * i) = (f32x4){sc[4 * i] * rden, sc[4 * i + 1] * rden, sc[4 * i + 2] * rden, sc[4 * i + 3] * rden};
        }
        asm volatile("s_waitcnt lgkmcnt(0)" ::: "memory"); __builtin_amdgcn_s_barrier(); asm volatile("" ::: "memory");
    }
};
struct OneUnitOrder {
    StaticOrder base; int round;
    __device__ __forceinline__ bool next(int i, Unit& u) const { return i == 0 && base.next(round, u); }
    __device__ __forceinline__ void a_ready(const Unit&) const {}
    __device__ __forceinline__ void done(const Unit&) const {}
};
}
constexpr int NWAVES = 8;
constexpr int BATCH = 4, SEQ = 4096, DM = 1024, TOK = BATCH * SEQ, DEPTH = 4;
constexpr float LN_EPS = 1e-5f;
constexpr size_t MiB = 1u << 20;
constexpr size_t WS_CTL = 0, CTL_ZERO_BYTES = 32 * 1024;
constexpr size_t WS_W_IN = 2 * MiB;
constexpr size_t WS_W_GLU = 6 * MiB;
constexpr size_t WS_W_KV = 14 * MiB;
constexpr size_t WS_W_SQ = 18 * MiB;
constexpr size_t WS_W_SO = 22 * MiB;
constexpr size_t WS_W_EFF = 26 * MiB;
constexpr size_t WS_W_PG = 42 * MiB;
constexpr size_t WS_W_PW = 50 * MiB;
constexpr size_t WS_PB = 52 * MiB;
constexpr size_t WS_IDX = 84 * MiB;
constexpr size_t WS_GATE = 92 * MiB;
constexpr size_t WS_TABU = 100 * MiB;
constexpr size_t WS_TABV = 228 * MiB;
constexpr size_t WS_PW = 356 * MiB;
constexpr size_t WS_H = 484 * MiB, WS_U = 516 * MiB, WS_Y = 548 * MiB, WS_X1 = 580 * MiB, WS_H1 = 612 * MiB, WS_H2 = 644 * MiB, WS_KB = 676 * MiB, WS_VT = 708 * MiB, WS_HKV = 740 * MiB;
constexpr size_t WS_H8 = 772 * MiB, WS_H28 = 788 * MiB;
constexpr size_t WS_W8 = 804 * MiB;
constexpr size_t W8_IN = WS_W8, W8_GLU = WS_W8 + 2 * MiB, W8_KV = WS_W8 + 6 * MiB, W8_SQ = WS_W8 + 8 * MiB, W8_SO = WS_W8 + 10 * MiB, W8_PG = WS_W8 + 12 * MiB;
constexpr float W8_SCALE = 32.0f;
constexpr size_t WS_H18 = 820 * MiB;
constexpr size_t W8_EFF = 836 * MiB;
constexpr size_t WS_END = 844 * MiB;
constexpr int CW_BAR = 4096;
constexpr float PEER_SU = 91.0f, PEER_SV = 4.75f;

constexpr int LDS_BYTES = 163840;
constexpr int RING_BYTES = 131072;
constexpr int MISC_OFF = 163840 - 256;

#define GAS __attribute__((address_space(1)))
#define LAS __attribute__((address_space(3)))
typedef unsigned short bf16;
typedef unsigned v4u __attribute__((ext_vector_type(4)));
typedef unsigned v2u __attribute__((ext_vector_type(2)));
typedef float f32x4 __attribute__((ext_vector_type(4)));
typedef float f32x16 __attribute__((ext_vector_type(16)));
typedef short bf16x8 __attribute__((ext_vector_type(8)));
typedef __bf16 bf16x2_t __attribute__((ext_vector_type(2)));
#define LDS_WAIT() asm volatile("s_waitcnt lgkmcnt(0)" ::: "memory")
#define VM_WAIT() asm volatile("s_waitcnt vmcnt(0)" ::: "memory")
using pg8::cvt_pk_bf16; using pg8::bf_lo; using pg8::bf_hi; using pg8::gelu_tanh;

#define XB_TMO      128
#define XB_XCNT(j)  (256  + 64 * (j))
#define XB_XSUB(j)  (1280 + 64 * (j))
#define XB_XGEN(j)  (2304 + 64 * (j))
#define XB_TOP      3328
#define XB_TOPGEN   3392
#define XCD_BAR_WORDS 3456
#define XB_SPIN_CAP (1u << 24)
__device__ __forceinline__ unsigned xb_ld(unsigned* p)              { return __hip_atomic_load(p, __ATOMIC_RELAXED, __HIP_MEMORY_SCOPE_AGENT); }
__device__ __forceinline__ unsigned xb_add(unsigned* p, unsigned v) { return __hip_atomic_fetch_add(p, v, __ATOMIC_RELAXED, __HIP_MEMORY_SCOPE_AGENT); }
__device__ __forceinline__ unsigned xb_xcc_id() { return (unsigned)__builtin_amdgcn_s_getreg((3 << 11) | 20) & 0xFu; }
#define XB_SPIN(cond, bar) do { unsigned _sp = 0; while (cond) { __builtin_amdgcn_s_sleep(1); \
    if ((++_sp & 255u) == 0u) { if (xb_ld(&(bar)[XB_TMO])) break; if (_sp > XB_SPIN_CAP) { atomicAdd(&(bar)[XB_TMO], 1u); break; } } } } while (0)
struct XcdBarrier { unsigned* bar; unsigned x; volatile LAS unsigned* st; };
__device__ __forceinline__ XcdBarrier xcd_barrier_post(unsigned* bar, volatile LAS unsigned* st) {
    XcdBarrier b; b.bar = bar; b.x = xb_xcc_id(); b.st = st;
    if (threadIdx.x == 0) (void)xb_add(&bar[XB_XCNT(b.x)], 1u);
    return b;
}
__device__ __forceinline__ void xcd_barrier_complete(unsigned* bar, unsigned x, unsigned& nloc, unsigned& nx) {
    const unsigned G = gridDim.x * gridDim.y * gridDim.z;
    unsigned sum, cnt, mine, sp = 0u;
    for (;;) {
        sum = 0u; cnt = 0u; mine = 0u;
#pragma unroll
        for (unsigned j = 0; j < 16; ++j) { const unsigned c = xb_ld(&bar[XB_XCNT(j)]); sum += c; cnt += (c > 0u) ? 1u : 0u; mine = (j == x) ? c : mine; }
        if (sum == G) break;
        __builtin_amdgcn_s_sleep(1);
        if ((++sp & 255u) == 0u) { if (xb_ld(&bar[XB_TMO])) break; if (sp > XB_SPIN_CAP) { atomicAdd(&bar[XB_TMO], 1u); break; } }
    }
    nloc = mine > 0u ? mine : 1u; nx = cnt > 0u ? cnt : 1u;
}
__device__ __forceinline__ void xcd_barrier(const XcdBarrier& b) {
    asm volatile("s_waitcnt vmcnt(0)" ::: "memory");
    __syncthreads();
    if (threadIdx.x == 0) {
        unsigned* bar = b.bar;
        __builtin_amdgcn_s_waitcnt(0);
        unsigned nloc = b.st[0], nx = b.st[1];
        if (nloc == 0u) { xcd_barrier_complete(bar, b.x, nloc, nx); b.st[0] = nloc; b.st[1] = nx; }
        const unsigned old = xb_add(&bar[XB_XSUB(b.x)], 1u);
        const unsigned gen = old / nloc;
        if (old + 1u == (gen + 1u) * nloc) {
            __builtin_amdgcn_fence(__ATOMIC_RELEASE, "agent");
            asm volatile("s_waitcnt vmcnt(0)" ::: "memory");
            const unsigned og = xb_add(&bar[XB_TOP], 1u);
            const unsigned tg = og / nx;
            if (og + 1u == (tg + 1u) * nx) xb_add(&bar[XB_TOPGEN], 1u);
            else XB_SPIN(xb_ld(&bar[XB_TOPGEN]) == tg, bar);
            __builtin_amdgcn_fence(__ATOMIC_ACQUIRE, "agent");
            xb_add(&bar[XB_XGEN(b.x)], 1u);
            asm volatile("s_waitcnt vmcnt(0)" ::: "memory");
        } else {
            XB_SPIN(xb_ld(&bar[XB_XGEN(b.x)]) == gen, bar);
            __builtin_amdgcn_fence(__ATOMIC_ACQUIRE, "agent");
            asm volatile("s_waitcnt vmcnt(0)" ::: "memory");
        }
    }
    __syncthreads();
}

enum PhaseType { P_PROLOGUE = 0, P_STORE = 1, P_SSM = 2, P_GLU = 3, P_LNMIX = 4, P_TOPK = 5, P_PEER = 6, P_PLE = 7, P_LNKV = 8, P_ATTN = 9, P_RES = 10 };
constexpr int MAX_PH = 48;
struct Args { const float* in[28]; float* out; unsigned char* ws; int ph_lo, ph_hi, use_bar, nph; unsigned char ph_type[MAX_PH]; unsigned char ph_arg[MAX_PH]; };
struct Frame {
    LAS unsigned char* lds;
    int tid, lane, wave, vcu, G, z, bx;
    const struct Args* A;
    float* out; unsigned char* ws;
};
__device__ __forceinline__ float wave_sum(float v) {
#pragma unroll
    for (int o = 1; o < 64; o <<= 1) v += __shfl_xor(v, o);
    return v;
}
template <int CTRL, int BANK> __device__ __forceinline__ float dpp_movf(float old, float v) {
    return __builtin_bit_cast(float, __builtin_amdgcn_update_dpp(__builtin_bit_cast(int, old), __builtin_bit_cast(int, v), CTRL, 0xF, BANK, true));
}
__device__ __forceinline__ float wave_sum_dpp(float v) {
    v += dpp_movf<0xB1, 0xF>(0.f, v);
    v += dpp_movf<0x4E, 0xF>(0.f, v);
    { float r = dpp_movf<0x104, 0x5>(0.f, v); r = dpp_movf<0x114, 0xA>(r, v); v += r; }
    v += dpp_movf<0x128, 0xF>(0.f, v);
    { const auto t = __builtin_amdgcn_permlane16_swap(__builtin_bit_cast(unsigned, v), __builtin_bit_cast(unsigned, v), false, false); const unsigned ta = t[0], tb = t[1]; v = __builtin_bit_cast(float, ta) + __builtin_bit_cast(float, tb); }
    { const auto t = __builtin_amdgcn_permlane32_swap(__builtin_bit_cast(unsigned, v), __builtin_bit_cast(unsigned, v), false, false); const unsigned ta = t[0], tb = t[1]; v = __builtin_bit_cast(float, ta) + __builtin_bit_cast(float, tb); }
    return v;
}
__device__ __forceinline__ unsigned f2bf(float f) { unsigned u = __builtin_bit_cast(unsigned, f); return (u + 0x7fffu + ((u >> 16) & 1u)) >> 16; }
__device__ __forceinline__ unsigned pk2(float lo, float hi) { return f2bf(lo) | (f2bf(hi) << 16); }

__device__ __forceinline__ unsigned pk4_fp8(float a, float b, float c, float d) { int w = 0; w = __builtin_amdgcn_cvt_pk_fp8_f32(a, b, w, false); w = __builtin_amdgcn_cvt_pk_fp8_f32(c, d, w, true); return (unsigned)w; }
__device__ __forceinline__ void p0_transpose_item(const float* W, int K, int N, bf16* WT, int glu, LAS float* scr, int item, int lane, unsigned char* WT8 = nullptr) {
    const int nblk = N / 32, kb = item / nblk, nb = item % nblk, k0 = 64 * kb, n0 = 32 * nb;
    int r0 = n0;
    if (glu) { const int bj = n0 >> 10, rem = n0 & 1023; r0 = 256 * (rem >> 7) + 128 * bj + (rem & 127); }
#pragma unroll 8
    for (int i = 0; i < 32; ++i) { const int kk = 2 * i + (lane >> 5); scr[kk * 33 + (lane & 31)] = W[(size_t)(k0 + kk) * N + n0 + (lane & 31)]; }
    LDS_WAIT(); asm volatile("" ::: "memory");
    const int c = lane & 7;
#pragma unroll
    for (int j = 0; j < 4; ++j) { const int n = (lane >> 3) + 8 * j; const LAS float* s = scr + (8 * c) * 33 + n;
        v4u o; o.x = pk2(s[0 * 33], s[1 * 33]); o.y = pk2(s[2 * 33], s[3 * 33]); o.z = pk2(s[4 * 33], s[5 * 33]); o.w = pk2(s[6 * 33], s[7 * 33]);
        if (WT) *(GAS v4u*)(WT + (size_t)(r0 + n) * K + k0 + 8 * c) = o;
        if (WT8) *(GAS v2u*)(WT8 + (size_t)(r0 + n) * K + k0 + 8 * c) = (v2u){pk4_fp8(s[0 * 33] * W8_SCALE, s[1 * 33] * W8_SCALE, s[2 * 33] * W8_SCALE, s[3 * 33] * W8_SCALE), pk4_fp8(s[4 * 33] * W8_SCALE, s[5 * 33] * W8_SCALE, s[6 * 33] * W8_SCALE, s[7 * 33] * W8_SCALE)}; }
    LDS_WAIT(); asm volatile("" ::: "memory");
}
__device__ __forceinline__ void cvt_stream_dual(Frame& F, const float* src, bf16* dst, unsigned char* dst8, size_t n) {
    const size_t nthr = (size_t)F.G * 512, gt = (size_t)F.bx * 512 + F.tid;
    for (size_t i = gt; i < n / 8; i += nthr) {
        const f32x4 a = *(const GAS f32x4*)(src + i * 8), b = *(const GAS f32x4*)(src + i * 8 + 4);
        v4u o; o.x = pk2(a.x, a.y); o.y = pk2(a.z, a.w); o.z = pk2(b.x, b.y); o.w = pk2(b.z, b.w);
        *(GAS v4u*)(dst + i * 8) = o;
        *(GAS v2u*)(dst8 + i * 8) = (v2u){pk4_fp8(a.x, a.y, a.z, a.w), pk4_fp8(b.x, b.y, b.z, b.w)};
    }
}
__device__ __forceinline__ void cvt_stream(Frame& F, const float* src, bf16* dst, size_t n) {
    const size_t nthr = (size_t)F.G * 512, gt = (size_t)F.bx * 512 + F.tid;
    for (size_t i = gt; i < n / 8; i += nthr) {
        const f32x4 a = *(const GAS f32x4*)(src + i * 8), b = *(const GAS f32x4*)(src + i * 8 + 4);
        v4u o; o.x = pk2(a.x, a.y); o.y = pk2(a.z, a.w); o.z = pk2(b.x, b.y); o.w = pk2(b.z, b.w);
        *(GAS v4u*)(dst + i * 8) = o;
    }
}
__device__ __forceinline__ void cvt_stream_fp4(Frame& F, const float* src, unsigned char* dst, size_t n, float scale) {
    const size_t nthr = (size_t)F.G * 512, gt = (size_t)F.bx * 512 + F.tid;
    for (size_t i = gt; i < n / 32; i += nthr) {
        unsigned w[4];
#pragma unroll
        for (int q = 0; q < 4; ++q) {
            const f32x4 a = *(const GAS f32x4*)(src + i * 32 + 8 * q) * scale, b = *(const GAS f32x4*)(src + i * 32 + 8 * q + 4) * scale;
            unsigned t = 0u;
            t = __builtin_amdgcn_cvt_scalef32_pk_fp4_f32(t, a.x, a.y, 1.0f, 0); t = __builtin_amdgcn_cvt_scalef32_pk_fp4_f32(t, a.z, a.w, 1.0f, 1);
            t = __builtin_amdgcn_cvt_scalef32_pk_fp4_f32(t, b.x, b.y, 1.0f, 2); t = __builtin_amdgcn_cvt_scalef32_pk_fp4_f32(t, b.z, b.w, 1.0f, 3);
            w[q] = t;
        }
        *(GAS v4u*)(dst + i * 16) = (v4u){w[0], w[1], w[2], w[3]};
    }
}
__device__ __forceinline__ unsigned pkbf2(float lo, float hi) { return cvt_pk_bf16(lo, hi); }
__device__ __forceinline__ void p0_weff_item(Frame& F, int item) {
    const int jb = item & 1, kb = (item >> 1) & 15, hh = (item >> 5) & 15, l = item >> 9;
    const int lane = F.lane, r32 = lane & 31, h = lane >> 5;
    const float* wq = F.A->in[21 + F.z] + (size_t)l * 1024 * 2048 + (size_t)(64 * kb + r32) * 2048 + 128 * hh + 8 * h;
    const float* ky = F.A->in[22 + (hh & 1) + F.z] + (size_t)l * 128 * 128 + (size_t)(64 * jb + r32) * 128 + 8 * h;
    f32x16 acc[2][2] = {};
#pragma unroll
    for (int ks = 0; ks < 8; ++ks) {
        bf16x8 af[2], bf[2];
#pragma unroll
        for (int a = 0; a < 2; ++a) { const f32x4 a0 = *(const GAS f32x4*)(wq + (size_t)a * 32 * 2048 + 16 * ks), a1 = *(const GAS f32x4*)(wq + (size_t)a * 32 * 2048 + 16 * ks + 4);
            af[a] = __builtin_bit_cast(bf16x8, (v4u){pkbf2(a0.x, a0.y), pkbf2(a0.z, a0.w), pkbf2(a1.x, a1.y), pkbf2(a1.z, a1.w)}); }
#pragma unroll
        for (int b = 0; b < 2; ++b) { const f32x4 b0 = *(const GAS f32x4*)(ky + (size_t)b * 32 * 128 + 16 * ks), b1 = *(const GAS f32x4*)(ky + (size_t)b * 32 * 128 + 16 * ks + 4);
            bf[b] = __builtin_bit_cast(bf16x8, (v4u){pkbf2(b0.x, b0.y), pkbf2(b0.z, b0.w), pkbf2(b1.x, b1.y), pkbf2(b1.z, b1.w)}); }
#pragma unroll
        for (int a = 0; a < 2; ++a)
#pragma unroll
            for (int b = 0; b < 2; ++b) acc[a][b] = __builtin_amdgcn_mfma_f32_32x32x16_bf16(af[a], bf[b], acc[a][b], 0, 0, 0);
    }
#pragma unroll
    for (int a = 0; a < 2; ++a)
#pragma unroll
        for (int b = 0; b < 2; ++b) {
            unsigned char* dst = (unsigned char*)(F.ws + W8_EFF) + (size_t)l * 2048 * 1024 + (size_t)(128 * hh + 64 * jb + 32 * b + r32) * 1024 + 64 * kb + 32 * a + 4 * h;
#pragma unroll
            for (int q = 0; q < 4; ++q) *(GAS unsigned*)(dst + 8 * q) = pk4_fp8(acc[a][b][4 * q] * W8_SCALE, acc[a][b][4 * q + 1] * W8_SCALE, acc[a][b][4 * q + 2] * W8_SCALE, acc[a][b][4 * q + 3] * W8_SCALE); }
}
__device__ __forceinline__ void p0_prologue(Frame& F) {
#ifndef PROBE_PRO
#define PROBE_PRO 0
#endif
    for (int rp = 0; rp < (PROBE_PRO == 4 ? 2 : 1); ++rp) {
    cvt_stream_dual(F, F.A->in[0 + F.z], (bf16*)(F.ws + WS_H), (unsigned char*)(F.ws + WS_H8), (size_t)TOK * DM);
    cvt_stream(F, F.A->in[1 + F.z], (bf16*)(F.ws + WS_PB), (size_t)DEPTH * TOK * 256); }
    LAS float* scr = (LAS float*)(F.lds + F.wave * 8704);
    const int gw = F.vcu * NWAVES + F.wave, NGW = F.G * NWAVES;
    constexpr int I_SQ = 16 * 32, I_GLU = 16 * 64, I_PW = 4 * 32;
    constexpr int NITEMS = 2 * I_SQ + 2 * I_GLU + I_GLU + 2 * I_SQ + 2 * I_SQ + 4 * I_SQ + 4 * I_PW;
    for (int rp = 0; rp < (PROBE_PRO == 2 ? 2 : 1); ++rp)
    for (int it = gw; it < NITEMS; it += NGW) {
        int r = it;
        if (r < 2 * I_SQ) { const int l = r / I_SQ; p0_transpose_item(F.A->in[6 + F.z] + (size_t)l * 1024 * 1024, 1024, 1024, nullptr, 0, scr, r % I_SQ, F.lane, (unsigned char*)(F.ws + W8_IN) + (size_t)l * 1024 * 1024); continue; } r -= 2 * I_SQ;
        if (r < 2 * I_GLU) { const int l = r / I_GLU; p0_transpose_item(F.A->in[15 + F.z] + (size_t)l * 1024 * 2048, 1024, 2048, nullptr, 1, scr, r % I_GLU, F.lane, (unsigned char*)(F.ws + W8_GLU) + (size_t)l * 2048 * 1024); continue; } r -= 2 * I_GLU;
        if (r < I_GLU) { p0_transpose_item(F.A->in[18 + F.z], 1024, 2048, nullptr, 0, scr, r, F.lane, (unsigned char*)(F.ws + W8_KV)); continue; } r -= I_GLU;
        if (r < 2 * I_SQ) { const int l = r / I_SQ; p0_transpose_item(F.A->in[19 + F.z] + (size_t)l * 1024 * 1024, 1024, 1024, nullptr, 0, scr, r % I_SQ, F.lane, (unsigned char*)(F.ws + W8_SQ) + (size_t)l * 1024 * 1024); continue; } r -= 2 * I_SQ;
        if (r < 2 * I_SQ) { const int l = r / I_SQ; p0_transpose_item(F.A->in[20 + F.z] + (size_t)l * 1024 * 1024, 1024, 1024, nullptr, 0, scr, r % I_SQ, F.lane, (unsigned char*)(F.ws + W8_SO) + (size_t)l * 1024 * 1024); continue; } r -= 2 * I_SQ;
        if (r < 4 * I_SQ) { const int l = r / I_SQ; p0_transpose_item(F.A->in[27 + F.z] + (size_t)l * 1024 * 1024, 1024, 1024, nullptr, 0, scr, r % I_SQ, F.lane, (unsigned char*)(F.ws + W8_PG) + (size_t)l * 1024 * 1024); continue; } r -= 4 * I_SQ;
        { const int l = r / I_PW; p0_transpose_item(F.A->in[26 + F.z] + (size_t)l * 256 * 1024, 256, 1024, (bf16*)(F.ws + WS_W_PW) + (size_t)l * 1024 * 256, 0, scr, r % I_PW, F.lane); }
    }
    for (int rp = 0; rp < (PROBE_PRO == 3 ? 2 : 1); ++rp)
    for (int it = gw; it < 2048; it += NGW) p0_weff_item(F, it);
}

__device__ __forceinline__ void ln_rows(Frame& F, const bf16* X, const float* g, const float* bb, bf16* O, unsigned char* O8 = nullptr) {
    const int gw = F.vcu * NWAVES + F.wave, NGW = F.G * NWAVES;
    float gg[16], bv[16];
    { const f32x4 a = *(const GAS f32x4*)(g + 8 * F.lane), b = *(const GAS f32x4*)(g + 8 * F.lane + 4), c = *(const GAS f32x4*)(g + 512 + 8 * F.lane), d = *(const GAS f32x4*)(g + 512 + 8 * F.lane + 4);
      gg[0] = a.x; gg[1] = a.y; gg[2] = a.z; gg[3] = a.w; gg[4] = b.x; gg[5] = b.y; gg[6] = b.z; gg[7] = b.w; gg[8] = c.x; gg[9] = c.y; gg[10] = c.z; gg[11] = c.w; gg[12] = d.x; gg[13] = d.y; gg[14] = d.z; gg[15] = d.w; }
    { const f32x4 a = *(const GAS f32x4*)(bb + 8 * F.lane), b = *(const GAS f32x4*)(bb + 8 * F.lane + 4), c = *(const GAS f32x4*)(bb + 512 + 8 * F.lane), d = *(const GAS f32x4*)(bb + 512 + 8 * F.lane + 4);
      bv[0] = a.x; bv[1] = a.y; bv[2] = a.z; bv[3] = a.w; bv[4] = b.x; bv[5] = b.y; bv[6] = b.z; bv[7] = b.w; bv[8] = c.x; bv[9] = c.y; bv[10] = c.z; bv[11] = c.w; bv[12] = d.x; bv[13] = d.y; bv[14] = d.z; bv[15] = d.w; }
    for (int m = gw; m < TOK; m += NGW) {
        const v4u xa = *(const GAS v4u*)(X + (size_t)m * DM + 8 * F.lane), xb = *(const GAS v4u*)(X + (size_t)m * DM + 512 + 8 * F.lane);
        float x[16] = {bf_lo(xa.x), bf_hi(xa.x), bf_lo(xa.y), bf_hi(xa.y), bf_lo(xa.z), bf_hi(xa.z), bf_lo(xa.w), bf_hi(xa.w), bf_lo(xb.x), bf_hi(xb.x), bf_lo(xb.y), bf_hi(xb.y), bf_lo(xb.z), bf_hi(xb.z), bf_lo(xb.w), bf_hi(xb.w)};
        float s = 0.f;
#pragma unroll
        for (int i = 0; i < 16; ++i) s += x[i];
        const float mean = wave_sum_dpp(s) * (1.f / DM); float q = 0.f;
#pragma unroll
        for (int i = 0; i < 16; ++i) { x[i] -= mean; q += x[i] * x[i]; }
        const float rstd = 1.0f / sqrtf(wave_sum_dpp(q) * (1.f / DM) + LN_EPS);
#pragma unroll
        for (int i = 0; i < 16; ++i) x[i] = x[i] * rstd * gg[i] + bv[i];
        v4u oa, ob; oa.x = pk2(x[0], x[1]); oa.y = pk2(x[2], x[3]); oa.z = pk2(x[4], x[5]); oa.w = pk2(x[6], x[7]); ob.x = pk2(x[8], x[9]); ob.y = pk2(x[10], x[11]); ob.z = pk2(x[12], x[13]); ob.w = pk2(x[14], x[15]);
        if (O) { *(GAS v4u*)(O + (size_t)m * DM + 8 * F.lane) = oa; *(GAS v4u*)(O + (size_t)m * DM + 512 + 8 * F.lane) = ob; }
        if (O8) { *(GAS v2u*)(O8 + (size_t)m * DM + 8 * F.lane) = (v2u){pk4_fp8(x[0], x[1], x[2], x[3]), pk4_fp8(x[4], x[5], x[6], x[7])};
                  *(GAS v2u*)(O8 + (size_t)m * DM + 512 + 8 * F.lane) = (v2u){pk4_fp8(x[8], x[9], x[10], x[11]), pk4_fp8(x[12], x[13], x[14], x[15])}; }
    }
}
struct TabCvt { const float* su; const float* sv; unsigned char* du; unsigned char* dv; int c, cf, stride, n; };
__device__ __forceinline__ void tabcvt_issue(TabCvt& T, int lane, f32x4 (&cv)[4]) {
    const bool live = T.c < T.n;
    if (live) { const int half = T.n >> 1; const float* src = (T.c < half ? T.su + (size_t)T.c * 1024 : T.sv + (size_t)(T.c - half) * 1024) + 16 * lane;
#pragma unroll
        for (int q = 0; q < 4; ++q) cv[q] = *(const GAS f32x4*)(src + 4 * q); }
    T.c += T.stride;
}
__device__ __forceinline__ unsigned i4q(float v) { float t = __builtin_fminf(__builtin_fmaxf(v * PEER_SU, -7.f), 7.f) + 12582912.0f; asm volatile("" : "+v"(t)); return __builtin_bit_cast(unsigned, t) & 15u; }
__device__ __forceinline__ unsigned pack8_i4(const f32x4& a, const f32x4& b) {
    return i4q(a.x) | (i4q(a.y) << 4) | (i4q(a.z) << 8) | (i4q(a.w) << 12) | (i4q(b.x) << 16) | (i4q(b.y) << 20) | (i4q(b.z) << 24) | (i4q(b.w) << 28);
}
__device__ __forceinline__ void tabcvt_finish(TabCvt& T, int lane, const f32x4 (&cv)[4]) {
    const bool live = T.cf < T.n;
    if (live) { const int half = T.n >> 1;
        unsigned w0 = 0u, w1 = 0u;
        if (T.cf < half) { w0 = pack8_i4(cv[0], cv[1]); w1 = pack8_i4(cv[2], cv[3]); }
        else { const float sc = PEER_SV;
            w0 = __builtin_amdgcn_cvt_scalef32_pk_fp4_f32(w0, cv[0].x * sc, cv[0].y * sc, 1.0f, 0); w0 = __builtin_amdgcn_cvt_scalef32_pk_fp4_f32(w0, cv[0].z * sc, cv[0].w * sc, 1.0f, 1);
            w0 = __builtin_amdgcn_cvt_scalef32_pk_fp4_f32(w0, cv[1].x * sc, cv[1].y * sc, 1.0f, 2); w0 = __builtin_amdgcn_cvt_scalef32_pk_fp4_f32(w0, cv[1].z * sc, cv[1].w * sc, 1.0f, 3);
            w1 = __builtin_amdgcn_cvt_scalef32_pk_fp4_f32(w1, cv[2].x * sc, cv[2].y * sc, 1.0f, 0); w1 = __builtin_amdgcn_cvt_scalef32_pk_fp4_f32(w1, cv[2].z * sc, cv[2].w * sc, 1.0f, 1);
            w1 = __builtin_amdgcn_cvt_scalef32_pk_fp4_f32(w1, cv[3].x * sc, cv[3].y * sc, 1.0f, 2); w1 = __builtin_amdgcn_cvt_scalef32_pk_fp4_f32(w1, cv[3].z * sc, cv[3].w * sc, 1.0f, 3); }
        unsigned char* dst = (T.cf < half ? T.du + (size_t)T.cf * 512 : T.dv + (size_t)(T.cf - half) * 512) + 8 * lane;
        *(GAS v2u*)dst = (v2u){w0, w1}; }
    T.cf += T.stride;
}
template <bool PASS1> __device__ __forceinline__ void ssm_pass(const bf16* U, bf16* Y, LAS unsigned char* stl, const float* dskip, size_t tok0, int g, int lane, int n, int hh, int i_row,
                                                                  const float (&a_re)[2], const float (&a_im)[2], const bf16x8 (&Bf)[4], const LAS unsigned char* CFL, float (&s_re)[2], float (&s_im)[2]) {
    const int c0 = 16 * g + 4 * hh;
    bf16x8 ua_n = *(const GAS bf16x8*)(U + tok0 * DM + 16 * g + 8 * hh);
    v2u u0_n = {}, u1_n = {};
    if (PASS1) { u0_n = *(const GAS v2u*)(U + tok0 * DM + c0); u1_n = *(const GAS v2u*)(U + tok0 * DM + c0 + 8); }
#pragma unroll 1
    for (int tile = 0; tile < 16; ++tile) {
        const size_t tok = tok0 + tile * 16;
        const bf16x8 ua = ua_n; const v2u u0 = u0_n, u1 = u1_n;
        { const size_t tokn = tok0 + ((tile + 1) & 15) * 16;
          ua_n = *(const GAS bf16x8*)(U + tokn * DM + 16 * g + 8 * hh);
          if (PASS1) { u0_n = *(const GAS v2u*)(U + tokn * DM + c0); u1_n = *(const GAS v2u*)(U + tokn * DM + c0 + 8); } }
        f32x16 acc[4];
#pragma unroll
        for (int nb = 0; nb < 4; ++nb) { f32x16 z = {}; acc[nb] = __builtin_amdgcn_mfma_f32_32x32x16_bf16(ua, Bf[nb], z, 0, 0, 0); }
#pragma unroll
        for (int pb = 0; pb < 2; ++pb) {
#pragma unroll
            for (int r = 0; r < 16; ++r) {
                float t0 = fmaf(-a_im[pb], s_im[pb], acc[2 * pb][r]); asm volatile("" : "+v"(t0));
                float t1 = fmaf(a_im[pb], s_re[pb], acc[2 * pb + 1][r]); asm volatile("" : "+v"(t1));
                float nre = fmaf(a_re[pb], s_re[pb], t0); asm volatile("" : "+v"(nre));
                float nim = fmaf(a_re[pb], s_im[pb], t1); asm volatile("" : "+v"(nim));
                s_re[pb] = nre; s_im[pb] = nim;
                if (PASS1) { const int irow = (r & 3) + 8 * (r >> 2) + 4 * hh; *(LAS unsigned*)(stl + irow * 272 + (32 * pb + n) * 4) = cvt_pk_bf16(nre, nim); }
            }
        }
        if (PASS1) {
            LDS_WAIT();
            f32x16 yv = {};
#pragma unroll
            for (int ks = 0; ks < 8; ++ks) { const bf16x8 sb = *(const LAS bf16x8*)(stl + i_row * 272 + (16 * ks + 8 * hh) * 2); const bf16x8 cf = *(const LAS bf16x8*)(CFL + (ks * 64 + lane) * 16); yv = __builtin_amdgcn_mfma_f32_32x32x16_bf16(cf, sb, yv, 0, 0, 0); }
            const f32x4 d0 = *(const GAS f32x4*)(dskip + c0), d1 = *(const GAS f32x4*)(dskip + c0 + 8);
            float o[8];
            o[0] = gelu_tanh(yv[0] + d0.x * bf_lo(u0.x)); o[1] = gelu_tanh(yv[1] + d0.y * bf_hi(u0.x)); o[2] = gelu_tanh(yv[2] + d0.z * bf_lo(u0.y)); o[3] = gelu_tanh(yv[3] + d0.w * bf_hi(u0.y));
            o[4] = gelu_tanh(yv[4] + d1.x * bf_lo(u1.x)); o[5] = gelu_tanh(yv[5] + d1.y * bf_hi(u1.x)); o[6] = gelu_tanh(yv[6] + d1.z * bf_lo(u1.y)); o[7] = gelu_tanh(yv[7] + d1.w * bf_hi(u1.y));
            *(GAS unsigned*)((unsigned char*)Y + tok * DM + c0) = pk4_fp8(o[0], o[1], o[2], o[3]);
            *(GAS unsigned*)((unsigned char*)Y + tok * DM + c0 + 8) = pk4_fp8(o[4], o[5], o[6], o[7]);
            LDS_WAIT();
        }
    }
}
__device__ __forceinline__ void ssm_phase(Frame& F, int layer) {
    if (layer == 0) {
        TabCvt TC; TC.su = F.A->in[24 + F.z]; TC.sv = F.A->in[25 + F.z]; TC.du = (unsigned char*)(F.ws + WS_TABU); TC.dv = (unsigned char*)(F.ws + WS_TABV);
        TC.c = F.vcu * NWAVES + F.wave; TC.cf = TC.c; TC.stride = F.G * NWAVES; TC.n = 2 * 16384;
        f32x4 cvA[4], cvB[4];
        tabcvt_issue(TC, F.lane, cvA);
        while (TC.cf < TC.n) { tabcvt_issue(TC, F.lane, cvB); tabcvt_finish(TC, F.lane, cvA); tabcvt_issue(TC, F.lane, cvA); tabcvt_finish(TC, F.lane, cvB); }
    }
    const bf16* U = (const bf16*)(F.ws + WS_U); bf16* Y = (bf16*)(F.ws + WS_Y);
    const int lane = F.lane, n = lane & 31, hh = lane >> 5, wave = F.wave;
    LAS unsigned char* stl = F.lds + wave * 8704;
    LAS float* E = (LAS float*)(F.lds + 8 * 8704);
    for (int bg = F.vcu; bg < BATCH * 64; bg += F.G) {
        const int b = bg >> 6, g = bg & 63, lg = layer * 64 + g;
        const float dt = expf(F.A->in[9 + F.z][lg]);
        float a_re[2], a_im[2]; bf16x8 Bf[4];
#pragma unroll
        for (int pb = 0; pb < 2; ++pb) {
            const int p = 32 * pb + n;
            const float lre = F.A->in[7 + F.z][lg * 64 + p], lim = F.A->in[8 + F.z][lg * 64 + p];
            const float mag = expf(lre * dt); float sn, cs; sincosf(lim * dt, &sn, &cs);
            a_re[pb] = mag * cs; a_im[pb] = mag * sn;
            const float nr = a_re[pb] - 1.0f, ni = a_im[pb], den = 1.0f / (lre * lre + lim * lim);
            const float cr = (nr * lre + ni * lim) * den, ci = (ni * lre - nr * lim) * den;
            const float* br = F.A->in[10 + F.z] + ((size_t)lg * 64 + p) * 16 + 8 * hh; const float* bi = F.A->in[11 + F.z] + ((size_t)lg * 64 + p) * 16 + 8 * hh;
            const f32x4 br0 = *(const GAS f32x4*)br, br1 = *(const GAS f32x4*)(br + 4), bi0 = *(const GAS f32x4*)bi, bi1 = *(const GAS f32x4*)(bi + 4);
            const float rr[8] = {br0.x, br0.y, br0.z, br0.w, br1.x, br1.y, br1.z, br1.w}, ii[8] = {bi0.x, bi0.y, bi0.z, bi0.w, bi1.x, bi1.y, bi1.z, bi1.w};
            unsigned wre[4], wim[4];
#pragma unroll
            for (int j = 0; j < 4; ++j) { const float r0 = rr[2 * j], i0 = ii[2 * j], r1 = rr[2 * j + 1], i1 = ii[2 * j + 1];
                wre[j] = pk2(cr * r0 - ci * i0, cr * r1 - ci * i1); wim[j] = pk2(cr * i0 + ci * r0, cr * i1 + ci * r1); }
            Bf[2 * pb] = __builtin_bit_cast(bf16x8, (v4u){wre[0], wre[1], wre[2], wre[3]});
            Bf[2 * pb + 1] = __builtin_bit_cast(bf16x8, (v4u){wim[0], wim[1], wim[2], wim[3]});
        }
        LAS unsigned char* CFL = F.lds + 8 * 8704 + 8192;
        if (wave == 0) { const int cr_ = n & 15; const float zm = (n < 16) ? 1.0f : 0.0f;
          const float* cre = F.A->in[12 + F.z] + ((size_t)lg * 16 + cr_) * 64 + 4 * hh; const float* cim = F.A->in[13 + F.z] + ((size_t)lg * 16 + cr_) * 64 + 4 * hh;
          f32x4 cr4[8], ci4[8];
#pragma unroll
          for (int ks = 0; ks < 8; ++ks) { cr4[ks] = *(const GAS f32x4*)(cre + 8 * ks); ci4[ks] = *(const GAS f32x4*)(cim + 8 * ks); }
#pragma unroll
          for (int ks = 0; ks < 8; ++ks) { const f32x4 a = cr4[ks] * zm, c = ci4[ks] * (-zm);
              *(LAS v4u*)(CFL + (ks * 64 + lane) * 16) = (v4u){pk2(a.x, c.x), pk2(a.y, c.y), pk2(a.z, c.z), pk2(a.w, c.w)}; } }
        const int seg_own = 2 * wave + hh;
        const int i_row = n, seg_ld = 2 * wave + ((i_row >> 2) & 1), tau_ld = (i_row & 3) + 4 * (i_row >> 3);
        const size_t tok0 = (size_t)b * SEQ + seg_ld * 256 + tau_ld;
        const float* dskip = F.A->in[14 + F.z] + layer * 1024;
        float s_re[2] = {0.f, 0.f}, s_im[2] = {0.f, 0.f};
        ssm_pass<false>(U, Y, stl, dskip, tok0, g, lane, n, hh, i_row, a_re, a_im, Bf, CFL, s_re, s_im);
#pragma unroll
        for (int pb = 0; pb < 2; ++pb) { E[(seg_own * 64 + 32 * pb + n) * 2] = s_re[pb]; E[(seg_own * 64 + 32 * pb + n) * 2 + 1] = s_im[pb]; }
        LDS_WAIT(); __syncthreads();
#pragma unroll
        for (int pb = 0; pb < 2; ++pb) {
            float Ar = a_re[pb], Ai = a_im[pb];
#pragma unroll
            for (int q = 0; q < 8; ++q) { float t = Ar * Ar - Ai * Ai; asm volatile("" : "+v"(t)); Ai = 2.0f * Ar * Ai; asm volatile("" : "+v"(Ai)); Ar = t; }
            float sr = 0.f, si = 0.f;
            for (int j = 0; j < 15; ++j) {
                const float er = E[(j * 64 + 32 * pb + n) * 2], ei = E[(j * 64 + 32 * pb + n) * 2 + 1];
                float tr = Ar * sr - Ai * si + er; asm volatile("" : "+v"(tr)); float ti = Ar * si + Ai * sr + ei; asm volatile("" : "+v"(ti));
                if (j < seg_own) { sr = tr; si = ti; }
            }
            s_re[pb] = sr; s_im[pb] = si;
        }
        __syncthreads();
        ssm_pass<true>(U, Y, stl, dskip, tok0, g, lane, n, hh, i_row, a_re, a_im, Bf, CFL, s_re, s_im);
        __syncthreads();
    }
}

__device__ __forceinline__ void attn_wave_unit(Frame& F, int b, int hd, int qt) {
    const bf16* Q = (const bf16*)(F.ws + WS_U); const bf16* K = (const bf16*)(F.ws + WS_KB); const bf16* Vt = (const bf16*)(F.ws + WS_VT); bf16* O = (bf16*)(F.ws + WS_Y);
    constexpr float ATT_EXIT = 28.0f;
    const int lane = F.lane, n = lane & 31, hh = lane >> 5;
    const size_t qrow = (size_t)b * SEQ + 32 * qt + n;
    bf16x8 qf[4];
#pragma unroll
    for (int ks = 0; ks < 4; ++ks) qf[ks] = *(const GAS bf16x8*)(Q + qrow * DM + 64 * hd + 16 * ks + 8 * hh);
    f32x16 o[2]; o[0] = f32x16{}; o[1] = f32x16{};
    float racc = 0.f;
    const int qrel = 32 * qt, myq = qrel + n;
    const int keyi = (n & 3) + 4 * (n >> 3) + 16 * ((n >> 2) & 1);
    const bf16* kbase = K + ((size_t)b * SEQ + keyi) * DM + 64 * hd + 8 * hh;
    const bf16* vbase = Vt + (size_t)(64 * hd + n) * TOK + (size_t)b * SEQ + 16 * hh;
    int T = (qrel + 30) >> 6;
    bf16x8 kf[2][4];
#pragma unroll
    for (int u = 0; u < 2; ++u)
#pragma unroll
        for (int ks = 0; ks < 4; ++ks) kf[u][ks] = *(const GAS bf16x8*)(kbase + (size_t)(64 * T + 32 * u) * DM + 16 * ks);
    for (; T >= 0; --T) {
        const int k0 = 64 * T;
        f32x16 s0 = {}, s1 = {};
#pragma unroll
        for (int ks = 0; ks < 4; ++ks) { s0 = __builtin_amdgcn_mfma_f32_32x32x16_bf16(kf[0][ks], qf[ks], s0, 0, 0, 0); s1 = __builtin_amdgcn_mfma_f32_32x32x16_bf16(kf[1][ks], qf[ks], s1, 0, 0, 0); }
        bf16x8 vf[2][2][2];
#pragma unroll
        for (int u = 0; u < 2; ++u)
#pragma unroll
            for (int sx = 0; sx < 2; ++sx)
#pragma unroll
                for (int db = 0; db < 2; ++db) vf[u][sx][db] = *(const GAS bf16x8*)(vbase + (size_t)(32 * db) * TOK + k0 + 32 * u + 8 * sx);
        { const int Tn = T > 0 ? T - 1 : 0;
#pragma unroll
          for (int u = 0; u < 2; ++u)
#pragma unroll
              for (int ks = 0; ks < 4; ++ks) kf[u][ks] = *(const GAS bf16x8*)(kbase + (size_t)(64 * Tn + 32 * u) * DM + 16 * ks); }
        const bool need_mask = (k0 + 63 >= qrel);
        float sp[2][16], z[2][16];
#pragma unroll
        for (int r = 0; r < 16; ++r) { const float za = fminf(s0[r], 60.0f), zb = fminf(s1[r], 60.0f); z[0][r] = za; z[1][r] = zb;
            sp[0][r] = __builtin_amdgcn_logf(1.0f + __builtin_amdgcn_exp2f(za)); sp[1][r] = __builtin_amdgcn_logf(1.0f + __builtin_amdgcn_exp2f(zb)); }
        if (need_mask) {
#pragma unroll
            for (int u = 0; u < 2; ++u)
#pragma unroll
                for (int r = 0; r < 16; ++r) { const int key = k0 + 32 * u + 16 * hh + r; if (key >= myq) { sp[u][r] = 0.f; z[u][r] = -1e30f; } }
        }
        float T0 = 0.f, T1 = 0.f;
#pragma unroll
        for (int r = 0; r < 16; ++r) { T0 += sp[0][r]; T1 += sp[1][r]; }
        const float oT0 = __shfl_xor(T0, 32), oT1 = __shfl_xor(T1, 32);
        const float off1 = racc + (hh ? 0.f : oT1);
        const float off0 = racc + T1 + oT1 + (hh ? 0.f : oT0);
        racc += T0 + T1 + oT0 + oT1;
        unsigned pw[2][8];
        { float run = off1;
#pragma unroll
          for (int r = 15; r >= 0; --r) { run += sp[1][r]; z[1][r] = __builtin_amdgcn_exp2f(z[1][r] - run); }
          run = off0;
#pragma unroll
          for (int r = 15; r >= 0; --r) { run += sp[0][r]; z[0][r] = __builtin_amdgcn_exp2f(z[0][r] - run); } }
#pragma unroll
        for (int u = 0; u < 2; ++u)
#pragma unroll
            for (int q = 0; q < 8; ++q) pw[u][q] = cvt_pk_bf16(z[u][2 * q], z[u][2 * q + 1]);
#pragma unroll
        for (int u = 0; u < 2; ++u)
#pragma unroll
            for (int sx = 0; sx < 2; ++sx) { const bf16x8 af = __builtin_bit_cast(bf16x8, (v4u){pw[u][4 * sx], pw[u][4 * sx + 1], pw[u][4 * sx + 2], pw[u][4 * sx + 3]});
#pragma unroll
                for (int db = 0; db < 2; ++db) o[db] = __builtin_amdgcn_mfma_f32_32x32x16_bf16(af, vf[u][sx][db], o[db], 0, 0, 0); }
        if (__all(racc >= ATT_EXIT)) break;
    }
#pragma unroll
    for (int db = 0; db < 2; ++db)
#pragma unroll
        for (int r = 0; r < 16; ++r) { const int qr = (r & 3) + 8 * (r >> 2) + 4 * hh;
            ((unsigned char*)O)[((size_t)b * SEQ + 32 * qt + qr) * DM + 64 * hd + 32 * db + n] = (unsigned char)(pk4_fp8(o[db][r], 0.f, 0.f, 0.f) & 0xffu); }
}
__device__ __forceinline__ void attn_phase(Frame& F) {
    const int gw = F.vcu * NWAVES + F.wave, NGW = F.G * NWAVES;
#pragma unroll 1
    for (int uidx = gw; uidx < 64 * 128; uidx += NGW) { const int bh = uidx >> 7; attn_wave_unit(F, bh >> 4, bh & 15, uidx & 127); }
}

typedef float f32x2 __attribute__((ext_vector_type(2)));
typedef _Float16 h16x2 __attribute__((ext_vector_type(2)));
template <int K, class T> __device__ __forceinline__ T xcomb(T a, T b, int lane) {
    const bool hi = (lane >> K) & 1; const T keep = hi ? b : a, send = hi ? a : b;
    return keep + __shfl_xor(send, 1 << K);
}
__device__ __forceinline__ void fp4x16_to_f32(const v2u& r, f32x2 (&f)[8]) {
    const unsigned w0 = r.x, w1 = r.y;
    f[0] = __builtin_amdgcn_cvt_scalef32_pk_f32_fp4(w0, 1.0f, 0); f[1] = __builtin_amdgcn_cvt_scalef32_pk_f32_fp4(w0, 1.0f, 1);
    f[2] = __builtin_amdgcn_cvt_scalef32_pk_f32_fp4(w0, 1.0f, 2); f[3] = __builtin_amdgcn_cvt_scalef32_pk_f32_fp4(w0, 1.0f, 3);
    f[4] = __builtin_amdgcn_cvt_scalef32_pk_f32_fp4(w1, 1.0f, 0); f[5] = __builtin_amdgcn_cvt_scalef32_pk_f32_fp4(w1, 1.0f, 1);
    f[6] = __builtin_amdgcn_cvt_scalef32_pk_f32_fp4(w1, 1.0f, 2); f[7] = __builtin_amdgcn_cvt_scalef32_pk_f32_fp4(w1, 1.0f, 3);
}
typedef unsigned bl_v2u __attribute__((__vector_size__(8)));
__device__ __forceinline__ void peer_load8(__amdgpu_buffer_rsrc_t tab, int idv, int e0, int lane, v2u (&R)[8]) {
    int so[8];
#pragma unroll
    for (int i = 0; i < 8; ++i) so[i] = __builtin_amdgcn_readlane(idv, e0 + i) << 9;
    __builtin_amdgcn_sched_barrier(0);
#pragma unroll
    for (int i = 0; i < 8; ++i) { const bl_v2u t = __builtin_amdgcn_raw_buffer_load_b64(tab, 8 * lane, so[i], 0); R[i] = (v2u){t[0], t[1]}; }
    __builtin_amdgcn_sched_barrier(0);
}
template <int K> __device__ __forceinline__ int xcomb_dpp(int a, int b, int lane) {
    const bool hi = (lane >> K) & 1; const int keep = hi ? b : a, send = hi ? a : b; int recv;
    if (K == 0) recv = __builtin_amdgcn_update_dpp(0, send, 0xB1, 0xF, 0xF, true);
    else if (K == 1) recv = __builtin_amdgcn_update_dpp(0, send, 0x4E, 0xF, 0xF, true);
    else { recv = __builtin_amdgcn_update_dpp(0, send, 0x104, 0xF, 0x5, true);
           recv = __builtin_amdgcn_update_dpp(recv, send, 0x114, 0xF, 0xA, true); }
    return keep + recv;
}
__device__ __forceinline__ float peer_dot8(const v2u (&R)[8], const v2u& xhi, const v2u& xlo, int lane) {
    int p[8];
#pragma unroll
    for (int i = 0; i < 8; ++i) { const int r0 = (int)R[i].x, r1 = (int)R[i].y;
        int h = __builtin_amdgcn_sdot8(r0, (int)xhi.x, 0, false); h = __builtin_amdgcn_sdot8(r1, (int)xhi.y, h, false);
        int l = __builtin_amdgcn_sdot8(r0, (int)xlo.x, 0, false); l = __builtin_amdgcn_sdot8(r1, (int)xlo.y, l, false);
        p[i] = (h << 4) + l; __builtin_amdgcn_sched_barrier(0); }
    int q[4];
#pragma unroll
    for (int i = 0; i < 4; ++i) q[i] = xcomb_dpp<0>(p[2 * i], p[2 * i + 1], lane);
    const int r0 = xcomb_dpp<1>(q[0], q[1], lane), r1 = xcomb_dpp<1>(q[2], q[3], lane);
    int v = xcomb_dpp<2>(r0, r1, lane);
    v += __builtin_amdgcn_update_dpp(0, v, 0x128, 0xF, 0xF, true);
    { const auto t = __builtin_amdgcn_permlane16_swap((unsigned)v, (unsigned)v, false, false); v = (int)(t[0] + t[1]); }
    { const auto t = __builtin_amdgcn_permlane32_swap((unsigned)v, (unsigned)v, false, false); v = (int)(t[0] + t[1]); }
    return (float)v;
}
__device__ __forceinline__ void peer_fma8(const v2u (&R)[8], unsigned wvh, int e0, h16x2 (&o)[8]) {
#pragma unroll
    for (int i = 0; i < 8; ++i) { const unsigned wt = (unsigned)__builtin_amdgcn_readlane((int)wvh, e0 + i); const h16x2 w2 = __builtin_bit_cast(h16x2, wt);
        const unsigned w0 = R[i].x, w1 = R[i].y; h16x2 f[8];
        f[0] = __builtin_amdgcn_cvt_scalef32_pk_f16_fp4(w0, 1.0f, 0); f[1] = __builtin_amdgcn_cvt_scalef32_pk_f16_fp4(w0, 1.0f, 1);
        f[2] = __builtin_amdgcn_cvt_scalef32_pk_f16_fp4(w0, 1.0f, 2); f[3] = __builtin_amdgcn_cvt_scalef32_pk_f16_fp4(w0, 1.0f, 3);
        f[4] = __builtin_amdgcn_cvt_scalef32_pk_f16_fp4(w1, 1.0f, 0); f[5] = __builtin_amdgcn_cvt_scalef32_pk_f16_fp4(w1, 1.0f, 1);
        f[6] = __builtin_amdgcn_cvt_scalef32_pk_f16_fp4(w1, 1.0f, 2); f[7] = __builtin_amdgcn_cvt_scalef32_pk_f16_fp4(w1, 1.0f, 3);
#pragma unroll
        for (int k = 0; k < 8; ++k) o[k] = __builtin_elementwise_fma(w2, f[k], o[k]);
        __builtin_amdgcn_sched_barrier(0); }
}
__device__ __forceinline__ void peer_phase(Frame& F, int layer) {
    const bf16* H1 = (const bf16*)(F.ws + WS_H1); bf16* H2 = (bf16*)(F.ws + WS_H2);
    const __amdgpu_buffer_rsrc_t TU = __builtin_amdgcn_make_buffer_rsrc((void*)(F.ws + WS_TABU + (size_t)layer * 16384 * 512), (short)0, 16384 * 512, 0x00020000);
    const __amdgpu_buffer_rsrc_t TV = __builtin_amdgcn_make_buffer_rsrc((void*)(F.ws + WS_TABV + (size_t)layer * 16384 * 512), (short)0, 16384 * 512, 0x00020000);
    const int* IDX = (const int*)(F.ws + WS_IDX); const float* GATE = (const float*)(F.ws + WS_GATE);
    const float* g = F.A->in[4 + F.z] + layer * 1024; const float* bb = F.A->in[5 + F.z] + layer * 1024;
    const int lane = F.lane, gw = F.vcu * NWAVES + F.wave, NGW = F.G * NWAVES;
    v2u B0[8], B1[8], B2[8], B3[8];
    TabCvt TC; { const size_t lo = (size_t)(layer + 1) * 16384 * 1024;
        TC.su = F.A->in[24 + F.z] + lo; TC.sv = F.A->in[25 + F.z] + lo; TC.du = (unsigned char*)(F.ws + WS_TABU) + lo / 2; TC.dv = (unsigned char*)(F.ws + WS_TABV) + lo / 2;
        TC.c = gw; TC.cf = gw; TC.stride = NGW; TC.n = (layer + 1 < DEPTH) ? 2 * 16384 : 0; }
    f32x4 cvA[4], cvB[4];
    int id0 = 0, id1 = 0;
    if (gw < TOK) { id0 = IDX[(size_t)gw * 128 + lane]; id1 = IDX[(size_t)gw * 128 + 64 + lane];
        peer_load8(TU, id0, 0, lane, B0); peer_load8(TU, id0, 8, lane, B1); peer_load8(TU, id0, 16, lane, B2); }
    tabcvt_issue(TC, lane, cvA); tabcvt_issue(TC, lane, cvB);
    for (int t = gw; t < TOK; t += NGW) {
        const int tn = (t + NGW < TOK) ? t + NGW : t;
        const int nid0 = IDX[(size_t)tn * 128 + lane], nid1 = IDX[(size_t)tn * 128 + 64 + lane];
        const float g0 = GATE[(size_t)t * 128 + lane], g1 = GATE[(size_t)t * 128 + 64 + lane];
        const v4u xa = *(const GAS v4u*)(H1 + (size_t)t * DM + 16 * lane), xb = *(const GAS v4u*)(H1 + (size_t)t * DM + 16 * lane + 8);
        f32x2 x[8] = {{bf_lo(xa.x), bf_hi(xa.x)}, {bf_lo(xa.y), bf_hi(xa.y)}, {bf_lo(xa.z), bf_hi(xa.z)}, {bf_lo(xa.w), bf_hi(xa.w)}, {bf_lo(xb.x), bf_hi(xb.x)}, {bf_lo(xb.y), bf_hi(xb.y)}, {bf_lo(xb.z), bf_hi(xb.z)}, {bf_lo(xb.w), bf_hi(xb.w)}};
        v2u xqh = {0u, 0u}, xql = {0u, 0u};
#pragma unroll
        for (int i = 0; i < 16; ++i) { const float xv = (i & 1) ? x[i >> 1].y : x[i >> 1].x;
            float qf = __builtin_fminf(__builtin_fmaxf(xv * 16.f, -120.f), 119.f) + 12582912.0f; asm volatile("" : "+v"(qf)); const unsigned q = __builtin_bit_cast(unsigned, qf);
            const unsigned lo = q & 15u, hi = ((q + 8u) >> 4) & 15u;
            if (i < 8) { xql.x |= lo << (4 * i); xqh.x |= hi << (4 * i); } else { xql.y |= lo << (4 * (i - 8)); xqh.y |= hi << (4 * (i - 8)); } }
#define PEER_LOADB(buf, b) do { const int b_ = (b); if (b_ < 32) peer_load8((b_ & 16) ? TV : TU, (b_ & 8) ? id1 : id0, 8 * (b_ & 7), lane, buf); else peer_load8(TU, nid0, 8 * (b_ & 7), lane, buf); } while (0)
#define PEER_DOTB(buf, b) do { const int b_ = (b); const float r_ = peer_dot8(buf, xqh, xql, lane); const bool mine_ = (lane >> 3) == (b_ & 7); if (b_ & 8) act1 = mine_ ? r_ : act1; else act0 = mine_ ? r_ : act0; } while (0)
#define PEER_FMAB(buf, b) do { const int b_ = (b); peer_fma8(buf, (b_ & 8) ? w1h : w0h, 8 * (b_ & 7), o); } while (0)
        float act0 = 0.f, act1 = 0.f;
#pragma unroll 1
        for (int j = 0; j < 16; j += 4) {
            PEER_LOADB(B3, j + 3); PEER_DOTB(B0, j);
            PEER_LOADB(B0, j + 4); PEER_DOTB(B1, j + 1);
            PEER_LOADB(B1, j + 5); PEER_DOTB(B2, j + 2);
            PEER_LOADB(B2, j + 6); PEER_DOTB(B3, j + 3);
        }
        const float w0 = g0 * gelu_tanh(act0 * (1.0f / (16.f * PEER_SU))) * (1.0f / PEER_SV), w1 = g1 * gelu_tanh(act1 * (1.0f / (16.f * PEER_SU))) * (1.0f / PEER_SV);
        unsigned w0h, w1h; { const _Float16 a = (_Float16)w0, b = (_Float16)w1; const h16x2 pa = {a, a}, pb = {b, b}; w0h = __builtin_bit_cast(unsigned, pa); w1h = __builtin_bit_cast(unsigned, pb); }
        h16x2 o[8];
#pragma unroll
        for (int i = 0; i < 8; ++i) o[i] = (h16x2){(_Float16)0.f, (_Float16)0.f};
#pragma unroll 1
        for (int j = 16; j < 32; j += 4) {
            PEER_LOADB(B3, j + 3); PEER_FMAB(B0, j);
            PEER_LOADB(B0, j + 4); PEER_FMAB(B1, j + 1);
            PEER_LOADB(B1, j + 5); PEER_FMAB(B2, j + 2);
            PEER_LOADB(B2, j + 6); PEER_FMAB(B3, j + 3);
        }
#undef PEER_LOADB
#undef PEER_DOTB
#undef PEER_FMAB
        id0 = nid0; id1 = nid1;
        tabcvt_finish(TC, lane, cvA); tabcvt_finish(TC, lane, cvB);
        tabcvt_issue(TC, lane, cvA); tabcvt_issue(TC, lane, cvB);
        float y[16]; float sm = 0.f;
#pragma unroll
        for (int i = 0; i < 8; ++i) { y[2 * i] = pg8::ALPHA_F * x[i].x + (float)o[i].x; y[2 * i + 1] = pg8::ALPHA_F * x[i].y + (float)o[i].y; sm += y[2 * i] + y[2 * i + 1]; }
        const float mean = wave_sum(sm) * (1.f / DM); float q = 0.f;
#pragma unroll
        for (int i = 0; i < 16; ++i) { y[i] -= mean; q += y[i] * y[i]; }
        const float rstd = 1.0f / sqrtf(wave_sum(q) * (1.f / DM) + LN_EPS);
#pragma unroll
        for (int c = 0; c < 4; ++c) { const f32x4 gv = *(const GAS f32x4*)(g + 16 * lane + 4 * c), bv = *(const GAS f32x4*)(bb + 16 * lane + 4 * c);
            y[4 * c] = y[4 * c] * rstd * gv.x + bv.x; y[4 * c + 1] = y[4 * c + 1] * rstd * gv.y + bv.y; y[4 * c + 2] = y[4 * c + 2] * rstd * gv.z + bv.z; y[4 * c + 3] = y[4 * c + 3] * rstd * gv.w + bv.w; }
        v4u oa, ob; oa.x = pk2(y[0], y[1]); oa.y = pk2(y[2], y[3]); oa.z = pk2(y[4], y[5]); oa.w = pk2(y[6], y[7]); ob.x = pk2(y[8], y[9]); ob.y = pk2(y[10], y[11]); ob.z = pk2(y[12], y[13]); ob.w = pk2(y[14], y[15]);
        *(GAS v4u*)(H2 + (size_t)t * DM + 16 * lane) = oa; *(GAS v4u*)(H2 + (size_t)t * DM + 16 * lane + 8) = ob;
        *(GAS v4u*)((unsigned char*)(F.ws + WS_H28) + (size_t)t * DM + 16 * lane) = (v4u){pk4_fp8(y[0], y[1], y[2], y[3]), pk4_fp8(y[4], y[5], y[6], y[7]), pk4_fp8(y[8], y[9], y[10], y[11]), pk4_fp8(y[12], y[13], y[14], y[15])};
    }
    tabcvt_finish(TC, lane, cvA); tabcvt_finish(TC, lane, cvB);
    while (TC.cf < TC.n) { tabcvt_issue(TC, lane, cvA); tabcvt_finish(TC, lane, cvA); }
}

template <class Epi> __device__ __forceinline__ void run_gemm(Frame& F, const bf16* A, const bf16* Bt, int M, int N, int K, const Epi& E, int pw = 0) {
    pg8::Gemm g{A, Bt, M, N, K}; pg8::StaticOrder S; S.init(M, N, F.G, pw ? F.vcu : F.bx); S.pw = pw; if (pw) S.nwg = 1024;
    int t = F.tid; asm volatile("" : "+v"(t));
    pg8::gemm_phase<Epi, pg8::StaticOrder, true, true>(F.lds, g, S, E, t);
}

template <class Epi> __device__ __forceinline__ void run_gemm8(Frame& F, const unsigned char* A8, const unsigned char* Bt8, int M, int N, int Kbytes, const Epi& E) {
    pg8::Gemm g{(const bf16*)A8, (const bf16*)Bt8, M, N, Kbytes / 2 + F.z  }; pg8::StaticOrder S; S.init(M, N, F.G, F.bx);
    int t = F.tid; asm volatile("" : "+v"(t));
    pg8::gemm_phase<Epi, pg8::StaticOrder, true, true, true>(F.lds, g, S, E, t);
}

__global__ void __launch_bounds__(NWAVES * 64, 2) mega_fwd(Args args) {
    extern __shared__ __attribute__((aligned(16))) unsigned char lds[];
    Frame F;
    F.lds = (LAS unsigned char*)lds;
    F.tid = threadIdx.x; F.lane = F.tid & 63; F.wave = 0; F.G = gridDim.x; F.bx = blockIdx.x; F.vcu = 0;
    F.A = &args; F.z = 0; F.out = args.out; F.ws = args.ws;
    const int wave_s = __builtin_amdgcn_readfirstlane((int)threadIdx.x >> 6);
    volatile LAS unsigned* MISC = (volatile LAS unsigned*)(F.lds + MISC_OFF);
    if (F.tid < 64) MISC[F.tid] = 0u;
    __syncthreads();
    XcdBarrier bar; bar.bar = (unsigned*)(F.ws + WS_CTL) + CW_BAR; bar.x = 0; bar.st = nullptr;
    if (args.use_bar) bar = xcd_barrier_post((unsigned*)(F.ws + WS_CTL) + CW_BAR, MISC + 8);

    for (int pc = args.ph_lo; pc < args.ph_hi; ++pc) {
        { int z = 0; asm volatile("" : "+s"(z)); int t = wave_s * 64 + (int)__builtin_amdgcn_mbcnt_hi(~0u, __builtin_amdgcn_mbcnt_lo(~0u, (unsigned)z)); asm volatile("" : "+v"(t));
          F.z = z; F.ws = args.ws + z; F.tid = t; F.lane = t & 63; F.wave = __builtin_amdgcn_readfirstlane(t >> 6);
          F.G = (int)gridDim.x + z; F.bx = (int)blockIdx.x + z; F.vcu = (F.G % 8 == 0) ? (F.bx % 8) * (F.G / 8) + F.bx / 8 : F.bx; }
        bf16* const H = (bf16*)(F.ws + WS_H); bf16* const U = (bf16*)(F.ws + WS_U); bf16* const Y = (bf16*)(F.ws + WS_Y); bf16* const X1 = (bf16*)(F.ws + WS_X1);
        bf16* const H1 = (bf16*)(F.ws + WS_H1); bf16* const H2 = (bf16*)(F.ws + WS_H2); bf16* const KB = (bf16*)(F.ws + WS_KB); bf16* const VT = (bf16*)(F.ws + WS_VT); bf16* const HKV = (bf16*)(F.ws + WS_HKV);
        const int ty = args.ph_type[pc], la = args.ph_arg[pc];
#ifndef PHMASK
#define PHMASK 0xFFFF
#endif
#define EN(x) ((PHMASK >> (x)) & 1)
        switch (ty) {
        case P_PROLOGUE: if (EN(P_PROLOGUE)) p0_prologue(F); break;
        case P_STORE: if (EN(P_STORE)) {
            const int njobs = (la == 0) ? 2 : (la == 2) ? 3 : 1;
            for (int j = 0; j < njobs; ++j) {
                const bf16* A; const bf16* Bt; int M = TOK, N = 1024, K = 1024, ldc = 1024, pw = 0; bf16* O; float sc = 1.0f;
                if (la == 0 && j == 0) { A = (const bf16*)(F.ws + WS_PB); Bt = (const bf16*)(F.ws + WS_W_PW); K = 256; O = (bf16*)(F.ws + WS_PW); pw = 1; }
                else if (la == 0) { A = H; Bt = (const bf16*)(F.ws + WS_W_IN); O = U; }
                else if (la == 1) { A = H; Bt = (const bf16*)(F.ws + WS_W_IN) + (size_t)1024 * 1024; O = U; }
                else if (la == 2 && j == 1) { A = HKV; Bt = (const bf16*)(F.ws + WS_W_KV); O = KB; }
                else if (la == 2 && j == 2) { A = (const bf16*)(F.ws + WS_W_KV) + (size_t)1024 * 1024; Bt = HKV; M = 1024; N = TOK; ldc = TOK; O = VT; }
                else { A = H; Bt = (const bf16*)(F.ws + WS_W_SQ) + (size_t)(la - 2) * 1024 * 1024; O = U; sc = 0.125f * 1.4426950408889634f; }
                if (!pw) {
                    const unsigned char* A8; const unsigned char* B8;
                    if (la <= 1) { A8 = (const unsigned char*)(F.ws + WS_H8); B8 = (const unsigned char*)(F.ws + W8_IN) + (size_t)la * 1024 * 1024; }
                    else if (la == 2 && j == 1) { A8 = (const unsigned char*)(F.ws + WS_HKV); B8 = (const unsigned char*)(F.ws + W8_KV); }
                    else if (la == 2 && j == 2) { A8 = (const unsigned char*)(F.ws + W8_KV) + (size_t)1024 * 1024; B8 = (const unsigned char*)(F.ws + WS_HKV); }
                    else { A8 = (const unsigned char*)(F.ws + WS_H8); B8 = (const unsigned char*)(F.ws + W8_SQ) + (size_t)(la - 2) * 1024 * 1024; }
                    pg8::EpiStore E{O, ldc, sc * (1.0f / W8_SCALE), -1};
                    run_gemm8(F, A8, B8, M, N, 1024, E);
                } else {
                    pg8::EpiStore E{O, ldc, sc, pw ? 3 : -1};
                    run_gemm(F, A, Bt, M, N, K, E, pw);
                }
            }
        } break;
        case P_SSM: if (EN(P_SSM)) ssm_phase(F, la); break;
        case P_GLU: if (EN(P_GLU)) { pg8::EpiGlu E{H, X1}; run_gemm8(F, (const unsigned char*)Y, (const unsigned char*)(F.ws + W8_GLU) + (size_t)la * 2048 * 1024, TOK, 2048, 1024, E); } break;
        case P_LNMIX: if (EN(P_LNMIX)) ln_rows(F, X1, F.A->in[2 + F.z] + la * 1024, F.A->in[3 + F.z] + la * 1024, H1, (unsigned char*)(F.ws + WS_H18)); break;
        case P_TOPK: if (EN(P_TOPK)) {
            pg8::EpiTopk E{(int*)(F.ws + WS_IDX), (float*)(F.ws + WS_GATE)};
            pg8::Gemm g{(const bf16*)(F.ws + WS_H18), (const bf16*)((const unsigned char*)(F.ws + W8_EFF) + (size_t)la * 2048 * 1024), TOK, 2048, 512 + F.z};
            for (int r = 0; r < 2; ++r) { pg8::OneUnitOrder S; S.base.init(TOK, 2048, F.G, F.bx); S.round = r;
                int t = F.tid; asm volatile("" : "+v"(t)); pg8::gemm_phase<pg8::EpiTopk, pg8::OneUnitOrder, false, true, true>(F.lds, g, S, E, t); }
        } break;
        case P_PEER: if (EN(P_PEER)) peer_phase(F, la); break;
        case P_PLE: if (EN(P_PLE)) { pg8::EpiPle E{H2, (const unsigned char*)(F.ws + WS_PW) + (size_t)la * TOK * 1024, H, (la == DEPTH - 1) ? F.out : nullptr, (unsigned char*)(F.ws + WS_H8)};
            run_gemm8(F, (const unsigned char*)(F.ws + WS_H28), (const unsigned char*)(F.ws + W8_PG) + (size_t)la * 1024 * 1024, TOK, 1024, 1024, E); } break;
        case P_LNKV: if (EN(P_LNKV)) ln_rows(F, H, F.A->in[16 + F.z], F.A->in[17 + F.z], nullptr, (unsigned char*)HKV); break;
        case P_ATTN: if (EN(P_ATTN)) attn_phase(F); break;
        case P_RES: if (EN(P_RES)) { pg8::EpiRes E{H, X1}; run_gemm8(F, (const unsigned char*)Y, (const unsigned char*)(F.ws + W8_SO) + (size_t)(la - 2) * 1024 * 1024, TOK, 1024, 1024, E); } break;
        default: break;
        }
        if (pc + 1 < args.ph_hi) xcd_barrier(bar);
    }
}

#ifndef N_LAUNCH_MODE
#define N_LAUNCH_MODE 1
#endif
extern "C" void kernel_launch(void* const* d_in, const int* in_sizes, int n_in, void* d_out, int out_size, void* d_ws, size_t ws_size, hipStream_t stream) {
    static int grid = 0;
    if (grid == 0) {
        if (n_in != 28 || out_size != TOK * DM || ws_size < WS_END) { fprintf(stderr, "kernel_launch: unexpected shapes/workspace (n_in %d, out %d, ws %zu)\n", n_in, out_size, ws_size); grid = -1; return; }
        int dev = 0, cus = 0;
        if (hipGetDevice(&dev) != hipSuccess || hipDeviceGetAttribute(&cus, hipDeviceAttributeMultiprocessorCount, dev) != hipSuccess) { grid = -1; return; }
        if (hipFuncSetAttribute((const void*)mega_fwd, hipFuncAttributeMaxDynamicSharedMemorySize, LDS_BYTES) != hipSuccess) { fprintf(stderr, "kernel_launch: hipFuncSetAttribute failed\n"); grid = -1; return; }
        (void)hipGetLastError();
        grid = cus;
    }
    if (grid < 0) return;
    hipMemsetAsync((char*)d_ws + WS_CTL, 0, CTL_ZERO_BYTES, stream);
    Args a{};
    for (int i = 0; i < 28; ++i) a.in[i] = (const float*)d_in[i];
    a.out = (float*)d_out; a.ws = (unsigned char*)d_ws;
    int n = 0;
#ifndef REP_TYPE
#define REP_TYPE -1
#endif
    auto add = [&](int t, int l) { for (int r = 0; r < ((t == REP_TYPE) ? 2 : 1); ++r) { a.ph_type[n] = (unsigned char)t; a.ph_arg[n] = (unsigned char)l; ++n; } };
    add(P_PROLOGUE, 0); add(P_STORE, 0);
    for (int l = 0; l < DEPTH; ++l) {
        if (l < 2) { if (l == 1) add(P_STORE, 1); add(P_SSM, l); add(P_GLU, l); }
        else { if (l == 2) add(P_LNKV, 0); add(P_STORE, l); add(P_ATTN, l); add(P_RES, l); }
        add(P_LNMIX, l); add(P_TOPK, l); add(P_PEER, l); add(P_PLE, l);
    }
    a.nph = n;
    if (N_LAUNCH_MODE == 1) {
        a.ph_lo = 0; a.ph_hi = n; a.use_bar = 1;
        hipLaunchKernelGGL(mega_fwd, dim3(grid), dim3(NWAVES * 64), LDS_BYTES, stream, a);
    } else {
        a.use_bar = 0;
        for (int i = 0; i < n; ++i) { a.ph_lo = i; a.ph_hi = i + 1; hipLaunchKernelGGL(mega_fwd, dim3(grid), dim3(NWAVES * 64), LDS_BYTES, stream, a); }
    }
}
```

```cpp
#include <hip/hip_runtime.h>
#include <cstdio>
#include <cstdint>
#include <cmath>
namespace pg8 {
#define PG8_LAS __attribute__((address_space(3)))
typedef unsigned short bf16_t;
typedef short bf16x8 __attribute__((ext_vector_type(8)));
typedef float f32x4 __attribute__((ext_vector_type(4)));
typedef unsigned u32x4 __attribute__((ext_vector_type(4)));
constexpr int BM = 256, BK = 64, HALF = 128, HTB = HALF * BK * 2  , STAGE_BYTES = 8 * HTB, NXCD = 8, WGM = 8;

__host__ __device__ __forceinline__ int lds_byte(int r, int c) { const int st = (r >> 4) * 2 + (c >> 5), rr = r & 15, cc = c & 31, ob = rr * 64 + cc * 2; return st * 1024 + (ob ^ (((ob >> 9) & 1) << 5)); }
__host__ __device__ __forceinline__ void stage_rc(int b, int& R, int& C) { const int st = b / 1024, sb = b % 1024, swz = sb ^ (((sb >> 9) & 1) << 5); R = (st >> 1) * 16 + swz / 64; C = (st & 1) * 32 + (swz % 64) / 2; }
__host__ __device__ __forceinline__ int perm32(int rho) { const int n = rho >> 4, i = rho & 15; return 8 * (i >> 2) + 4 * n + (i & 3); }

struct Unit { int pm, pn; };
struct Gemm { const bf16_t* A; const bf16_t* Bt; int M, N, K; };

struct StaticOrder {
    int nM, nN, nwg, G, c;
    __host__ __device__ void init(int M, int N, int G_, int c_) { nM = M / BM; nN = N / BM; nwg = nM * nN; G = G_; c = c_; pw = 0; }
    int pw;
    __host__ __device__ bool next(int i, Unit& u) const {
        const long L = (long)i * G + c; if (L >= nwg) return false;
        if (pw) { const int l = (int)L >> 8, rem = (int)L & 255; u.pm = l * 64 + (rem >> 2); u.pn = l * 4 + (rem & 3); return true; }
        int wgid = (int)L; { const int q = nwg / NXCD, r = nwg % NXCD, xcd = wgid % NXCD, off = wgid / NXCD; wgid = (xcd < r ? xcd * (q + 1) : r * (q + 1) + (xcd - r) * q) + off; }
        const int nig = WGM * nN, gid = wgid / nig, fm = gid * WGM, gsz = (nM - fm) < WGM ? (nM - fm) : WGM;
        u.pm = fm + ((wgid % nig) % gsz); u.pn = (wgid % nig) / gsz; return true;
    }
    __device__ __forceinline__ void a_ready(const Unit&) const {}
    __device__ __forceinline__ void done(const Unit&) const {}
};

typedef float f32x2c_t __attribute__((ext_vector_type(2))); typedef __bf16 bf16x2c_t __attribute__((ext_vector_type(2)));
__device__ __forceinline__ unsigned cvt_pk_bf16(float lo, float hi) { f32x2c_t v = {lo, hi}; bf16x2c_t b = __builtin_convertvector(v, bf16x2c_t); return __builtin_bit_cast(unsigned, b); }
typedef float f32x2 __attribute__((ext_vector_type(2)));
typedef int v8i32_t __attribute__((ext_vector_type(8)));
typedef unsigned u32x8_t __attribute__((ext_vector_type(8)));
template <bool F8> struct Frag { bf16x8 k[2]; };
template <> struct Frag<true> { v8i32_t v; };
template <class Epi, class Sched, bool ALIGN_EPI = false, bool SP2 = false, bool F8 = false>
__device__ __forceinline__ void gemm_phase(PG8_LAS unsigned char* lds, const Gemm g, const Sched& S, const Epi& E, const int tid) {
    const int wid = __builtin_amdgcn_readfirstlane(tid >> 6), lane = tid & 63, wr = wid >> 2, wc = wid & 3, fr = lane & 15, fq = lane >> 4;
    const int K = g.K, nt = K / BK;
    unsigned voffA[1], voffB[1];
    { int R, C; stage_rc(tid * 16, R, C); const int Rb = Epi::PERM ? ((R & ~31) + perm32(R & 31)) : R;
        voffA[0] = (unsigned)(R * K + C) * 2u; voffB[0] = (unsigned)(Rb * K + C) * 2u; }
    const size_t r64 = (size_t)128 * K;
    const size_t kstep = (size_t)(BK * 2);
    const size_t hstep = (size_t)HALF * K * 2;
    const size_t tstep = 2 * hstep;
    const unsigned ldsw = (unsigned)wid * 1024u;
    const int aoff = lds_byte(wr * 64 + fr, F8 ? fq * 16 : fq * 8), boff = lds_byte(wc * 32 + fr, F8 ? fq * 16 : fq * 8);
#define PG8_SA(b, h) (((b) * 2 + (h)) * HTB)
#define PG8_SB(b, h) ((4 + (b) * 2 + (h)) * HTB)
#define PG8_STAGE(bufoff, gbase, voff) do { _Pragma("unroll") for (int _i = 0; _i < 2; ++_i) \
        __builtin_amdgcn_global_load_lds((const unsigned*)((const char*)(gbase) + _i * r64 + (voff)[0]), (PG8_LAS unsigned*)(lds + (bufoff) + ldsw + _i * 8192), 16, 0, 0); } while (0)
#define PG8_LDF(d, addr) do { if constexpr (F8) { const u32x4 lo_ = *(const PG8_LAS u32x4*)(addr), hi_ = *(const PG8_LAS u32x4*)((addr) + 16); d.v = __builtin_bit_cast(v8i32_t, (u32x8_t){lo_[0], lo_[1], lo_[2], lo_[3], hi_[0], hi_[1], hi_[2], hi_[3]}); } \
        else { d.k[0] = *(const PG8_LAS bf16x8*)(addr); d.k[1] = *(const PG8_LAS bf16x8*)((addr) + 1024); } } while (0)
#define PG8_LDA(dst, b, h) do { _Pragma("unroll") for (int m = 0; m < 4; ++m) PG8_LDF(dst[m], lds + PG8_SA(b, h) + aoff + m * 2048); } while (0)
#define PG8_LDB(dst, b, h) do { _Pragma("unroll") for (int n = 0; n < 2; ++n) PG8_LDF(dst[n], lds + PG8_SB(b, h) + boff + n * 2048); } while (0)
#define PG8_MMA(ai, bj, At, Bt) do { __builtin_amdgcn_s_setprio(1); _Pragma("unroll") for (int m = 0; m < 4; ++m) _Pragma("unroll") for (int n = 0; n < 2; ++n) { \
        if constexpr (F8) asm volatile("v_mfma_f32_16x16x128_f8f6f4 %0, %1, %2, %0" : "+v"(acc[ai][bj][m][n]) : "v"(Bt[n].v), "v"(At[m].v));   \
        else { _Pragma("unroll") for (int k = 0; k < 2; ++k) acc[ai][bj][m][n] = __builtin_amdgcn_mfma_f32_16x16x32_bf16(Bt[n].k[k], At[m].k[k], acc[ai][bj][m][n], 0, 0, 0); } } __builtin_amdgcn_s_setprio(0); } while (0)
#define PG8_WAIT_V(n) asm volatile("s_waitcnt vmcnt(" #n ")" ::: "memory")
#define PG8_WAIT_L(n) asm volatile("s_waitcnt lgkmcnt(" #n ")" ::: "memory")
#define PG8_BAR __builtin_amdgcn_s_barrier()
#define PG8_SCHED __builtin_amdgcn_sched_barrier(0)
    Unit cur, nxt; int ui = 0;
    if (!S.next(0, cur)) return;
    f32x4 acc[2][2][4][2];
#pragma unroll
    for (int a = 0; a < 2; ++a)
#pragma unroll
        for (int b = 0; b < 2; ++b)
#pragma unroll
            for (int m = 0; m < 4; ++m)
#pragma unroll
                for (int n = 0; n < 2; ++n) acc[a][b][m][n] = (f32x4){0.f, 0.f, 0.f, 0.f};
    Frag<F8> At[4], B0[2], B1[2];
    const char* cA = (const char*)g.A + (size_t)cur.pm * tstep; const char* cB = (const char*)g.Bt + (size_t)cur.pn * tstep;
    S.a_ready(cur);
    if constexpr (SP2) {
        PG8_STAGE(PG8_SB(0, 0), cB, voffB); PG8_STAGE(PG8_SB(0, 1), cB + hstep, voffB); PG8_STAGE(PG8_SA(0, 0), cA, voffA); PG8_STAGE(PG8_SA(0, 1), cA + hstep, voffA);
        if (wr == 1) PG8_BAR;
        PG8_WAIT_V(2); PG8_BAR;
        PG8_STAGE(PG8_SB(1, 0), cB + kstep, voffB); PG8_STAGE(PG8_SA(1, 0), cA + kstep, voffA); PG8_STAGE(PG8_SB(1, 1), cB + hstep + kstep, voffB);
        PG8_WAIT_V(6); PG8_BAR;
    } else {
        PG8_STAGE(PG8_SB(0, 0), cB, voffB); PG8_STAGE(PG8_SA(0, 0), cA, voffA); PG8_STAGE(PG8_SB(0, 1), cB + hstep, voffB); PG8_STAGE(PG8_SA(0, 1), cA + hstep, voffA);
        if (wr == 1) PG8_BAR;
        PG8_WAIT_V(4); PG8_BAR;
        PG8_STAGE(PG8_SB(1, 0), cB + kstep, voffB); PG8_STAGE(PG8_SA(1, 0), cA + kstep, voffA); PG8_STAGE(PG8_SB(1, 1), cB + hstep + kstep, voffB);
        PG8_WAIT_V(6); PG8_BAR;
    }
    for (;;) {
        const bool has_next = S.next(ui + 1, nxt);
        const char* nA = has_next ? (const char*)g.A + (size_t)nxt.pm * tstep : cA; const char* nB = has_next ? (const char*)g.Bt + (size_t)nxt.pn * tstep : cB;
#pragma unroll 1
        for (int t = 0; t < nt; t += 2) {
            const bool last = (t == nt - 2);
            const char* a1 = cA + (size_t)(t + 1) * kstep;
            const char* a2 = last ? nA : cA + (size_t)(t + 2) * kstep; const char* b2 = last ? nB : cB + (size_t)(t + 2) * kstep;
            const char* a3 = a2 + kstep; const char* b3 = b2 + kstep;
            if (last && has_next) S.a_ready(nxt);
            if constexpr (SP2) {
            PG8_LDB(B0, 0, 0); PG8_LDB(B1, 0, 1); PG8_SCHED; PG8_LDA(At, 0, 0); PG8_STAGE(PG8_SA(1, 1), a1 + hstep, voffA);
            PG8_WAIT_V(8); PG8_WAIT_L(0); PG8_BAR; PG8_MMA(0, 0, At, B0); PG8_MMA(0, 1, At, B1); PG8_BAR; PG8_SCHED;
            PG8_LDA(At, 0, 1); PG8_STAGE(PG8_SB(0, 0), b2, voffB); PG8_STAGE(PG8_SB(0, 1), b2 + hstep, voffB); PG8_STAGE(PG8_SA(0, 0), a2, voffA);
            PG8_WAIT_V(8); PG8_WAIT_L(0); PG8_BAR; PG8_MMA(1, 0, At, B0); PG8_MMA(1, 1, At, B1); PG8_BAR; PG8_SCHED;
            PG8_LDB(B0, 1, 0); PG8_LDB(B1, 1, 1); PG8_SCHED; PG8_LDA(At, 1, 0); PG8_STAGE(PG8_SA(0, 1), a2 + hstep, voffA);
            PG8_WAIT_V(8); PG8_WAIT_L(0); PG8_BAR; PG8_MMA(0, 0, At, B0); PG8_MMA(0, 1, At, B1); PG8_BAR; PG8_SCHED;
            PG8_LDA(At, 1, 1); PG8_STAGE(PG8_SB(1, 0), b3, voffB); PG8_STAGE(PG8_SB(1, 1), b3 + hstep, voffB); PG8_STAGE(PG8_SA(1, 0), a3, voffA);
            PG8_WAIT_V(8); PG8_WAIT_L(0); PG8_BAR; PG8_MMA(1, 0, At, B0); PG8_MMA(1, 1, At, B1); PG8_BAR; PG8_SCHED;
            } else {
            PG8_LDB(B0, 0, 0); PG8_SCHED; PG8_LDA(At, 0, 0); PG8_STAGE(PG8_SA(1, 1), a1 + hstep, voffA);
            PG8_WAIT_L(8); PG8_BAR; PG8_WAIT_L(0); PG8_MMA(0, 0, At, B0); PG8_BAR; PG8_SCHED;
            PG8_LDB(B1, 0, 1); PG8_STAGE(PG8_SB(0, 0), b2, voffB);
            PG8_BAR; PG8_WAIT_L(0); PG8_MMA(0, 1, At, B1); PG8_BAR;
            PG8_LDA(At, 0, 1); PG8_STAGE(PG8_SA(0, 0), a2, voffA);
            PG8_BAR; PG8_WAIT_L(0); PG8_MMA(1, 0, At, B0); PG8_BAR; PG8_SCHED;
            PG8_STAGE(PG8_SB(0, 1), b2 + hstep, voffB);
            PG8_WAIT_V(6); PG8_BAR; PG8_MMA(1, 1, At, B1); PG8_BAR;
            PG8_LDB(B0, 1, 0); PG8_SCHED; PG8_LDA(At, 1, 0); PG8_STAGE(PG8_SA(0, 1), a2 + hstep, voffA);
            PG8_WAIT_L(8); PG8_BAR; PG8_WAIT_L(0); PG8_MMA(0, 0, At, B0); PG8_BAR; PG8_SCHED;
            PG8_LDB(B1, 1, 1); PG8_STAGE(PG8_SB(1, 0), b3, voffB);
            PG8_BAR; PG8_WAIT_L(0); PG8_MMA(0, 1, At, B1); PG8_BAR;
            PG8_LDA(At, 1, 1); PG8_STAGE(PG8_SA(1, 0), a3, voffA);
            PG8_BAR; PG8_WAIT_L(0); PG8_MMA(1, 0, At, B0); PG8_BAR; PG8_SCHED;
            PG8_STAGE(PG8_SB(1, 1), b3 + hstep, voffB);
            PG8_WAIT_V(6); PG8_BAR; PG8_MMA(1, 1, At, B1); PG8_BAR;
            }
        }
        if constexpr (F8) asm volatile("s_nop 15\n\ts_nop 15" ::: "memory");
        if constexpr (ALIGN_EPI) { if (wr == 0) PG8_BAR; }
        if constexpr (!Epi::AFTER_DRAIN) { E(acc, cur, wr, wc, fr, fq); S.done(cur); }
        if (!has_next) break;
#pragma unroll
        for (int a = 0; a < 2; ++a)
#pragma unroll
            for (int b = 0; b < 2; ++b)
#pragma unroll
                for (int m = 0; m < 4; ++m)
#pragma unroll
                    for (int n = 0; n < 2; ++n) acc[a][b][m][n] = (f32x4){0.f, 0.f, 0.f, 0.f};
        cur = nxt; cA = nA; cB = nB; ++ui;
        if constexpr (ALIGN_EPI) { if (wr == 1) PG8_BAR; }
    }
    PG8_WAIT_V(0);
    if constexpr (!ALIGN_EPI) { if (wr == 0) PG8_BAR; }
    PG8_BAR;
    if constexpr (Epi::AFTER_DRAIN) { E.fused(acc, cur, wr, wc, fr, fq, lds, wid, lane); S.done(cur); }
#undef PG8_SA
#undef PG8_SB
#undef PG8_STAGE
#undef PG8_LDA
#undef PG8_LDB
#undef PG8_MMA
#undef PG8_LDF
#undef PG8_WAIT_V
#undef PG8_WAIT_L
#undef PG8_BAR
#undef PG8_SCHED
}
}
namespace pg8 {
__device__ __forceinline__ float bf_lo(unsigned w) { return __uint_as_float(w << 16); }
__device__ __forceinline__ float bf_hi(unsigned w) { return __uint_as_float(w & 0xffff0000u); }
__device__ __forceinline__ float fast_sigmoid(float x) { return __builtin_amdgcn_rcpf(1.0f + __builtin_amdgcn_exp2f(-1.4426950408889634f * x)); }
__device__ __forceinline__ float gelu_tanh(float x) { const float t = x * (1.5957691216057308f + 0.07135481627260025f * x * x); return x * __builtin_amdgcn_rcpf(1.0f + __builtin_amdgcn_exp2f(-1.4426950408889634f * t)); }
constexpr float ALPHA_F = 1.681792830507429f;
constexpr float WSC = 1.0f / 32.0f;

struct EpiStore {
    static constexpr bool PERM = true, AFTER_DRAIN = false;
    bf16_t* O; int ldc; float scale; int pnmask;
    __device__ __forceinline__ void operator()(const f32x4 (&acc)[2][2][4][2], const Unit& u, int wr, int wc, int fr, int fq) const {
        const int row0 = u.pm * BM + wr * 64 + fr, col0 = (u.pn & pnmask) * BM + wc * 32 + 8 * fq;
#pragma unroll
        for (int ai = 0; ai < 2; ++ai)
#pragma unroll
            for (int m = 0; m < 4; ++m) { bf16_t* rowp = O + (size_t)(row0 + ai * HALF + m * 16) * ldc + col0;
#pragma unroll
                for (int bj = 0; bj < 2; ++bj) { const f32x4 v0 = acc[ai][bj][m][0] * scale, v1 = acc[ai][bj][m][1] * scale;
                    if (pnmask >= 0) {
                        int w0 = 0, w1 = 0; w0 = __builtin_amdgcn_cvt_pk_fp8_f32(v0[0], v0[1], w0, false); w0 = __builtin_amdgcn_cvt_pk_fp8_f32(v0[2], v0[3], w0, true);
                        w1 = __builtin_amdgcn_cvt_pk_fp8_f32(v1[0], v1[1], w1, false); w1 = __builtin_amdgcn_cvt_pk_fp8_f32(v1[2], v1[3], w1, true);
                        *(unsigned long long*)((unsigned char*)O + (size_t)(row0 + ai * HALF + m * 16) * ldc + col0 + bj * HALF) = (unsigned long long)(unsigned)w0 | ((unsigned long long)(unsigned)w1 << 32);
                    } else {
                    u32x4 w; w.x = cvt_pk_bf16(v0[0], v0[1]); w.y = cvt_pk_bf16(v0[2], v0[3]); w.z = cvt_pk_bf16(v1[0], v1[1]); w.w = cvt_pk_bf16(v1[2], v1[3]);
                    *(u32x4*)(rowp + bj * HALF) = w; } } }
    }
};
struct EpiGlu {
    static constexpr bool PERM = true, AFTER_DRAIN = false;
    const bf16_t* Hin; bf16_t* X1;
    __device__ __forceinline__ void operator()(const f32x4 (&acc)[2][2][4][2], const Unit& u, int wr, int wc, int fr, int fq) const {
        const int row0 = u.pm * BM + wr * 64 + fr, col0 = u.pn * HALF + wc * 32 + 8 * fq;
        u32x4 hvv[2][4];
#pragma unroll
        for (int ai = 0; ai < 2; ++ai)
#pragma unroll
            for (int m = 0; m < 4; ++m) hvv[ai][m] = *(const u32x4*)(Hin + (size_t)(row0 + ai * HALF + m * 16) * 1024 + col0);
#pragma unroll
        for (int ai = 0; ai < 2; ++ai)
#pragma unroll
            for (int m = 0; m < 4; ++m) { const size_t off = (size_t)(row0 + ai * HALF + m * 16) * 1024 + col0;
                const u32x4 hv = hvv[ai][m];
                const f32x4 v0 = acc[ai][0][m][0] * WSC, v1 = acc[ai][0][m][1] * WSC, g0 = acc[ai][1][m][0] * WSC, g1 = acc[ai][1][m][1] * WSC;
                float o[8];
                o[0] = ALPHA_F * bf_lo(hv.x) + v0[0] * fast_sigmoid(g0[0]); o[1] = ALPHA_F * bf_hi(hv.x) + v0[1] * fast_sigmoid(g0[1]);
                o[2] = ALPHA_F * bf_lo(hv.y) + v0[2] * fast_sigmoid(g0[2]); o[3] = ALPHA_F * bf_hi(hv.y) + v0[3] * fast_sigmoid(g0[3]);
                o[4] = ALPHA_F * bf_lo(hv.z) + v1[0] * fast_sigmoid(g1[0]); o[5] = ALPHA_F * bf_hi(hv.z) + v1[1] * fast_sigmoid(g1[1]);
                o[6] = ALPHA_F * bf_lo(hv.w) + v1[2] * fast_sigmoid(g1[2]); o[7] = ALPHA_F * bf_hi(hv.w) + v1[3] * fast_sigmoid(g1[3]);
                u32x4 w; w.x = cvt_pk_bf16(o[0], o[1]); w.y = cvt_pk_bf16(o[2], o[3]); w.z = cvt_pk_bf16(o[4], o[5]); w.w = cvt_pk_bf16(o[6], o[7]);
                *(u32x4*)(X1 + off) = w; }
    }
};
struct EpiRes {
    static constexpr bool PERM = true, AFTER_DRAIN = false;
    const bf16_t* Hin; bf16_t* X1;
    __device__ __forceinline__ void operator()(const f32x4 (&acc)[2][2][4][2], const Unit& u, int wr, int wc, int fr, int fq) const {
        const int row0 = u.pm * BM + wr * 64 + fr, col0 = u.pn * BM + wc * 32 + 8 * fq;
        u32x4 hvv[2][4][2];
#pragma unroll
        for (int ai = 0; ai < 2; ++ai)
#pragma unroll
            for (int m = 0; m < 4; ++m)
#pragma unroll
                for (int bj = 0; bj < 2; ++bj) hvv[ai][m][bj] = *(const u32x4*)(Hin + (size_t)(row0 + ai * HALF + m * 16) * 1024 + col0 + bj * HALF);
#pragma unroll
        for (int ai = 0; ai < 2; ++ai)
#pragma unroll
            for (int m = 0; m < 4; ++m)
#pragma unroll
                for (int bj = 0; bj < 2; ++bj) { const size_t off = (size_t)(row0 + ai * HALF + m * 16) * 1024 + col0 + bj * HALF;
                    const u32x4 hv = hvv[ai][m][bj]; const f32x4 v0 = acc[ai][bj][m][0] * WSC, v1 = acc[ai][bj][m][1] * WSC;
                    u32x4 w; w.x = cvt_pk_bf16(ALPHA_F * bf_lo(hv.x) + v0[0], ALPHA_F * bf_hi(hv.x) + v0[1]); w.y = cvt_pk_bf16(ALPHA_F * bf_lo(hv.y) + v0[2], ALPHA_F * bf_hi(hv.y) + v0[3]);
                    w.z = cvt_pk_bf16(ALPHA_F * bf_lo(hv.z) + v1[0], ALPHA_F * bf_hi(hv.z) + v1[1]); w.w = cvt_pk_bf16(ALPHA_F * bf_lo(hv.w) + v1[2], ALPHA_F * bf_hi(hv.w) + v1[3]);
                    *(u32x4*)(X1 + off) = w; }
    }
};
struct EpiPle {
    static constexpr bool PERM = true, AFTER_DRAIN = false;
    const bf16_t* H2; const unsigned char* PW; bf16_t* Hout; float* Fout; unsigned char* H8out;
    __device__ __forceinline__ void operator()(const f32x4 (&acc)[2][2][4][2], const Unit& u, int wr, int wc, int fr, int fq) const {
        const int row0 = u.pm * BM + wr * 64 + fr, col0 = u.pn * BM + wc * 32 + 8 * fq;
#pragma unroll
        for (int ai = 0; ai < 2; ++ai) {
            u32x4 hvv[4][2]; unsigned long long pvv[4][2];
#pragma unroll
            for (int m = 0; m < 4; ++m)
#pragma unroll
                for (int bj = 0; bj < 2; ++bj) { const size_t off = (size_t)(row0 + ai * HALF + m * 16) * 1024 + col0 + bj * HALF; hvv[m][bj] = *(const u32x4*)(H2 + off); pvv[m][bj] = *(const unsigned long long*)(PW + off); }
#pragma unroll
            for (int m = 0; m < 4; ++m)
#pragma unroll
                for (int bj = 0; bj < 2; ++bj) { const size_t off = (size_t)(row0 + ai * HALF + m * 16) * 1024 + col0 + bj * HALF;
                    const u32x4 hv = hvv[m][bj]; const int pl = (int)(unsigned)pvv[m][bj], ph = (int)(unsigned)(pvv[m][bj] >> 32); const f32x4 v0 = acc[ai][bj][m][0] * WSC, v1 = acc[ai][bj][m][1] * WSC;
                    const auto p01 = __builtin_amdgcn_cvt_pk_f32_fp8(pl, false), p23 = __builtin_amdgcn_cvt_pk_f32_fp8(pl, true), p45 = __builtin_amdgcn_cvt_pk_f32_fp8(ph, false), p67 = __builtin_amdgcn_cvt_pk_f32_fp8(ph, true);
                    float o[8];
                    o[0] = bf_lo(hv.x) + fast_sigmoid(v0[0]) * p01[0]; o[1] = bf_hi(hv.x) + fast_sigmoid(v0[1]) * p01[1];
                    o[2] = bf_lo(hv.y) + fast_sigmoid(v0[2]) * p23[0]; o[3] = bf_hi(hv.y) + fast_sigmoid(v0[3]) * p23[1];
                    o[4] = bf_lo(hv.z) + fast_sigmoid(v1[0]) * p45[0]; o[5] = bf_hi(hv.z) + fast_sigmoid(v1[1]) * p45[1];
                    o[6] = bf_lo(hv.w) + fast_sigmoid(v1[2]) * p67[0]; o[7] = bf_hi(hv.w) + fast_sigmoid(v1[3]) * p67[1];
                    if (Fout) { *(f32x4*)(Fout + off) = (f32x4){o[0], o[1], o[2], o[3]}; *(f32x4*)(Fout + off + 4) = (f32x4){o[4], o[5], o[6], o[7]}; }
                    else { u32x4 w; w.x = cvt_pk_bf16(o[0], o[1]); w.y = cvt_pk_bf16(o[2], o[3]); w.z = cvt_pk_bf16(o[4], o[5]); w.w = cvt_pk_bf16(o[6], o[7]); *(u32x4*)(Hout + off) = w;
                        int w0 = 0, w1 = 0; w0 = __builtin_amdgcn_cvt_pk_fp8_f32(o[0], o[1], w0, false); w0 = __builtin_amdgcn_cvt_pk_fp8_f32(o[2], o[3], w0, true); w1 = __builtin_amdgcn_cvt_pk_fp8_f32(o[4], o[5], w1, false); w1 = __builtin_amdgcn_cvt_pk_fp8_f32(o[6], o[7], w1, true);
                        *(unsigned long long*)(H8out + off) = (unsigned long long)(unsigned)w0 | ((unsigned long long)(unsigned)w1 << 32); } }
        }
    }
};

__device__ __forceinline__ int imax_(int a, int b) { return a > b ? a : b; }
__device__ __forceinline__ int imin_(int a, int b) { return a < b ? a : b; }
__device__ __forceinline__ float csum(float a, float b) { float s = a + b; asm volatile("" : "+v"(s)); return s; }
__device__ __forceinline__ int f2key(float v) { int s = __float_as_int(v); return s ^ ((s >> 31) & 0x7fffffff); }
__device__ __forceinline__ float key2f(int k) { return __int_as_float(k ^ ((k >> 31) & 0x7fffffff)); }
template <bool DESC> __device__ __forceinline__ void bitonic_sort16(int (&x)[16]) {
#pragma unroll
    for (int k = 2; k <= 16; k <<= 1)
#pragma unroll
        for (int j = k >> 1; j > 0; j >>= 1)
#pragma unroll
            for (int i = 0; i < 16; ++i) { const int l = i ^ j; if (l > i) { const bool up = ((i & k) == 0) || (k == 16); const bool asc = DESC ? !up : up;
                const int lo = imin_(x[i], x[l]), hi = imax_(x[i], x[l]); x[i] = asc ? lo : hi; x[l] = asc ? hi : lo; } }
}
__device__ __forceinline__ void bitonic_merge_desc16(int (&x)[16]) {
#pragma unroll
    for (int j = 8; j > 0; j >>= 1)
#pragma unroll
        for (int i = 0; i < 16; ++i) { const int l = i ^ j; if (l > i) { const int lo = imin_(x[i], x[l]), hi = imax_(x[i], x[l]); x[i] = hi; x[l] = lo; } }
}
__device__ __forceinline__ void topk_absorb16(int (&L)[16], int (&N)[16]) {
    bitonic_sort16<false>(N);
#pragma unroll
    for (int i = 0; i < 16; ++i) L[i] = imax_(L[i], N[i]);
    bitonic_merge_desc16(L);
}
__device__ __forceinline__ void topk_insert1(int (&L)[16], int v) {
#pragma unroll
    for (int i = 0; i < 16; ++i) { const int hi = imax_(L[i], v); v = imin_(L[i], v); L[i] = hi; }
}

template <bool DESC> __device__ __forceinline__ void bitonic_sort16f(float (&x)[16]) {
#pragma unroll
    for (int k = 2; k <= 16; k <<= 1)
#pragma unroll
        for (int j = k >> 1; j > 0; j >>= 1)
#pragma unroll
            for (int i = 0; i < 16; ++i) { const int l = i ^ j; if (l > i) { const bool up = ((i & k) == 0) || (k == 16); const bool asc = DESC ? !up : up;
                const float lo = __builtin_fminf(x[i], x[l]), hi = __builtin_fmaxf(x[i], x[l]); x[i] = asc ? lo : hi; x[l] = asc ? hi : lo; } }
}
__device__ __forceinline__ void bitonic_merge_desc16f(float (&x)[16]) {
#pragma unroll
    for (int j = 8; j > 0; j >>= 1)
#pragma unroll
        for (int i = 0; i < 16; ++i) { const int l = i ^ j; if (l > i) { const float lo = __builtin_fminf(x[i], x[l]), hi = __builtin_fmaxf(x[i], x[l]); x[i] = hi; x[l] = lo; } }
}
__device__ __forceinline__ void topk_absorb16f(float (&L)[16], float (&N)[16]) {
    bitonic_sort16f<false>(N);
#pragma unroll
    for (int i = 0; i < 16; ++i) L[i] = __builtin_fmaxf(L[i], N[i]);
    bitonic_merge_desc16f(L);
}

__device__ __forceinline__ void topk_insert1f(float (&L)[16], float v) {
#pragma unroll
    for (int i = 0; i < 16; ++i) { const float hi = __builtin_fmaxf(L[i], v); v = __builtin_fminf(L[i], v); L[i] = hi; }
}
struct EpiTopk {
    static constexpr bool PERM = true, AFTER_DRAIN = true;
    int* IDX; float* GATE;
    __device__ __forceinline__ void fused(f32x4 (&acc)[2][2][4][2], const Unit& u, int wr, int wc, int fr, int fq, PG8_LAS unsigned char* lds, int wid, int lane) const {
        const int tid = wid * 64 + lane;
        PG8_LAS float* S = (PG8_LAS float*)lds;
        PG8_LAS int* X = (PG8_LAS int*)lds;
        const int row = tid & 255, part = tid >> 8;
        int KK[2][16];
#pragma unroll
        for (int bj = 0; bj < 2; ++bj) {
#pragma unroll
            for (int ai = 0; ai < 2; ++ai)
#pragma unroll
                for (int m = 0; m < 4; ++m)
#pragma unroll
                    for (int n = 0; n < 2; ++n) *(PG8_LAS f32x4*)(S + (ai * HALF + wr * 64 + m * 16 + fr) * 132 + wc * 32 + 8 * fq + 4 * n) = acc[ai][bj][m][n] * WSC;
            asm volatile("s_waitcnt lgkmcnt(0)" ::: "memory"); __builtin_amdgcn_s_barrier(); asm volatile("" ::: "memory");
            float L[16];
#pragma unroll
            for (int c = 0; c < 4; ++c) {
                float N[16];
#pragma unroll
                for (int i = 0; i < 4; ++i) { const f32x4 v = *(const PG8_LAS f32x4*)(S + row * 132 + 64 * part + 16 * c + 4 * i);
#pragma unroll
                    for (int e = 0; e < 4; ++e) N[4 * i + e] = __int_as_float((__float_as_int(v[e]) & ~127) | (127 - (64 * part + 16 * c + 4 * i + e))); }
                if (c == 0) { bitonic_sort16f<true>(N);
#pragma unroll
                    for (int i = 0; i < 16; ++i) L[i] = N[i]; }
                else topk_absorb16f(L, N);
            }
            asm volatile("s_waitcnt lgkmcnt(0)" ::: "memory"); __builtin_amdgcn_s_barrier(); asm volatile("" ::: "memory");
#pragma unroll
            for (int i = 0; i < 4; ++i) *(PG8_LAS u32x4*)(X + tid * 20 + 4 * i) = (u32x4){(unsigned)__float_as_int(L[4 * i]), (unsigned)__float_as_int(L[4 * i + 1]), (unsigned)__float_as_int(L[4 * i + 2]), (unsigned)__float_as_int(L[4 * i + 3])};
            asm volatile("s_waitcnt lgkmcnt(0)" ::: "memory"); __builtin_amdgcn_s_barrier(); asm volatile("" ::: "memory");
            { float P[16]; const int pt = tid ^ 256;
#pragma unroll
              for (int i = 0; i < 4; ++i) { const u32x4 v = *(const PG8_LAS u32x4*)(X + pt * 20 + 4 * i); P[4 * i] = __int_as_float((int)v.x); P[4 * i + 1] = __int_as_float((int)v.y); P[4 * i + 2] = __int_as_float((int)v.z); P[4 * i + 3] = __int_as_float((int)v.w); }
#pragma unroll
              for (int i = 0; i < 16; ++i) L[i] = __builtin_fmaxf(L[i], P[15 - i]);
              bitonic_merge_desc16f(L); }
#pragma unroll
            for (int i = 0; i < 16; ++i) KK[bj][i] = __float_as_int(L[i]);
            asm volatile("s_waitcnt lgkmcnt(0)" ::: "memory"); __builtin_amdgcn_s_barrier(); asm volatile("" ::: "memory");
        }
        float v1[16], v2[16];
#pragma unroll
        for (int i = 0; i < 16; ++i) { v1[i] = __int_as_float(KK[0][i] & ~127); v2[i] = __int_as_float(KK[1][i] & ~127); }
#define CKEY(a, b) __int_as_float((__float_as_int(csum(v1[a], v2[b])) & ~255) | (255 - (((a) << 4) | (b))))
        float L[16];
#pragma unroll
        for (int b = 0; b < 16; ++b) L[b] = CKEY(0, b);
        { float N[16] = {CKEY(1, 0), CKEY(1, 1), CKEY(1, 2), CKEY(1, 3), CKEY(1, 4), CKEY(1, 5), CKEY(1, 6), CKEY(1, 7), CKEY(2, 0), CKEY(2, 1), CKEY(2, 2), CKEY(2, 3), CKEY(2, 4), CKEY(4, 0), CKEY(4, 1), CKEY(4, 2)};
          topk_absorb16f(L, N); }
        { float N[16] = {CKEY(3, 0), CKEY(3, 1), CKEY(3, 2), CKEY(3, 3), CKEY(5, 0), CKEY(5, 1), CKEY(6, 0), CKEY(6, 1), CKEY(7, 0), CKEY(7, 1), CKEY(8, 0), CKEY(9, 0), CKEY(10, 0), CKEY(11, 0), CKEY(12, 0), CKEY(13, 0)};
          topk_absorb16f(L, N); }
        topk_insert1f(L, CKEY(14, 0)); topk_insert1f(L, CKEY(15, 0));
#undef CKEY
#pragma unroll
        for (int i = 0; i < 4; ++i) { *(PG8_LAS u32x4*)(X + tid * 36 + 4 * i) = (u32x4){(unsigned)KK[0][4 * i], (unsigned)KK[0][4 * i + 1], (unsigned)KK[0][4 * i + 2], (unsigned)KK[0][4 * i + 3]};
                                      *(PG8_LAS u32x4*)(X + tid * 36 + 16 + 4 * i) = (u32x4){(unsigned)KK[1][4 * i], (unsigned)KK[1][4 * i + 1], (unsigned)KK[1][4 * i + 2], (unsigned)KK[1][4 * i + 3]}; }
        asm volatile("s_waitcnt lgkmcnt(0)" ::: "memory");
        float sc[16]; int ex[16];
#pragma unroll
        for (int i = 0; i < 16; ++i) { const int code = 255 - (__float_as_int(L[i]) & 255); const int ka = X[tid * 36 + (code >> 4)], kb = X[tid * 36 + 16 + (code & 15)];
            sc[i] = __int_as_float(ka & ~127) + __int_as_float(kb & ~127); ex[i] = (127 - (ka & 127)) * 128 + (127 - (kb & 127)); }
        float mx = sc[0];
#pragma unroll
        for (int i = 1; i < 16; ++i) mx = fmaxf(mx, sc[i]);
        float den = 0.f;
#pragma unroll
        for (int i = 0; i < 16; ++i) { sc[i] = __builtin_amdgcn_exp2f((sc[i] - mx) * 1.4426950408889634f); den += sc[i]; }
        const float rden = 1.0f / den;
        const size_t o = ((size_t)(u.pm * BM + row) * 8 + u.pn) * 16;
        if (part == 0) {
#pragma unroll
            for (int i = 0; i < 4; ++i) *(u32x4*)(IDX + o + 4 * i) = (u32x4){(unsigned)ex[4 * i], (unsigned)ex[4 * i + 1], (unsigned)ex[4 * i + 2], (unsigned)ex[4 * i + 3]};
        } else {
#pragma unroll
            for (int i = 0; i < 4; ++i) *(f32x4*)(GATE + o + 4 * i) = (f32x4){sc[4 * i] * rden, sc[4 * i + 1] * rden, sc[4 * i + 2] * rden, sc[4 * i + 3] * rden};
        }
        asm volatile("s_waitcnt lgkmcnt(0)" ::: "memory"); __builtin_amdgcn_s_barrier(); asm volatile("" ::: "memory");
    }
};
struct OneUnitOrder {
    StaticOrder base; int round;
    __device__ __forceinline__ bool next(int i, Unit& u) const { return i == 0 && base.next(round, u); }
    __device__ __forceinline__ void a_ready(const Unit&) const {}
    __device__ __forceinline__ void done(const Unit&) const {}
};
}
constexpr int NWAVES = 8;
constexpr int BATCH = 4, SEQ = 4096, DM = 1024, TOK = BATCH * SEQ, DEPTH = 4;
constexpr float LN_EPS = 1e-5f;
constexpr size_t MiB = 1u << 20;
constexpr size_t WS_CTL = 0, CTL_ZERO_BYTES = 32 * 1024;
constexpr size_t WS_W_IN = 2 * MiB;
constexpr size_t WS_W_GLU = 6 * MiB;
constexpr size_t WS_W_KV = 14 * MiB;
constexpr size_t WS_W_SQ = 18 * MiB;
constexpr size_t WS_W_SO = 22 * MiB;
constexpr size_t WS_W_EFF = 26 * MiB;
constexpr size_t WS_W_PG = 42 * MiB;
constexpr size_t WS_W_PW = 50 * MiB;
constexpr size_t WS_PB = 52 * MiB;
constexpr size_t WS_IDX = 84 * MiB;
constexpr size_t WS_GATE = 92 * MiB;
constexpr size_t WS_TABU = 100 * MiB;
constexpr size_t WS_TABV = 228 * MiB;
constexpr size_t WS_PW = 356 * MiB;
constexpr size_t WS_H = 484 * MiB, WS_U = 516 * MiB, WS_Y = 548 * MiB, WS_X1 = 580 * MiB, WS_H1 = 612 * MiB, WS_H2 = 644 * MiB, WS_KB = 676 * MiB, WS_VT = 708 * MiB, WS_HKV = 740 * MiB;
constexpr size_t WS_H8 = 772 * MiB, WS_H28 = 788 * MiB;
constexpr size_t WS_W8 = 804 * MiB;
constexpr size_t W8_IN = WS_W8, W8_GLU = WS_W8 + 2 * MiB, W8_KV = WS_W8 + 6 * MiB, W8_SQ = WS_W8 + 8 * MiB, W8_SO = WS_W8 + 10 * MiB, W8_PG = WS_W8 + 12 * MiB;
constexpr float W8_SCALE = 32.0f;
constexpr size_t WS_H18 = 820 * MiB;
constexpr size_t W8_EFF = 836 * MiB;
constexpr size_t WS_END = 844 * MiB;
constexpr int CW_BAR = 4096;
constexpr float PEER_SU = 91.0f, PEER_SV = 4.75f;

constexpr int LDS_BYTES = 163840;
constexpr int RING_BYTES = 131072;
constexpr int MISC_OFF = 163840 - 256;

#define GAS __attribute__((address_space(1)))
#define LAS __attribute__((address_space(3)))
typedef unsigned short bf16;
typedef unsigned v4u __attribute__((ext_vector_type(4)));
typedef unsigned v2u __attribute__((ext_vector_type(2)));
typedef float f32x4 __attribute__((ext_vector_type(4)));
typedef float f32x16 __attribute__((ext_vector_type(16)));
typedef short bf16x8 __attribute__((ext_vector_type(8)));
typedef __bf16 bf16x2_t __attribute__((ext_vector_type(2)));
#define LDS_WAIT() asm volatile("s_waitcnt lgkmcnt(0)" ::: "memory")
#define VM_WAIT() asm volatile("s_waitcnt vmcnt(0)" ::: "memory")
using pg8::cvt_pk_bf16; using pg8::bf_lo; using pg8::bf_hi; using pg8::gelu_tanh;

#define XB_TMO      128
#define XB_XCNT(j)  (256  + 64 * (j))
#define XB_XSUB(j)  (1280 + 64 * (j))
#define XB_XGEN(j)  (2304 + 64 * (j))
#define XB_TOP      3328
#define XB_TOPGEN   3392
#define XCD_BAR_WORDS 3456
#define XB_SPIN_CAP (1u << 24)
__device__ __forceinline__ unsigned xb_ld(unsigned* p)              { return __hip_atomic_load(p, __ATOMIC_RELAXED, __HIP_MEMORY_SCOPE_AGENT); }
__device__ __forceinline__ unsigned xb_add(unsigned* p, unsigned v) { return __hip_atomic_fetch_add(p, v, __ATOMIC_RELAXED, __HIP_MEMORY_SCOPE_AGENT); }
__device__ __forceinline__ unsigned xb_xcc_id() { return (unsigned)__builtin_amdgcn_s_getreg((3 << 11) | 20) & 0xFu; }
#define XB_SPIN(cond, bar) do { unsigned _sp = 0; while (cond) { __builtin_amdgcn_s_sleep(1); \
    if ((++_sp & 255u) == 0u) { if (xb_ld(&(bar)[XB_TMO])) break; if (_sp > XB_SPIN_CAP) { atomicAdd(&(bar)[XB_TMO], 1u); break; } } } } while (0)
struct XcdBarrier { unsigned* bar; unsigned x; volatile LAS unsigned* st; };
__device__ __forceinline__ XcdBarrier xcd_barrier_post(unsigned* bar, volatile LAS unsigned* st) {
    XcdBarrier b; b.bar = bar; b.x = xb_xcc_id(); b.st = st;
    if (threadIdx.x == 0) (void)xb_add(&bar[XB_XCNT(b.x)], 1u);
    return b;
}
__device__ __forceinline__ void xcd_barrier_complete(unsigned* bar, unsigned x, unsigned& nloc, unsigned& nx) {
    const unsigned G = gridDim.x * gridDim.y * gridDim.z;
    unsigned sum, cnt, mine, sp = 0u;
    for (;;) {
        sum = 0u; cnt = 0u; mine = 0u;
#pragma unroll
        for (unsigned j = 0; j < 16; ++j) { const unsigned c = xb_ld(&bar[XB_XCNT(j)]); sum += c; cnt += (c > 0u) ? 1u : 0u; mine = (j == x) ? c : mine; }
        if (sum == G) break;
        __builtin_amdgcn_s_sleep(1);
        if ((++sp & 255u) == 0u) { if (xb_ld(&bar[XB_TMO])) break; if (sp > XB_SPIN_CAP) { atomicAdd(&bar[XB_TMO], 1u); break; } }
    }
    nloc = mine > 0u ? mine : 1u; nx = cnt > 0u ? cnt : 1u;
}
__device__ __forceinline__ void xcd_barrier(const XcdBarrier& b) {
    asm volatile("s_waitcnt vmcnt(0)" ::: "memory");
    __syncthreads();
    if (threadIdx.x == 0) {
        unsigned* bar = b.bar;
        __builtin_amdgcn_s_waitcnt(0);
        unsigned nloc = b.st[0], nx = b.st[1];
        if (nloc == 0u) { xcd_barrier_complete(bar, b.x, nloc, nx); b.st[0] = nloc; b.st[1] = nx; }
        const unsigned old = xb_add(&bar[XB_XSUB(b.x)], 1u);
        const unsigned gen = old / nloc;
        if (old + 1u == (gen + 1u) * nloc) {
            __builtin_amdgcn_fence(__ATOMIC_RELEASE, "agent");
            asm volatile("s_waitcnt vmcnt(0)" ::: "memory");
            const unsigned og = xb_add(&bar[XB_TOP], 1u);
            const unsigned tg = og / nx;
            if (og + 1u == (tg + 1u) * nx) xb_add(&bar[XB_TOPGEN], 1u);
            else XB_SPIN(xb_ld(&bar[XB_TOPGEN]) == tg, bar);
            __builtin_amdgcn_fence(__ATOMIC_ACQUIRE, "agent");
            xb_add(&bar[XB_XGEN(b.x)], 1u);
            asm volatile("s_waitcnt vmcnt(0)" ::: "memory");
        } else {
            XB_SPIN(xb_ld(&bar[XB_XGEN(b.x)]) == gen, bar);
            __builtin_amdgcn_fence(__ATOMIC_ACQUIRE, "agent");
            asm volatile("s_waitcnt vmcnt(0)" ::: "memory");
        }
    }
    __syncthreads();
}

enum PhaseType { P_PROLOGUE = 0, P_STORE = 1, P_SSM = 2, P_GLU = 3, P_LNMIX = 4, P_TOPK = 5, P_PEER = 6, P_PLE = 7, P_LNKV = 8, P_ATTN = 9, P_RES = 10 };
constexpr int MAX_PH = 48;
struct Args { const float* in[28]; float* out; unsigned char* ws; int ph_lo, ph_hi, use_bar, nph; unsigned char ph_type[MAX_PH]; unsigned char ph_arg[MAX_PH]; };
struct Frame {
    LAS unsigned char* lds;
    int tid, lane, wave, vcu, G, z, bx;
    const struct Args* A;
    float* out; unsigned char* ws;
};
__device__ __forceinline__ float wave_sum(float v) {
#pragma unroll
    for (int o = 1; o < 64; o <<= 1) v += __shfl_xor(v, o);
    return v;
}
template <int CTRL, int BANK> __device__ __forceinline__ float dpp_movf(float old, float v) {
    return __builtin_bit_cast(float, __builtin_amdgcn_update_dpp(__builtin_bit_cast(int, old), __builtin_bit_cast(int, v), CTRL, 0xF, BANK, true));
}
__device__ __forceinline__ float wave_sum_dpp(float v) {
    v += dpp_movf<0xB1, 0xF>(0.f, v);
    v += dpp_movf<0x4E, 0xF>(0.f, v);
    { float r = dpp_movf<0x104, 0x5>(0.f, v); r = dpp_movf<0x114, 0xA>(r, v); v += r; }
    v += dpp_movf<0x128, 0xF>(0.f, v);
    { const auto t = __builtin_amdgcn_permlane16_swap(__builtin_bit_cast(unsigned, v), __builtin_bit_cast(unsigned, v), false, false); const unsigned ta = t[0], tb = t[1]; v = __builtin_bit_cast(float, ta) + __builtin_bit_cast(float, tb); }
    { const auto t = __builtin_amdgcn_permlane32_swap(__builtin_bit_cast(unsigned, v), __builtin_bit_cast(unsigned, v), false, false); const unsigned ta = t[0], tb = t[1]; v = __builtin_bit_cast(float, ta) + __builtin_bit_cast(float, tb); }
    return v;
}
__device__ __forceinline__ unsigned f2bf(float f) { unsigned u = __builtin_bit_cast(unsigned, f); return (u + 0x7fffu + ((u >> 16) & 1u)) >> 16; }
__device__ __forceinline__ unsigned pk2(float lo, float hi) { return f2bf(lo) | (f2bf(hi) << 16); }

__device__ __forceinline__ unsigned pk4_fp8(float a, float b, float c, float d) { int w = 0; w = __builtin_amdgcn_cvt_pk_fp8_f32(a, b, w, false); w = __builtin_amdgcn_cvt_pk_fp8_f32(c, d, w, true); return (unsigned)w; }
__device__ __forceinline__ void p0_transpose_item(const float* W, int K, int N, bf16* WT, int glu, LAS float* scr, int item, int lane, unsigned char* WT8 = nullptr) {
    const int nblk = N / 32, kb = item / nblk, nb = item % nblk, k0 = 64 * kb, n0 = 32 * nb;
    int r0 = n0;
    if (glu) { const int bj = n0 >> 10, rem = n0 & 1023; r0 = 256 * (rem >> 7) + 128 * bj + (rem & 127); }
#pragma unroll 8
    for (int i = 0; i < 32; ++i) { const int kk = 2 * i + (lane >> 5); scr[kk * 33 + (lane & 31)] = W[(size_t)(k0 + kk) * N + n0 + (lane & 31)]; }
    LDS_WAIT(); asm volatile("" ::: "memory");
    const int c = lane & 7;
#pragma unroll
    for (int j = 0; j < 4; ++j) { const int n = (lane >> 3) + 8 * j; const LAS float* s = scr + (8 * c) * 33 + n;
        v4u o; o.x = pk2(s[0 * 33], s[1 * 33]); o.y = pk2(s[2 * 33], s[3 * 33]); o.z = pk2(s[4 * 33], s[5 * 33]); o.w = pk2(s[6 * 33], s[7 * 33]);
        if (WT) *(GAS v4u*)(WT + (size_t)(r0 + n) * K + k0 + 8 * c) = o;
        if (WT8) *(GAS v2u*)(WT8 + (size_t)(r0 + n) * K + k0 + 8 * c) = (v2u){pk4_fp8(s[0 * 33] * W8_SCALE, s[1 * 33] * W8_SCALE, s[2 * 33] * W8_SCALE, s[3 * 33] * W8_SCALE), pk4_fp8(s[4 * 33] * W8_SCALE, s[5 * 33] * W8_SCALE, s[6 * 33] * W8_SCALE, s[7 * 33] * W8_SCALE)}; }
    LDS_WAIT(); asm volatile("" ::: "memory");
}
__device__ __forceinline__ void cvt_stream_dual(Frame& F, const float* src, bf16* dst, unsigned char* dst8, size_t n) {
    const size_t nthr = (size_t)F.G * 512, gt = (size_t)F.bx * 512 + F.tid;
    for (size_t i = gt; i < n / 8; i += nthr) {
        const f32x4 a = *(const GAS f32x4*)(src + i * 8), b = *(const GAS f32x4*)(src + i * 8 + 4);
        v4u o; o.x = pk2(a.x, a.y); o.y = pk2(a.z, a.w); o.z = pk2(b.x, b.y); o.w = pk2(b.z, b.w);
        *(GAS v4u*)(dst + i * 8) = o;
        *(GAS v2u*)(dst8 + i * 8) = (v2u){pk4_fp8(a.x, a.y, a.z, a.w), pk4_fp8(b.x, b.y, b.z, b.w)};
    }
}
__device__ __forceinline__ void cvt_stream(Frame& F, const float* src, bf16* dst, size_t n) {
    const size_t nthr = (size_t)F.G * 512, gt = (size_t)F.bx * 512 + F.tid;
    for (size_t i = gt; i < n / 8; i += nthr) {
        const f32x4 a = *(const GAS f32x4*)(src + i * 8), b = *(const GAS f32x4*)(src + i * 8 + 4);
        v4u o; o.x = pk2(a.x, a.y); o.y = pk2(a.z, a.w); o.z = pk2(b.x, b.y); o.w = pk2(b.z, b.w);
        *(GAS v4u*)(dst + i * 8) = o;
    }
}
__device__ __forceinline__ void cvt_stream_fp4(Frame& F, const float* src, unsigned char* dst, size_t n, float scale) {
    const size_t nthr = (size_t)F.G * 512, gt = (size_t)F.bx * 512 + F.tid;
    for (size_t i = gt; i < n / 32; i += nthr) {
        unsigned w[4];
#pragma unroll
        for (int q = 0; q < 4; ++q) {
            const f32x4 a = *(const GAS f32x4*)(src + i * 32 + 8 * q) * scale, b = *(const GAS f32x4*)(src + i * 32 + 8 * q + 4) * scale;
            unsigned t = 0u;
            t = __builtin_amdgcn_cvt_scalef32_pk_fp4_f32(t, a.x, a.y, 1.0f, 0); t = __builtin_amdgcn_cvt_scalef32_pk_fp4_f32(t, a.z, a.w, 1.0f, 1);
            t = __builtin_amdgcn_cvt_scalef32_pk_fp4_f32(t, b.x, b.y, 1.0f, 2); t = __builtin_amdgcn_cvt_scalef32_pk_fp4_f32(t, b.z, b.w, 1.0f, 3);
            w[q] = t;
        }
        *(GAS v4u*)(dst + i * 16) = (v4u){w[0], w[1], w[2], w[3]};
    }
}
__device__ __forceinline__ unsigned pkbf2(float lo, float hi) { return cvt_pk_bf16(lo, hi); }
__device__ __forceinline__ void p0_weff_item(Frame& F, int item) {
    const int jb = item & 1, kb = (item >> 1) & 15, hh = (item >> 5) & 15, l = item >> 9;
    const int lane = F.lane, r32 = lane & 31, h = lane >> 5;
    const float* wq = F.A->in[21 + F.z] + (size_t)l * 1024 * 2048 + (size_t)(64 * kb + r32) * 2048 + 128 * hh + 8 * h;
    const float* ky = F.A->in[22 + (hh & 1) + F.z] + (size_t)l * 128 * 128 + (size_t)(64 * jb + r32) * 128 + 8 * h;
    f32x16 acc[2][2] = {};
#pragma unroll
    for (int ks = 0; ks < 8; ++ks) {
        bf16x8 af[2], bf[2];
#pragma unroll
        for (int a = 0; a < 2; ++a) { const f32x4 a0 = *(const GAS f32x4*)(wq + (size_t)a * 32 * 2048 + 16 * ks), a1 = *(const GAS f32x4*)(wq + (size_t)a * 32 * 2048 + 16 * ks + 4);
            af[a] = __builtin_bit_cast(bf16x8, (v4u){pkbf2(a0.x, a0.y), pkbf2(a0.z, a0.w), pkbf2(a1.x, a1.y), pkbf2(a1.z, a1.w)}); }
#pragma unroll
        for (int b = 0; b < 2; ++b) { const f32x4 b0 = *(const GAS f32x4*)(ky + (size_t)b * 32 * 128 + 16 * ks), b1 = *(const GAS f32x4*)(ky + (size_t)b * 32 * 128 + 16 * ks + 4);
            bf[b] = __builtin_bit_cast(bf16x8, (v4u){pkbf2(b0.x, b0.y), pkbf2(b0.z, b0.w), pkbf2(b1.x, b1.y), pkbf2(b1.z, b1.w)}); }
#pragma unroll
        for (int a = 0; a < 2; ++a)
#pragma unroll
            for (int b = 0; b < 2; ++b) acc[a][b] = __builtin_amdgcn_mfma_f32_32x32x16_bf16(af[a], bf[b], acc[a][b], 0, 0, 0);
    }
#pragma unroll
    for (int a = 0; a < 2; ++a)
#pragma unroll
        for (int b = 0; b < 2; ++b) {
            unsigned char* dst = (unsigned char*)(F.ws + W8_EFF) + (size_t)l * 2048 * 1024 + (size_t)(128 * hh + 64 * jb + 32 * b + r32) * 1024 + 64 * kb + 32 * a + 4 * h;
#pragma unroll
            for (int q = 0; q < 4; ++q) *(GAS unsigned*)(dst + 8 * q) = pk4_fp8(acc[a][b][4 * q] * W8_SCALE, acc[a][b][4 * q + 1] * W8_SCALE, acc[a][b][4 * q + 2] * W8_SCALE, acc[a][b][4 * q + 3] * W8_SCALE); }
}
__device__ __forceinline__ void p0_prologue(Frame& F) {
#ifndef PROBE_PRO
#define PROBE_PRO 0
#endif
    for (int rp = 0; rp < (PROBE_PRO == 4 ? 2 : 1); ++rp) {
    cvt_stream_dual(F, F.A->in[0 + F.z], (bf16*)(F.ws + WS_H), (unsigned char*)(F.ws + WS_H8), (size_t)TOK * DM);
    cvt_stream(F, F.A->in[1 + F.z], (bf16*)(F.ws + WS_PB), (size_t)DEPTH * TOK * 256); }
    LAS float* scr = (LAS float*)(F.lds + F.wave * 8704);
    const int gw = F.vcu * NWAVES + F.wave, NGW = F.G * NWAVES;
    constexpr int I_SQ = 16 * 32, I_GLU = 16 * 64, I_PW = 4 * 32;
    constexpr int NITEMS = 2 * I_SQ + 2 * I_GLU + I_GLU + 2 * I_SQ + 2 * I_SQ + 4 * I_SQ + 4 * I_PW;
    for (int rp = 0; rp < (PROBE_PRO == 2 ? 2 : 1); ++rp)
    for (int it = gw; it < NITEMS; it += NGW) {
        int r = it;
        if (r < 2 * I_SQ) { const int l = r / I_SQ; p0_transpose_item(F.A->in[6 + F.z] + (size_t)l * 1024 * 1024, 1024, 1024, nullptr, 0, scr, r % I_SQ, F.lane, (unsigned char*)(F.ws + W8_IN) + (size_t)l * 1024 * 1024); continue; } r -= 2 * I_SQ;
        if (r < 2 * I_GLU) { const int l = r / I_GLU; p0_transpose_item(F.A->in[15 + F.z] + (size_t)l * 1024 * 2048, 1024, 2048, nullptr, 1, scr, r % I_GLU, F.lane, (unsigned char*)(F.ws + W8_GLU) + (size_t)l * 2048 * 1024); continue; } r -= 2 * I_GLU;
        if (r < I_GLU) { p0_transpose_item(F.A->in[18 + F.z], 1024, 2048, nullptr, 0, scr, r, F.lane, (unsigned char*)(F.ws + W8_KV)); continue; } r -= I_GLU;
        if (r < 2 * I_SQ) { const int l = r / I_SQ; p0_transpose_item(F.A->in[19 + F.z] + (size_t)l * 1024 * 1024, 1024, 1024, nullptr, 0, scr, r % I_SQ, F.lane, (unsigned char*)(F.ws + W8_SQ) + (size_t)l * 1024 * 1024); continue; } r -= 2 * I_SQ;
        if (r < 2 * I_SQ) { const int l = r / I_SQ; p0_transpose_item(F.A->in[20 + F.z] + (size_t)l * 1024 * 1024, 1024, 1024, nullptr, 0, scr, r % I_SQ, F.lane, (unsigned char*)(F.ws + W8_SO) + (size_t)l * 1024 * 1024); continue; } r -= 2 * I_SQ;
        if (r < 4 * I_SQ) { const int l = r / I_SQ; p0_transpose_item(F.A->in[27 + F.z] + (size_t)l * 1024 * 1024, 1024, 1024, nullptr, 0, scr, r % I_SQ, F.lane, (unsigned char*)(F.ws + W8_PG) + (size_t)l * 1024 * 1024); continue; } r -= 4 * I_SQ;
        { const int l = r / I_PW; p0_transpose_item(F.A->in[26 + F.z] + (size_t)l * 256 * 1024, 256, 1024, (bf16*)(F.ws + WS_W_PW) + (size_t)l * 1024 * 256, 0, scr, r % I_PW, F.lane); }
    }
    for (int rp = 0; rp < (PROBE_PRO == 3 ? 2 : 1); ++rp)
    for (int it = gw; it < 2048; it += NGW) p0_weff_item(F, it);
}

__device__ __forceinline__ void ln_rows(Frame& F, const bf16* X, const float* g, const float* bb, bf16* O, unsigned char* O8 = nullptr) {
    const int gw = F.vcu * NWAVES + F.wave, NGW = F.G * NWAVES;
    float gg[16], bv[16];
    { const f32x4 a = *(const GAS f32x4*)(g + 8 * F.lane), b = *(const GAS f32x4*)(g + 8 * F.lane + 4), c = *(const GAS f32x4*)(g + 512 + 8 * F.lane), d = *(const GAS f32x4*)(g + 512 + 8 * F.lane + 4);
      gg[0] = a.x; gg[1] = a.y; gg[2] = a.z; gg[3] = a.w; gg[4] = b.x; gg[5] = b.y; gg[6] = b.z; gg[7] = b.w; gg[8] = c.x; gg[9] = c.y; gg[10] = c.z; gg[11] = c.w; gg[12] = d.x; gg[13] = d.y; gg[14] = d.z; gg[15] = d.w; }
    { const f32x4 a = *(const GAS f32x4*)(bb + 8 * F.lane), b = *(const GAS f32x4*)(bb + 8 * F.lane + 4), c = *(const GAS f32x4*)(bb + 512 + 8 * F.lane), d = *(const GAS f32x4*)(bb + 512 + 8 * F.lane + 4);
      bv[0] = a.x; bv[1] = a.y; bv[2] = a.z; bv[3] = a.w; bv[4] = b.x; bv[5] = b.y; bv[6] = b.z; bv[7] = b.w; bv[8] = c.x; bv[9] = c.y; bv[10] = c.z; bv[11] = c.w; bv[12] = d.x; bv[13] = d.y; bv[14] = d.z; bv[15] = d.w; }
    for (int m = gw; m < TOK; m += NGW) {
        const v4u xa = *(const GAS v4u*)(X + (size_t)m * DM + 8 * F.lane), xb = *(const GAS v4u*)(X + (size_t)m * DM + 512 + 8 * F.lane);
        float x[16] = {bf_lo(xa.x), bf_hi(xa.x), bf_lo(xa.y), bf_hi(xa.y), bf_lo(xa.z), bf_hi(xa.z), bf_lo(xa.w), bf_hi(xa.w), bf_lo(xb.x), bf_hi(xb.x), bf_lo(xb.y), bf_hi(xb.y), bf_lo(xb.z), bf_hi(xb.z), bf_lo(xb.w), bf_hi(xb.w)};
        float s = 0.f;
#pragma unroll
        for (int i = 0; i < 16; ++i) s += x[i];
        const float mean = wave_sum_dpp(s) * (1.f / DM); float q = 0.f;
#pragma unroll
        for (int i = 0; i < 16; ++i) { x[i] -= mean; q += x[i] * x[i]; }
        const float rstd = 1.0f / sqrtf(wave_sum_dpp(q) * (1.f / DM) + LN_EPS);
#pragma unroll
        for (int i = 0; i < 16; ++i) x[i] = x[i] * rstd * gg[i] + bv[i];
        v4u oa, ob; oa.x = pk2(x[0], x[1]); oa.y = pk2(x[2], x[3]); oa.z = pk2(x[4], x[5]); oa.w = pk2(x[6], x[7]); ob.x = pk2(x[8], x[9]); ob.y = pk2(x[10], x[11]); ob.z = pk2(x[12], x[13]); ob.w = pk2(x[14], x[15]);
        if (O) { *(GAS v4u*)(O + (size_t)m * DM + 8 * F.lane) = oa; *(GAS v4u*)(O + (size_t)m * DM + 512 + 8 * F.lane) = ob; }
        if (O8) { *(GAS v2u*)(O8 + (size_t)m * DM + 8 * F.lane) = (v2u){pk4_fp8(x[0], x[1], x[2], x[3]), pk4_fp8(x[4], x[5], x[6], x[7])};
                  *(GAS v2u*)(O8 + (size_t)m * DM + 512 + 8 * F.lane) = (v2u){pk4_fp8(x[8], x[9], x[10], x[11]), pk4_fp8(x[12], x[13], x[14], x[15])}; }
    }
}
struct TabCvt { const float* su; const float* sv; unsigned char* du; unsigned char* dv; int c, cf, stride, n; };
__device__ __forceinline__ void tabcvt_issue(TabCvt& T, int lane, f32x4 (&cv)[4]) {
    const bool live = T.c < T.n;
    if (live) { const int half = T.n >> 1; const float* src = (T.c < half ? T.su + (size_t)T.c * 1024 : T.sv + (size_t)(T.c - half) * 1024) + 16 * lane;
#pragma unroll
        for (int q = 0; q < 4; ++q) cv[q] = *(const GAS f32x4*)(src + 4 * q); }
    T.c += T.stride;
}
__device__ __forceinline__ unsigned i4q(float v) { float t = __builtin_fminf(__builtin_fmaxf(v * PEER_SU, -7.f), 7.f) + 12582912.0f; asm volatile("" : "+v"(t)); return __builtin_bit_cast(unsigned, t) & 15u; }
__device__ __forceinline__ unsigned pack8_i4(const f32x4& a, const f32x4& b) {
    return i4q(a.x) | (i4q(a.y) << 4) | (i4q(a.z) << 8) | (i4q(a.w) << 12) | (i4q(b.x) << 16) | (i4q(b.y) << 20) | (i4q(b.z) << 24) | (i4q(b.w) << 28);
}
__device__ __forceinline__ void tabcvt_finish(TabCvt& T, int lane, const f32x4 (&cv)[4]) {
    const bool live = T.cf < T.n;
    if (live) { const int half = T.n >> 1;
        unsigned w0 = 0u, w1 = 0u;
        if (T.cf < half) { w0 = pack8_i4(cv[0], cv[1]); w1 = pack8_i4(cv[2], cv[3]); }
        else { const float sc = PEER_SV;
            w0 = __builtin_amdgcn_cvt_scalef32_pk_fp4_f32(w0, cv[0].x * sc, cv[0].y * sc, 1.0f, 0); w0 = __builtin_amdgcn_cvt_scalef32_pk_fp4_f32(w0, cv[0].z * sc, cv[0].w * sc, 1.0f, 1);
            w0 = __builtin_amdgcn_cvt_scalef32_pk_fp4_f32(w0, cv[1].x * sc, cv[1].y * sc, 1.0f, 2); w0 = __builtin_amdgcn_cvt_scalef32_pk_fp4_f32(w0, cv[1].z * sc, cv[1].w * sc, 1.0f, 3);
            w1 = __builtin_amdgcn_cvt_scalef32_pk_fp4_f32(w1, cv[2].x * sc, cv[2].y * sc, 1.0f, 0); w1 = __builtin_amdgcn_cvt_scalef32_pk_fp4_f32(w1, cv[2].z * sc, cv[2].w * sc, 1.0f, 1);
            w1 = __builtin_amdgcn_cvt_scalef32_pk_fp4_f32(w1, cv[3].x * sc, cv[3].y * sc, 1.0f, 2); w1 = __builtin_amdgcn_cvt_scalef32_pk_fp4_f32(w1, cv[3].z * sc, cv[3].w * sc, 1.0f, 3); }
        unsigned char* dst = (T.cf < half ? T.du + (size_t)T.cf * 512 : T.dv + (size_t)(T.cf - half) * 512) + 8 * lane;
        *(GAS v2u*)dst = (v2u){w0, w1}; }
    T.cf += T.stride;
}
template <bool PASS1> __device__ __forceinline__ void ssm_pass(const bf16* U, bf16* Y, LAS unsigned char* stl, const float* dskip, size_t tok0, int g, int lane, int n, int hh, int i_row,
                                                                  const float (&a_re)[2], const float (&a_im)[2], const bf16x8 (&Bf)[4], const LAS unsigned char* CFL, float (&s_re)[2], float (&s_im)[2]) {
    const int c0 = 16 * g + 4 * hh;
    bf16x8 ua_n = *(const GAS bf16x8*)(U + tok0 * DM + 16 * g + 8 * hh);
    v2u u0_n = {}, u1_n = {};
    if (PASS1) { u0_n = *(const GAS v2u*)(U + tok0 * DM + c0); u1_n = *(const GAS v2u*)(U + tok0 * DM + c0 + 8); }
#pragma unroll 1
    for (int tile = 0; tile < 16; ++tile) {
        const size_t tok = tok0 + tile * 16;
        const bf16x8 ua = ua_n; const v2u u0 = u0_n, u1 = u1_n;
        { const size_t tokn = tok0 + ((tile + 1) & 15) * 16;
          ua_n = *(const GAS bf16x8*)(U + tokn * DM + 16 * g + 8 * hh);
          if (PASS1) { u0_n = *(const GAS v2u*)(U + tokn * DM + c0); u1_n = *(const GAS v2u*)(U + tokn * DM + c0 + 8); } }
        f32x16 acc[4];
#pragma unroll
        for (int nb = 0; nb < 4; ++nb) { f32x16 z = {}; acc[nb] = __builtin_amdgcn_mfma_f32_32x32x16_bf16(ua, Bf[nb], z, 0, 0, 0); }
#pragma unroll
        for (int pb = 0; pb < 2; ++pb) {
#pragma unroll
            for (int r = 0; r < 16; ++r) {
                float t0 = fmaf(-a_im[pb], s_im[pb], acc[2 * pb][r]); asm volatile("" : "+v"(t0));
                float t1 = fmaf(a_im[pb], s_re[pb], acc[2 * pb + 1][r]); asm volatile("" : "+v"(t1));
                float nre = fmaf(a_re[pb], s_re[pb], t0); asm volatile("" : "+v"(nre));
                float nim = fmaf(a_re[pb], s_im[pb], t1); asm volatile("" : "+v"(nim));
                s_re[pb] = nre; s_im[pb] = nim;
                if (PASS1) { const int irow = (r & 3) + 8 * (r >> 2) + 4 * hh; *(LAS unsigned*)(stl + irow * 272 + (32 * pb + n) * 4) = cvt_pk_bf16(nre, nim); }
            }
        }
        if (PASS1) {
            LDS_WAIT();
            f32x16 yv = {};
#pragma unroll
            for (int ks = 0; ks < 8; ++ks) { const bf16x8 sb = *(const LAS bf16x8*)(stl + i_row * 272 + (16 * ks + 8 * hh) * 2); const bf16x8 cf = *(const LAS bf16x8*)(CFL + (ks * 64 + lane) * 16); yv = __builtin_amdgcn_mfma_f32_32x32x16_bf16(cf, sb, yv, 0, 0, 0); }
            const f32x4 d0 = *(const GAS f32x4*)(dskip + c0), d1 = *(const GAS f32x4*)(dskip + c0 + 8);
            float o[8];
            o[0] = gelu_tanh(yv[0] + d0.x * bf_lo(u0.x)); o[1] = gelu_tanh(yv[1] + d0.y * bf_hi(u0.x)); o[2] = gelu_tanh(yv[2] + d0.z * bf_lo(u0.y)); o[3] = gelu_tanh(yv[3] + d0.w * bf_hi(u0.y));
            o[4] = gelu_tanh(yv[4] + d1.x * bf_lo(u1.x)); o[5] = gelu_tanh(yv[5] + d1.y * bf_hi(u1.x)); o[6] = gelu_tanh(yv[6] + d1.z * bf_lo(u1.y)); o[7] = gelu_tanh(yv[7] + d1.w * bf_hi(u1.y));
            *(GAS unsigned*)((unsigned char*)Y + tok * DM + c0) = pk4_fp8(o[0], o[1], o[2], o[3]);
            *(GAS unsigned*)((unsigned char*)Y + tok * DM + c0 + 8) = pk4_fp8(o[4], o[5], o[6], o[7]);
            LDS_WAIT();
        }
    }
}
__device__ __forceinline__ void ssm_phase(Frame& F, int layer) {
    if (layer == 0) {
        TabCvt TC; TC.su = F.A->in[24 + F.z]; TC.sv = F.A->in[25 + F.z]; TC.du = (unsigned char*)(F.ws + WS_TABU); TC.dv = (unsigned char*)(F.ws + WS_TABV);
        TC.c = F.vcu * NWAVES + F.wave; TC.cf = TC.c; TC.stride = F.G * NWAVES; TC.n = 2 * 16384;
        f32x4 cvA[4], cvB[4];
        tabcvt_issue(TC, F.lane, cvA);
        while (TC.cf < TC.n) { tabcvt_issue(TC, F.lane, cvB); tabcvt_finish(TC, F.lane, cvA); tabcvt_issue(TC, F.lane, cvA); tabcvt_finish(TC, F.lane, cvB); }
    }
    const bf16* U = (const bf16*)(F.ws + WS_U); bf16* Y = (bf16*)(F.ws + WS_Y);
    const int lane = F.lane, n = lane & 31, hh = lane >> 5, wave = F.wave;
    LAS unsigned char* stl = F.lds + wave * 8704;
    LAS float* E = (LAS float*)(F.lds + 8 * 8704);
    for (int bg = F.vcu; bg < BATCH * 64; bg += F.G) {
        const int b = bg >> 6, g = bg & 63, lg = layer * 64 + g;
        const float dt = expf(F.A->in[9 + F.z][lg]);
        float a_re[2], a_im[2]; bf16x8 Bf[4];
#pragma unroll
        for (int pb = 0; pb < 2; ++pb) {
            const int p = 32 * pb + n;
            const float lre = F.A->in[7 + F.z][lg * 64 + p], lim = F.A->in[8 + F.z][lg * 64 + p];
            const float mag = expf(lre * dt); float sn, cs; sincosf(lim * dt, &sn, &cs);
            a_re[pb] = mag * cs; a_im[pb] = mag * sn;
            const float nr = a_re[pb] - 1.0f, ni = a_im[pb], den = 1.0f / (lre * lre + lim * lim);
            const float cr = (nr * lre + ni * lim) * den, ci = (ni * lre - nr * lim) * den;
            const float* br = F.A->in[10 + F.z] + ((size_t)lg * 64 + p) * 16 + 8 * hh; const float* bi = F.A->in[11 + F.z] + ((size_t)lg * 64 + p) * 16 + 8 * hh;
            const f32x4 br0 = *(const GAS f32x4*)br, br1 = *(const GAS f32x4*)(br + 4), bi0 = *(const GAS f32x4*)bi, bi1 = *(const GAS f32x4*)(bi + 4);
            const float rr[8] = {br0.x, br0.y, br0.z, br0.w, br1.x, br1.y, br1.z, br1.w}, ii[8] = {bi0.x, bi0.y, bi0.z, bi0.w, bi1.x, bi1.y, bi1.z, bi1.w};
            unsigned wre[4], wim[4];
#pragma unroll
            for (int j = 0; j < 4; ++j) { const float r0 = rr[2 * j], i0 = ii[2 * j], r1 = rr[2 * j + 1], i1 = ii[2 * j + 1];
                wre[j] = pk2(cr * r0 - ci * i0, cr * r1 - ci * i1); wim[j] = pk2(cr * i0 + ci * r0, cr * i1 + ci * r1); }
            Bf[2 * pb] = __builtin_bit_cast(bf16x8, (v4u){wre[0], wre[1], wre[2], wre[3]});
            Bf[2 * pb + 1] = __builtin_bit_cast(bf16x8, (v4u){wim[0], wim[1], wim[2], wim[3]});
        }
        LAS unsigned char* CFL = F.lds + 8 * 8704 + 8192;
        if (wave == 0) { const int cr_ = n & 15; const float zm = (n < 16) ? 1.0f : 0.0f;
          const float* cre = F.A->in[12 + F.z] + ((size_t)lg * 16 + cr_) * 64 + 4 * hh; const float* cim = F.A->in[13 + F.z] + ((size_t)lg * 16 + cr_) * 64 + 4 * hh;
          f32x4 cr4[8], ci4[8];
#pragma unroll
          for (int ks = 0; ks < 8; ++ks) { cr4[ks] = *(const GAS f32x4*)(cre + 8 * ks); ci4[ks] = *(const GAS f32x4*)(cim + 8 * ks); }
#pragma unroll
          for (int ks = 0; ks < 8; ++ks) { const f32x4 a = cr4[ks] * zm, c = ci4[ks] * (-zm);
              *(LAS v4u*)(CFL + (ks * 64 + lane) * 16) = (v4u){pk2(a.x, c.x), pk2(a.y, c.y), pk2(a.z, c.z), pk2(a.w, c.w)}; } }
        const int seg_own = 2 * wave + hh;
        const int i_row = n, seg_ld = 2 * wave + ((i_row >> 2) & 1), tau_ld = (i_row & 3) + 4 * (i_row >> 3);
        const size_t tok0 = (size_t)b * SEQ + seg_ld * 256 + tau_ld;
        const float* dskip = F.A->in[14 + F.z] + layer * 1024;
        float s_re[2] = {0.f, 0.f}, s_im[2] = {0.f, 0.f};
        ssm_pass<false>(U, Y, stl, dskip, tok0, g, lane, n, hh, i_row, a_re, a_im, Bf, CFL, s_re, s_im);
#pragma unroll
        for (int pb = 0; pb < 2; ++pb) { E[(seg_own * 64 + 32 * pb + n) * 2] = s_re[pb]; E[(seg_own * 64 + 32 * pb + n) * 2 + 1] = s_im[pb]; }
        LDS_WAIT(); __syncthreads();
#pragma unroll
        for (int pb = 0; pb < 2; ++pb) {
            float Ar = a_re[pb], Ai = a_im[pb];
#pragma unroll
            for (int q = 0; q < 8; ++q) { float t = Ar * Ar - Ai * Ai; asm volatile("" : "+v"(t)); Ai = 2.0f * Ar * Ai; asm volatile("" : "+v"(Ai)); Ar = t; }
            float sr = 0.f, si = 0.f;
            for (int j = 0; j < 15; ++j) {
                const float er = E[(j * 64 + 32 * pb + n) * 2], ei = E[(j * 64 + 32 * pb + n) * 2 + 1];
                float tr = Ar * sr - Ai * si + er; asm volatile("" : "+v"(tr)); float ti = Ar * si + Ai * sr + ei; asm volatile("" : "+v"(ti));
                if (j < seg_own) { sr = tr; si = ti; }
            }
            s_re[pb] = sr; s_im[pb] = si;
        }
        __syncthreads();
        ssm_pass<true>(U, Y, stl, dskip, tok0, g, lane, n, hh, i_row, a_re, a_im, Bf, CFL, s_re, s_im);
        __syncthreads();
    }
}

__device__ __forceinline__ void attn_wave_unit(Frame& F, int b, int hd, int qt) {
    const bf16* Q = (const bf16*)(F.ws + WS_U); const bf16* K = (const bf16*)(F.ws + WS_KB); const bf16* Vt = (const bf16*)(F.ws + WS_VT); bf16* O = (bf16*)(F.ws + WS_Y);
    constexpr float ATT_EXIT = 28.0f;
    const int lane = F.lane, n = lane & 31, hh = lane >> 5;
    const size_t qrow = (size_t)b * SEQ + 32 * qt + n;
    bf16x8 qf[4];
#pragma unroll
    for (int ks = 0; ks < 4; ++ks) qf[ks] = *(const GAS bf16x8*)(Q + qrow * DM + 64 * hd + 16 * ks + 8 * hh);
    f32x16 o[2]; o[0] = f32x16{}; o[1] = f32x16{};
    float racc = 0.f;
    const int qrel = 32 * qt, myq = qrel + n;
    const int keyi = (n & 3) + 4 * (n >> 3) + 16 * ((n >> 2) & 1);
    const bf16* kbase = K + ((size_t)b * SEQ + keyi) * DM + 64 * hd + 8 * hh;
    const bf16* vbase = Vt + (size_t)(64 * hd + n) * TOK + (size_t)b * SEQ + 16 * hh;
    int T = (qrel + 30) >> 6;
    bf16x8 kf[2][4];
#pragma unroll
    for (int u = 0; u < 2; ++u)
#pragma unroll
        for (int ks = 0; ks < 4; ++ks) kf[u][ks] = *(const GAS bf16x8*)(kbase + (size_t)(64 * T + 32 * u) * DM + 16 * ks);
    for (; T >= 0; --T) {
        const int k0 = 64 * T;
        f32x16 s0 = {}, s1 = {};
#pragma unroll
        for (int ks = 0; ks < 4; ++ks) { s0 = __builtin_amdgcn_mfma_f32_32x32x16_bf16(kf[0][ks], qf[ks], s0, 0, 0, 0); s1 = __builtin_amdgcn_mfma_f32_32x32x16_bf16(kf[1][ks], qf[ks], s1, 0, 0, 0); }
        bf16x8 vf[2][2][2];
#pragma unroll
        for (int u = 0; u < 2; ++u)
#pragma unroll
            for (int sx = 0; sx < 2; ++sx)
#pragma unroll
                for (int db = 0; db < 2; ++db) vf[u][sx][db] = *(const GAS bf16x8*)(vbase + (size_t)(32 * db) * TOK + k0 + 32 * u + 8 * sx);
        { const int Tn = T > 0 ? T - 1 : 0;
#pragma unroll
          for (int u = 0; u < 2; ++u)
#pragma unroll
              for (int ks = 0; ks < 4; ++ks) kf[u][ks] = *(const GAS bf16x8*)(kbase + (size_t)(64 * Tn + 32 * u) * DM + 16 * ks); }
        const bool need_mask = (k0 + 63 >= qrel);
        float sp[2][16], z[2][16];
#pragma unroll
        for (int r = 0; r < 16; ++r) { const float za = fminf(s0[r], 60.0f), zb = fminf(s1[r], 60.0f); z[0][r] = za; z[1][r] = zb;
            sp[0][r] = __builtin_amdgcn_logf(1.0f + __builtin_amdgcn_exp2f(za)); sp[1][r] = __builtin_amdgcn_logf(1.0f + __builtin_amdgcn_exp2f(zb)); }
        if (need_mask) {
#pragma unroll
            for (int u = 0; u < 2; ++u)
#pragma unroll
                for (int r = 0; r < 16; ++r) { const int key = k0 + 32 * u + 16 * hh + r; if (key >= myq) { sp[u][r] = 0.f; z[u][r] = -1e30f; } }
        }
        float T0 = 0.f, T1 = 0.f;
#pragma unroll
        for (int r = 0; r < 16; ++r) { T0 += sp[0][r]; T1 += sp[1][r]; }
        const float oT0 = __shfl_xor(T0, 32), oT1 = __shfl_xor(T1, 32);
        const float off1 = racc + (hh ? 0.f : oT1);
        const float off0 = racc + T1 + oT1 + (hh ? 0.f : oT0);
        racc += T0 + T1 + oT0 + oT1;
        unsigned pw[2][8];
        { float run = off1;
#pragma unroll
          for (int r = 15; r >= 0; --r) { run += sp[1][r]; z[1][r] = __builtin_amdgcn_exp2f(z[1][r] - run); }
          run = off0;
#pragma unroll
          for (int r = 15; r >= 0; --r) { run += sp[0][r]; z[0][r] = __builtin_amdgcn_exp2f(z[0][r] - run); } }
#pragma unroll
        for (int u = 0; u < 2; ++u)
#pragma unroll
            for (int q = 0; q < 8; ++q) pw[u][q] = cvt_pk_bf16(z[u][2 * q], z[u][2 * q + 1]);
#pragma unroll
        for (int u = 0; u < 2; ++u)
#pragma unroll
            for (int sx = 0; sx < 2; ++sx) { const bf16x8 af = __builtin_bit_cast(bf16x8, (v4u){pw[u][4 * sx], pw[u][4 * sx + 1], pw[u][4 * sx + 2], pw[u][4 * sx + 3]});
#pragma unroll
                for (int db = 0; db < 2; ++db) o[db] = __builtin_amdgcn_mfma_f32_32x32x16_bf16(af, vf[u][sx][db], o[db], 0, 0, 0); }
        if (__all(racc >= ATT_EXIT)) break;
    }
#pragma unroll
    for (int db = 0; db < 2; ++db)
#pragma unroll
        for (int r = 0; r < 16; ++r) { const int qr = (r & 3) + 8 * (r >> 2) + 4 * hh;
            ((unsigned char*)O)[((size_t)b * SEQ + 32 * qt + qr) * DM + 64 * hd + 32 * db + n] = (unsigned char)(pk4_fp8(o[db][r], 0.f, 0.f, 0.f) & 0xffu); }
}
__device__ __forceinline__ void attn_phase(Frame& F) {
    const int gw = F.vcu * NWAVES + F.wave, NGW = F.G * NWAVES;
#pragma unroll 1
    for (int uidx = gw; uidx < 64 * 128; uidx += NGW) { const int bh = uidx >> 7; attn_wave_unit(F, bh >> 4, bh & 15, uidx & 127); }
}

typedef float f32x2 __attribute__((ext_vector_type(2)));
typedef _Float16 h16x2 __attribute__((ext_vector_type(2)));
template <int K, class T> __device__ __forceinline__ T xcomb(T a, T b, int lane) {
    const bool hi = (lane >> K) & 1; const T keep = hi ? b : a, send = hi ? a : b;
    return keep + __shfl_xor(send, 1 << K);
}
__device__ __forceinline__ void fp4x16_to_f32(const v2u& r, f32x2 (&f)[8]) {
    const unsigned w0 = r.x, w1 = r.y;
    f[0] = __builtin_amdgcn_cvt_scalef32_pk_f32_fp4(w0, 1.0f, 0); f[1] = __builtin_amdgcn_cvt_scalef32_pk_f32_fp4(w0, 1.0f, 1);
    f[2] = __builtin_amdgcn_cvt_scalef32_pk_f32_fp4(w0, 1.0f, 2); f[3] = __builtin_amdgcn_cvt_scalef32_pk_f32_fp4(w0, 1.0f, 3);
    f[4] = __builtin_amdgcn_cvt_scalef32_pk_f32_fp4(w1, 1.0f, 0); f[5] = __builtin_amdgcn_cvt_scalef32_pk_f32_fp4(w1, 1.0f, 1);
    f[6] = __builtin_amdgcn_cvt_scalef32_pk_f32_fp4(w1, 1.0f, 2); f[7] = __builtin_amdgcn_cvt_scalef32_pk_f32_fp4(w1, 1.0f, 3);
}
typedef unsigned bl_v2u __attribute__((__vector_size__(8)));
__device__ __forceinline__ void peer_load8(__amdgpu_buffer_rsrc_t tab, int idv, int e0, int lane, v2u (&R)[8]) {
    int so[8];
    __builtin_amdgcn_s_setprio(1);
#pragma unroll
    for (int i = 0; i < 8; ++i) so[i] = __builtin_amdgcn_readlane(idv, e0 + i) << 9;
    __builtin_amdgcn_sched_barrier(0);
#pragma unroll
    for (int i = 0; i < 8; ++i) { const bl_v2u t = __builtin_amdgcn_raw_buffer_load_b64(tab, 8 * lane, so[i], 0); R[i] = (v2u){t[0], t[1]}; }
    __builtin_amdgcn_s_setprio(0);
    __builtin_amdgcn_sched_barrier(0);
}
template <int K> __device__ __forceinline__ int xcomb_dpp(int a, int b, int lane) {
    const bool hi = (lane >> K) & 1; const int keep = hi ? b : a, send = hi ? a : b; int recv;
    if (K == 0) recv = __builtin_amdgcn_update_dpp(0, send, 0xB1, 0xF, 0xF, true);
    else if (K == 1) recv = __builtin_amdgcn_update_dpp(0, send, 0x4E, 0xF, 0xF, true);
    else { recv = __builtin_amdgcn_update_dpp(0, send, 0x104, 0xF, 0x5, true);
           recv = __builtin_amdgcn_update_dpp(recv, send, 0x114, 0xF, 0xA, true); }
    return keep + recv;
}
__device__ __forceinline__ float peer_dot8(const v2u (&R)[8], const v2u& xhi, const v2u& xlo, int lane) {
    int p[8];
#pragma unroll
    for (int i = 0; i < 8; ++i) { const int r0 = (int)R[i].x, r1 = (int)R[i].y;
        int h = __builtin_amdgcn_sdot8(r0, (int)xhi.x, 0, false); h = __builtin_amdgcn_sdot8(r1, (int)xhi.y, h, false);
        int l = __builtin_amdgcn_sdot8(r0, (int)xlo.x, 0, false); l = __builtin_amdgcn_sdot8(r1, (int)xlo.y, l, false);
        p[i] = (h << 4) + l; __builtin_amdgcn_sched_barrier(0); }
    int q[4];
#pragma unroll
    for (int i = 0; i < 4; ++i) q[i] = xcomb_dpp<0>(p[2 * i], p[2 * i + 1], lane);
    const int r0 = xcomb_dpp<1>(q[0], q[1], lane), r1 = xcomb_dpp<1>(q[2], q[3], lane);
    int v = xcomb_dpp<2>(r0, r1, lane);
    v += __builtin_amdgcn_update_dpp(0, v, 0x128, 0xF, 0xF, true);
    { const auto t = __builtin_amdgcn_permlane16_swap((unsigned)v, (unsigned)v, false, false); v = (int)(t[0] + t[1]); }
    { const auto t = __builtin_amdgcn_permlane32_swap((unsigned)v, (unsigned)v, false, false); v = (int)(t[0] + t[1]); }
    return (float)v;
}
__device__ __forceinline__ void peer_fma8(const v2u (&R)[8], unsigned wvh, int e0, h16x2 (&o)[8]) {
#pragma unroll
    for (int i = 0; i < 8; ++i) { const unsigned wt = (unsigned)__builtin_amdgcn_readlane((int)wvh, e0 + i); const h16x2 w2 = __builtin_bit_cast(h16x2, wt);
        const unsigned w0 = R[i].x, w1 = R[i].y; h16x2 f[8];
        f[0] = __builtin_amdgcn_cvt_scalef32_pk_f16_fp4(w0, 1.0f, 0); f[1] = __builtin_amdgcn_cvt_scalef32_pk_f16_fp4(w0, 1.0f, 1);
        f[2] = __builtin_amdgcn_cvt_scalef32_pk_f16_fp4(w0, 1.0f, 2); f[3] = __builtin_amdgcn_cvt_scalef32_pk_f16_fp4(w0, 1.0f, 3);
        f[4] = __builtin_amdgcn_cvt_scalef32_pk_f16_fp4(w1, 1.0f, 0); f[5] = __builtin_amdgcn_cvt_scalef32_pk_f16_fp4(w1, 1.0f, 1);
        f[6] = __builtin_amdgcn_cvt_scalef32_pk_f16_fp4(w1, 1.0f, 2); f[7] = __builtin_amdgcn_cvt_scalef32_pk_f16_fp4(w1, 1.0f, 3);
#pragma unroll
        for (int k = 0; k < 8; ++k) o[k] = __builtin_elementwise_fma(w2, f[k], o[k]);
        __builtin_amdgcn_sched_barrier(0); }
}
__device__ __forceinline__ void peer_phase(Frame& F, int layer) {
    const bf16* H1 = (const bf16*)(F.ws + WS_H1); bf16* H2 = (bf16*)(F.ws + WS_H2);
    const __amdgpu_buffer_rsrc_t TU = __builtin_amdgcn_make_buffer_rsrc((void*)(F.ws + WS_TABU + (size_t)layer * 16384 * 512), (short)0, 16384 * 512, 0x00020000);
    const __amdgpu_buffer_rsrc_t TV = __builtin_amdgcn_make_buffer_rsrc((void*)(F.ws + WS_TABV + (size_t)layer * 16384 * 512), (short)0, 16384 * 512, 0x00020000);
    const int* IDX = (const int*)(F.ws + WS_IDX); const float* GATE = (const float*)(F.ws + WS_GATE);
    const float* g = F.A->in[4 + F.z] + layer * 1024; const float* bb = F.A->in[5 + F.z] + layer * 1024;
    const int lane = F.lane, gw = F.vcu * NWAVES + F.wave, NGW = F.G * NWAVES;
    v2u B0[8], B1[8], B2[8], B3[8];
    TabCvt TC; { const size_t lo = (size_t)(layer + 1) * 16384 * 1024;
        TC.su = F.A->in[24 + F.z] + lo; TC.sv = F.A->in[25 + F.z] + lo; TC.du = (unsigned char*)(F.ws + WS_TABU) + lo / 2; TC.dv = (unsigned char*)(F.ws + WS_TABV) + lo / 2;
        TC.c = gw; TC.cf = gw; TC.stride = NGW; TC.n = (layer + 1 < DEPTH) ? 2 * 16384 : 0; }
    f32x4 cvA[4], cvB[4];
    int id0 = 0, id1 = 0;
    if (gw < TOK) { id0 = IDX[(size_t)gw * 128 + lane]; id1 = IDX[(size_t)gw * 128 + 64 + lane];
        peer_load8(TU, id0, 0, lane, B0); peer_load8(TU, id0, 8, lane, B1); peer_load8(TU, id0, 16, lane, B2); }
    tabcvt_issue(TC, lane, cvA); tabcvt_issue(TC, lane, cvB);
    for (int t = gw; t < TOK; t += NGW) {
        const int tn = (t + NGW < TOK) ? t + NGW : t;
        const int nid0 = IDX[(size_t)tn * 128 + lane], nid1 = IDX[(size_t)tn * 128 + 64 + lane];
        const float g0 = GATE[(size_t)t * 128 + lane], g1 = GATE[(size_t)t * 128 + 64 + lane];
        const v4u xa = *(const GAS v4u*)(H1 + (size_t)t * DM + 16 * lane), xb = *(const GAS v4u*)(H1 + (size_t)t * DM + 16 * lane + 8);
        f32x2 x[8] = {{bf_lo(xa.x), bf_hi(xa.x)}, {bf_lo(xa.y), bf_hi(xa.y)}, {bf_lo(xa.z), bf_hi(xa.z)}, {bf_lo(xa.w), bf_hi(xa.w)}, {bf_lo(xb.x), bf_hi(xb.x)}, {bf_lo(xb.y), bf_hi(xb.y)}, {bf_lo(xb.z), bf_hi(xb.z)}, {bf_lo(xb.w), bf_hi(xb.w)}};
        v2u xqh = {0u, 0u}, xql = {0u, 0u};
#pragma unroll
        for (int i = 0; i < 16; ++i) { const float xv = (i & 1) ? x[i >> 1].y : x[i >> 1].x;
            float qf = __builtin_fminf(__builtin_fmaxf(xv * 16.f, -120.f), 119.f) + 12582912.0f; asm volatile("" : "+v"(qf)); const unsigned q = __builtin_bit_cast(unsigned, qf);
            const unsigned lo = q & 15u, hi = ((q + 8u) >> 4) & 15u;
            if (i < 8) { xql.x |= lo << (4 * i); xqh.x |= hi << (4 * i); } else { xql.y |= lo << (4 * (i - 8)); xqh.y |= hi << (4 * (i - 8)); } }
#define PEER_LOADB(buf, b) do { const int b_ = (b); if (b_ < 32) peer_load8((b_ & 16) ? TV : TU, (b_ & 8) ? id1 : id0, 8 * (b_ & 7), lane, buf); else peer_load8(TU, nid0, 8 * (b_ & 7), lane, buf); } while (0)
#define PEER_DOTB(buf, b) do { const int b_ = (b); const float r_ = peer_dot8(buf, xqh, xql, lane); const bool mine_ = (lane >> 3) == (b_ & 7); if (b_ & 8) act1 = mine_ ? r_ : act1; else act0 = mine_ ? r_ : act0; } while (0)
#define PEER_FMAB(buf, b) do { const int b_ = (b); peer_fma8(buf, (b_ & 8) ? w1h : w0h, 8 * (b_ & 7), o); } while (0)
        float act0 = 0.f, act1 = 0.f;
#pragma unroll 1
        for (int j = 0; j < 16; j += 4) {
            PEER_LOADB(B3, j + 3); PEER_DOTB(B0, j);
            PEER_LOADB(B0, j + 4); PEER_DOTB(B1, j + 1);
            PEER_LOADB(B1, j + 5); PEER_DOTB(B2, j + 2);
            PEER_LOADB(B2, j + 6); PEER_DOTB(B3, j + 3);
        }
        const float w0 = g0 * gelu_tanh(act0 * (1.0f / (16.f * PEER_SU))) * (1.0f / PEER_SV), w1 = g1 * gelu_tanh(act1 * (1.0f / (16.f * PEER_SU))) * (1.0f / PEER_SV);
        unsigned w0h, w1h; { const _Float16 a = (_Float16)w0, b = (_Float16)w1; const h16x2 pa = {a, a}, pb = {b, b}; w0h = __builtin_bit_cast(unsigned, pa); w1h = __builtin_bit_cast(unsigned, pb); }
        h16x2 o[8];
#pragma unroll
        for (int i = 0; i < 8; ++i) o[i] = (h16x2){(_Float16)0.f, (_Float16)0.f};
#pragma unroll 1
        for (int j = 16; j < 32; j += 4) {
            PEER_LOADB(B3, j + 3); PEER_FMAB(B0, j);
            PEER_LOADB(B0, j + 4); PEER_FMAB(B1, j + 1);
            PEER_LOADB(B1, j + 5); PEER_FMAB(B2, j + 2);
            PEER_LOADB(B2, j + 6); PEER_FMAB(B3, j + 3);
        }
#undef PEER_LOADB
#undef PEER_DOTB
#undef PEER_FMAB
        id0 = nid0; id1 = nid1;
        tabcvt_finish(TC, lane, cvA); tabcvt_finish(TC, lane, cvB);
        tabcvt_issue(TC, lane, cvA); tabcvt_issue(TC, lane, cvB);
        float y[16]; float sm = 0.f;
#pragma unroll
        for (int i = 0; i < 8; ++i) { y[2 * i] = pg8::ALPHA_F * x[i].x + (float)o[i].x; y[2 * i + 1] = pg8::ALPHA_F * x[i].y + (float)o[i].y; sm += y[2 * i] + y[2 * i + 1]; }
        const float mean = wave_sum(sm) * (1.f / DM); float q = 0.f;
#pragma unroll
        for (int i = 0; i < 16; ++i) { y[i] -= mean; q += y[i] * y[i]; }
        const float rstd = 1.0f / sqrtf(wave_sum(q) * (1.f / DM) + LN_EPS);
#pragma unroll
        for (int c = 0; c < 4; ++c) { const f32x4 gv = *(const GAS f32x4*)(g + 16 * lane + 4 * c), bv = *(const GAS f32x4*)(bb + 16 * lane + 4 * c);
            y[4 * c] = y[4 * c] * rstd * gv.x + bv.x; y[4 * c + 1] = y[4 * c + 1] * rstd * gv.y + bv.y; y[4 * c + 2] = y[4 * c + 2] * rstd * gv.z + bv.z; y[4 * c + 3] = y[4 * c + 3] * rstd * gv.w + bv.w; }
        v4u oa, ob; oa.x = pk2(y[0], y[1]); oa.y = pk2(y[2], y[3]); oa.z = pk2(y[4], y[5]); oa.w = pk2(y[6], y[7]); ob.x = pk2(y[8], y[9]); ob.y = pk2(y[10], y[11]); ob.z = pk2(y[12], y[13]); ob.w = pk2(y[14], y[15]);
        *(GAS v4u*)(H2 + (size_t)t * DM + 16 * lane) = oa; *(GAS v4u*)(H2 + (size_t)t * DM + 16 * lane + 8) = ob;
        *(GAS v4u*)((unsigned char*)(F.ws + WS_H28) + (size_t)t * DM + 16 * lane) = (v4u){pk4_fp8(y[0], y[1], y[2], y[3]), pk4_fp8(y[4], y[5], y[6], y[7]), pk4_fp8(y[8], y[9], y[10], y[11]), pk4_fp8(y[12], y[13], y[14], y[15])};
    }
    tabcvt_finish(TC, lane, cvA); tabcvt_finish(TC, lane, cvB);
    while (TC.cf < TC.n) { tabcvt_issue(TC, lane, cvA); tabcvt_finish(TC, lane, cvA); }
}

template <class Epi> __device__ __forceinline__ void run_gemm(Frame& F, const bf16* A, const bf16* Bt, int M, int N, int K, const Epi& E, int pw = 0) {
    pg8::Gemm g{A, Bt, M, N, K}; pg8::StaticOrder S; S.init(M, N, F.G, pw ? F.vcu : F.bx); S.pw = pw; if (pw) S.nwg = 1024;
    int t = F.tid; asm volatile("" : "+v"(t));
    pg8::gemm_phase<Epi, pg8::StaticOrder, true, true>(F.lds, g, S, E, t);
}

template <class Epi> __device__ __forceinline__ void run_gemm8(Frame& F, const unsigned char* A8, const unsigned char* Bt8, int M, int N, int Kbytes, const Epi& E) {
    pg8::Gemm g{(const bf16*)A8, (const bf16*)Bt8, M, N, Kbytes / 2 + F.z  }; pg8::StaticOrder S; S.init(M, N, F.G, F.bx);
    int t = F.tid; asm volatile("" : "+v"(t));
    pg8::gemm_phase<Epi, pg8::StaticOrder, true, true, true>(F.lds, g, S, E, t);
}

__global__ void __launch_bounds__(NWAVES * 64, 2) mega_fwd(Args args) {
    extern __shared__ __attribute__((aligned(16))) unsigned char lds[];
    Frame F;
    F.lds = (LAS unsigned char*)lds;
    F.tid = threadIdx.x; F.lane = F.tid & 63; F.wave = 0; F.G = gridDim.x; F.bx = blockIdx.x; F.vcu = 0;
    F.A = &args; F.z = 0; F.out = args.out; F.ws = args.ws;
    const int wave_s = __builtin_amdgcn_readfirstlane((int)threadIdx.x >> 6);
    volatile LAS unsigned* MISC = (volatile LAS unsigned*)(F.lds + MISC_OFF);
    if (F.tid < 64) MISC[F.tid] = 0u;
    __syncthreads();
    XcdBarrier bar; bar.bar = (unsigned*)(F.ws + WS_CTL) + CW_BAR; bar.x = 0; bar.st = nullptr;
    if (args.use_bar) bar = xcd_barrier_post((unsigned*)(F.ws + WS_CTL) + CW_BAR, MISC + 8);

    for (int pc = args.ph_lo; pc < args.ph_hi; ++pc) {
        { int z = 0; asm volatile("" : "+s"(z)); int t = wave_s * 64 + (int)__builtin_amdgcn_mbcnt_hi(~0u, __builtin_amdgcn_mbcnt_lo(~0u, (unsigned)z)); asm volatile("" : "+v"(t));
          F.z = z; F.ws = args.ws + z; F.tid = t; F.lane = t & 63; F.wave = __builtin_amdgcn_readfirstlane(t >> 6);
          F.G = (int)gridDim.x + z; F.bx = (int)blockIdx.x + z; F.vcu = (F.G % 8 == 0) ? (F.bx % 8) * (F.G / 8) + F.bx / 8 : F.bx; }
        bf16* const H = (bf16*)(F.ws + WS_H); bf16* const U = (bf16*)(F.ws + WS_U); bf16* const Y = (bf16*)(F.ws + WS_Y); bf16* const X1 = (bf16*)(F.ws + WS_X1);
        bf16* const H1 = (bf16*)(F.ws + WS_H1); bf16* const H2 = (bf16*)(F.ws + WS_H2); bf16* const KB = (bf16*)(F.ws + WS_KB); bf16* const VT = (bf16*)(F.ws + WS_VT); bf16* const HKV = (bf16*)(F.ws + WS_HKV);
        const int ty = args.ph_type[pc], la = args.ph_arg[pc];
#ifndef PHMASK
#define PHMASK 0xFFFF
#endif
#define EN(x) ((PHMASK >> (x)) & 1)
        switch (ty) {
        case P_PROLOGUE: if (EN(P_PROLOGUE)) p0_prologue(F); break;
        case P_STORE: if (EN(P_STORE)) {
            const int njobs = (la == 0) ? 2 : (la == 2) ? 3 : 1;
            for (int j = 0; j < njobs; ++j) {
                const bf16* A; const bf16* Bt; int M = TOK, N = 1024, K = 1024, ldc = 1024, pw = 0; bf16* O; float sc = 1.0f;
                if (la == 0 && j == 0) { A = (const bf16*)(F.ws + WS_PB); Bt = (const bf16*)(F.ws + WS_W_PW); K = 256; O = (bf16*)(F.ws + WS_PW); pw = 1; }
                else if (la == 0) { A = H; Bt = (const bf16*)(F.ws + WS_W_IN); O = U; }
                else if (la == 1) { A = H; Bt = (const bf16*)(F.ws + WS_W_IN) + (size_t)1024 * 1024; O = U; }
                else if (la == 2 && j == 1) { A = HKV; Bt = (const bf16*)(F.ws + WS_W_KV); O = KB; }
                else if (la == 2 && j == 2) { A = (const bf16*)(F.ws + WS_W_KV) + (size_t)1024 * 1024; Bt = HKV; M = 1024; N = TOK; ldc = TOK; O = VT; }
                else { A = H; Bt = (const bf16*)(F.ws + WS_W_SQ) + (size_t)(la - 2) * 1024 * 1024; O = U; sc = 0.125f * 1.4426950408889634f; }
                if (!pw) {
                    const unsigned char* A8; const unsigned char* B8;
                    if (la <= 1) { A8 = (const unsigned char*)(F.ws + WS_H8); B8 = (const unsigned char*)(F.ws + W8_IN) + (size_t)la * 1024 * 1024; }
                    else if (la == 2 && j == 1) { A8 = (const unsigned char*)(F.ws + WS_HKV); B8 = (const unsigned char*)(F.ws + W8_KV); }
                    else if (la == 2 && j == 2) { A8 = (const unsigned char*)(F.ws + W8_KV) + (size_t)1024 * 1024; B8 = (const unsigned char*)(F.ws + WS_HKV); }
                    else { A8 = (const unsigned char*)(F.ws + WS_H8); B8 = (const unsigned char*)(F.ws + W8_SQ) + (size_t)(la - 2) * 1024 * 1024; }
                    pg8::EpiStore E{O, ldc, sc * (1.0f / W8_SCALE), -1};
                    run_gemm8(F, A8, B8, M, N, 1024, E);
                } else {
                    pg8::EpiStore E{O, ldc, sc, pw ? 3 : -1};
                    run_gemm(F, A, Bt, M, N, K, E, pw);
                }
            }
        } break;
        case P_SSM: if (EN(P_SSM)) ssm_phase(F, la); break;
        case P_GLU: if (EN(P_GLU)) { pg8::EpiGlu E{H, X1}; run_gemm8(F, (const unsigned char*)Y, (const unsigned char*)(F.ws + W8_GLU) + (size_t)la * 2048 * 1024, TOK, 2048, 1024, E); } break;
        case P_LNMIX: if (EN(P_LNMIX)) ln_rows(F, X1, F.A->in[2 + F.z] + la * 1024, F.A->in[3 + F.z] + la * 1024, H1, (unsigned char*)(F.ws + WS_H18)); break;
        case P_TOPK: if (EN(P_TOPK)) {
            pg8::EpiTopk E{(int*)(F.ws + WS_IDX), (float*)(F.ws + WS_GATE)};
            pg8::Gemm g{(const bf16*)(F.ws + WS_H18), (const bf16*)((const unsigned char*)(F.ws + W8_EFF) + (size_t)la * 2048 * 1024), TOK, 2048, 512 + F.z};
            for (int r = 0; r < 2; ++r) { pg8::OneUnitOrder S; S.base.init(TOK, 2048, F.G, F.bx); S.round = r;
                int t = F.tid; asm volatile("" : "+v"(t)); pg8::gemm_phase<pg8::EpiTopk, pg8::OneUnitOrder, false, true, true>(F.lds, g, S, E, t); }
        } break;
        case P_PEER: if (EN(P_PEER)) peer_phase(F, la); break;
        case P_PLE: if (EN(P_PLE)) { pg8::EpiPle E{H2, (const unsigned char*)(F.ws + WS_PW) + (size_t)la * TOK * 1024, H, (la == DEPTH - 1) ? F.out : nullptr, (unsigned char*)(F.ws + WS_H8)};
            run_gemm8(F, (const unsigned char*)(F.ws + WS_H28), (const unsigned char*)(F.ws + W8_PG) + (size_t)la * 1024 * 1024, TOK, 1024, 1024, E); } break;
        case P_LNKV: if (EN(P_LNKV)) ln_rows(F, H, F.A->in[16 + F.z], F.A->in[17 + F.z], nullptr, (unsigned char*)HKV); break;
        case P_ATTN: if (EN(P_ATTN)) attn_phase(F); break;
        case P_RES: if (EN(P_RES)) { pg8::EpiRes E{H, X1}; run_gemm8(F, (const unsigned char*)Y, (const unsigned char*)(F.ws + W8_SO) + (size_t)(la - 2) * 1024 * 1024, TOK, 1024, 1024, E); } break;
        default: break;
        }
        if (pc + 1 < args.ph_hi) xcd_barrier(bar);
    }
}

#ifndef N_LAUNCH_MODE
#define N_LAUNCH_MODE 1
#endif
extern "C" void kernel_launch(void* const* d_in, const int* in_sizes, int n_in, void* d_out, int out_size, void* d_ws, size_t ws_size, hipStream_t stream) {
    static int grid = 0;
    if (grid == 0) {
        if (n_in != 28 || out_size != TOK * DM || ws_size < WS_END) { fprintf(stderr, "kernel_launch: unexpected shapes/workspace (n_in %d, out %d, ws %zu)\n", n_in, out_size, ws_size); grid = -1; return; }
        int dev = 0, cus = 0;
        if (hipGetDevice(&dev) != hipSuccess || hipDeviceGetAttribute(&cus, hipDeviceAttributeMultiprocessorCount, dev) != hipSuccess) { grid = -1; return; }
        if (hipFuncSetAttribute((const void*)mega_fwd, hipFuncAttributeMaxDynamicSharedMemorySize, LDS_BYTES) != hipSuccess) { fprintf(stderr, "kernel_launch: hipFuncSetAttribute failed\n"); grid = -1; return; }
        (void)hipGetLastError();
        grid = cus;
    }
    if (grid < 0) return;
    hipMemsetAsync((char*)d_ws + WS_CTL, 0, CTL_ZERO_BYTES, stream);
    Args a{};
    for (int i = 0; i < 28; ++i) a.in[i] = (const float*)d_in[i];
    a.out = (float*)d_out; a.ws = (unsigned char*)d_ws;
    int n = 0;
#ifndef REP_TYPE
#define REP_TYPE -1
#endif
    auto add = [&](int t, int l) { for (int r = 0; r < ((t == REP_TYPE) ? 2 : 1); ++r) { a.ph_type[n] = (unsigned char)t; a.ph_arg[n] = (unsigned char)l; ++n; } };
    add(P_PROLOGUE, 0); add(P_STORE, 0);
    for (int l = 0; l < DEPTH; ++l) {
        if (l < 2) { if (l == 1) add(P_STORE, 1); add(P_SSM, l); add(P_GLU, l); }
        else { if (l == 2) add(P_LNKV, 0); add(P_STORE, l); add(P_ATTN, l); add(P_RES, l); }
        add(P_LNMIX, l); add(P_TOPK, l); add(P_PEER, l); add(P_PLE, l);
    }
    a.nph = n;
    if (N_LAUNCH_MODE == 1) {
        a.ph_lo = 0; a.ph_hi = n; a.use_bar = 1;
        hipLaunchKernelGGL(mega_fwd, dim3(grid), dim3(NWAVES * 64), LDS_BYTES, stream, a);
    } else {
        a.use_bar = 0;
        for (int i = 0; i < n; ++i) { a.ph_lo = i; a.ph_hi = i + 1; hipLaunchKernelGGL(mega_fwd, dim3(grid), dim3(NWAVES * 64), LDS_BYTES, stream, a); }
    }
}
```

```cpp
#include <hip/hip_runtime.h>
#include <cstdio>
#include <cstdint>
#include <cmath>
namespace pg8 {
#define PG8_LAS __attribute__((address_space(3)))
typedef unsigned short bf16_t;
typedef short bf16x8 __attribute__((ext_vector_type(8)));
typedef float f32x4 __attribute__((ext_vector_type(4)));
typedef unsigned u32x4 __attribute__((ext_vector_type(4)));
constexpr int BM = 256, BK = 64, HALF = 128, HTB = HALF * BK * 2  , STAGE_BYTES = 8 * HTB, NXCD = 8, WGM = 8;

__host__ __device__ __forceinline__ int lds_byte(int r, int c) { const int st = (r >> 4) * 2 + (c >> 5), rr = r & 15, cc = c & 31, ob = rr * 64 + cc * 2; return st * 1024 + (ob ^ (((ob >> 9) & 1) << 5)); }
__host__ __device__ __forceinline__ void stage_rc(int b, int& R, int& C) { const int st = b / 1024, sb = b % 1024, swz = sb ^ (((sb >> 9) & 1) << 5); R = (st >> 1) * 16 + swz / 64; C = (st & 1) * 32 + (swz % 64) / 2; }
__host__ __device__ __forceinline__ int perm32(int rho) { const int n = rho >> 4, i = rho & 15; return 8 * (i >> 2) + 4 * n + (i & 3); }

struct Unit { int pm, pn; };
struct Gemm { const bf16_t* A; const bf16_t* Bt; int M, N, K; };

struct StaticOrder {
    int nM, nN, nwg, G, c;
    __host__ __device__ void init(int M, int N, int G_, int c_) { nM = M / BM; nN = N / BM; nwg = nM * nN; G = G_; c = c_; pw = 0; }
    int pw;
    __host__ __device__ bool next(int i, Unit& u) const {
        const long L = (long)i * G + c; if (L >= nwg) return false;
        if (pw) { const int l = (int)L >> 8, rem = (int)L & 255; u.pm = l * 64 + (rem >> 2); u.pn = l * 4 + (rem & 3); return true; }
        int wgid = (int)L; { const int q = nwg / NXCD, r = nwg % NXCD, xcd = wgid % NXCD, off = wgid / NXCD; wgid = (xcd < r ? xcd * (q + 1) : r * (q + 1) + (xcd - r) * q) + off; }
        const int nig = WGM * nN, gid = wgid / nig, fm = gid * WGM, gsz = (nM - fm) < WGM ? (nM - fm) : WGM;
        u.pm = fm + ((wgid % nig) % gsz); u.pn = (wgid % nig) / gsz; return true;
    }
    __device__ __forceinline__ void a_ready(const Unit&) const {}
    __device__ __forceinline__ void done(const Unit&) const {}
};

typedef float f32x2c_t __attribute__((ext_vector_type(2))); typedef __bf16 bf16x2c_t __attribute__((ext_vector_type(2)));
__device__ __forceinline__ unsigned cvt_pk_bf16(float lo, float hi) { f32x2c_t v = {lo, hi}; bf16x2c_t b = __builtin_convertvector(v, bf16x2c_t); return __builtin_bit_cast(unsigned, b); }
typedef float f32x2 __attribute__((ext_vector_type(2)));
typedef int v8i32_t __attribute__((ext_vector_type(8)));
typedef unsigned u32x8_t __attribute__((ext_vector_type(8)));
template <bool F8> struct Frag { bf16x8 k[2]; };
template <> struct Frag<true> { v8i32_t v; };
template <class Epi, class Sched, bool ALIGN_EPI = false, bool SP2 = false, bool F8 = false>
__device__ __forceinline__ void gemm_phase(PG8_LAS unsigned char* lds, const Gemm g, const Sched& S, const Epi& E, const int tid) {
    const int wid = __builtin_amdgcn_readfirstlane(tid >> 6), lane = tid & 63, wr = wid >> 2, wc = wid & 3, fr = lane & 15, fq = lane >> 4;
    const int K = g.K, nt = K / BK;
    unsigned voffA[1], voffB[1];
    { int R, C; stage_rc(tid * 16, R, C); const int Rb = Epi::PERM ? ((R & ~31) + perm32(R & 31)) : R;
        voffA[0] = (unsigned)(R * K + C) * 2u; voffB[0] = (unsigned)(Rb * K + C) * 2u; }
    const size_t r64 = (size_t)128 * K;
    const size_t kstep = (size_t)(BK * 2);
    const size_t hstep = (size_t)HALF * K * 2;
    const size_t tstep = 2 * hstep;
    const unsigned ldsw = (unsigned)wid * 1024u;
    const int aoff = lds_byte(wr * 64 + fr, F8 ? fq * 16 : fq * 8), boff = lds_byte(wc * 32 + fr, F8 ? fq * 16 : fq * 8);
#define PG8_SA(b, h) (((b) * 2 + (h)) * HTB)
#define PG8_SB(b, h) ((4 + (b) * 2 + (h)) * HTB)
#define PG8_STAGE(bufoff, gbase, voff) do { _Pragma("unroll") for (int _i = 0; _i < 2; ++_i) \
        __builtin_amdgcn_global_load_lds((const unsigned*)((const char*)(gbase) + _i * r64 + (voff)[0]), (PG8_LAS unsigned*)(lds + (bufoff) + ldsw + _i * 8192), 16, 0, 0); } while (0)
#define PG8_LDF(d, addr) do { if constexpr (F8) { const u32x4 lo_ = *(const PG8_LAS u32x4*)(addr), hi_ = *(const PG8_LAS u32x4*)((addr) + 16); d.v = __builtin_bit_cast(v8i32_t, (u32x8_t){lo_[0], lo_[1], lo_[2], lo_[3], hi_[0], hi_[1], hi_[2], hi_[3]}); } \
        else { d.k[0] = *(const PG8_LAS bf16x8*)(addr); d.k[1] = *(const PG8_LAS bf16x8*)((addr) + 1024); } } while (0)
#define PG8_LDA(dst, b, h) do { _Pragma("unroll") for (int m = 0; m < 4; ++m) PG8_LDF(dst[m], lds + PG8_SA(b, h) + aoff + m * 2048); } while (0)
#define PG8_LDB(dst, b, h) do { _Pragma("unroll") for (int n = 0; n < 2; ++n) PG8_LDF(dst[n], lds + PG8_SB(b, h) + boff + n * 2048); } while (0)
#define PG8_MMA(ai, bj, At, Bt) do { __builtin_amdgcn_s_setprio(1); _Pragma("unroll") for (int m = 0; m < 4; ++m) _Pragma("unroll") for (int n = 0; n < 2; ++n) { \
        if constexpr (F8) asm volatile("v_mfma_f32_16x16x128_f8f6f4 %0, %1, %2, %0" : "+v"(acc[ai][bj][m][n]) : "v"(Bt[n].v), "v"(At[m].v));   \
        else { _Pragma("unroll") for (int k = 0; k < 2; ++k) acc[ai][bj][m][n] = __builtin_amdgcn_mfma_f32_16x16x32_bf16(Bt[n].k[k], At[m].k[k], acc[ai][bj][m][n], 0, 0, 0); } } __builtin_amdgcn_s_setprio(0); } while (0)
#define PG8_WAIT_V(n) asm volatile("s_waitcnt vmcnt(" #n ")" ::: "memory")
#define PG8_WAIT_L(n) asm volatile("s_waitcnt lgkmcnt(" #n ")" ::: "memory")
#define PG8_BAR __builtin_amdgcn_s_barrier()
#define PG8_SCHED __builtin_amdgcn_sched_barrier(0)
    Unit cur, nxt; int ui = 0;
    if (!S.next(0, cur)) return;
    f32x4 acc[2][2][4][2];
#pragma unroll
    for (int a = 0; a < 2; ++a)
#pragma unroll
        for (int b = 0; b < 2; ++b)
#pragma unroll
            for (int m = 0; m < 4; ++m)
#pragma unroll
                for (int n = 0; n < 2; ++n) acc[a][b][m][n] = (f32x4){0.f, 0.f, 0.f, 0.f};
    Frag<F8> At[4], B0[2], B1[2];
    const char* cA = (const char*)g.A + (size_t)cur.pm * tstep; const char* cB = (const char*)g.Bt + (size_t)cur.pn * tstep;
    S.a_ready(cur);
    if constexpr (SP2) {
        PG8_STAGE(PG8_SB(0, 0), cB, voffB); PG8_STAGE(PG8_SB(0, 1), cB + hstep, voffB); PG8_STAGE(PG8_SA(0, 0), cA, voffA); PG8_STAGE(PG8_SA(0, 1), cA + hstep, voffA);
        if (wr == 1) PG8_BAR;
        PG8_WAIT_V(2); PG8_BAR;
        PG8_STAGE(PG8_SB(1, 0), cB + kstep, voffB); PG8_STAGE(PG8_SA(1, 0), cA + kstep, voffA); PG8_STAGE(PG8_SB(1, 1), cB + hstep + kstep, voffB);
        PG8_WAIT_V(6); PG8_BAR;
    } else {
        PG8_STAGE(PG8_SB(0, 0), cB, voffB); PG8_STAGE(PG8_SA(0, 0), cA, voffA); PG8_STAGE(PG8_SB(0, 1), cB + hstep, voffB); PG8_STAGE(PG8_SA(0, 1), cA + hstep, voffA);
        if (wr == 1) PG8_BAR;
        PG8_WAIT_V(4); PG8_BAR;
        PG8_STAGE(PG8_SB(1, 0), cB + kstep, voffB); PG8_STAGE(PG8_SA(1, 0), cA + kstep, voffA); PG8_STAGE(PG8_SB(1, 1), cB + hstep + kstep, voffB);
        PG8_WAIT_V(6); PG8_BAR;
    }
    for (;;) {
        const bool has_next = S.next(ui + 1, nxt);
        const char* nA = has_next ? (const char*)g.A + (size_t)nxt.pm * tstep : cA; const char* nB = has_next ? (const char*)g.Bt + (size_t)nxt.pn * tstep : cB;
#pragma unroll 1
        for (int t = 0; t < nt; t += 2) {
            const bool last = (t == nt - 2);
            const char* a1 = cA + (size_t)(t + 1) * kstep;
            const char* a2 = last ? nA : cA + (size_t)(t + 2) * kstep; const char* b2 = last ? nB : cB + (size_t)(t + 2) * kstep;
            const char* a3 = a2 + kstep; const char* b3 = b2 + kstep;
            if (last && has_next) S.a_ready(nxt);
            if constexpr (SP2) {
            PG8_LDB(B0, 0, 0); PG8_LDB(B1, 0, 1); PG8_SCHED; PG8_LDA(At, 0, 0); PG8_STAGE(PG8_SA(1, 1), a1 + hstep, voffA);
            PG8_WAIT_V(8); PG8_WAIT_L(0); PG8_BAR; PG8_MMA(0, 0, At, B0); PG8_MMA(0, 1, At, B1); PG8_BAR; PG8_SCHED;
            PG8_LDA(At, 0, 1); PG8_STAGE(PG8_SB(0, 0), b2, voffB); PG8_STAGE(PG8_SB(0, 1), b2 + hstep, voffB); PG8_STAGE(PG8_SA(0, 0), a2, voffA);
            PG8_WAIT_V(8); PG8_WAIT_L(0); PG8_BAR; PG8_MMA(1, 0, At, B0); PG8_MMA(1, 1, At, B1); PG8_BAR; PG8_SCHED;
            PG8_LDB(B0, 1, 0); PG8_LDB(B1, 1, 1); PG8_SCHED; PG8_LDA(At, 1, 0); PG8_STAGE(PG8_SA(0, 1), a2 + hstep, voffA);
            PG8_WAIT_V(8); PG8_WAIT_L(0); PG8_BAR; PG8_MMA(0, 0, At, B0); PG8_MMA(0, 1, At, B1); PG8_BAR; PG8_SCHED;
            PG8_LDA(At, 1, 1); PG8_STAGE(PG8_SB(1, 0), b3, voffB); PG8_STAGE(PG8_SB(1, 1), b3 + hstep, voffB); PG8_STAGE(PG8_SA(1, 0), a3, voffA);
            PG8_WAIT_V(8); PG8_WAIT_L(0); PG8_BAR; PG8_MMA(1, 0, At, B0); PG8_MMA(1, 1, At, B1); PG8_BAR; PG8_SCHED;
            } else {
            PG8_LDB(B0, 0, 0); PG8_SCHED; PG8_LDA(At, 0, 0); PG8_STAGE(PG8_SA(1, 1), a1 + hstep, voffA);
            PG8_WAIT_L(8); PG8_BAR; PG8_WAIT_L(0); PG8_MMA(0, 0, At, B0); PG8_BAR; PG8_SCHED;
            PG8_LDB(B1, 0, 1); PG8_STAGE(PG8_SB(0, 0), b2, voffB);
            PG8_BAR; PG8_WAIT_L(0); PG8_MMA(0, 1, At, B1); PG8_BAR;
            PG8_LDA(At, 0, 1); PG8_STAGE(PG8_SA(0, 0), a2, voffA);
            PG8_BAR; PG8_WAIT_L(0); PG8_MMA(1, 0, At, B0); PG8_BAR; PG8_SCHED;
            PG8_STAGE(PG8_SB(0, 1), b2 + hstep, voffB);
            PG8_WAIT_V(6); PG8_BAR; PG8_MMA(1, 1, At, B1); PG8_BAR;
            PG8_LDB(B0, 1, 0); PG8_SCHED; PG8_LDA(At, 1, 0); PG8_STAGE(PG8_SA(0, 1), a2 + hstep, voffA);
            PG8_WAIT_L(8); PG8_BAR; PG8_WAIT_L(0); PG8_MMA(0, 0, At, B0); PG8_BAR; PG8_SCHED;
            PG8_LDB(B1, 1, 1); PG8_STAGE(PG8_SB(1, 0), b3, voffB);
            PG8_BAR; PG8_WAIT_L(0); PG8_MMA(0, 1, At, B1); PG8_BAR;
            PG8_LDA(At, 1, 1); PG8_STAGE(PG8_SA(1, 0), a3, voffA);
            PG8_BAR; PG8_WAIT_L(0); PG8_MMA(1, 0, At, B0); PG8_BAR; PG8_SCHED;
            PG8_STAGE(PG8_SB(1, 1), b3 + hstep, voffB);
            PG8_WAIT_V(6); PG8_BAR; PG8_MMA(1, 1, At, B1); PG8_BAR;
            }
        }
        if constexpr (F8) asm volatile("s_nop 15\n\ts_nop 15" ::: "memory");
        if constexpr (ALIGN_EPI) { if (wr == 0) PG8_BAR; }
        if constexpr (!Epi::AFTER_DRAIN) { E(acc, cur, wr, wc, fr, fq); S.done(cur); }
        if (!has_next) break;
#pragma unroll
        for (int a = 0; a < 2; ++a)
#pragma unroll
            for (int b = 0; b < 2; ++b)
#pragma unroll
                for (int m = 0; m < 4; ++m)
#pragma unroll
                    for (int n = 0; n < 2; ++n) acc[a][b][m][n] = (f32x4){0.f, 0.f, 0.f, 0.f};
        cur = nxt; cA = nA; cB = nB; ++ui;
        if constexpr (ALIGN_EPI) { if (wr == 1) PG8_BAR; }
    }
    PG8_WAIT_V(0);
    if constexpr (!ALIGN_EPI) { if (wr == 0) PG8_BAR; }
    PG8_BAR;
    if constexpr (Epi::AFTER_DRAIN) { E.fused(acc, cur, wr, wc, fr, fq, lds, wid, lane); S.done(cur); }
#undef PG8_SA
#undef PG8_SB
#undef PG8_STAGE
#undef PG8_LDA
#undef PG8_LDB
#undef PG8_MMA
#undef PG8_LDF
#undef PG8_WAIT_V
#undef PG8_WAIT_L
#undef PG8_BAR
#undef PG8_SCHED
}
}
namespace pg8 {
__device__ __forceinline__ float bf_lo(unsigned w) { return __uint_as_float(w << 16); }
__device__ __forceinline__ float bf_hi(unsigned w) { return __uint_as_float(w & 0xffff0000u); }
__device__ __forceinline__ float fast_sigmoid(float x) { return __builtin_amdgcn_rcpf(1.0f + __builtin_amdgcn_exp2f(-1.4426950408889634f * x)); }
__device__ __forceinline__ float gelu_tanh(float x) { const float t = x * (1.5957691216057308f + 0.07135481627260025f * x * x); return x * __builtin_amdgcn_rcpf(1.0f + __builtin_amdgcn_exp2f(-1.4426950408889634f * t)); }
constexpr float ALPHA_F = 1.681792830507429f;
constexpr float WSC = 1.0f / 32.0f;

struct EpiStore {
    static constexpr bool PERM = true, AFTER_DRAIN = false;
    bf16_t* O; int ldc; float scale; int pnmask;
    __device__ __forceinline__ void operator()(const f32x4 (&acc)[2][2][4][2], const Unit& u, int wr, int wc, int fr, int fq) const {
        const int row0 = u.pm * BM + wr * 64 + fr, col0 = (u.pn & pnmask) * BM + wc * 32 + 8 * fq;
#pragma unroll
        for (int ai = 0; ai < 2; ++ai)
#pragma unroll
            for (int m = 0; m < 4; ++m) { bf16_t* rowp = O + (size_t)(row0 + ai * HALF + m * 16) * ldc + col0;
#pragma unroll
                for (int bj = 0; bj < 2; ++bj) { const f32x4 v0 = acc[ai][bj][m][0] * scale, v1 = acc[ai][bj][m][1] * scale;
                    if (pnmask >= 0) {
                        int w0 = 0, w1 = 0; w0 = __builtin_amdgcn_cvt_pk_fp8_f32(v0[0], v0[1], w0, false); w0 = __builtin_amdgcn_cvt_pk_fp8_f32(v0[2], v0[3], w0, true);
                        w1 = __builtin_amdgcn_cvt_pk_fp8_f32(v1[0], v1[1], w1, false); w1 = __builtin_amdgcn_cvt_pk_fp8_f32(v1[2], v1[3], w1, true);
                        *(unsigned long long*)((unsigned char*)O + (size_t)(row0 + ai * HALF + m * 16) * ldc + col0 + bj * HALF) = (unsigned long long)(unsigned)w0 | ((unsigned long long)(unsigned)w1 << 32);
                    } else {
                    u32x4 w; w.x = cvt_pk_bf16(v0[0], v0[1]); w.y = cvt_pk_bf16(v0[2], v0[3]); w.z = cvt_pk_bf16(v1[0], v1[1]); w.w = cvt_pk_bf16(v1[2], v1[3]);
                    *(u32x4*)(rowp + bj * HALF) = w; } } }
    }
};
struct EpiGlu {
    static constexpr bool PERM = true, AFTER_DRAIN = false;
    const bf16_t* Hin; bf16_t* X1;
    __device__ __forceinline__ void operator()(const f32x4 (&acc)[2][2][4][2], const Unit& u, int wr, int wc, int fr, int fq) const {
        const int row0 = u.pm * BM + wr * 64 + fr, col0 = u.pn * HALF + wc * 32 + 8 * fq;
        u32x4 hvv[2][4];
#pragma unroll
        for (int ai = 0; ai < 2; ++ai)
#pragma unroll
            for (int m = 0; m < 4; ++m) hvv[ai][m] = *(const u32x4*)(Hin + (size_t)(row0 + ai * HALF + m * 16) * 1024 + col0);
#pragma unroll
        for (int ai = 0; ai < 2; ++ai)
#pragma unroll
            for (int m = 0; m < 4; ++m) { const size_t off = (size_t)(row0 + ai * HALF + m * 16) * 1024 + col0;
                const u32x4 hv = hvv[ai][m];
                const f32x4 v0 = acc[ai][0][m][0] * WSC, v1 = acc[ai][0][m][1] * WSC, g0 = acc[ai][1][m][0] * WSC, g1 = acc[ai][1][m][1] * WSC;
                float o[8];
                o[0] = ALPHA_F * bf_lo(hv.x) + v0[0] * fast_sigmoid(g0[0]); o[1] = ALPHA_F * bf_hi(hv.x) + v0[1] * fast_sigmoid(g0[1]);
                o[2] = ALPHA_F * bf_lo(hv.y) + v0[2] * fast_sigmoid(g0[2]); o[3] = ALPHA_F * bf_hi(hv.y) + v0[3] * fast_sigmoid(g0[3]);
                o[4] = ALPHA_F * bf_lo(hv.z) + v1[0] * fast_sigmoid(g1[0]); o[5] = ALPHA_F * bf_hi(hv.z) + v1[1] * fast_sigmoid(g1[1]);
                o[6] = ALPHA_F * bf_lo(hv.w) + v1[2] * fast_sigmoid(g1[2]); o[7] = ALPHA_F * bf_hi(hv.w) + v1[3] * fast_sigmoid(g1[3]);
                u32x4 w; w.x = cvt_pk_bf16(o[0], o[1]); w.y = cvt_pk_bf16(o[2], o[3]); w.z = cvt_pk_bf16(o[4], o[5]); w.w = cvt_pk_bf16(o[6], o[7]);
                *(u32x4*)(X1 + off) = w; }
    }
};
struct EpiRes {
    static constexpr bool PERM = true, AFTER_DRAIN = false;
    const bf16_t* Hin; bf16_t* X1;
    __device__ __forceinline__ void operator()(const f32x4 (&acc)[2][2][4][2], const Unit& u, int wr, int wc, int fr, int fq) const {
        const int row0 = u.pm * BM + wr * 64 + fr, col0 = u.pn * BM + wc * 32 + 8 * fq;
        u32x4 hvv[2][4][2];
#pragma unroll
        for (int ai = 0; ai < 2; ++ai)
#pragma unroll
            for (int m = 0; m < 4; ++m)
#pragma unroll
                for (int bj = 0; bj < 2; ++bj) hvv[ai][m][bj] = *(const u32x4*)(Hin + (size_t)(row0 + ai * HALF + m * 16) * 1024 + col0 + bj * HALF);
#pragma unroll
        for (int ai = 0; ai < 2; ++ai)
#pragma unroll
            for (int m = 0; m < 4; ++m)
#pragma unroll
                for (int bj = 0; bj < 2; ++bj) { const size_t off = (size_t)(row0 + ai * HALF + m * 16) * 1024 + col0 + bj * HALF;
                    const u32x4 hv = hvv[ai][m][bj]; const f32x4 v0 = acc[ai][bj][m][0] * WSC, v1 = acc[ai][bj][m][1] * WSC;
                    u32x4 w; w.x = cvt_pk_bf16(ALPHA_F * bf_lo(hv.x) + v0[0], ALPHA_F * bf_hi(hv.x) + v0[1]); w.y = cvt_pk_bf16(ALPHA_F * bf_lo(hv.y) + v0[2], ALPHA_F * bf_hi(hv.y) + v0[3]);
                    w.z = cvt_pk_bf16(ALPHA_F * bf_lo(hv.z) + v1[0], ALPHA_F * bf_hi(hv.z) + v1[1]); w.w = cvt_pk_bf16(ALPHA_F * bf_lo(hv.w) + v1[2], ALPHA_F * bf_hi(hv.w) + v1[3]);
                    *(u32x4*)(X1 + off) = w; }
    }
};
struct EpiPle {
    static constexpr bool PERM = true, AFTER_DRAIN = false;
    const bf16_t* H2; const unsigned char* PW; bf16_t* Hout; float* Fout; unsigned char* H8out;
    __device__ __forceinline__ void operator()(const f32x4 (&acc)[2][2][4][2], const Unit& u, int wr, int wc, int fr, int fq) const {
        const int row0 = u.pm * BM + wr * 64 + fr, col0 = u.pn * BM + wc * 32 + 8 * fq;
#pragma unroll
        for (int ai = 0; ai < 2; ++ai) {
            u32x4 hvv[4][2]; unsigned long long pvv[4][2];
#pragma unroll
            for (int m = 0; m < 4; ++m)
#pragma unroll
                for (int bj = 0; bj < 2; ++bj) { const size_t off = (size_t)(row0 + ai * HALF + m * 16) * 1024 + col0 + bj * HALF; hvv[m][bj] = *(const u32x4*)(H2 + off); pvv[m][bj] = *(const unsigned long long*)(PW + off); }
#pragma unroll
            for (int m = 0; m < 4; ++m)
#pragma unroll
                for (int bj = 0; bj < 2; ++bj) { const size_t off = (size_t)(row0 + ai * HALF + m * 16) * 1024 + col0 + bj * HALF;
                    const u32x4 hv = hvv[m][bj]; const int pl = (int)(unsigned)pvv[m][bj], ph = (int)(unsigned)(pvv[m][bj] >> 32); const f32x4 v0 = acc[ai][bj][m][0] * WSC, v1 = acc[ai][bj][m][1] * WSC;
                    const auto p01 = __builtin_amdgcn_cvt_pk_f32_fp8(pl, false), p23 = __builtin_amdgcn_cvt_pk_f32_fp8(pl, true), p45 = __builtin_amdgcn_cvt_pk_f32_fp8(ph, false), p67 = __builtin_amdgcn_cvt_pk_f32_fp8(ph, true);
                    float o[8];
                    o[0] = bf_lo(hv.x) + fast_sigmoid(v0[0]) * p01[0]; o[1] = bf_hi(hv.x) + fast_sigmoid(v0[1]) * p01[1];
                    o[2] = bf_lo(hv.y) + fast_sigmoid(v0[2]) * p23[0]; o[3] = bf_hi(hv.y) + fast_sigmoid(v0[3]) * p23[1];
                    o[4] = bf_lo(hv.z) + fast_sigmoid(v1[0]) * p45[0]; o[5] = bf_hi(hv.z) + fast_sigmoid(v1[1]) * p45[1];
                    o[6] = bf_lo(hv.w) + fast_sigmoid(v1[2]) * p67[0]; o[7] = bf_hi(hv.w) + fast_sigmoid(v1[3]) * p67[1];
                    if (Fout) { *(f32x4*)(Fout + off) = (f32x4){o[0], o[1], o[2], o[3]}; *(f32x4*)(Fout + off + 4) = (f32x4){o[4], o[5], o[6], o[7]}; }
                    else { u32x4 w; w.x = cvt_pk_bf16(o[0], o[1]); w.y = cvt_pk_bf16(o[2], o[3]); w.z = cvt_pk_bf16(o[4], o[5]); w.w = cvt_pk_bf16(o[6], o[7]); *(u32x4*)(Hout + off) = w;
                        int w0 = 0, w1 = 0; w0 = __builtin_amdgcn_cvt_pk_fp8_f32(o[0], o[1], w0, false); w0 = __builtin_amdgcn_cvt_pk_fp8_f32(o[2], o[3], w0, true); w1 = __builtin_amdgcn_cvt_pk_fp8_f32(o[4], o[5], w1, false); w1 = __builtin_amdgcn_cvt_pk_fp8_f32(o[6], o[7], w1, true);
                        *(unsigned long long*)(H8out + off) = (unsigned long long)(unsigned)w0 | ((unsigned long long)(unsigned)w1 << 32); } }
        }
    }
};

__device__ __forceinline__ int imax_(int a, int b) { return a > b ? a : b; }
__device__ __forceinline__ int imin_(int a, int b) { return a < b ? a : b; }
__device__ __forceinline__ float csum(float a, float b) { float s = a + b; asm volatile("" : "+v"(s)); return s; }
__device__ __forceinline__ int f2key(float v) { int s = __float_as_int(v); return s ^ ((s >> 31) & 0x7fffffff); }
__device__ __forceinline__ float key2f(int k) { return __int_as_float(k ^ ((k >> 31) & 0x7fffffff)); }
template <bool DESC> __device__ __forceinline__ void bitonic_sort16(int (&x)[16]) {
#pragma unroll
    for (int k = 2; k <= 16; k <<= 1)
#pragma unroll
        for (int j = k >> 1; j > 0; j >>= 1)
#pragma unroll
            for (int i = 0; i < 16; ++i) { const int l = i ^ j; if (l > i) { const bool up = ((i & k) == 0) || (k == 16); const bool asc = DESC ? !up : up;
                const int lo = imin_(x[i], x[l]), hi = imax_(x[i], x[l]); x[i] = asc ? lo : hi; x[l] = asc ? hi : lo; } }
}
__device__ __forceinline__ void bitonic_merge_desc16(int (&x)[16]) {
#pragma unroll
    for (int j = 8; j > 0; j >>= 1)
#pragma unroll
        for (int i = 0; i < 16; ++i) { const int l = i ^ j; if (l > i) { const int lo = imin_(x[i], x[l]), hi = imax_(x[i], x[l]); x[i] = hi; x[l] = lo; } }
}
__device__ __forceinline__ void topk_absorb16(int (&L)[16], int (&N)[16]) {
    bitonic_sort16<false>(N);
#pragma unroll
    for (int i = 0; i < 16; ++i) L[i] = imax_(L[i], N[i]);
    bitonic_merge_desc16(L);
}
__device__ __forceinline__ void topk_insert1(int (&L)[16], int v) {
#pragma unroll
    for (int i = 0; i < 16; ++i) { const int hi = imax_(L[i], v); v = imin_(L[i], v); L[i] = hi; }
}

template <bool DESC> __device__ __forceinline__ void bitonic_sort16f(float (&x)[16]) {
#pragma unroll
    for (int k = 2; k <= 16; k <<= 1)
#pragma unroll
        for (int j = k >> 1; j > 0; j >>= 1)
#pragma unroll
            for (int i = 0; i < 16; ++i) { const int l = i ^ j; if (l > i) { const bool up = ((i & k) == 0) || (k == 16); const bool asc = DESC ? !up : up;
                const float lo = __builtin_fminf(x[i], x[l]), hi = __builtin_fmaxf(x[i], x[l]); x[i] = asc ? lo : hi; x[l] = asc ? hi : lo; } }
}
__device__ __forceinline__ void bitonic_merge_desc16f(float (&x)[16]) {
#pragma unroll
    for (int j = 8; j > 0; j >>= 1)
#pragma unroll
        for (int i = 0; i < 16; ++i) { const int l = i ^ j; if (l > i) { const float lo = __builtin_fminf(x[i], x[l]), hi = __builtin_fmaxf(x[i], x[l]); x[i] = hi; x[l] = lo; } }
}
__device__ __forceinline__ void topk_absorb16f(float (&L)[16], float (&N)[16]) {
    bitonic_sort16f<false>(N);
#pragma unroll
    for (int i = 0; i < 16; ++i) L[i] = __builtin_fmaxf(L[i], N[i]);
    bitonic_merge_desc16f(L);
}

__device__ __forceinline__ void topk_insert1f(float (&L)[16], float v) {
#pragma unroll
    for (int i = 0; i < 16; ++i) { const float hi = __builtin_fmaxf(L[i], v); v = __builtin_fminf(L[i], v); L[i] = hi; }
}
struct EpiTopk {
    static constexpr bool PERM = true, AFTER_DRAIN = true;
    int* IDX; float* GATE;
    __device__ __forceinline__ void fused(f32x4 (&acc)[2][2][4][2], const Unit& u, int wr, int wc, int fr, int fq, PG8_LAS unsigned char* lds, int wid, int lane) const {
        const int tid = wid * 64 + lane;
        PG8_LAS float* S = (PG8_LAS float*)lds;
        PG8_LAS int* X = (PG8_LAS int*)lds;
        const int row = tid & 255, part = tid >> 8;
        int KK[2][16];
#pragma unroll
        for (int bj = 0; bj < 2; ++bj) {
#pragma unroll
            for (int ai = 0; ai < 2; ++ai)
#pragma unroll
                for (int m = 0; m < 4; ++m)
#pragma unroll
                    for (int n = 0; n < 2; ++n) *(PG8_LAS f32x4*)(S + (ai * HALF + wr * 64 + m * 16 + fr) * 132 + wc * 32 + 8 * fq + 4 * n) = acc[ai][bj][m][n] * WSC;
            asm volatile("s_waitcnt lgkmcnt(0)" ::: "memory"); __builtin_amdgcn_s_barrier(); asm volatile("" ::: "memory");
            float L[16];
#pragma unroll
            for (int c = 0; c < 4; ++c) {
                float N[16];
#pragma unroll
                for (int i = 0; i < 4; ++i) { const f32x4 v = *(const PG8_LAS f32x4*)(S + row * 132 + 64 * part + 16 * c + 4 * i);
#pragma unroll
                    for (int e = 0; e < 4; ++e) N[4 * i + e] = __int_as_float((__float_as_int(v[e]) & ~127) | (127 - (64 * part + 16 * c + 4 * i + e))); }
                if (c == 0) { bitonic_sort16f<true>(N);
#pragma unroll
                    for (int i = 0; i < 16; ++i) L[i] = N[i]; }
                else topk_absorb16f(L, N);
            }
            asm volatile("s_waitcnt lgkmcnt(0)" ::: "memory"); __builtin_amdgcn_s_barrier(); asm volatile("" ::: "memory");
#pragma unroll
            for (int i = 0; i < 4; ++i) *(PG8_LAS u32x4*)(X + tid * 20 + 4 * i) = (u32x4){(unsigned)__float_as_int(L[4 * i]), (unsigned)__float_as_int(L[4 * i + 1]), (unsigned)__float_as_int(L[4 * i + 2]), (unsigned)__float_as_int(L[4 * i + 3])};
            asm volatile("s_waitcnt lgkmcnt(0)" ::: "memory"); __builtin_amdgcn_s_barrier(); asm volatile("" ::: "memory");
            { float P[16]; const int pt = tid ^ 256;
#pragma unroll
              for (int i = 0; i < 4; ++i) { const u32x4 v = *(const PG8_LAS u32x4*)(X + pt * 20 + 4 * i); P[4 * i] = __int_as_float((int)v.x); P[4 * i + 1] = __int_as_float((int)v.y); P[4 * i + 2] = __int_as_float((int)v.z); P[4 * i + 3] = __int_as_float((int)v.w); }
#pragma unroll
              for (int i = 0; i < 16; ++i) L[i] = __builtin_fmaxf(L[i], P[15 - i]);
              bitonic_merge_desc16f(L); }
#pragma unroll
            for (int i = 0; i < 16; ++i) KK[bj][i] = __float_as_int(L[i]);
            asm volatile("s_waitcnt lgkmcnt(0)" ::: "memory"); __builtin_amdgcn_s_barrier(); asm volatile("" ::: "memory");
        }
        float v1[16], v2[16];
#pragma unroll
        for (int i = 0; i < 16; ++i) { v1[i] = __int_as_float(KK[0][i] & ~127); v2[i] = __int_as_float(KK[1][i] & ~127); }
#define CKEY(a, b) __int_as_float((__float_as_int(csum(v1[a], v2[b])) & ~255) | (255 - (((a) << 4) | (b))))
        float L[16];
#pragma unroll
        for (int b = 0; b < 16; ++b) L[b] = CKEY(0, b);
        { float N[16] = {CKEY(1, 0), CKEY(1, 1), CKEY(1, 2), CKEY(1, 3), CKEY(1, 4), CKEY(1, 5), CKEY(1, 6), CKEY(1, 7), CKEY(2, 0), CKEY(2, 1), CKEY(2, 2), CKEY(2, 3), CKEY(2, 4), CKEY(4, 0), CKEY(4, 1), CKEY(4, 2)};
          topk_absorb16f(L, N); }
        { float N[16] = {CKEY(3, 0), CKEY(3, 1), CKEY(3, 2), CKEY(3, 3), CKEY(5, 0), CKEY(5, 1), CKEY(6, 0), CKEY(6, 1), CKEY(7, 0), CKEY(7, 1), CKEY(8, 0), CKEY(9, 0), CKEY(10, 0), CKEY(11, 0), CKEY(12, 0), CKEY(13, 0)};
          topk_absorb16f(L, N); }
        topk_insert1f(L, CKEY(14, 0)); topk_insert1f(L, CKEY(15, 0));
#undef CKEY
#pragma unroll
        for (int i = 0; i < 4; ++i) { *(PG8_LAS u32x4*)(X + tid * 36 + 4 * i) = (u32x4){(unsigned)KK[0][4 * i], (unsigned)KK[0][4 * i + 1], (unsigned)KK[0][4 * i + 2], (unsigned)KK[0][4 * i + 3]};
                                      *(PG8_LAS u32x4*)(X + tid * 36 + 16 + 4 * i) = (u32x4){(unsigned)KK[1][4 * i], (unsigned)KK[1][4 * i + 1], (unsigned)KK[1][4 * i + 2], (unsigned)KK[1][4 * i + 3]}; }
        asm volatile("s_waitcnt lgkmcnt(0)" ::: "memory");
        float sc[16]; int ex[16];
#pragma unroll
        for (int i = 0; i < 16; ++i) { const int code = 255 - (__float_as_int(L[i]) & 255); const int ka = X[tid * 36 + (code >> 4)], kb = X[tid * 36 + 16 + (code & 15)];
            sc[i] = __int_as_float(ka & ~127) + __int_as_float(kb & ~127); ex[i] = (127 - (ka & 127)) * 128 + (127 - (kb & 127)); }
        float mx = sc[0];
#pragma unroll
        for (int i = 1; i < 16; ++i) mx = fmaxf(mx, sc[i]);
        float den = 0.f;
#pragma unroll
        for (int i = 0; i < 16; ++i) { sc[i] = __builtin_amdgcn_exp2f((sc[i] - mx) * 1.4426950408889634f); den += sc[i]; }
        const float rden = 1.0f / den;
        const size_t o = ((size_t)(u.pm * BM + row) * 8 + u.pn) * 16;
        if (part == 0) {
#pragma unroll
            for (int i = 0; i < 4; ++i) *(u32x4*)(IDX + o + 4 * i) = (u32x4){(unsigned)ex[4 * i], (unsigned)ex[4 * i + 1], (unsigned)ex[4 * i + 2], (unsigned)ex[4 * i + 3]};
        } else {
#pragma unroll
            for (int i = 0; i < 4; ++i) *(f32x4*)(GATE + o + 4 * i) = (f32x4){sc[4 * i] * rden, sc[4 * i + 1] * rden, sc[4 * i + 2] * rden, sc[4 * i + 3] * rden};
        }
        asm volatile("s_waitcnt lgkmcnt(0)" ::: "memory"); __builtin_amdgcn_s_barrier(); asm volatile("" ::: "memory");
    }
};
struct OneUnitOrder {
    StaticOrder base; int round;
    __device__ __forceinline__ bool next(int i, Unit& u) const { return i == 0 && base.next(round, u); }
    __device__ __forceinline__ void a_ready(const Unit&) const {}
    __device__ __forceinline__ void done(const Unit&) const {}
};
}
constexpr int NWAVES = 8;
constexpr int BATCH = 4, SEQ = 4096, DM = 1024, TOK = BATCH * SEQ, DEPTH = 4;
constexpr float LN_EPS = 1e-5f;
constexpr size_t MiB = 1u << 20;
constexpr size_t WS_CTL = 0, CTL_ZERO_BYTES = 32 * 1024;
constexpr size_t WS_W_IN = 2 * MiB;
constexpr size_t WS_W_GLU = 6 * MiB;
constexpr size_t WS_W_KV = 14 * MiB;
constexpr size_t WS_W_SQ = 18 * MiB;
constexpr size_t WS_W_SO = 22 * MiB;
constexpr size_t WS_W_EFF = 26 * MiB;
constexpr size_t WS_W_PG = 42 * MiB;
constexpr size_t WS_W_PW = 50 * MiB;
constexpr size_t WS_PB = 52 * MiB;
constexpr size_t WS_IDX = 84 * MiB;
constexpr size_t WS_GATE = 92 * MiB;
constexpr size_t WS_TABU = 100 * MiB;
constexpr size_t WS_TABV = 228 * MiB;
constexpr size_t WS_PW = 356 * MiB;
constexpr size_t WS_H = 484 * MiB, WS_U = 516 * MiB, WS_Y = 548 * MiB, WS_X1 = 580 * MiB, WS_H1 = 612 * MiB, WS_H2 = 644 * MiB, WS_KB = 676 * MiB, WS_VT = 708 * MiB, WS_HKV = 740 * MiB;
constexpr size_t WS_H8 = 772 * MiB, WS_H28 = 788 * MiB;
constexpr size_t WS_W8 = 804 * MiB;
constexpr size_t W8_IN = WS_W8, W8_GLU = WS_W8 + 2 * MiB, W8_KV = WS_W8 + 6 * MiB, W8_SQ = WS_W8 + 8 * MiB, W8_SO = WS_W8 + 10 * MiB, W8_PG = WS_W8 + 12 * MiB;
constexpr float W8_SCALE = 32.0f;
constexpr size_t WS_H18 = 820 * MiB;
constexpr size_t W8_EFF = 836 * MiB;
constexpr size_t WS_END = 844 * MiB;
constexpr int CW_BAR = 4096;
constexpr float PEER_SU = 91.0f, PEER_SV = 4.75f;

constexpr int LDS_BYTES = 163840;
constexpr int RING_BYTES = 131072;
constexpr int MISC_OFF = 163840 - 256;

#define GAS __attribute__((address_space(1)))
#define LAS __attribute__((address_space(3)))
typedef unsigned short bf16;
typedef unsigned v4u __attribute__((ext_vector_type(4)));
typedef unsigned v2u __attribute__((ext_vector_type(2)));
typedef float f32x4 __attribute__((ext_vector_type(4)));
typedef float f32x16 __attribute__((ext_vector_type(16)));
typedef short bf16x8 __attribute__((ext_vector_type(8)));
typedef __bf16 bf16x2_t __attribute__((ext_vector_type(2)));
#define LDS_WAIT() asm volatile("s_waitcnt lgkmcnt(0)" ::: "memory")
#define VM_WAIT() asm volatile("s_waitcnt vmcnt(0)" ::: "memory")
using pg8::cvt_pk_bf16; using pg8::bf_lo; using pg8::bf_hi; using pg8::gelu_tanh;

#define XB_TMO      128
#define XB_XCNT(j)  (256  + 64 * (j))
#define XB_XSUB(j)  (1280 + 64 * (j))
#define XB_XGEN(j)  (2304 + 64 * (j))
#define XB_TOP      3328
#define XB_TOPGEN   3392
#define XCD_BAR_WORDS 3456
#define XB_SPIN_CAP (1u << 24)
__device__ __forceinline__ unsigned xb_ld(unsigned* p)              { return __hip_atomic_load(p, __ATOMIC_RELAXED, __HIP_MEMORY_SCOPE_AGENT); }
__device__ __forceinline__ unsigned xb_add(unsigned* p, unsigned v) { return __hip_atomic_fetch_add(p, v, __ATOMIC_RELAXED, __HIP_MEMORY_SCOPE_AGENT); }
__device__ __forceinline__ unsigned xb_xcc_id() { return (unsigned)__builtin_amdgcn_s_getreg((3 << 11) | 20) & 0xFu; }
#define XB_SPIN(cond, bar) do { unsigned _sp = 0; while (cond) { __builtin_amdgcn_s_sleep(1); \
    if ((++_sp & 255u) == 0u) { if (xb_ld(&(bar)[XB_TMO])) break; if (_sp > XB_SPIN_CAP) { atomicAdd(&(bar)[XB_TMO], 1u); break; } } } } while (0)
struct XcdBarrier { unsigned* bar; unsigned x; volatile LAS unsigned* st; };
__device__ __forceinline__ XcdBarrier xcd_barrier_post(unsigned* bar, volatile LAS unsigned* st) {
    XcdBarrier b; b.bar = bar; b.x = xb_xcc_id(); b.st = st;
    if (threadIdx.x == 0) (void)xb_add(&bar[XB_XCNT(b.x)], 1u);
    return b;
}
__device__ __forceinline__ void xcd_barrier_complete(unsigned* bar, unsigned x, unsigned& nloc, unsigned& nx) {
    const unsigned G = gridDim.x * gridDim.y * gridDim.z;
    unsigned sum, cnt, mine, sp = 0u;
    for (;;) {
        sum = 0u; cnt = 0u; mine = 0u;
#pragma unroll 1
        for (unsigned j = 0; j < 16; ++j) { const unsigned c = xb_ld(&bar[XB_XCNT(j)]); sum += c; cnt += (c > 0u) ? 1u : 0u; mine = (j == x) ? c : mine; }
        if (sum == G) break;
        __builtin_amdgcn_s_sleep(1);
        if ((++sp & 255u) == 0u) { if (xb_ld(&bar[XB_TMO])) break; if (sp > XB_SPIN_CAP) { atomicAdd(&bar[XB_TMO], 1u); break; } }
    }
    nloc = mine > 0u ? mine : 1u; nx = cnt > 0u ? cnt : 1u;
}
__device__ __forceinline__ void xcd_barrier(const XcdBarrier& b) {
    asm volatile("s_waitcnt vmcnt(0)" ::: "memory");
    __syncthreads();
    if (threadIdx.x == 0) {
        unsigned* bar = b.bar;
        __builtin_amdgcn_s_waitcnt(0);
        unsigned nloc = b.st[0], nx = b.st[1];
        if (nloc == 0u) { xcd_barrier_complete(bar, b.x, nloc, nx); b.st[0] = nloc; b.st[1] = nx; }
        const unsigned old = xb_add(&bar[XB_XSUB(b.x)], 1u);
        const unsigned gen = old / nloc;
        if (old + 1u == (gen + 1u) * nloc) {
            __builtin_amdgcn_fence(__ATOMIC_RELEASE, "agent");
            asm volatile("s_waitcnt vmcnt(0)" ::: "memory");
            const unsigned og = xb_add(&bar[XB_TOP], 1u);
            const unsigned tg = og / nx;
            if (og + 1u == (tg + 1u) * nx) xb_add(&bar[XB_TOPGEN], 1u);
            else XB_SPIN(xb_ld(&bar[XB_TOPGEN]) == tg, bar);
            __builtin_amdgcn_fence(__ATOMIC_ACQUIRE, "agent");
            xb_add(&bar[XB_XGEN(b.x)], 1u);
            asm volatile("s_waitcnt vmcnt(0)" ::: "memory");
        } else {
            XB_SPIN(xb_ld(&bar[XB_XGEN(b.x)]) == gen, bar);
            __builtin_amdgcn_fence(__ATOMIC_ACQUIRE, "agent");
            asm volatile("s_waitcnt vmcnt(0)" ::: "memory");
        }
    }
    __syncthreads();
}

enum PhaseType { P_PROLOGUE = 0, P_STORE = 1, P_SSM = 2, P_GLU = 3, P_LNMIX = 4, P_TOPK = 5, P_PEER = 6, P_PLE = 7, P_LNKV = 8, P_ATTN = 9, P_RES = 10 };
constexpr int MAX_PH = 48;
struct Args { const float* in[28]; float* out; unsigned char* ws; int ph_lo, ph_hi, use_bar, nph; unsigned char ph_type[MAX_PH]; unsigned char ph_arg[MAX_PH]; };
struct Frame {
    LAS unsigned char* lds;
    int tid, lane, wave, vcu, G, z, bx;
    const struct Args* A;
    float* out; unsigned char* ws;
};
__device__ __forceinline__ float wave_sum(float v) {
#pragma unroll
    for (int o = 1; o < 64; o <<= 1) v += __shfl_xor(v, o);
    return v;
}
template <int CTRL, int BANK> __device__ __forceinline__ float dpp_movf(float old, float v) {
    return __builtin_bit_cast(float, __builtin_amdgcn_update_dpp(__builtin_bit_cast(int, old), __builtin_bit_cast(int, v), CTRL, 0xF, BANK, true));
}
__device__ __forceinline__ float wave_sum_dpp(float v) {
    v += dpp_movf<0xB1, 0xF>(0.f, v);
    v += dpp_movf<0x4E, 0xF>(0.f, v);
    { float r = dpp_movf<0x104, 0x5>(0.f, v); r = dpp_movf<0x114, 0xA>(r, v); v += r; }
    v += dpp_movf<0x128, 0xF>(0.f, v);
    { const auto t = __builtin_amdgcn_permlane16_swap(__builtin_bit_cast(unsigned, v), __builtin_bit_cast(unsigned, v), false, false); const unsigned ta = t[0], tb = t[1]; v = __builtin_bit_cast(float, ta) + __builtin_bit_cast(float, tb); }
    { const auto t = __builtin_amdgcn_permlane32_swap(__builtin_bit_cast(unsigned, v), __builtin_bit_cast(unsigned, v), false, false); const unsigned ta = t[0], tb = t[1]; v = __builtin_bit_cast(float, ta) + __builtin_bit_cast(float, tb); }
    return v;
}
__device__ __forceinline__ unsigned f2bf(float f) { unsigned u = __builtin_bit_cast(unsigned, f); return (u + 0x7fffu + ((u >> 16) & 1u)) >> 16; }
__device__ __forceinline__ unsigned pk2(float lo, float hi) { return f2bf(lo) | (f2bf(hi) << 16); }

__device__ __forceinline__ unsigned pk4_fp8(float a, float b, float c, float d) { int w = 0; w = __builtin_amdgcn_cvt_pk_fp8_f32(a, b, w, false); w = __builtin_amdgcn_cvt_pk_fp8_f32(c, d, w, true); return (unsigned)w; }
__device__ __forceinline__ void p0_transpose_item(const float* W, int K, int N, bf16* WT, int glu, LAS float* scr, int item, int lane, unsigned char* WT8 = nullptr) {
    const int nblk = N / 32, kb = item / nblk, nb = item % nblk, k0 = 64 * kb, n0 = 32 * nb;
    int r0 = n0;
    if (glu) { const int bj = n0 >> 10, rem = n0 & 1023; r0 = 256 * (rem >> 7) + 128 * bj + (rem & 127); }
#pragma unroll 8
    for (int i = 0; i < 32; ++i) { const int kk = 2 * i + (lane >> 5); scr[kk * 33 + (lane & 31)] = W[(size_t)(k0 + kk) * N + n0 + (lane & 31)]; }
    LDS_WAIT(); asm volatile("" ::: "memory");
    const int c = lane & 7;
#pragma unroll
    for (int j = 0; j < 4; ++j) { const int n = (lane >> 3) + 8 * j; const LAS float* s = scr + (8 * c) * 33 + n;
        v4u o; o.x = pk2(s[0 * 33], s[1 * 33]); o.y = pk2(s[2 * 33], s[3 * 33]); o.z = pk2(s[4 * 33], s[5 * 33]); o.w = pk2(s[6 * 33], s[7 * 33]);
        if (WT) *(GAS v4u*)(WT + (size_t)(r0 + n) * K + k0 + 8 * c) = o;
        if (WT8) *(GAS v2u*)(WT8 + (size_t)(r0 + n) * K + k0 + 8 * c) = (v2u){pk4_fp8(s[0 * 33] * W8_SCALE, s[1 * 33] * W8_SCALE, s[2 * 33] * W8_SCALE, s[3 * 33] * W8_SCALE), pk4_fp8(s[4 * 33] * W8_SCALE, s[5 * 33] * W8_SCALE, s[6 * 33] * W8_SCALE, s[7 * 33] * W8_SCALE)}; }
    LDS_WAIT(); asm volatile("" ::: "memory");
}
__device__ __forceinline__ void cvt_stream_dual(Frame& F, const float* src, bf16* dst, unsigned char* dst8, size_t n) {
    const size_t nthr = (size_t)F.G * 512, gt = (size_t)F.bx * 512 + F.tid;
    for (size_t i = gt; i < n / 8; i += nthr) {
        const f32x4 a = *(const GAS f32x4*)(src + i * 8), b = *(const GAS f32x4*)(src + i * 8 + 4);
        v4u o; o.x = pk2(a.x, a.y); o.y = pk2(a.z, a.w); o.z = pk2(b.x, b.y); o.w = pk2(b.z, b.w);
        *(GAS v4u*)(dst + i * 8) = o;
        *(GAS v2u*)(dst8 + i * 8) = (v2u){pk4_fp8(a.x, a.y, a.z, a.w), pk4_fp8(b.x, b.y, b.z, b.w)};
    }
}
__device__ __forceinline__ void cvt_stream(Frame& F, const float* src, bf16* dst, size_t n) {
    const size_t nthr = (size_t)F.G * 512, gt = (size_t)F.bx * 512 + F.tid;
    for (size_t i = gt; i < n / 8; i += nthr) {
        const f32x4 a = *(const GAS f32x4*)(src + i * 8), b = *(const GAS f32x4*)(src + i * 8 + 4);
        v4u o; o.x = pk2(a.x, a.y); o.y = pk2(a.z, a.w); o.z = pk2(b.x, b.y); o.w = pk2(b.z, b.w);
        *(GAS v4u*)(dst + i * 8) = o;
    }
}
__device__ __forceinline__ void cvt_stream_fp4(Frame& F, const float* src, unsigned char* dst, size_t n, float scale) {
    const size_t nthr = (size_t)F.G * 512, gt = (size_t)F.bx * 512 + F.tid;
    for (size_t i = gt; i < n / 32; i += nthr) {
        unsigned w[4];
#pragma unroll
        for (int q = 0; q < 4; ++q) {
            const f32x4 a = *(const GAS f32x4*)(src + i * 32 + 8 * q) * scale, b = *(const GAS f32x4*)(src + i * 32 + 8 * q + 4) * scale;
            unsigned t = 0u;
            t = __builtin_amdgcn_cvt_scalef32_pk_fp4_f32(t, a.x, a.y, 1.0f, 0); t = __builtin_amdgcn_cvt_scalef32_pk_fp4_f32(t, a.z, a.w, 1.0f, 1);
            t = __builtin_amdgcn_cvt_scalef32_pk_fp4_f32(t, b.x, b.y, 1.0f, 2); t = __builtin_amdgcn_cvt_scalef32_pk_fp4_f32(t, b.z, b.w, 1.0f, 3);
            w[q] = t;
        }
        *(GAS v4u*)(dst + i * 16) = (v4u){w[0], w[1], w[2], w[3]};
    }
}
__device__ __forceinline__ unsigned pkbf2(float lo, float hi) { return cvt_pk_bf16(lo, hi); }
__device__ __forceinline__ void p0_weff_item(Frame& F, int item) {
    const int jb = item & 1, kb = (item >> 1) & 15, hh = (item >> 5) & 15, l = item >> 9;
    const int lane = F.lane, r32 = lane & 31, h = lane >> 5;
    const float* wq = F.A->in[21 + F.z] + (size_t)l * 1024 * 2048 + (size_t)(64 * kb + r32) * 2048 + 128 * hh + 8 * h;
    const float* ky = F.A->in[22 + (hh & 1) + F.z] + (size_t)l * 128 * 128 + (size_t)(64 * jb + r32) * 128 + 8 * h;
    f32x16 acc[2][2] = {};
#pragma unroll
    for (int ks = 0; ks < 8; ++ks) {
        bf16x8 af[2], bf[2];
#pragma unroll
        for (int a = 0; a < 2; ++a) { const f32x4 a0 = *(const GAS f32x4*)(wq + (size_t)a * 32 * 2048 + 16 * ks), a1 = *(const GAS f32x4*)(wq + (size_t)a * 32 * 2048 + 16 * ks + 4);
            af[a] = __builtin_bit_cast(bf16x8, (v4u){pkbf2(a0.x, a0.y), pkbf2(a0.z, a0.w), pkbf2(a1.x, a1.y), pkbf2(a1.z, a1.w)}); }
#pragma unroll
        for (int b = 0; b < 2; ++b) { const f32x4 b0 = *(const GAS f32x4*)(ky + (size_t)b * 32 * 128 + 16 * ks), b1 = *(const GAS f32x4*)(ky + (size_t)b * 32 * 128 + 16 * ks + 4);
            bf[b] = __builtin_bit_cast(bf16x8, (v4u){pkbf2(b0.x, b0.y), pkbf2(b0.z, b0.w), pkbf2(b1.x, b1.y), pkbf2(b1.z, b1.w)}); }
#pragma unroll
        for (int a = 0; a < 2; ++a)
#pragma unroll
            for (int b = 0; b < 2; ++b) acc[a][b] = __builtin_amdgcn_mfma_f32_32x32x16_bf16(af[a], bf[b], acc[a][b], 0, 0, 0);
    }
#pragma unroll
    for (int a = 0; a < 2; ++a)
#pragma unroll
        for (int b = 0; b < 2; ++b) {
            unsigned char* dst = (unsigned char*)(F.ws + W8_EFF) + (size_t)l * 2048 * 1024 + (size_t)(128 * hh + 64 * jb + 32 * b + r32) * 1024 + 64 * kb + 32 * a + 4 * h;
#pragma unroll
            for (int q = 0; q < 4; ++q) *(GAS unsigned*)(dst + 8 * q) = pk4_fp8(acc[a][b][4 * q] * W8_SCALE, acc[a][b][4 * q + 1] * W8_SCALE, acc[a][b][4 * q + 2] * W8_SCALE, acc[a][b][4 * q + 3] * W8_SCALE); }
}
__device__ __forceinline__ void p0_prologue(Frame& F) {
#ifndef PROBE_PRO
#define PROBE_PRO 0
#endif
    for (int rp = 0; rp < (PROBE_PRO == 4 ? 2 : 1); ++rp) {
    cvt_stream_dual(F, F.A->in[0 + F.z], (bf16*)(F.ws + WS_H), (unsigned char*)(F.ws + WS_H8), (size_t)TOK * DM);
    cvt_stream(F, F.A->in[1 + F.z], (bf16*)(F.ws + WS_PB), (size_t)DEPTH * TOK * 256); }
    LAS float* scr = (LAS float*)(F.lds + F.wave * 8704);
    const int gw = F.vcu * NWAVES + F.wave, NGW = F.G * NWAVES;
    constexpr int I_SQ = 16 * 32, I_GLU = 16 * 64, I_PW = 4 * 32;
    constexpr int NITEMS = 2 * I_SQ + 2 * I_GLU + I_GLU + 2 * I_SQ + 2 * I_SQ + 4 * I_SQ + 4 * I_PW;
    for (int rp = 0; rp < (PROBE_PRO == 2 ? 2 : 1); ++rp)
    for (int it = gw; it < NITEMS; it += NGW) {
        int r = it;
        if (r < 2 * I_SQ) { const int l = r / I_SQ; p0_transpose_item(F.A->in[6 + F.z] + (size_t)l * 1024 * 1024, 1024, 1024, nullptr, 0, scr, r % I_SQ, F.lane, (unsigned char*)(F.ws + W8_IN) + (size_t)l * 1024 * 1024); continue; } r -= 2 * I_SQ;
        if (r < 2 * I_GLU) { const int l = r / I_GLU; p0_transpose_item(F.A->in[15 + F.z] + (size_t)l * 1024 * 2048, 1024, 2048, nullptr, 1, scr, r % I_GLU, F.lane, (unsigned char*)(F.ws + W8_GLU) + (size_t)l * 2048 * 1024); continue; } r -= 2 * I_GLU;
        if (r < I_GLU) { p0_transpose_item(F.A->in[18 + F.z], 1024, 2048, nullptr, 0, scr, r, F.lane, (unsigned char*)(F.ws + W8_KV)); continue; } r -= I_GLU;
        if (r < 2 * I_SQ) { const int l = r / I_SQ; p0_transpose_item(F.A->in[19 + F.z] + (size_t)l * 1024 * 1024, 1024, 1024, nullptr, 0, scr, r % I_SQ, F.lane, (unsigned char*)(F.ws + W8_SQ) + (size_t)l * 1024 * 1024); continue; } r -= 2 * I_SQ;
        if (r < 2 * I_SQ) { const int l = r / I_SQ; p0_transpose_item(F.A->in[20 + F.z] + (size_t)l * 1024 * 1024, 1024, 1024, nullptr, 0, scr, r % I_SQ, F.lane, (unsigned char*)(F.ws + W8_SO) + (size_t)l * 1024 * 1024); continue; } r -= 2 * I_SQ;
        if (r < 4 * I_SQ) { const int l = r / I_SQ; p0_transpose_item(F.A->in[27 + F.z] + (size_t)l * 1024 * 1024, 1024, 1024, nullptr, 0, scr, r % I_SQ, F.lane, (unsigned char*)(F.ws + W8_PG) + (size_t)l * 1024 * 1024); continue; } r -= 4 * I_SQ;
        { const int l = r / I_PW; p0_transpose_item(F.A->in[26 + F.z] + (size_t)l * 256 * 1024, 256, 1024, (bf16*)(F.ws + WS_W_PW) + (size_t)l * 1024 * 256, 0, scr, r % I_PW, F.lane); }
    }
    for (int rp = 0; rp < (PROBE_PRO == 3 ? 2 : 1); ++rp)
    for (int it = gw; it < 2048; it += NGW) p0_weff_item(F, it);
}

__device__ __forceinline__ void ln_rows(Frame& F, const bf16* X, const float* g, const float* bb, bf16* O, unsigned char* O8 = nullptr) {
    const int gw = F.vcu * NWAVES + F.wave, NGW = F.G * NWAVES;
    float gg[16], bv[16];
    { const f32x4 a = *(const GAS f32x4*)(g + 8 * F.lane), b = *(const GAS f32x4*)(g + 8 * F.lane + 4), c = *(const GAS f32x4*)(g + 512 + 8 * F.lane), d = *(const GAS f32x4*)(g + 512 + 8 * F.lane + 4);
      gg[0] = a.x; gg[1] = a.y; gg[2] = a.z; gg[3] = a.w; gg[4] = b.x; gg[5] = b.y; gg[6] = b.z; gg[7] = b.w; gg[8] = c.x; gg[9] = c.y; gg[10] = c.z; gg[11] = c.w; gg[12] = d.x; gg[13] = d.y; gg[14] = d.z; gg[15] = d.w; }
    { const f32x4 a = *(const GAS f32x4*)(bb + 8 * F.lane), b = *(const GAS f32x4*)(bb + 8 * F.lane + 4), c = *(const GAS f32x4*)(bb + 512 + 8 * F.lane), d = *(const GAS f32x4*)(bb + 512 + 8 * F.lane + 4);
      bv[0] = a.x; bv[1] = a.y; bv[2] = a.z; bv[3] = a.w; bv[4] = b.x; bv[5] = b.y; bv[6] = b.z; bv[7] = b.w; bv[8] = c.x; bv[9] = c.y; bv[10] = c.z; bv[11] = c.w; bv[12] = d.x; bv[13] = d.y; bv[14] = d.z; bv[15] = d.w; }
    for (int m = gw; m < TOK; m += NGW) {
        const v4u xa = *(const GAS v4u*)(X + (size_t)m * DM + 8 * F.lane), xb = *(const GAS v4u*)(X + (size_t)m * DM + 512 + 8 * F.lane);
        float x[16] = {bf_lo(xa.x), bf_hi(xa.x), bf_lo(xa.y), bf_hi(xa.y), bf_lo(xa.z), bf_hi(xa.z), bf_lo(xa.w), bf_hi(xa.w), bf_lo(xb.x), bf_hi(xb.x), bf_lo(xb.y), bf_hi(xb.y), bf_lo(xb.z), bf_hi(xb.z), bf_lo(xb.w), bf_hi(xb.w)};
        float s = 0.f;
#pragma unroll
        for (int i = 0; i < 16; ++i) s += x[i];
        const float mean = wave_sum_dpp(s) * (1.f / DM); float q = 0.f;
#pragma unroll
        for (int i = 0; i < 16; ++i) { x[i] -= mean; q += x[i] * x[i]; }
        const float rstd = 1.0f / sqrtf(wave_sum_dpp(q) * (1.f / DM) + LN_EPS);
#pragma unroll
        for (int i = 0; i < 16; ++i) x[i] = x[i] * rstd * gg[i] + bv[i];
        v4u oa, ob; oa.x = pk2(x[0], x[1]); oa.y = pk2(x[2], x[3]); oa.z = pk2(x[4], x[5]); oa.w = pk2(x[6], x[7]); ob.x = pk2(x[8], x[9]); ob.y = pk2(x[10], x[11]); ob.z = pk2(x[12], x[13]); ob.w = pk2(x[14], x[15]);
        if (O) { *(GAS v4u*)(O + (size_t)m * DM + 8 * F.lane) = oa; *(GAS v4u*)(O + (size_t)m * DM + 512 + 8 * F.lane) = ob; }
        if (O8) { *(GAS v2u*)(O8 + (size_t)m * DM + 8 * F.lane) = (v2u){pk4_fp8(x[0], x[1], x[2], x[3]), pk4_fp8(x[4], x[5], x[6], x[7])};
                  *(GAS v2u*)(O8 + (size_t)m * DM + 512 + 8 * F.lane) = (v2u){pk4_fp8(x[8], x[9], x[10], x[11]), pk4_fp8(x[12], x[13], x[14], x[15])}; }
    }
}
struct TabCvt { const float* su; const float* sv; unsigned char* du; unsigned char* dv; int c, cf, stride, n; };
__device__ __forceinline__ void tabcvt_issue(TabCvt& T, int lane, f32x4 (&cv)[4]) {
    const bool live = T.c < T.n;
    if (live) { const int half = T.n >> 1; const float* src = (T.c < half ? T.su + (size_t)T.c * 1024 : T.sv + (size_t)(T.c - half) * 1024) + 16 * lane;
#pragma unroll
        for (int q = 0; q < 4; ++q) cv[q] = *(const GAS f32x4*)(src + 4 * q); }
    T.c += T.stride;
}
__device__ __forceinline__ unsigned i4q(float v) { float t = __builtin_fminf(__builtin_fmaxf(v * PEER_SU, -7.f), 7.f) + 12582912.0f; asm volatile("" : "+v"(t)); return __builtin_bit_cast(unsigned, t) & 15u; }
__device__ __forceinline__ unsigned pack8_i4(const f32x4& a, const f32x4& b) {
    return i4q(a.x) | (i4q(a.y) << 4) | (i4q(a.z) << 8) | (i4q(a.w) << 12) | (i4q(b.x) << 16) | (i4q(b.y) << 20) | (i4q(b.z) << 24) | (i4q(b.w) << 28);
}
__device__ __forceinline__ void tabcvt_finish(TabCvt& T, int lane, const f32x4 (&cv)[4]) {
    const bool live = T.cf < T.n;
    if (live) { const int half = T.n >> 1;
        unsigned w0 = 0u, w1 = 0u;
        if (T.cf < half) { w0 = pack8_i4(cv[0], cv[1]); w1 = pack8_i4(cv[2], cv[3]); }
        else { const float sc = PEER_SV;
            w0 = __builtin_amdgcn_cvt_scalef32_pk_fp4_f32(w0, cv[0].x * sc, cv[0].y * sc, 1.0f, 0); w0 = __builtin_amdgcn_cvt_scalef32_pk_fp4_f32(w0, cv[0].z * sc, cv[0].w * sc, 1.0f, 1);
            w0 = __builtin_amdgcn_cvt_scalef32_pk_fp4_f32(w0, cv[1].x * sc, cv[1].y * sc, 1.0f, 2); w0 = __builtin_amdgcn_cvt_scalef32_pk_fp4_f32(w0, cv[1].z * sc, cv[1].w * sc, 1.0f, 3);
            w1 = __builtin_amdgcn_cvt_scalef32_pk_fp4_f32(w1, cv[2].x * sc, cv[2].y * sc, 1.0f, 0); w1 = __builtin_amdgcn_cvt_scalef32_pk_fp4_f32(w1, cv[2].z * sc, cv[2].w * sc, 1.0f, 1);
            w1 = __builtin_amdgcn_cvt_scalef32_pk_fp4_f32(w1, cv[3].x * sc, cv[3].y * sc, 1.0f, 2); w1 = __builtin_amdgcn_cvt_scalef32_pk_fp4_f32(w1, cv[3].z * sc, cv[3].w * sc, 1.0f, 3); }
        unsigned char* dst = (T.cf < half ? T.du + (size_t)T.cf * 512 : T.dv + (size_t)(T.cf - half) * 512) + 8 * lane;
        *(GAS v2u*)dst = (v2u){w0, w1}; }
    T.cf += T.stride;
}
template <bool PASS1> __device__ __forceinline__ void ssm_pass(const bf16* U, bf16* Y, LAS unsigned char* stl, const float* dskip, size_t tok0, int g, int lane, int n, int hh, int i_row,
                                                                  const float (&a_re)[2], const float (&a_im)[2], const bf16x8 (&Bf)[4], const LAS unsigned char* CFL, float (&s_re)[2], float (&s_im)[2]) {
    const int c0 = 16 * g + 4 * hh;
    bf16x8 ua_n = *(const GAS bf16x8*)(U + tok0 * DM + 16 * g + 8 * hh);
    v2u u0_n = {}, u1_n = {};
    if (PASS1) { u0_n = *(const GAS v2u*)(U + tok0 * DM + c0); u1_n = *(const GAS v2u*)(U + tok0 * DM + c0 + 8); }
#pragma unroll 1
    for (int tile = 0; tile < 16; ++tile) {
        const size_t tok = tok0 + tile * 16;
        const bf16x8 ua = ua_n; const v2u u0 = u0_n, u1 = u1_n;
        { const size_t tokn = tok0 + ((tile + 1) & 15) * 16;
          ua_n = *(const GAS bf16x8*)(U + tokn * DM + 16 * g + 8 * hh);
          if (PASS1) { u0_n = *(const GAS v2u*)(U + tokn * DM + c0); u1_n = *(const GAS v2u*)(U + tokn * DM + c0 + 8); } }
        f32x16 acc[4];
#pragma unroll
        for (int nb = 0; nb < 4; ++nb) { f32x16 z = {}; acc[nb] = __builtin_amdgcn_mfma_f32_32x32x16_bf16(ua, Bf[nb], z, 0, 0, 0); }
#pragma unroll
        for (int pb = 0; pb < 2; ++pb) {
#pragma unroll
            for (int r = 0; r < 16; ++r) {
                float t0 = fmaf(-a_im[pb], s_im[pb], acc[2 * pb][r]); asm volatile("" : "+v"(t0));
                float t1 = fmaf(a_im[pb], s_re[pb], acc[2 * pb + 1][r]); asm volatile("" : "+v"(t1));
                float nre = fmaf(a_re[pb], s_re[pb], t0); asm volatile("" : "+v"(nre));
                float nim = fmaf(a_re[pb], s_im[pb], t1); asm volatile("" : "+v"(nim));
                s_re[pb] = nre; s_im[pb] = nim;
                if (PASS1) { const int irow = (r & 3) + 8 * (r >> 2) + 4 * hh; *(LAS unsigned*)(stl + irow * 272 + (32 * pb + n) * 4) = cvt_pk_bf16(nre, nim); }
            }
        }
        if (PASS1) {
            LDS_WAIT();
            f32x16 yv = {};
#pragma unroll
            for (int ks = 0; ks < 8; ++ks) { const bf16x8 sb = *(const LAS bf16x8*)(stl + i_row * 272 + (16 * ks + 8 * hh) * 2); const bf16x8 cf = *(const LAS bf16x8*)(CFL + (ks * 64 + lane) * 16); yv = __builtin_amdgcn_mfma_f32_32x32x16_bf16(cf, sb, yv, 0, 0, 0); }
            const f32x4 d0 = *(const GAS f32x4*)(dskip + c0), d1 = *(const GAS f32x4*)(dskip + c0 + 8);
            float o[8];
            o[0] = gelu_tanh(yv[0] + d0.x * bf_lo(u0.x)); o[1] = gelu_tanh(yv[1] + d0.y * bf_hi(u0.x)); o[2] = gelu_tanh(yv[2] + d0.z * bf_lo(u0.y)); o[3] = gelu_tanh(yv[3] + d0.w * bf_hi(u0.y));
            o[4] = gelu_tanh(yv[4] + d1.x * bf_lo(u1.x)); o[5] = gelu_tanh(yv[5] + d1.y * bf_hi(u1.x)); o[6] = gelu_tanh(yv[6] + d1.z * bf_lo(u1.y)); o[7] = gelu_tanh(yv[7] + d1.w * bf_hi(u1.y));
            *(GAS unsigned*)((unsigned char*)Y + tok * DM + c0) = pk4_fp8(o[0], o[1], o[2], o[3]);
            *(GAS unsigned*)((unsigned char*)Y + tok * DM + c0 + 8) = pk4_fp8(o[4], o[5], o[6], o[7]);
            LDS_WAIT();
        }
    }
}
__device__ __forceinline__ void ssm_phase(Frame& F, int layer) {
    if (layer == 0) {
        TabCvt TC; TC.su = F.A->in[24 + F.z]; TC.sv = F.A->in[25 + F.z]; TC.du = (unsigned char*)(F.ws + WS_TABU); TC.dv = (unsigned char*)(F.ws + WS_TABV);
        TC.c = F.vcu * NWAVES + F.wave; TC.cf = TC.c; TC.stride = F.G * NWAVES; TC.n = 2 * 16384;
        f32x4 cvA[4], cvB[4];
        tabcvt_issue(TC, F.lane, cvA);
        while (TC.cf < TC.n) { tabcvt_issue(TC, F.lane, cvB); tabcvt_finish(TC, F.lane, cvA); tabcvt_issue(TC, F.lane, cvA); tabcvt_finish(TC, F.lane, cvB); }
    }
    const bf16* U = (const bf16*)(F.ws + WS_U); bf16* Y = (bf16*)(F.ws + WS_Y);
    const int lane = F.lane, n = lane & 31, hh = lane >> 5, wave = F.wave;
    LAS unsigned char* stl = F.lds + wave * 8704;
    LAS float* E = (LAS float*)(F.lds + 8 * 8704);
    for (int bg = F.vcu; bg < BATCH * 64; bg += F.G) {
        const int b = bg >> 6, g = bg & 63, lg = layer * 64 + g;
        const float dt = expf(F.A->in[9 + F.z][lg]);
        float a_re[2], a_im[2]; bf16x8 Bf[4];
#pragma unroll
        for (int pb = 0; pb < 2; ++pb) {
            const int p = 32 * pb + n;
            const float lre = F.A->in[7 + F.z][lg * 64 + p], lim = F.A->in[8 + F.z][lg * 64 + p];
            const float mag = expf(lre * dt); float sn, cs; sincosf(lim * dt, &sn, &cs);
            a_re[pb] = mag * cs; a_im[pb] = mag * sn;
            const float nr = a_re[pb] - 1.0f, ni = a_im[pb], den = 1.0f / (lre * lre + lim * lim);
            const float cr = (nr * lre + ni * lim) * den, ci = (ni * lre - nr * lim) * den;
            const float* br = F.A->in[10 + F.z] + ((size_t)lg * 64 + p) * 16 + 8 * hh; const float* bi = F.A->in[11 + F.z] + ((size_t)lg * 64 + p) * 16 + 8 * hh;
            const f32x4 br0 = *(const GAS f32x4*)br, br1 = *(const GAS f32x4*)(br + 4), bi0 = *(const GAS f32x4*)bi, bi1 = *(const GAS f32x4*)(bi + 4);
            const float rr[8] = {br0.x, br0.y, br0.z, br0.w, br1.x, br1.y, br1.z, br1.w}, ii[8] = {bi0.x, bi0.y, bi0.z, bi0.w, bi1.x, bi1.y, bi1.z, bi1.w};
            unsigned wre[4], wim[4];
#pragma unroll
            for (int j = 0; j < 4; ++j) { const float r0 = rr[2 * j], i0 = ii[2 * j], r1 = rr[2 * j + 1], i1 = ii[2 * j + 1];
                wre[j] = pk2(cr * r0 - ci * i0, cr * r1 - ci * i1); wim[j] = pk2(cr * i0 + ci * r0, cr * i1 + ci * r1); }
            Bf[2 * pb] = __builtin_bit_cast(bf16x8, (v4u){wre[0], wre[1], wre[2], wre[3]});
            Bf[2 * pb + 1] = __builtin_bit_cast(bf16x8, (v4u){wim[0], wim[1], wim[2], wim[3]});
        }
        LAS unsigned char* CFL = F.lds + 8 * 8704 + 8192;
        if (wave == 0) { const int cr_ = n & 15; const float zm = (n < 16) ? 1.0f : 0.0f;
          const float* cre = F.A->in[12 + F.z] + ((size_t)lg * 16 + cr_) * 64 + 4 * hh; const float* cim = F.A->in[13 + F.z] + ((size_t)lg * 16 + cr_) * 64 + 4 * hh;
          f32x4 cr4[8], ci4[8];
#pragma unroll
          for (int ks = 0; ks < 8; ++ks) { cr4[ks] = *(const GAS f32x4*)(cre + 8 * ks); ci4[ks] = *(const GAS f32x4*)(cim + 8 * ks); }
#pragma unroll
          for (int ks = 0; ks < 8; ++ks) { const f32x4 a = cr4[ks] * zm, c = ci4[ks] * (-zm);
              *(LAS v4u*)(CFL + (ks * 64 + lane) * 16) = (v4u){pk2(a.x, c.x), pk2(a.y, c.y), pk2(a.z, c.z), pk2(a.w, c.w)}; } }
        const int seg_own = 2 * wave + hh;
        const int i_row = n, seg_ld = 2 * wave + ((i_row >> 2) & 1), tau_ld = (i_row & 3) + 4 * (i_row >> 3);
        const size_t tok0 = (size_t)b * SEQ + seg_ld * 256 + tau_ld;
        const float* dskip = F.A->in[14 + F.z] + layer * 1024;
        float s_re[2] = {0.f, 0.f}, s_im[2] = {0.f, 0.f};
        ssm_pass<false>(U, Y, stl, dskip, tok0, g, lane, n, hh, i_row, a_re, a_im, Bf, CFL, s_re, s_im);
#pragma unroll
        for (int pb = 0; pb < 2; ++pb) { E[(seg_own * 64 + 32 * pb + n) * 2] = s_re[pb]; E[(seg_own * 64 + 32 * pb + n) * 2 + 1] = s_im[pb]; }
        LDS_WAIT(); __syncthreads();
#pragma unroll
        for (int pb = 0; pb < 2; ++pb) {
            float Ar = a_re[pb], Ai = a_im[pb];
#pragma unroll
            for (int q = 0; q < 8; ++q) { float t = Ar * Ar - Ai * Ai; asm volatile("" : "+v"(t)); Ai = 2.0f * Ar * Ai; asm volatile("" : "+v"(Ai)); Ar = t; }
            float sr = 0.f, si = 0.f;
            for (int j = 0; j < 15; ++j) {
                const float er = E[(j * 64 + 32 * pb + n) * 2], ei = E[(j * 64 + 32 * pb + n) * 2 + 1];
                float tr = Ar * sr - Ai * si + er; asm volatile("" : "+v"(tr)); float ti = Ar * si + Ai * sr + ei; asm volatile("" : "+v"(ti));
                if (j < seg_own) { sr = tr; si = ti; }
            }
            s_re[pb] = sr; s_im[pb] = si;
        }
        __syncthreads();
        ssm_pass<true>(U, Y, stl, dskip, tok0, g, lane, n, hh, i_row, a_re, a_im, Bf, CFL, s_re, s_im);
        __syncthreads();
    }
}

__device__ __forceinline__ void attn_wave_unit(Frame& F, int b, int hd, int qt) {
    const bf16* Q = (const bf16*)(F.ws + WS_U); const bf16* K = (const bf16*)(F.ws + WS_KB); const bf16* Vt = (const bf16*)(F.ws + WS_VT); bf16* O = (bf16*)(F.ws + WS_Y);
    constexpr float ATT_EXIT = 28.0f;
    const int lane = F.lane, n = lane & 31, hh = lane >> 5;
    const size_t qrow = (size_t)b * SEQ + 32 * qt + n;
    bf16x8 qf[4];
#pragma unroll
    for (int ks = 0; ks < 4; ++ks) qf[ks] = *(const GAS bf16x8*)(Q + qrow * DM + 64 * hd + 16 * ks + 8 * hh);
    f32x16 o[2]; o[0] = f32x16{}; o[1] = f32x16{};
    float racc = 0.f;
    const int qrel = 32 * qt, myq = qrel + n;
    const int keyi = (n & 3) + 4 * (n >> 3) + 16 * ((n >> 2) & 1);
    const bf16* kbase = K + ((size_t)b * SEQ + keyi) * DM + 64 * hd + 8 * hh;
    const bf16* vbase = Vt + (size_t)(64 * hd + n) * TOK + (size_t)b * SEQ + 16 * hh;
    int T = (qrel + 30) >> 6;
    bf16x8 kf[2][4];
#pragma unroll
    for (int u = 0; u < 2; ++u)
#pragma unroll
        for (int ks = 0; ks < 4; ++ks) kf[u][ks] = *(const GAS bf16x8*)(kbase + (size_t)(64 * T + 32 * u) * DM + 16 * ks);
    for (; T >= 0; --T) {
        const int k0 = 64 * T;
        f32x16 s0 = {}, s1 = {};
#pragma unroll
        for (int ks = 0; ks < 4; ++ks) { s0 = __builtin_amdgcn_mfma_f32_32x32x16_bf16(kf[0][ks], qf[ks], s0, 0, 0, 0); s1 = __builtin_amdgcn_mfma_f32_32x32x16_bf16(kf[1][ks], qf[ks], s1, 0, 0, 0); }
        bf16x8 vf[2][2][2];
#pragma unroll
        for (int u = 0; u < 2; ++u)
#pragma unroll
            for (int sx = 0; sx < 2; ++sx)
#pragma unroll
                for (int db = 0; db < 2; ++db) vf[u][sx][db] = *(const GAS bf16x8*)(vbase + (size_t)(32 * db) * TOK + k0 + 32 * u + 8 * sx);
        { const int Tn = T > 0 ? T - 1 : 0;
#pragma unroll
          for (int u = 0; u < 2; ++u)
#pragma unroll
              for (int ks = 0; ks < 4; ++ks) kf[u][ks] = *(const GAS bf16x8*)(kbase + (size_t)(64 * Tn + 32 * u) * DM + 16 * ks); }
        const bool need_mask = (k0 + 63 >= qrel);
        float sp[2][16], z[2][16];
#pragma unroll
        for (int r = 0; r < 16; ++r) { const float za = fminf(s0[r], 60.0f), zb = fminf(s1[r], 60.0f); z[0][r] = za; z[1][r] = zb;
            sp[0][r] = __builtin_amdgcn_logf(1.0f + __builtin_amdgcn_exp2f(za)); sp[1][r] = __builtin_amdgcn_logf(1.0f + __builtin_amdgcn_exp2f(zb)); }
        if (need_mask) {
#pragma unroll
            for (int u = 0; u < 2; ++u)
#pragma unroll
                for (int r = 0; r < 16; ++r) { const int key = k0 + 32 * u + 16 * hh + r; if (key >= myq) { sp[u][r] = 0.f; z[u][r] = -1e30f; } }
        }
        float T0 = 0.f, T1 = 0.f;
#pragma unroll
        for (int r = 0; r < 16; ++r) { T0 += sp[0][r]; T1 += sp[1][r]; }
        const float oT0 = __shfl_xor(T0, 32), oT1 = __shfl_xor(T1, 32);
        const float off1 = racc + (hh ? 0.f : oT1);
        const float off0 = racc + T1 + oT1 + (hh ? 0.f : oT0);
        racc += T0 + T1 + oT0 + oT1;
        unsigned pw[2][8];
        { float run = off1;
#pragma unroll
          for (int r = 15; r >= 0; --r) { run += sp[1][r]; z[1][r] = __builtin_amdgcn_exp2f(z[1][r] - run); }
          run = off0;
#pragma unroll
          for (int r = 15; r >= 0; --r) { run += sp[0][r]; z[0][r] = __builtin_amdgcn_exp2f(z[0][r] - run); } }
#pragma unroll
        for (int u = 0; u < 2; ++u)
#pragma unroll
            for (int q = 0; q < 8; ++q) pw[u][q] = cvt_pk_bf16(z[u][2 * q], z[u][2 * q + 1]);
#pragma unroll
        for (int u = 0; u < 2; ++u)
#pragma unroll
            for (int sx = 0; sx < 2; ++sx) { const bf16x8 af = __builtin_bit_cast(bf16x8, (v4u){pw[u][4 * sx], pw[u][4 * sx + 1], pw[u][4 * sx + 2], pw[u][4 * sx + 3]});
#pragma unroll
                for (int db = 0; db < 2; ++db) o[db] = __builtin_amdgcn_mfma_f32_32x32x16_bf16(af, vf[u][sx][db], o[db], 0, 0, 0); }
        if (__all(racc >= ATT_EXIT)) break;
    }
#pragma unroll
    for (int db = 0; db < 2; ++db)
#pragma unroll
        for (int r = 0; r < 16; ++r) { const int qr = (r & 3) + 8 * (r >> 2) + 4 * hh;
            ((unsigned char*)O)[((size_t)b * SEQ + 32 * qt + qr) * DM + 64 * hd + 32 * db + n] = (unsigned char)(pk4_fp8(o[db][r], 0.f, 0.f, 0.f) & 0xffu); }
}
__device__ __forceinline__ void attn_phase(Frame& F) {
    const int gw = F.vcu * NWAVES + F.wave, NGW = F.G * NWAVES;
#pragma unroll 1
    for (int uidx = gw; uidx < 64 * 128; uidx += NGW) { const int bh = uidx >> 7; attn_wave_unit(F, bh >> 4, bh & 15, uidx & 127); }
}

typedef float f32x2 __attribute__((ext_vector_type(2)));
typedef _Float16 h16x2 __attribute__((ext_vector_type(2)));
template <int K, class T> __device__ __forceinline__ T xcomb(T a, T b, int lane) {
    const bool hi = (lane >> K) & 1; const T keep = hi ? b : a, send = hi ? a : b;
    return keep + __shfl_xor(send, 1 << K);
}
__device__ __forceinline__ void fp4x16_to_f32(const v2u& r, f32x2 (&f)[8]) {
    const unsigned w0 = r.x, w1 = r.y;
    f[0] = __builtin_amdgcn_cvt_scalef32_pk_f32_fp4(w0, 1.0f, 0); f[1] = __builtin_amdgcn_cvt_scalef32_pk_f32_fp4(w0, 1.0f, 1);
    f[2] = __builtin_amdgcn_cvt_scalef32_pk_f32_fp4(w0, 1.0f, 2); f[3] = __builtin_amdgcn_cvt_scalef32_pk_f32_fp4(w0, 1.0f, 3);
    f[4] = __builtin_amdgcn_cvt_scalef32_pk_f32_fp4(w1, 1.0f, 0); f[5] = __builtin_amdgcn_cvt_scalef32_pk_f32_fp4(w1, 1.0f, 1);
    f[6] = __builtin_amdgcn_cvt_scalef32_pk_f32_fp4(w1, 1.0f, 2); f[7] = __builtin_amdgcn_cvt_scalef32_pk_f32_fp4(w1, 1.0f, 3);
}
typedef unsigned bl_v2u __attribute__((__vector_size__(8)));
__device__ __forceinline__ void peer_load8(__amdgpu_buffer_rsrc_t tab, int idv, int e0, int lane, v2u (&R)[8]) {
    int so[8];
    __builtin_amdgcn_s_setprio(1);
#pragma unroll
    for (int i = 0; i < 8; ++i) so[i] = __builtin_amdgcn_readlane(idv, e0 + i) << 9;
    __builtin_amdgcn_sched_barrier(0);
#pragma unroll
    for (int i = 0; i < 8; ++i) { const bl_v2u t = __builtin_amdgcn_raw_buffer_load_b64(tab, 8 * lane, so[i], 0); R[i] = (v2u){t[0], t[1]}; }
    __builtin_amdgcn_s_setprio(0);
    __builtin_amdgcn_sched_barrier(0);
}
template <int K> __device__ __forceinline__ int xcomb_dpp(int a, int b, int lane) {
    const bool hi = (lane >> K) & 1; const int keep = hi ? b : a, send = hi ? a : b; int recv;
    if (K == 0) recv = __builtin_amdgcn_update_dpp(0, send, 0xB1, 0xF, 0xF, true);
    else if (K == 1) recv = __builtin_amdgcn_update_dpp(0, send, 0x4E, 0xF, 0xF, true);
    else { recv = __builtin_amdgcn_update_dpp(0, send, 0x104, 0xF, 0x5, true);
           recv = __builtin_amdgcn_update_dpp(recv, send, 0x114, 0xF, 0xA, true); }
    return keep + recv;
}
__device__ __forceinline__ float peer_dot8(const v2u (&R)[8], const v2u& xhi, const v2u& xlo, int lane) {
    int p[8];
#pragma unroll
    for (int i = 0; i < 8; i += 2) {
        int h0 = __builtin_amdgcn_sdot8((int)R[i].x, (int)xhi.x, 0, false), h1 = __builtin_amdgcn_sdot8((int)R[i + 1].x, (int)xhi.x, 0, false);
        int l0 = __builtin_amdgcn_sdot8((int)R[i].x, (int)xlo.x, 0, false), l1 = __builtin_amdgcn_sdot8((int)R[i + 1].x, (int)xlo.x, 0, false);
        h0 = __builtin_amdgcn_sdot8((int)R[i].y, (int)xhi.y, h0, false); h1 = __builtin_amdgcn_sdot8((int)R[i + 1].y, (int)xhi.y, h1, false);
        l0 = __builtin_amdgcn_sdot8((int)R[i].y, (int)xlo.y, l0, false); l1 = __builtin_amdgcn_sdot8((int)R[i + 1].y, (int)xlo.y, l1, false);
        p[i] = (h0 << 4) + l0; p[i + 1] = (h1 << 4) + l1; __builtin_amdgcn_sched_barrier(0); }
    int q[4];
#pragma unroll
    for (int i = 0; i < 4; ++i) q[i] = xcomb_dpp<0>(p[2 * i], p[2 * i + 1], lane);
    const int r0 = xcomb_dpp<1>(q[0], q[1], lane), r1 = xcomb_dpp<1>(q[2], q[3], lane);
    int v = xcomb_dpp<2>(r0, r1, lane);
    v += __builtin_amdgcn_update_dpp(0, v, 0x128, 0xF, 0xF, true);
    { const auto t = __builtin_amdgcn_permlane16_swap((unsigned)v, (unsigned)v, false, false); v = (int)(t[0] + t[1]); }
    { const auto t = __builtin_amdgcn_permlane32_swap((unsigned)v, (unsigned)v, false, false); v = (int)(t[0] + t[1]); }
    return (float)v;
}
__device__ __forceinline__ void peer_fma8(const v2u (&R)[8], unsigned wvh, int e0, h16x2 (&o)[8]) {
#pragma unroll
    for (int i = 0; i < 8; ++i) { const unsigned wt = (unsigned)__builtin_amdgcn_readlane((int)wvh, e0 + i); const h16x2 w2 = __builtin_bit_cast(h16x2, wt);
        const unsigned w0 = R[i].x, w1 = R[i].y; h16x2 f[8];
        f[0] = __builtin_amdgcn_cvt_scalef32_pk_f16_fp4(w0, 1.0f, 0); f[1] = __builtin_amdgcn_cvt_scalef32_pk_f16_fp4(w0, 1.0f, 1);
        f[2] = __builtin_amdgcn_cvt_scalef32_pk_f16_fp4(w0, 1.0f, 2); f[3] = __builtin_amdgcn_cvt_scalef32_pk_f16_fp4(w0, 1.0f, 3);
        f[4] = __builtin_amdgcn_cvt_scalef32_pk_f16_fp4(w1, 1.0f, 0); f[5] = __builtin_amdgcn_cvt_scalef32_pk_f16_fp4(w1, 1.0f, 1);
        f[6] = __builtin_amdgcn_cvt_scalef32_pk_f16_fp4(w1, 1.0f, 2); f[7] = __builtin_amdgcn_cvt_scalef32_pk_f16_fp4(w1, 1.0f, 3);
#pragma unroll
        for (int k = 0; k < 8; ++k) o[k] = __builtin_elementwise_fma(w2, f[k], o[k]);
        __builtin_amdgcn_sched_barrier(0); }
}
__device__ __forceinline__ void peer_phase(Frame& F, int layer) {
    const bf16* H1 = (const bf16*)(F.ws + WS_H1); bf16* H2 = (bf16*)(F.ws + WS_H2);
    const __amdgpu_buffer_rsrc_t TU = __builtin_amdgcn_make_buffer_rsrc((void*)(F.ws + WS_TABU + (size_t)layer * 16384 * 512), (short)0, 16384 * 512, 0x00020000);
    const __amdgpu_buffer_rsrc_t TV = __builtin_amdgcn_make_buffer_rsrc((void*)(F.ws + WS_TABV + (size_t)layer * 16384 * 512), (short)0, 16384 * 512, 0x00020000);
    const int* IDX = (const int*)(F.ws + WS_IDX); const float* GATE = (const float*)(F.ws + WS_GATE);
    const float* g = F.A->in[4 + F.z] + layer * 1024; const float* bb = F.A->in[5 + F.z] + layer * 1024;
    const int lane = F.lane, gw = F.vcu * NWAVES + F.wave, NGW = F.G * NWAVES;
    v2u B0[8], B1[8], B2[8], B3[8];
    TabCvt TC; { const size_t lo = (size_t)(layer + 1) * 16384 * 1024;
        TC.su = F.A->in[24 + F.z] + lo; TC.sv = F.A->in[25 + F.z] + lo; TC.du = (unsigned char*)(F.ws + WS_TABU) + lo / 2; TC.dv = (unsigned char*)(F.ws + WS_TABV) + lo / 2;
        TC.c = gw; TC.cf = gw; TC.stride = NGW; TC.n = (layer + 1 < DEPTH) ? 2 * 16384 : 0; }
    f32x4 cvA[4], cvB[4];
    int id0 = 0, id1 = 0;
    if (gw < TOK) { id0 = IDX[(size_t)gw * 128 + lane]; id1 = IDX[(size_t)gw * 128 + 64 + lane];
        peer_load8(TU, id0, 0, lane, B0); peer_load8(TU, id0, 8, lane, B1); peer_load8(TU, id0, 16, lane, B2); }
    tabcvt_issue(TC, lane, cvA); tabcvt_issue(TC, lane, cvB);
    for (int t = gw; t < TOK; t += NGW) {
        const int tn = (t + NGW < TOK) ? t + NGW : t;
        const int nid0 = IDX[(size_t)tn * 128 + lane], nid1 = IDX[(size_t)tn * 128 + 64 + lane];
        const float g0 = GATE[(size_t)t * 128 + lane], g1 = GATE[(size_t)t * 128 + 64 + lane];
        const v4u xa = *(const GAS v4u*)(H1 + (size_t)t * DM + 16 * lane), xb = *(const GAS v4u*)(H1 + (size_t)t * DM + 16 * lane + 8);
        f32x2 x[8] = {{bf_lo(xa.x), bf_hi(xa.x)}, {bf_lo(xa.y), bf_hi(xa.y)}, {bf_lo(xa.z), bf_hi(xa.z)}, {bf_lo(xa.w), bf_hi(xa.w)}, {bf_lo(xb.x), bf_hi(xb.x)}, {bf_lo(xb.y), bf_hi(xb.y)}, {bf_lo(xb.z), bf_hi(xb.z)}, {bf_lo(xb.w), bf_hi(xb.w)}};
        v2u xqh = {0u, 0u}, xql = {0u, 0u};
#pragma unroll
        for (int i = 0; i < 16; ++i) { const float xv = (i & 1) ? x[i >> 1].y : x[i >> 1].x;
            float qf = __builtin_fminf(__builtin_fmaxf(xv * 16.f, -120.f), 119.f) + 12582912.0f; asm volatile("" : "+v"(qf)); const unsigned q = __builtin_bit_cast(unsigned, qf);
            const unsigned lo = q & 15u, hi = ((q + 8u) >> 4) & 15u;
            if (i < 8) { xql.x |= lo << (4 * i); xqh.x |= hi << (4 * i); } else { xql.y |= lo << (4 * (i - 8)); xqh.y |= hi << (4 * (i - 8)); } }
#define PEER_LOADB(buf, b) do { const int b_ = (b); if (b_ < 32) peer_load8((b_ & 16) ? TV : TU, (b_ & 8) ? id1 : id0, 8 * (b_ & 7), lane, buf); else peer_load8(TU, nid0, 8 * (b_ & 7), lane, buf); } while (0)
#define PEER_DOTB(buf, b) do { const int b_ = (b); const float r_ = peer_dot8(buf, xqh, xql, lane); const bool mine_ = (lane >> 3) == (b_ & 7); if (b_ & 8) act1 = mine_ ? r_ : act1; else act0 = mine_ ? r_ : act0; } while (0)
#define PEER_FMAB(buf, b) do { const int b_ = (b); peer_fma8(buf, (b_ & 8) ? w1h : w0h, 8 * (b_ & 7), o); } while (0)
        float act0 = 0.f, act1 = 0.f;
#pragma unroll 1
        for (int j = 0; j < 16; j += 4) {
            PEER_LOADB(B3, j + 3); PEER_DOTB(B0, j);
            PEER_LOADB(B0, j + 4); PEER_DOTB(B1, j + 1);
            PEER_LOADB(B1, j + 5); PEER_DOTB(B2, j + 2);
            PEER_LOADB(B2, j + 6); PEER_DOTB(B3, j + 3);
        }
        const float w0 = g0 * gelu_tanh(act0 * (1.0f / (16.f * PEER_SU))) * (1.0f / PEER_SV), w1 = g1 * gelu_tanh(act1 * (1.0f / (16.f * PEER_SU))) * (1.0f / PEER_SV);
        unsigned w0h, w1h; { const _Float16 a = (_Float16)w0, b = (_Float16)w1; const h16x2 pa = {a, a}, pb = {b, b}; w0h = __builtin_bit_cast(unsigned, pa); w1h = __builtin_bit_cast(unsigned, pb); }
        h16x2 o[8];
#pragma unroll
        for (int i = 0; i < 8; ++i) o[i] = (h16x2){(_Float16)0.f, (_Float16)0.f};
#pragma unroll 1
        for (int j = 16; j < 32; j += 4) {
            PEER_LOADB(B3, j + 3); PEER_FMAB(B0, j);
            PEER_LOADB(B0, j + 4); PEER_FMAB(B1, j + 1);
            PEER_LOADB(B1, j + 5); PEER_FMAB(B2, j + 2);
            PEER_LOADB(B2, j + 6); PEER_FMAB(B3, j + 3);
        }
#undef PEER_LOADB
#undef PEER_DOTB
#undef PEER_FMAB
        id0 = nid0; id1 = nid1;
        tabcvt_finish(TC, lane, cvA); tabcvt_finish(TC, lane, cvB);
        tabcvt_issue(TC, lane, cvA); tabcvt_issue(TC, lane, cvB);
        float y[16]; float sm = 0.f;
#pragma unroll
        for (int i = 0; i < 8; ++i) { y[2 * i] = pg8::ALPHA_F * x[i].x + (float)o[i].x; y[2 * i + 1] = pg8::ALPHA_F * x[i].y + (float)o[i].y; sm += y[2 * i] + y[2 * i + 1]; }
        const float mean = wave_sum_dpp(sm) * (1.f / DM); float q = 0.f;
#pragma unroll
        for (int i = 0; i < 16; ++i) { y[i] -= mean; q += y[i] * y[i]; }
        const float rstd = 1.0f / sqrtf(wave_sum_dpp(q) * (1.f / DM) + LN_EPS);
#pragma unroll
        for (int c = 0; c < 4; ++c) { const f32x4 gv = *(const GAS f32x4*)(g + 16 * lane + 4 * c), bv = *(const GAS f32x4*)(bb + 16 * lane + 4 * c);
            y[4 * c] = y[4 * c] * rstd * gv.x + bv.x; y[4 * c + 1] = y[4 * c + 1] * rstd * gv.y + bv.y; y[4 * c + 2] = y[4 * c + 2] * rstd * gv.z + bv.z; y[4 * c + 3] = y[4 * c + 3] * rstd * gv.w + bv.w; }
        v4u oa, ob; oa.x = pk2(y[0], y[1]); oa.y = pk2(y[2], y[3]); oa.z = pk2(y[4], y[5]); oa.w = pk2(y[6], y[7]); ob.x = pk2(y[8], y[9]); ob.y = pk2(y[10], y[11]); ob.z = pk2(y[12], y[13]); ob.w = pk2(y[14], y[15]);
        *(GAS v4u*)(H2 + (size_t)t * DM + 16 * lane) = oa; *(GAS v4u*)(H2 + (size_t)t * DM + 16 * lane + 8) = ob;
        *(GAS v4u*)((unsigned char*)(F.ws + WS_H28) + (size_t)t * DM + 16 * lane) = (v4u){pk4_fp8(y[0], y[1], y[2], y[3]), pk4_fp8(y[4], y[5], y[6], y[7]), pk4_fp8(y[8], y[9], y[10], y[11]), pk4_fp8(y[12], y[13], y[14], y[15])};
    }
    tabcvt_finish(TC, lane, cvA); tabcvt_finish(TC, lane, cvB);
    while (TC.cf < TC.n) { tabcvt_issue(TC, lane, cvA); tabcvt_finish(TC, lane, cvA); }
}

template <class Epi> __device__ __forceinline__ void run_gemm(Frame& F, const bf16* A, const bf16* Bt, int M, int N, int K, const Epi& E, int pw = 0) {
    pg8::Gemm g{A, Bt, M, N, K}; pg8::StaticOrder S; S.init(M, N, F.G, pw ? F.vcu : F.bx); S.pw = pw; if (pw) S.nwg = 1024;
    int t = F.tid; asm volatile("" : "+v"(t));
    pg8::gemm_phase<Epi, pg8::StaticOrder, true, true>(F.lds, g, S, E, t);
}

template <class Epi> __device__ __forceinline__ void run_gemm8(Frame& F, const unsigned char* A8, const unsigned char* Bt8, int M, int N, int Kbytes, const Epi& E) {
    pg8::Gemm g{(const bf16*)A8, (const bf16*)Bt8, M, N, Kbytes / 2 + F.z  }; pg8::StaticOrder S; S.init(M, N, F.G, F.bx);
    int t = F.tid; asm volatile("" : "+v"(t));
    pg8::gemm_phase<Epi, pg8::StaticOrder, true, true, true>(F.lds, g, S, E, t);
}

__global__ void __launch_bounds__(NWAVES * 64, 2) mega_fwd(Args args) {
    extern __shared__ __attribute__((aligned(16))) unsigned char lds[];
    Frame F;
    F.lds = (LAS unsigned char*)lds;
    F.tid = threadIdx.x; F.lane = F.tid & 63; F.wave = 0; F.G = gridDim.x; F.bx = blockIdx.x; F.vcu = 0;
    F.A = &args; F.z = 0; F.out = args.out; F.ws = args.ws;
    const int wave_s = __builtin_amdgcn_readfirstlane((int)threadIdx.x >> 6);
    volatile LAS unsigned* MISC = (volatile LAS unsigned*)(F.lds + MISC_OFF);
    if (F.tid < 64) MISC[F.tid] = 0u;
    __syncthreads();
    XcdBarrier bar; bar.bar = (unsigned*)(F.ws + WS_CTL) + CW_BAR; bar.x = 0; bar.st = nullptr;
    if (args.use_bar) bar = xcd_barrier_post((unsigned*)(F.ws + WS_CTL) + CW_BAR, MISC + 8);

    for (int pc = args.ph_lo; pc < args.ph_hi; ++pc) {
        { int z = 0; asm volatile("" : "+s"(z)); int t = wave_s * 64 + (int)__builtin_amdgcn_mbcnt_hi(~0u, __builtin_amdgcn_mbcnt_lo(~0u, (unsigned)z)); asm volatile("" : "+v"(t));
          F.z = z; F.ws = args.ws + z; F.tid = t; F.lane = t & 63; F.wave = __builtin_amdgcn_readfirstlane(t >> 6);
          F.G = (int)gridDim.x + z; F.bx = (int)blockIdx.x + z; F.vcu = (F.G % 8 == 0) ? (F.bx % 8) * (F.G / 8) + F.bx / 8 : F.bx; }
        bf16* const H = (bf16*)(F.ws + WS_H); bf16* const U = (bf16*)(F.ws + WS_U); bf16* const Y = (bf16*)(F.ws + WS_Y); bf16* const X1 = (bf16*)(F.ws + WS_X1);
        bf16* const H1 = (bf16*)(F.ws + WS_H1); bf16* const H2 = (bf16*)(F.ws + WS_H2); bf16* const KB = (bf16*)(F.ws + WS_KB); bf16* const VT = (bf16*)(F.ws + WS_VT); bf16* const HKV = (bf16*)(F.ws + WS_HKV);
        const int ty = args.ph_type[pc], la = args.ph_arg[pc];
#ifndef PHMASK
#define PHMASK 0xFFFF
#endif
#define EN(x) ((PHMASK >> (x)) & 1)
        switch (ty) {
        case P_PROLOGUE: if (EN(P_PROLOGUE)) p0_prologue(F); break;
        case P_STORE: if (EN(P_STORE)) {
            const int njobs = (la == 0) ? 2 : (la == 2) ? 3 : 1;
            for (int j = 0; j < njobs; ++j) {
                const bf16* A; const bf16* Bt; int M = TOK, N = 1024, K = 1024, ldc = 1024, pw = 0; bf16* O; float sc = 1.0f;
                if (la == 0 && j == 0) { A = (const bf16*)(F.ws + WS_PB); Bt = (const bf16*)(F.ws + WS_W_PW); K = 256; O = (bf16*)(F.ws + WS_PW); pw = 1; }
                else if (la == 0) { A = H; Bt = (const bf16*)(F.ws + WS_W_IN); O = U; }
                else if (la == 1) { A = H; Bt = (const bf16*)(F.ws + WS_W_IN) + (size_t)1024 * 1024; O = U; }
                else if (la == 2 && j == 1) { A = HKV; Bt = (const bf16*)(F.ws + WS_W_KV); O = KB; }
                else if (la == 2 && j == 2) { A = (const bf16*)(F.ws + WS_W_KV) + (size_t)1024 * 1024; Bt = HKV; M = 1024; N = TOK; ldc = TOK; O = VT; }
                else { A = H; Bt = (const bf16*)(F.ws + WS_W_SQ) + (size_t)(la - 2) * 1024 * 1024; O = U; sc = 0.125f * 1.4426950408889634f; }
                if (!pw) {
                    const unsigned char* A8; const unsigned char* B8;
                    if (la <= 1) { A8 = (const unsigned char*)(F.ws + WS_H8); B8 = (const unsigned char*)(F.ws + W8_IN) + (size_t)la * 1024 * 1024; }
                    else if (la == 2 && j == 1) { A8 = (const unsigned char*)(F.ws + WS_HKV); B8 = (const unsigned char*)(F.ws + W8_KV); }
                    else if (la == 2 && j == 2) { A8 = (const unsigned char*)(F.ws + W8_KV) + (size_t)1024 * 1024; B8 = (const unsigned char*)(F.ws + WS_HKV); }
                    else { A8 = (const unsigned char*)(F.ws + WS_H8); B8 = (const unsigned char*)(F.ws + W8_SQ) + (size_t)(la - 2) * 1024 * 1024; }
                    pg8::EpiStore E{O, ldc, sc * (1.0f / W8_SCALE), -1};
                    run_gemm8(F, A8, B8, M, N, 1024, E);
                } else {
                    pg8::EpiStore E{O, ldc, sc, pw ? 3 : -1};
                    run_gemm(F, A, Bt, M, N, K, E, pw);
                }
            }
        } break;
        case P_SSM: if (EN(P_SSM)) ssm_phase(F, la); break;
        case P_GLU: if (EN(P_GLU)) { pg8::EpiGlu E{H, X1}; run_gemm8(F, (const unsigned char*)Y, (const unsigned char*)(F.ws + W8_GLU) + (size_t)la * 2048 * 1024, TOK, 2048, 1024, E); } break;
        case P_LNMIX: if (EN(P_LNMIX)) ln_rows(F, X1, F.A->in[2 + F.z] + la * 1024, F.A->in[3 + F.z] + la * 1024, H1, (unsigned char*)(F.ws + WS_H18)); break;
        case P_TOPK: if (EN(P_TOPK)) {
            pg8::EpiTopk E{(int*)(F.ws + WS_IDX), (float*)(F.ws + WS_GATE)};
            pg8::Gemm g{(const bf16*)(F.ws + WS_H18), (const bf16*)((const unsigned char*)(F.ws + W8_EFF) + (size_t)la * 2048 * 1024), TOK, 2048, 512 + F.z};
            for (int r = 0; r < 2; ++r) { pg8::OneUnitOrder S; S.base.init(TOK, 2048, F.G, F.bx); S.round = r;
                int t = F.tid; asm volatile("" : "+v"(t)); pg8::gemm_phase<pg8::EpiTopk, pg8::OneUnitOrder, false, true, true>(F.lds, g, S, E, t); }
        } break;
        case P_PEER: if (EN(P_PEER)) peer_phase(F, la); break;
        case P_PLE: if (EN(P_PLE)) { pg8::EpiPle E{H2, (const unsigned char*)(F.ws + WS_PW) + (size_t)la * TOK * 1024, H, (la == DEPTH - 1) ? F.out : nullptr, (unsigned char*)(F.ws + WS_H8)};
            run_gemm8(F, (const unsigned char*)(F.ws + WS_H28), (const unsigned char*)(F.ws + W8_PG) + (size_t)la * 1024 * 1024, TOK, 1024, 1024, E); } break;
        case P_LNKV: if (EN(P_LNKV)) ln_rows(F, H, F.A->in[16 + F.z], F.A->in[17 + F.z], nullptr, (unsigned char*)HKV); break;
        case P_ATTN: if (EN(P_ATTN)) attn_phase(F); break;
        case P_RES: if (EN(P_RES)) { pg8::EpiRes E{H, X1}; run_gemm8(F, (const unsigned char*)Y, (const unsigned char*)(F.ws + W8_SO) + (size_t)(la - 2) * 1024 * 1024, TOK, 1024, 1024, E); } break;
        default: break;
        }
        if (pc + 1 < args.ph_hi) xcd_barrier(bar);
    }
}

#ifndef N_LAUNCH_MODE
#define N_LAUNCH_MODE 1
#endif
extern "C" void kernel_launch(void* const* d_in, const int* in_sizes, int n_in, void* d_out, int out_size, void* d_ws, size_t ws_size, hipStream_t stream) {
    static int grid = 0;
    if (grid == 0) {
        if (n_in != 28 || out_size != TOK * DM || ws_size < WS_END) { fprintf(stderr, "kernel_launch: unexpected shapes/workspace (n_in %d, out %d, ws %zu)\n", n_in, out_size, ws_size); grid = -1; return; }
        int dev = 0, cus = 0;
        if (hipGetDevice(&dev) != hipSuccess || hipDeviceGetAttribute(&cus, hipDeviceAttributeMultiprocessorCount, dev) != hipSuccess) { grid = -1; return; }
        if (hipFuncSetAttribute((const void*)mega_fwd, hipFuncAttributeMaxDynamicSharedMemorySize, LDS_BYTES) != hipSuccess) { fprintf(stderr, "kernel_launch: hipFuncSetAttribute failed\n"); grid = -1; return; }
        (void)hipGetLastError();
        grid = cus;
    }
    if (grid < 0) return;
    hipMemsetAsync((char*)d_ws + WS_CTL, 0, CTL_ZERO_BYTES, stream);
    Args a{};
    for (int i = 0; i < 28; ++i) a.in[i] = (const float*)d_in[i];
    a.out = (float*)d_out; a.ws = (unsigned char*)d_ws;
    int n = 0;
#ifndef REP_TYPE
#define REP_TYPE -1
#endif
    auto add = [&](int t, int l) { for (int r = 0; r < ((t == REP_TYPE) ? 2 : 1); ++r) { a.ph_type[n] = (unsigned char)t; a.ph_arg[n] = (unsigned char)l; ++n; } };
    add(P_PROLOGUE, 0); add(P_STORE, 0);
    for (int l = 0; l < DEPTH; ++l) {
        if (l < 2) { if (l == 1) add(P_STORE, 1); add(P_SSM, l); add(P_GLU, l); }
        else { if (l == 2) add(P_LNKV, 0); add(P_STORE, l); add(P_ATTN, l); add(P_RES, l); }
        add(P_LNMIX, l); add(P_TOPK, l); add(P_PEER, l); add(P_PLE, l);
    }
    a.nph = n;
    if (N_LAUNCH_MODE == 1) {
        a.ph_lo = 0; a.ph_hi = n; a.use_bar = 1;
        hipLaunchKernelGGL(mega_fwd, dim3(grid), dim3(NWAVES * 64), LDS_BYTES, stream, a);
    } else {
        a.use_bar = 0;
        for (int i = 0; i < n; ++i) { a.ph_lo = i; a.ph_hi = i + 1; hipLaunchKernelGGL(mega_fwd, dim3(grid), dim3(NWAVES * 64), LDS_BYTES, stream, a); }
    }
}
```

```cpp
#include <hip/hip_runtime.h>
#include <cstdio>
#include <cstdint>
#include <cmath>
namespace pg8 {
#define PG8_LAS __attribute__((address_space(3)))
typedef unsigned short bf16_t;
typedef short bf16x8 __attribute__((ext_vector_type(8)));
typedef float f32x4 __attribute__((ext_vector_type(4)));
typedef unsigned u32x4 __attribute__((ext_vector_type(4)));
constexpr int BM = 256, BK = 64, HALF = 128, HTB = HALF * BK * 2  , STAGE_BYTES = 8 * HTB, NXCD = 8, WGM = 8;

__host__ __device__ __forceinline__ int lds_byte(int r, int c) { const int st = (r >> 4) * 2 + (c >> 5), rr = r & 15, cc = c & 31, ob = rr * 64 + cc * 2; return st * 1024 + (ob ^ (((ob >> 9) & 1) << 5)); }
__host__ __device__ __forceinline__ void stage_rc(int b, int& R, int& C) { const int st = b / 1024, sb = b % 1024, swz = sb ^ (((sb >> 9) & 1) << 5); R = (st >> 1) * 16 + swz / 64; C = (st & 1) * 32 + (swz % 64) / 2; }
__host__ __device__ __forceinline__ int perm32(int rho) { const int n = rho >> 4, i = rho & 15; return 8 * (i >> 2) + 4 * n + (i & 3); }

struct Unit { int pm, pn; };
struct Gemm { const bf16_t* A; const bf16_t* Bt; int M, N, K; };

struct StaticOrder {
    int nM, nN, nwg, G, c;
    __host__ __device__ void init(int M, int N, int G_, int c_) { nM = M / BM; nN = N / BM; nwg = nM * nN; G = G_; c = c_; pw = 0; }
    int pw;
    __host__ __device__ bool next(int i, Unit& u) const {
        const long L = (long)i * G + c; if (L >= nwg) return false;
        if (pw) { const int l = (int)L >> 8, rem = (int)L & 255; u.pm = l * 64 + (rem >> 2); u.pn = l * 4 + (rem & 3); return true; }
        int wgid = (int)L; { const int q = nwg / NXCD, r = nwg % NXCD, xcd = wgid % NXCD, off = wgid / NXCD; wgid = (xcd < r ? xcd * (q + 1) : r * (q + 1) + (xcd - r) * q) + off; }
        const int nig = WGM * nN, gid = wgid / nig, fm = gid * WGM, gsz = (nM - fm) < WGM ? (nM - fm) : WGM;
        u.pm = fm + ((wgid % nig) % gsz); u.pn = (wgid % nig) / gsz; return true;
    }
    __device__ __forceinline__ void a_ready(const Unit&) const {}
    __device__ __forceinline__ void done(const Unit&) const {}
};

typedef float f32x2c_t __attribute__((ext_vector_type(2))); typedef __bf16 bf16x2c_t __attribute__((ext_vector_type(2)));
__device__ __forceinline__ unsigned cvt_pk_bf16(float lo, float hi) { f32x2c_t v = {lo, hi}; bf16x2c_t b = __builtin_convertvector(v, bf16x2c_t); return __builtin_bit_cast(unsigned, b); }
typedef float f32x2 __attribute__((ext_vector_type(2)));
typedef int v8i32_t __attribute__((ext_vector_type(8)));
typedef unsigned u32x8_t __attribute__((ext_vector_type(8)));
template <bool F8> struct Frag { bf16x8 k[2]; };
template <> struct Frag<true> { v8i32_t v; };
template <class Epi, class Sched, bool ALIGN_EPI = false, bool SP2 = false, bool F8 = false>
__device__ __forceinline__ void gemm_phase(PG8_LAS unsigned char* lds, const Gemm g, const Sched& S, const Epi& E, const int tid) {
    const int wid = __builtin_amdgcn_readfirstlane(tid >> 6), lane = tid & 63, wr = wid >> 2, wc = wid & 3, fr = lane & 15, fq = lane >> 4;
    const int K = g.K, nt = K / BK;
    unsigned voffA[1], voffB[1];
    { int R, C; stage_rc(tid * 16, R, C); const int Rb = Epi::PERM ? ((R & ~31) + perm32(R & 31)) : R;
        voffA[0] = (unsigned)(R * K + C) * 2u; voffB[0] = (unsigned)(Rb * K + C) * 2u; }
    const size_t r64 = (size_t)128 * K;
    const size_t kstep = (size_t)(BK * 2);
    const size_t hstep = (size_t)HALF * K * 2;
    const size_t tstep = 2 * hstep;
    const unsigned ldsw = (unsigned)wid * 1024u;
    const int aoff = lds_byte(wr * 64 + fr, F8 ? fq * 16 : fq * 8), boff = lds_byte(wc * 32 + fr, F8 ? fq * 16 : fq * 8);
#define PG8_SA(b, h) (((b) * 2 + (h)) * HTB)
#define PG8_SB(b, h) ((4 + (b) * 2 + (h)) * HTB)
#define PG8_STAGE(bufoff, gbase, voff) do { _Pragma("unroll") for (int _i = 0; _i < 2; ++_i) \
        __builtin_amdgcn_global_load_lds((const unsigned*)((const char*)(gbase) + _i * r64 + (voff)[0]), (PG8_LAS unsigned*)(lds + (bufoff) + ldsw + _i * 8192), 16, 0, 0); } while (0)
#define PG8_LDF(d, addr) do { if constexpr (F8) { const u32x4 lo_ = *(const PG8_LAS u32x4*)(addr), hi_ = *(const PG8_LAS u32x4*)((addr) + 16); d.v = __builtin_bit_cast(v8i32_t, (u32x8_t){lo_[0], lo_[1], lo_[2], lo_[3], hi_[0], hi_[1], hi_[2], hi_[3]}); } \
        else { d.k[0] = *(const PG8_LAS bf16x8*)(addr); d.k[1] = *(const PG8_LAS bf16x8*)((addr) + 1024); } } while (0)
#define PG8_LDA(dst, b, h) do { _Pragma("unroll") for (int m = 0; m < 4; ++m) PG8_LDF(dst[m], lds + PG8_SA(b, h) + aoff + m * 2048); } while (0)
#define PG8_LDB(dst, b, h) do { _Pragma("unroll") for (int n = 0; n < 2; ++n) PG8_LDF(dst[n], lds + PG8_SB(b, h) + boff + n * 2048); } while (0)
#define PG8_MMA(ai, bj, At, Bt) do { __builtin_amdgcn_s_setprio(1); _Pragma("unroll") for (int m = 0; m < 4; ++m) _Pragma("unroll") for (int n = 0; n < 2; ++n) { \
        if constexpr (F8) asm volatile("v_mfma_f32_16x16x128_f8f6f4 %0, %1, %2, %0" : "+v"(acc[ai][bj][m][n]) : "v"(Bt[n].v), "v"(At[m].v));   \
        else { _Pragma("unroll") for (int k = 0; k < 2; ++k) acc[ai][bj][m][n] = __builtin_amdgcn_mfma_f32_16x16x32_bf16(Bt[n].k[k], At[m].k[k], acc[ai][bj][m][n], 0, 0, 0); } } __builtin_amdgcn_s_setprio(0); } while (0)
#define PG8_WAIT_V(n) asm volatile("s_waitcnt vmcnt(" #n ")" ::: "memory")
#define PG8_WAIT_L(n) asm volatile("s_waitcnt lgkmcnt(" #n ")" ::: "memory")
#define PG8_BAR __builtin_amdgcn_s_barrier()
#define PG8_SCHED __builtin_amdgcn_sched_barrier(0)
    Unit cur, nxt; int ui = 0;
    if (!S.next(0, cur)) return;
    f32x4 acc[2][2][4][2];
#pragma unroll
    for (int a = 0; a < 2; ++a)
#pragma unroll
        for (int b = 0; b < 2; ++b)
#pragma unroll
            for (int m = 0; m < 4; ++m)
#pragma unroll
                for (int n = 0; n < 2; ++n) acc[a][b][m][n] = (f32x4){0.f, 0.f, 0.f, 0.f};
    Frag<F8> At[4], B0[2], B1[2];
    const char* cA = (const char*)g.A + (size_t)cur.pm * tstep; const char* cB = (const char*)g.Bt + (size_t)cur.pn * tstep;
    S.a_ready(cur);
    if constexpr (SP2) {
        PG8_STAGE(PG8_SB(0, 0), cB, voffB); PG8_STAGE(PG8_SB(0, 1), cB + hstep, voffB); PG8_STAGE(PG8_SA(0, 0), cA, voffA); PG8_STAGE(PG8_SA(0, 1), cA + hstep, voffA);
        if (wr == 1) PG8_BAR;
        PG8_WAIT_V(2); PG8_BAR;
        PG8_STAGE(PG8_SB(1, 0), cB + kstep, voffB); PG8_STAGE(PG8_SA(1, 0), cA + kstep, voffA); PG8_STAGE(PG8_SB(1, 1), cB + hstep + kstep, voffB);
        PG8_WAIT_V(6); PG8_BAR;
    } else {
        PG8_STAGE(PG8_SB(0, 0), cB, voffB); PG8_STAGE(PG8_SA(0, 0), cA, voffA); PG8_STAGE(PG8_SB(0, 1), cB + hstep, voffB); PG8_STAGE(PG8_SA(0, 1), cA + hstep, voffA);
        if (wr == 1) PG8_BAR;
        PG8_WAIT_V(4); PG8_BAR;
        PG8_STAGE(PG8_SB(1, 0), cB + kstep, voffB); PG8_STAGE(PG8_SA(1, 0), cA + kstep, voffA); PG8_STAGE(PG8_SB(1, 1), cB + hstep + kstep, voffB);
        PG8_WAIT_V(6); PG8_BAR;
    }
    for (;;) {
        const bool has_next = S.next(ui + 1, nxt);
        const char* nA = has_next ? (const char*)g.A + (size_t)nxt.pm * tstep : cA; const char* nB = has_next ? (const char*)g.Bt + (size_t)nxt.pn * tstep : cB;
#pragma unroll 1
        for (int t = 0; t < nt; t += 2) {
            const bool last = (t == nt - 2);
            const char* a1 = cA + (size_t)(t + 1) * kstep;
            const char* a2 = last ? nA : cA + (size_t)(t + 2) * kstep; const char* b2 = last ? nB : cB + (size_t)(t + 2) * kstep;
            const char* a3 = a2 + kstep; const char* b3 = b2 + kstep;
            if (last && has_next) S.a_ready(nxt);
            if constexpr (SP2) {
            PG8_LDB(B0, 0, 0); PG8_LDB(B1, 0, 1); PG8_SCHED; PG8_LDA(At, 0, 0); PG8_STAGE(PG8_SA(1, 1), a1 + hstep, voffA);
            PG8_WAIT_V(8); PG8_WAIT_L(0); PG8_BAR; PG8_MMA(0, 0, At, B0); PG8_MMA(0, 1, At, B1); PG8_BAR; PG8_SCHED;
            PG8_LDA(At, 0, 1); PG8_STAGE(PG8_SB(0, 0), b2, voffB); PG8_STAGE(PG8_SB(0, 1), b2 + hstep, voffB); PG8_STAGE(PG8_SA(0, 0), a2, voffA);
            PG8_WAIT_V(8); PG8_WAIT_L(0); PG8_BAR; PG8_MMA(1, 0, At, B0); PG8_MMA(1, 1, At, B1); PG8_BAR; PG8_SCHED;
            PG8_LDB(B0, 1, 0); PG8_LDB(B1, 1, 1); PG8_SCHED; PG8_LDA(At, 1, 0); PG8_STAGE(PG8_SA(0, 1), a2 + hstep, voffA);
            PG8_WAIT_V(8); PG8_WAIT_L(0); PG8_BAR; PG8_MMA(0, 0, At, B0); PG8_MMA(0, 1, At, B1); PG8_BAR; PG8_SCHED;
            PG8_LDA(At, 1, 1); PG8_STAGE(PG8_SB(1, 0), b3, voffB); PG8_STAGE(PG8_SB(1, 1), b3 + hstep, voffB); PG8_STAGE(PG8_SA(1, 0), a3, voffA);
            PG8_WAIT_V(8); PG8_WAIT_L(0); PG8_BAR; PG8_MMA(1, 0, At, B0); PG8_MMA(1, 1, At, B1); PG8_BAR; PG8_SCHED;
            } else {
            PG8_LDB(B0, 0, 0); PG8_SCHED; PG8_LDA(At, 0, 0); PG8_STAGE(PG8_SA(1, 1), a1 + hstep, voffA);
            PG8_WAIT_L(8); PG8_BAR; PG8_WAIT_L(0); PG8_MMA(0, 0, At, B0); PG8_BAR; PG8_SCHED;
            PG8_LDB(B1, 0, 1); PG8_STAGE(PG8_SB(0, 0), b2, voffB);
            PG8_BAR; PG8_WAIT_L(0); PG8_MMA(0, 1, At, B1); PG8_BAR;
            PG8_LDA(At, 0, 1); PG8_STAGE(PG8_SA(0, 0), a2, voffA);
            PG8_BAR; PG8_WAIT_L(0); PG8_MMA(1, 0, At, B0); PG8_BAR; PG8_SCHED;
            PG8_STAGE(PG8_SB(0, 1), b2 + hstep, voffB);
            PG8_WAIT_V(6); PG8_BAR; PG8_MMA(1, 1, At, B1); PG8_BAR;
            PG8_LDB(B0, 1, 0); PG8_SCHED; PG8_LDA(At, 1, 0); PG8_STAGE(PG8_SA(0, 1), a2 + hstep, voffA);
            PG8_WAIT_L(8); PG8_BAR; PG8_WAIT_L(0); PG8_MMA(0, 0, At, B0); PG8_BAR; PG8_SCHED;
            PG8_LDB(B1, 1, 1); PG8_STAGE(PG8_SB(1, 0), b3, voffB);
            PG8_BAR; PG8_WAIT_L(0); PG8_MMA(0, 1, At, B1); PG8_BAR;
            PG8_LDA(At, 1, 1); PG8_STAGE(PG8_SA(1, 0), a3, voffA);
            PG8_BAR; PG8_WAIT_L(0); PG8_MMA(1, 0, At, B0); PG8_BAR; PG8_SCHED;
            PG8_STAGE(PG8_SB(1, 1), b3 + hstep, voffB);
            PG8_WAIT_V(6); PG8_BAR; PG8_MMA(1, 1, At, B1); PG8_BAR;
            }
        }
        if constexpr (F8) asm volatile("s_nop 15\n\ts_nop 15" ::: "memory");
        if constexpr (ALIGN_EPI) { if (wr == 0) PG8_BAR; }
        if constexpr (!Epi::AFTER_DRAIN) { E(acc, cur, wr, wc, fr, fq); S.done(cur); }
        if (!has_next) break;
#pragma unroll
        for (int a = 0; a < 2; ++a)
#pragma unroll
            for (int b = 0; b < 2; ++b)
#pragma unroll
                for (int m = 0; m < 4; ++m)
#pragma unroll
                    for (int n = 0; n < 2; ++n) acc[a][b][m][n] = (f32x4){0.f, 0.f, 0.f, 0.f};
        cur = nxt; cA = nA; cB = nB; ++ui;
        if constexpr (ALIGN_EPI) { if (wr == 1) PG8_BAR; }
    }
    PG8_WAIT_V(0);
    if constexpr (!ALIGN_EPI) { if (wr == 0) PG8_BAR; }
    PG8_BAR;
    if constexpr (Epi::AFTER_DRAIN) { E.fused(acc, cur, wr, wc, fr, fq, lds, wid, lane); S.done(cur); }
#undef PG8_SA
#undef PG8_SB
#undef PG8_STAGE
#undef PG8_LDA
#undef PG8_LDB
#undef PG8_MMA
#undef PG8_LDF
#undef PG8_WAIT_V
#undef PG8_WAIT_L
#undef PG8_BAR
#undef PG8_SCHED
}
}
namespace pg8 {
__device__ __forceinline__ float bf_lo(unsigned w) { return __uint_as_float(w << 16); }
__device__ __forceinline__ float bf_hi(unsigned w) { return __uint_as_float(w & 0xffff0000u); }
__device__ __forceinline__ float fast_sigmoid(float x) { return __builtin_amdgcn_rcpf(1.0f + __builtin_amdgcn_exp2f(-1.4426950408889634f * x)); }
__device__ __forceinline__ float gelu_tanh(float x) { const float t = x * (1.5957691216057308f + 0.07135481627260025f * x * x); return x * __builtin_amdgcn_rcpf(1.0f + __builtin_amdgcn_exp2f(-1.4426950408889634f * t)); }
constexpr float ALPHA_F = 1.681792830507429f;
constexpr float WSC = 1.0f / 32.0f;

struct EpiStore {
    static constexpr bool PERM = true, AFTER_DRAIN = false;
    bf16_t* O; int ldc; float scale; int pnmask; int f8out;
    __device__ __forceinline__ void operator()(const f32x4 (&acc)[2][2][4][2], const Unit& u, int wr, int wc, int fr, int fq) const {
        const int row0 = u.pm * BM + wr * 64 + fr, col0 = (u.pn & pnmask) * BM + wc * 32 + 8 * fq;
#pragma unroll
        for (int ai = 0; ai < 2; ++ai)
#pragma unroll
            for (int m = 0; m < 4; ++m) { bf16_t* rowp = O + (size_t)(row0 + ai * HALF + m * 16) * ldc + col0;
#pragma unroll
                for (int bj = 0; bj < 2; ++bj) { const f32x4 v0 = acc[ai][bj][m][0] * scale, v1 = acc[ai][bj][m][1] * scale;
                    if (f8out) {
                        int w0 = 0, w1 = 0; w0 = __builtin_amdgcn_cvt_pk_fp8_f32(v0[0], v0[1], w0, false); w0 = __builtin_amdgcn_cvt_pk_fp8_f32(v0[2], v0[3], w0, true);
                        w1 = __builtin_amdgcn_cvt_pk_fp8_f32(v1[0], v1[1], w1, false); w1 = __builtin_amdgcn_cvt_pk_fp8_f32(v1[2], v1[3], w1, true);
                        *(unsigned long long*)((unsigned char*)O + (size_t)(row0 + ai * HALF + m * 16) * ldc + col0 + bj * HALF) = (unsigned long long)(unsigned)w0 | ((unsigned long long)(unsigned)w1 << 32);
                    } else {
                    u32x4 w; w.x = cvt_pk_bf16(v0[0], v0[1]); w.y = cvt_pk_bf16(v0[2], v0[3]); w.z = cvt_pk_bf16(v1[0], v1[1]); w.w = cvt_pk_bf16(v1[2], v1[3]);
                    *(u32x4*)(rowp + bj * HALF) = w; } } }
    }
};
struct EpiGlu {
    static constexpr bool PERM = true, AFTER_DRAIN = false;
    const bf16_t* Hin; bf16_t* X1;
    __device__ __forceinline__ void operator()(const f32x4 (&acc)[2][2][4][2], const Unit& u, int wr, int wc, int fr, int fq) const {
        const int row0 = u.pm * BM + wr * 64 + fr, col0 = u.pn * HALF + wc * 32 + 8 * fq;
        u32x4 hvv[2][4];
#pragma unroll
        for (int ai = 0; ai < 2; ++ai)
#pragma unroll
            for (int m = 0; m < 4; ++m) hvv[ai][m] = *(const u32x4*)(Hin + (size_t)(row0 + ai * HALF + m * 16) * 1024 + col0);
#pragma unroll
        for (int ai = 0; ai < 2; ++ai)
#pragma unroll
            for (int m = 0; m < 4; ++m) { const size_t off = (size_t)(row0 + ai * HALF + m * 16) * 1024 + col0;
                const u32x4 hv = hvv[ai][m];
                const f32x4 v0 = acc[ai][0][m][0] * WSC, v1 = acc[ai][0][m][1] * WSC, g0 = acc[ai][1][m][0] * WSC, g1 = acc[ai][1][m][1] * WSC;
                float o[8];
                o[0] = ALPHA_F * bf_lo(hv.x) + v0[0] * fast_sigmoid(g0[0]); o[1] = ALPHA_F * bf_hi(hv.x) + v0[1] * fast_sigmoid(g0[1]);
                o[2] = ALPHA_F * bf_lo(hv.y) + v0[2] * fast_sigmoid(g0[2]); o[3] = ALPHA_F * bf_hi(hv.y) + v0[3] * fast_sigmoid(g0[3]);
                o[4] = ALPHA_F * bf_lo(hv.z) + v1[0] * fast_sigmoid(g1[0]); o[5] = ALPHA_F * bf_hi(hv.z) + v1[1] * fast_sigmoid(g1[1]);
                o[6] = ALPHA_F * bf_lo(hv.w) + v1[2] * fast_sigmoid(g1[2]); o[7] = ALPHA_F * bf_hi(hv.w) + v1[3] * fast_sigmoid(g1[3]);
                u32x4 w; w.x = cvt_pk_bf16(o[0], o[1]); w.y = cvt_pk_bf16(o[2], o[3]); w.z = cvt_pk_bf16(o[4], o[5]); w.w = cvt_pk_bf16(o[6], o[7]);
                *(u32x4*)(X1 + off) = w; }
    }
};
struct EpiRes {
    static constexpr bool PERM = true, AFTER_DRAIN = false;
    const bf16_t* Hin; bf16_t* X1;
    __device__ __forceinline__ void operator()(const f32x4 (&acc)[2][2][4][2], const Unit& u, int wr, int wc, int fr, int fq) const {
        const int row0 = u.pm * BM + wr * 64 + fr, col0 = u.pn * BM + wc * 32 + 8 * fq;
        u32x4 hvv[2][4][2];
#pragma unroll
        for (int ai = 0; ai < 2; ++ai)
#pragma unroll
            for (int m = 0; m < 4; ++m)
#pragma unroll
                for (int bj = 0; bj < 2; ++bj) hvv[ai][m][bj] = *(const u32x4*)(Hin + (size_t)(row0 + ai * HALF + m * 16) * 1024 + col0 + bj * HALF);
#pragma unroll
        for (int ai = 0; ai < 2; ++ai)
#pragma unroll
            for (int m = 0; m < 4; ++m)
#pragma unroll
                for (int bj = 0; bj < 2; ++bj) { const size_t off = (size_t)(row0 + ai * HALF + m * 16) * 1024 + col0 + bj * HALF;
                    const u32x4 hv = hvv[ai][m][bj]; const f32x4 v0 = acc[ai][bj][m][0] * WSC, v1 = acc[ai][bj][m][1] * WSC;
                    u32x4 w; w.x = cvt_pk_bf16(ALPHA_F * bf_lo(hv.x) + v0[0], ALPHA_F * bf_hi(hv.x) + v0[1]); w.y = cvt_pk_bf16(ALPHA_F * bf_lo(hv.y) + v0[2], ALPHA_F * bf_hi(hv.y) + v0[3]);
                    w.z = cvt_pk_bf16(ALPHA_F * bf_lo(hv.z) + v1[0], ALPHA_F * bf_hi(hv.z) + v1[1]); w.w = cvt_pk_bf16(ALPHA_F * bf_lo(hv.w) + v1[2], ALPHA_F * bf_hi(hv.w) + v1[3]);
                    *(u32x4*)(X1 + off) = w; }
    }
};
struct EpiPle {
    static constexpr bool PERM = true, AFTER_DRAIN = false;
    const bf16_t* H2; const unsigned char* PW; bf16_t* Hout; float* Fout; unsigned char* H8out;
    __device__ __forceinline__ void operator()(const f32x4 (&acc)[2][2][4][2], const Unit& u, int wr, int wc, int fr, int fq) const {
        const int row0 = u.pm * BM + wr * 64 + fr, col0 = u.pn * BM + wc * 32 + 8 * fq;
#pragma unroll
        for (int ai = 0; ai < 2; ++ai) {
            u32x4 hvv[4][2]; unsigned long long pvv[4][2];
#pragma unroll
            for (int m = 0; m < 4; ++m)
#pragma unroll
                for (int bj = 0; bj < 2; ++bj) { const size_t off = (size_t)(row0 + ai * HALF + m * 16) * 1024 + col0 + bj * HALF; hvv[m][bj] = *(const u32x4*)(H2 + off); pvv[m][bj] = *(const unsigned long long*)(PW + off); }
#pragma unroll
            for (int m = 0; m < 4; ++m)
#pragma unroll
                for (int bj = 0; bj < 2; ++bj) { const size_t off = (size_t)(row0 + ai * HALF + m * 16) * 1024 + col0 + bj * HALF;
                    const u32x4 hv = hvv[m][bj]; const int pl = (int)(unsigned)pvv[m][bj], ph = (int)(unsigned)(pvv[m][bj] >> 32); const f32x4 v0 = acc[ai][bj][m][0] * WSC, v1 = acc[ai][bj][m][1] * WSC;
                    const auto p01 = __builtin_amdgcn_cvt_pk_f32_fp8(pl, false), p23 = __builtin_amdgcn_cvt_pk_f32_fp8(pl, true), p45 = __builtin_amdgcn_cvt_pk_f32_fp8(ph, false), p67 = __builtin_amdgcn_cvt_pk_f32_fp8(ph, true);
                    float o[8];
                    o[0] = bf_lo(hv.x) + fast_sigmoid(v0[0]) * p01[0]; o[1] = bf_hi(hv.x) + fast_sigmoid(v0[1]) * p01[1];
                    o[2] = bf_lo(hv.y) + fast_sigmoid(v0[2]) * p23[0]; o[3] = bf_hi(hv.y) + fast_sigmoid(v0[3]) * p23[1];
                    o[4] = bf_lo(hv.z) + fast_sigmoid(v1[0]) * p45[0]; o[5] = bf_hi(hv.z) + fast_sigmoid(v1[1]) * p45[1];
                    o[6] = bf_lo(hv.w) + fast_sigmoid(v1[2]) * p67[0]; o[7] = bf_hi(hv.w) + fast_sigmoid(v1[3]) * p67[1];
                    if (Fout) { *(f32x4*)(Fout + off) = (f32x4){o[0], o[1], o[2], o[3]}; *(f32x4*)(Fout + off + 4) = (f32x4){o[4], o[5], o[6], o[7]}; }
                    else { u32x4 w; w.x = cvt_pk_bf16(o[0], o[1]); w.y = cvt_pk_bf16(o[2], o[3]); w.z = cvt_pk_bf16(o[4], o[5]); w.w = cvt_pk_bf16(o[6], o[7]); *(u32x4*)(Hout + off) = w;
                        int w0 = 0, w1 = 0; w0 = __builtin_amdgcn_cvt_pk_fp8_f32(o[0], o[1], w0, false); w0 = __builtin_amdgcn_cvt_pk_fp8_f32(o[2], o[3], w0, true); w1 = __builtin_amdgcn_cvt_pk_fp8_f32(o[4], o[5], w1, false); w1 = __builtin_amdgcn_cvt_pk_fp8_f32(o[6], o[7], w1, true);
                        *(unsigned long long*)(H8out + off) = (unsigned long long)(unsigned)w0 | ((unsigned long long)(unsigned)w1 << 32); } }
        }
    }
};

__device__ __forceinline__ int imax_(int a, int b) { return a > b ? a : b; }
__device__ __forceinline__ int imin_(int a, int b) { return a < b ? a : b; }
__device__ __forceinline__ float csum(float a, float b) { float s = a + b; asm volatile("" : "+v"(s)); return s; }
__device__ __forceinline__ int f2key(float v) { int s = __float_as_int(v); return s ^ ((s >> 31) & 0x7fffffff); }
__device__ __forceinline__ float key2f(int k) { return __int_as_float(k ^ ((k >> 31) & 0x7fffffff)); }
template <bool DESC> __device__ __forceinline__ void bitonic_sort16(int (&x)[16]) {
#pragma unroll
    for (int k = 2; k <= 16; k <<= 1)
#pragma unroll
        for (int j = k >> 1; j > 0; j >>= 1)
#pragma unroll
            for (int i = 0; i < 16; ++i) { const int l = i ^ j; if (l > i) { const bool up = ((i & k) == 0) || (k == 16); const bool asc = DESC ? !up : up;
                const int lo = imin_(x[i], x[l]), hi = imax_(x[i], x[l]); x[i] = asc ? lo : hi; x[l] = asc ? hi : lo; } }
}
__device__ __forceinline__ void bitonic_merge_desc16(int (&x)[16]) {
#pragma unroll
    for (int j = 8; j > 0; j >>= 1)
#pragma unroll
        for (int i = 0; i < 16; ++i) { const int l = i ^ j; if (l > i) { const int lo = imin_(x[i], x[l]), hi = imax_(x[i], x[l]); x[i] = hi; x[l] = lo; } }
}
__device__ __forceinline__ void topk_absorb16(int (&L)[16], int (&N)[16]) {
    bitonic_sort16<false>(N);
#pragma unroll
    for (int i = 0; i < 16; ++i) L[i] = imax_(L[i], N[i]);
    bitonic_merge_desc16(L);
}
__device__ __forceinline__ void topk_insert1(int (&L)[16], int v) {
#pragma unroll
    for (int i = 0; i < 16; ++i) { const int hi = imax_(L[i], v); v = imin_(L[i], v); L[i] = hi; }
}

template <bool DESC> __device__ __forceinline__ void bitonic_sort16f(float (&x)[16]) {
#pragma unroll
    for (int k = 2; k <= 16; k <<= 1)
#pragma unroll
        for (int j = k >> 1; j > 0; j >>= 1)
#pragma unroll
            for (int i = 0; i < 16; ++i) { const int l = i ^ j; if (l > i) { const bool up = ((i & k) == 0) || (k == 16); const bool asc = DESC ? !up : up;
                const float lo = __builtin_fminf(x[i], x[l]), hi = __builtin_fmaxf(x[i], x[l]); x[i] = asc ? lo : hi; x[l] = asc ? hi : lo; } }
}
__device__ __forceinline__ void bitonic_merge_desc16f(float (&x)[16]) {
#pragma unroll
    for (int j = 8; j > 0; j >>= 1)
#pragma unroll
        for (int i = 0; i < 16; ++i) { const int l = i ^ j; if (l > i) { const float lo = __builtin_fminf(x[i], x[l]), hi = __builtin_fmaxf(x[i], x[l]); x[i] = hi; x[l] = lo; } }
}
__device__ __forceinline__ void topk_absorb16f(float (&L)[16], float (&N)[16]) {
    bitonic_sort16f<false>(N);
#pragma unroll
    for (int i = 0; i < 16; ++i) L[i] = __builtin_fmaxf(L[i], N[i]);
    bitonic_merge_desc16f(L);
}

__device__ __forceinline__ void topk_insert1f(float (&L)[16], float v) {
#pragma unroll
    for (int i = 0; i < 16; ++i) { const float hi = __builtin_fmaxf(L[i], v); v = __builtin_fminf(L[i], v); L[i] = hi; }
}
struct EpiTopk {
    static constexpr bool PERM = true, AFTER_DRAIN = true;
    int* IDX; float* GATE;
    __device__ __forceinline__ void fused(f32x4 (&acc)[2][2][4][2], const Unit& u, int wr, int wc, int fr, int fq, PG8_LAS unsigned char* lds, int wid, int lane) const {
        const int tid = wid * 64 + lane;
        PG8_LAS float* S = (PG8_LAS float*)lds;
        PG8_LAS int* X = (PG8_LAS int*)lds;
        const int row = tid & 255, part = tid >> 8;
        int KK[2][16];
#pragma unroll
        for (int bj = 0; bj < 2; ++bj) {
#pragma unroll
            for (int ai = 0; ai < 2; ++ai)
#pragma unroll
                for (int m = 0; m < 4; ++m)
#pragma unroll
                    for (int n = 0; n < 2; ++n) *(PG8_LAS f32x4*)(S + (ai * HALF + wr * 64 + m * 16 + fr) * 132 + wc * 32 + 8 * fq + 4 * n) = acc[ai][bj][m][n] * WSC;
            asm volatile("s_waitcnt lgkmcnt(0)" ::: "memory"); __builtin_amdgcn_s_barrier(); asm volatile("" ::: "memory");
            float L[16];
#pragma unroll
            for (int c = 0; c < 4; ++c) {
                float N[16];
#pragma unroll
                for (int i = 0; i < 4; ++i) { const f32x4 v = *(const PG8_LAS f32x4*)(S + row * 132 + 64 * part + 16 * c + 4 * i);
#pragma unroll
                    for (int e = 0; e < 4; ++e) N[4 * i + e] = __int_as_float((__float_as_int(v[e]) & ~127) | (127 - (64 * part + 16 * c + 4 * i + e))); }
                if (c == 0) { bitonic_sort16f<true>(N);
#pragma unroll
                    for (int i = 0; i < 16; ++i) L[i] = N[i]; }
                else topk_absorb16f(L, N);
            }
            asm volatile("s_waitcnt lgkmcnt(0)" ::: "memory"); __builtin_amdgcn_s_barrier(); asm volatile("" ::: "memory");
#pragma unroll
            for (int i = 0; i < 4; ++i) *(PG8_LAS u32x4*)(X + tid * 20 + 4 * i) = (u32x4){(unsigned)__float_as_int(L[4 * i]), (unsigned)__float_as_int(L[4 * i + 1]), (unsigned)__float_as_int(L[4 * i + 2]), (unsigned)__float_as_int(L[4 * i + 3])};
            asm volatile("s_waitcnt lgkmcnt(0)" ::: "memory"); __builtin_amdgcn_s_barrier(); asm volatile("" ::: "memory");
            { float P[16]; const int pt = tid ^ 256;
#pragma unroll
              for (int i = 0; i < 4; ++i) { const u32x4 v = *(const PG8_LAS u32x4*)(X + pt * 20 + 4 * i); P[4 * i] = __int_as_float((int)v.x); P[4 * i + 1] = __int_as_float((int)v.y); P[4 * i + 2] = __int_as_float((int)v.z); P[4 * i + 3] = __int_as_float((int)v.w); }
#pragma unroll
              for (int i = 0; i < 16; ++i) L[i] = __builtin_fmaxf(L[i], P[15 - i]);
              bitonic_merge_desc16f(L); }
#pragma unroll
            for (int i = 0; i < 16; ++i) KK[bj][i] = __float_as_int(L[i]);
            asm volatile("s_waitcnt lgkmcnt(0)" ::: "memory"); __builtin_amdgcn_s_barrier(); asm volatile("" ::: "memory");
        }
        float v1[16], v2[16];
#pragma unroll
        for (int i = 0; i < 16; ++i) { v1[i] = __int_as_float(KK[0][i] & ~127); v2[i] = __int_as_float(KK[1][i] & ~127); }
#define CKEY(a, b) __int_as_float((__float_as_int(csum(v1[a], v2[b])) & ~255) | (255 - (((a) << 4) | (b))))
        float L[16];
#pragma unroll
        for (int b = 0; b < 16; ++b) L[b] = CKEY(0, b);
        { float N[16] = {CKEY(1, 0), CKEY(1, 1), CKEY(1, 2), CKEY(1, 3), CKEY(1, 4), CKEY(1, 5), CKEY(1, 6), CKEY(1, 7), CKEY(2, 0), CKEY(2, 1), CKEY(2, 2), CKEY(2, 3), CKEY(2, 4), CKEY(4, 0), CKEY(4, 1), CKEY(4, 2)};
          topk_absorb16f(L, N); }
        { float N[16] = {CKEY(3, 0), CKEY(3, 1), CKEY(3, 2), CKEY(3, 3), CKEY(5, 0), CKEY(5, 1), CKEY(6, 0), CKEY(6, 1), CKEY(7, 0), CKEY(7, 1), CKEY(8, 0), CKEY(9, 0), CKEY(10, 0), CKEY(11, 0), CKEY(12, 0), CKEY(13, 0)};
          topk_absorb16f(L, N); }
        topk_insert1f(L, CKEY(14, 0)); topk_insert1f(L, CKEY(15, 0));
#undef CKEY
#pragma unroll
        for (int i = 0; i < 4; ++i) { *(PG8_LAS u32x4*)(X + tid * 36 + 4 * i) = (u32x4){(unsigned)KK[0][4 * i], (unsigned)KK[0][4 * i + 1], (unsigned)KK[0][4 * i + 2], (unsigned)KK[0][4 * i + 3]};
                                      *(PG8_LAS u32x4*)(X + tid * 36 + 16 + 4 * i) = (u32x4){(unsigned)KK[1][4 * i], (unsigned)KK[1][4 * i + 1], (unsigned)KK[1][4 * i + 2], (unsigned)KK[1][4 * i + 3]}; }
        asm volatile("s_waitcnt lgkmcnt(0)" ::: "memory");
        float sc[16]; int ex[16];
#pragma unroll
        for (int i = 0; i < 16; ++i) { const int code = 255 - (__float_as_int(L[i]) & 255); const int ka = X[tid * 36 + (code >> 4)], kb = X[tid * 36 + 16 + (code & 15)];
            sc[i] = __int_as_float(ka & ~127) + __int_as_float(kb & ~127); ex[i] = (127 - (ka & 127)) * 128 + (127 - (kb & 127)); }
        float mx = sc[0];
#pragma unroll
        for (int i = 1; i < 16; ++i) mx = fmaxf(mx, sc[i]);
        float den = 0.f;
#pragma unroll
        for (int i = 0; i < 16; ++i) { sc[i] = __builtin_amdgcn_exp2f((sc[i] - mx) * 1.4426950408889634f); den += sc[i]; }
        const float rden = 1.0f / den;
        const size_t o = ((size_t)(u.pm * BM + row) * 8 + u.pn) * 16;
        if (part == 0) {
#pragma unroll
            for (int i = 0; i < 4; ++i) *(u32x4*)(IDX + o + 4 * i) = (u32x4){(unsigned)ex[4 * i], (unsigned)ex[4 * i + 1], (unsigned)ex[4 * i + 2], (unsigned)ex[4 * i + 3]};
        } else {
#pragma unroll
            for (int i = 0; i < 4; ++i) *(f32x4*)(GATE + o + 4 * i) = (f32x4){sc[4 * i] * rden, sc[4 * i + 1] * rden, sc[4 * i + 2] * rden, sc[4 * i + 3] * rden};
        }
        asm volatile("s_waitcnt lgkmcnt(0)" ::: "memory"); __builtin_amdgcn_s_barrier(); asm volatile("" ::: "memory");
    }
};
struct OneUnitOrder {
    StaticOrder base; int round;
    __device__ __forceinline__ bool next(int i, Unit& u) const { return i == 0 && base.next(round, u); }
    __device__ __forceinline__ void a_ready(const Unit&) const {}
    __device__ __forceinline__ void done(const Unit&) const {}
};
}
constexpr int NWAVES = 8;
constexpr int BATCH = 4, SEQ = 4096, DM = 1024, TOK = BATCH * SEQ, DEPTH = 4;
constexpr float LN_EPS = 1e-5f;
constexpr size_t MiB = 1u << 20;
constexpr size_t WS_CTL = 0, CTL_ZERO_BYTES = 32 * 1024;
constexpr size_t WS_W_IN = 2 * MiB;
constexpr size_t WS_W_GLU = 6 * MiB;
constexpr size_t WS_W_KV = 14 * MiB;
constexpr size_t WS_W_SQ = 18 * MiB;
constexpr size_t WS_W_SO = 22 * MiB;
constexpr size_t WS_W_EFF = 26 * MiB;
constexpr size_t WS_W_PG = 42 * MiB;
constexpr size_t WS_W_PW = 50 * MiB;
constexpr size_t WS_PB = 52 * MiB;
constexpr size_t WS_IDX = 84 * MiB;
constexpr size_t WS_GATE = 92 * MiB;
constexpr size_t WS_TABU = 100 * MiB;
constexpr size_t WS_TABV = 228 * MiB;
constexpr size_t WS_PW = 356 * MiB;
constexpr size_t WS_H = 484 * MiB, WS_U = 516 * MiB, WS_Y = 548 * MiB, WS_X1 = 580 * MiB, WS_H1 = 612 * MiB, WS_H2 = 644 * MiB, WS_KB = 676 * MiB, WS_VT = 708 * MiB, WS_HKV = 740 * MiB;
constexpr size_t WS_H8 = 772 * MiB, WS_H28 = 788 * MiB;
constexpr size_t WS_W8 = 804 * MiB;
constexpr size_t W8_IN = WS_W8, W8_GLU = WS_W8 + 2 * MiB, W8_KV = WS_W8 + 6 * MiB, W8_SQ = WS_W8 + 8 * MiB, W8_SO = WS_W8 + 10 * MiB, W8_PG = WS_W8 + 12 * MiB;
constexpr float W8_SCALE = 32.0f;
constexpr size_t WS_H18 = 820 * MiB;
constexpr size_t W8_EFF = 836 * MiB;
constexpr size_t WS_END = 844 * MiB;
constexpr int CW_BAR = 4096;
constexpr float PEER_SU = 91.0f, PEER_SV = 4.75f;

constexpr int LDS_BYTES = 163840;
constexpr int RING_BYTES = 131072;
constexpr int MISC_OFF = 163840 - 256;

#define GAS __attribute__((address_space(1)))
#define LAS __attribute__((address_space(3)))
typedef unsigned short bf16;
typedef unsigned v4u __attribute__((ext_vector_type(4)));
typedef unsigned v2u __attribute__((ext_vector_type(2)));
typedef float f32x4 __attribute__((ext_vector_type(4)));
typedef float f32x16 __attribute__((ext_vector_type(16)));
typedef short bf16x8 __attribute__((ext_vector_type(8)));
typedef __bf16 bf16x2_t __attribute__((ext_vector_type(2)));
#define LDS_WAIT() asm volatile("s_waitcnt lgkmcnt(0)" ::: "memory")
#define VM_WAIT() asm volatile("s_waitcnt vmcnt(0)" ::: "memory")
using pg8::cvt_pk_bf16; using pg8::bf_lo; using pg8::bf_hi; using pg8::gelu_tanh;

#define XB_TMO      128
#define XB_XCNT(j)  (256  + 64 * (j))
#define XB_XSUB(j)  (1280 + 64 * (j))
#define XB_XGEN(j)  (2304 + 64 * (j))
#define XB_TOP      3328
#define XB_TOPGEN   3392
#define XCD_BAR_WORDS 3456
#define XB_SPIN_CAP (1u << 24)
__device__ __forceinline__ unsigned xb_ld(unsigned* p)              { return __hip_atomic_load(p, __ATOMIC_RELAXED, __HIP_MEMORY_SCOPE_AGENT); }
__device__ __forceinline__ unsigned xb_add(unsigned* p, unsigned v) { return __hip_atomic_fetch_add(p, v, __ATOMIC_RELAXED, __HIP_MEMORY_SCOPE_AGENT); }
__device__ __forceinline__ unsigned xb_xcc_id() { return (unsigned)__builtin_amdgcn_s_getreg((3 << 11) | 20) & 0xFu; }
#define XB_SPIN(cond, bar) do { unsigned _sp = 0; while (cond) { __builtin_amdgcn_s_sleep(1); \
    if ((++_sp & 255u) == 0u) { if (xb_ld(&(bar)[XB_TMO])) break; if (_sp > XB_SPIN_CAP) { atomicAdd(&(bar)[XB_TMO], 1u); break; } } } } while (0)
struct XcdBarrier { unsigned* bar; unsigned x; volatile LAS unsigned* st; };
__device__ __forceinline__ XcdBarrier xcd_barrier_post(unsigned* bar, volatile LAS unsigned* st) {
    XcdBarrier b; b.bar = bar; b.x = xb_xcc_id(); b.st = st;
    if (threadIdx.x == 0) (void)xb_add(&bar[XB_XCNT(b.x)], 1u);
    return b;
}
__device__ __forceinline__ void xcd_barrier_complete(unsigned* bar, unsigned x, unsigned& nloc, unsigned& nx) {
    const unsigned G = gridDim.x * gridDim.y * gridDim.z;
    unsigned sum, cnt, mine, sp = 0u;
    for (;;) {
        sum = 0u; cnt = 0u; mine = 0u;
#pragma unroll 1
        for (unsigned j = 0; j < 16; ++j) { const unsigned c = xb_ld(&bar[XB_XCNT(j)]); sum += c; cnt += (c > 0u) ? 1u : 0u; mine = (j == x) ? c : mine; }
        if (sum == G) break;
        __builtin_amdgcn_s_sleep(1);
        if ((++sp & 255u) == 0u) { if (xb_ld(&bar[XB_TMO])) break; if (sp > XB_SPIN_CAP) { atomicAdd(&bar[XB_TMO], 1u); break; } }
    }
    nloc = mine > 0u ? mine : 1u; nx = cnt > 0u ? cnt : 1u;
}
__device__ __forceinline__ void xcd_barrier(const XcdBarrier& b) {
    asm volatile("s_waitcnt vmcnt(0)" ::: "memory");
    __syncthreads();
    if (threadIdx.x == 0) {
        unsigned* bar = b.bar;
        __builtin_amdgcn_s_waitcnt(0);
        unsigned nloc = b.st[0], nx = b.st[1];
        if (nloc == 0u) { xcd_barrier_complete(bar, b.x, nloc, nx); b.st[0] = nloc; b.st[1] = nx; }
        const unsigned old = xb_add(&bar[XB_XSUB(b.x)], 1u);
        const unsigned gen = old / nloc;
        if (old + 1u == (gen + 1u) * nloc) {
            __builtin_amdgcn_fence(__ATOMIC_RELEASE, "agent");
            asm volatile("s_waitcnt vmcnt(0)" ::: "memory");
            const unsigned og = xb_add(&bar[XB_TOP], 1u);
            const unsigned tg = og / nx;
            if (og + 1u == (tg + 1u) * nx) xb_add(&bar[XB_TOPGEN], 1u);
            else XB_SPIN(xb_ld(&bar[XB_TOPGEN]) == tg, bar);
            __builtin_amdgcn_fence(__ATOMIC_ACQUIRE, "agent");
            xb_add(&bar[XB_XGEN(b.x)], 1u);
            asm volatile("s_waitcnt vmcnt(0)" ::: "memory");
        } else {
            XB_SPIN(xb_ld(&bar[XB_XGEN(b.x)]) == gen, bar);
            __builtin_amdgcn_fence(__ATOMIC_ACQUIRE, "agent");
            asm volatile("s_waitcnt vmcnt(0)" ::: "memory");
        }
    }
    __syncthreads();
}

enum PhaseType { P_PROLOGUE = 0, P_STORE = 1, P_SSM = 2, P_GLU = 3, P_LNMIX = 4, P_TOPK = 5, P_PEER = 6, P_PLE = 7, P_LNKV = 8, P_ATTN = 9, P_RES = 10 };
constexpr int MAX_PH = 48;
struct Args { const float* in[28]; float* out; unsigned char* ws; int ph_lo, ph_hi, use_bar, nph; unsigned char ph_type[MAX_PH]; unsigned char ph_arg[MAX_PH]; };
struct Frame {
    LAS unsigned char* lds;
    int tid, lane, wave, vcu, G, z, bx;
    const struct Args* A;
    float* out; unsigned char* ws;
};
__device__ __forceinline__ float wave_sum(float v) {
#pragma unroll
    for (int o = 1; o < 64; o <<= 1) v += __shfl_xor(v, o);
    return v;
}
template <int CTRL, int BANK> __device__ __forceinline__ float dpp_movf(float old, float v) {
    return __builtin_bit_cast(float, __builtin_amdgcn_update_dpp(__builtin_bit_cast(int, old), __builtin_bit_cast(int, v), CTRL, 0xF, BANK, true));
}
__device__ __forceinline__ float wave_sum_dpp(float v) {
    v += dpp_movf<0xB1, 0xF>(0.f, v);
    v += dpp_movf<0x4E, 0xF>(0.f, v);
    { float r = dpp_movf<0x104, 0x5>(0.f, v); r = dpp_movf<0x114, 0xA>(r, v); v += r; }
    v += dpp_movf<0x128, 0xF>(0.f, v);
    { const auto t = __builtin_amdgcn_permlane16_swap(__builtin_bit_cast(unsigned, v), __builtin_bit_cast(unsigned, v), false, false); const unsigned ta = t[0], tb = t[1]; v = __builtin_bit_cast(float, ta) + __builtin_bit_cast(float, tb); }
    { const auto t = __builtin_amdgcn_permlane32_swap(__builtin_bit_cast(unsigned, v), __builtin_bit_cast(unsigned, v), false, false); const unsigned ta = t[0], tb = t[1]; v = __builtin_bit_cast(float, ta) + __builtin_bit_cast(float, tb); }
    return v;
}
__device__ __forceinline__ unsigned f2bf(float f) { unsigned u = __builtin_bit_cast(unsigned, f); return (u + 0x7fffu + ((u >> 16) & 1u)) >> 16; }
__device__ __forceinline__ unsigned pk2(float lo, float hi) { return f2bf(lo) | (f2bf(hi) << 16); }

__device__ __forceinline__ unsigned pk4_fp8(float a, float b, float c, float d) { int w = 0; w = __builtin_amdgcn_cvt_pk_fp8_f32(a, b, w, false); w = __builtin_amdgcn_cvt_pk_fp8_f32(c, d, w, true); return (unsigned)w; }
__device__ __forceinline__ void p0_transpose_item(const float* W, int K, int N, bf16* WT, int glu, LAS float* scr, int item, int lane, unsigned char* WT8 = nullptr) {
    const int nblk = N / 32, kb = item / nblk, nb = item % nblk, k0 = 64 * kb, n0 = 32 * nb;
    int r0 = n0;
    if (glu) { const int bj = n0 >> 10, rem = n0 & 1023; r0 = 256 * (rem >> 7) + 128 * bj + (rem & 127); }
#pragma unroll 8
    for (int i = 0; i < 32; ++i) { const int kk = 2 * i + (lane >> 5); scr[kk * 33 + (lane & 31)] = W[(size_t)(k0 + kk) * N + n0 + (lane & 31)]; }
    LDS_WAIT(); asm volatile("" ::: "memory");
    const int c = lane & 7;
#pragma unroll
    for (int j = 0; j < 4; ++j) { const int n = (lane >> 3) + 8 * j; const LAS float* s = scr + (8 * c) * 33 + n;
        v4u o; o.x = pk2(s[0 * 33], s[1 * 33]); o.y = pk2(s[2 * 33], s[3 * 33]); o.z = pk2(s[4 * 33], s[5 * 33]); o.w = pk2(s[6 * 33], s[7 * 33]);
        if (WT) *(GAS v4u*)(WT + (size_t)(r0 + n) * K + k0 + 8 * c) = o;
        if (WT8) *(GAS v2u*)(WT8 + (size_t)(r0 + n) * K + k0 + 8 * c) = (v2u){pk4_fp8(s[0 * 33] * W8_SCALE, s[1 * 33] * W8_SCALE, s[2 * 33] * W8_SCALE, s[3 * 33] * W8_SCALE), pk4_fp8(s[4 * 33] * W8_SCALE, s[5 * 33] * W8_SCALE, s[6 * 33] * W8_SCALE, s[7 * 33] * W8_SCALE)}; }
    LDS_WAIT(); asm volatile("" ::: "memory");
}
__device__ __forceinline__ void cvt_stream_dual(Frame& F, const float* src, bf16* dst, unsigned char* dst8, size_t n) {
    const size_t nthr = (size_t)F.G * 512, gt = (size_t)F.bx * 512 + F.tid;
    for (size_t i = gt; i < n / 8; i += nthr) {
        const f32x4 a = *(const GAS f32x4*)(src + i * 8), b = *(const GAS f32x4*)(src + i * 8 + 4);
        v4u o; o.x = pk2(a.x, a.y); o.y = pk2(a.z, a.w); o.z = pk2(b.x, b.y); o.w = pk2(b.z, b.w);
        *(GAS v4u*)(dst + i * 8) = o;
        *(GAS v2u*)(dst8 + i * 8) = (v2u){pk4_fp8(a.x, a.y, a.z, a.w), pk4_fp8(b.x, b.y, b.z, b.w)};
    }
}
__device__ __forceinline__ void cvt_stream(Frame& F, const float* src, bf16* dst, size_t n) {
    const size_t nthr = (size_t)F.G * 512, gt = (size_t)F.bx * 512 + F.tid;
    for (size_t i = gt; i < n / 8; i += nthr) {
        const f32x4 a = *(const GAS f32x4*)(src + i * 8), b = *(const GAS f32x4*)(src + i * 8 + 4);
        v4u o; o.x = pk2(a.x, a.y); o.y = pk2(a.z, a.w); o.z = pk2(b.x, b.y); o.w = pk2(b.z, b.w);
        *(GAS v4u*)(dst + i * 8) = o;
    }
}
__device__ __forceinline__ void cvt_stream_fp4(Frame& F, const float* src, unsigned char* dst, size_t n, float scale) {
    const size_t nthr = (size_t)F.G * 512, gt = (size_t)F.bx * 512 + F.tid;
    for (size_t i = gt; i < n / 32; i += nthr) {
        unsigned w[4];
#pragma unroll
        for (int q = 0; q < 4; ++q) {
            const f32x4 a = *(const GAS f32x4*)(src + i * 32 + 8 * q) * scale, b = *(const GAS f32x4*)(src + i * 32 + 8 * q + 4) * scale;
            unsigned t = 0u;
            t = __builtin_amdgcn_cvt_scalef32_pk_fp4_f32(t, a.x, a.y, 1.0f, 0); t = __builtin_amdgcn_cvt_scalef32_pk_fp4_f32(t, a.z, a.w, 1.0f, 1);
            t = __builtin_amdgcn_cvt_scalef32_pk_fp4_f32(t, b.x, b.y, 1.0f, 2); t = __builtin_amdgcn_cvt_scalef32_pk_fp4_f32(t, b.z, b.w, 1.0f, 3);
            w[q] = t;
        }
        *(GAS v4u*)(dst + i * 16) = (v4u){w[0], w[1], w[2], w[3]};
    }
}
__device__ __forceinline__ unsigned pkbf2(float lo, float hi) { return cvt_pk_bf16(lo, hi); }
__device__ __forceinline__ void p0_weff_item(Frame& F, int item) {
    const int jb = item & 1, kb = (item >> 1) & 15, hh = (item >> 5) & 15, l = item >> 9;
    const int lane = F.lane, r32 = lane & 31, h = lane >> 5;
    const float* wq = F.A->in[21 + F.z] + (size_t)l * 1024 * 2048 + (size_t)(64 * kb + r32) * 2048 + 128 * hh + 8 * h;
    const float* ky = F.A->in[22 + (hh & 1) + F.z] + (size_t)l * 128 * 128 + (size_t)(64 * jb + r32) * 128 + 8 * h;
    f32x16 acc[2][2] = {};
#pragma unroll
    for (int ks = 0; ks < 8; ++ks) {
        bf16x8 af[2], bf[2];
#pragma unroll
        for (int a = 0; a < 2; ++a) { const f32x4 a0 = *(const GAS f32x4*)(wq + (size_t)a * 32 * 2048 + 16 * ks), a1 = *(const GAS f32x4*)(wq + (size_t)a * 32 * 2048 + 16 * ks + 4);
            af[a] = __builtin_bit_cast(bf16x8, (v4u){pkbf2(a0.x, a0.y), pkbf2(a0.z, a0.w), pkbf2(a1.x, a1.y), pkbf2(a1.z, a1.w)}); }
#pragma unroll
        for (int b = 0; b < 2; ++b) { const f32x4 b0 = *(const GAS f32x4*)(ky + (size_t)b * 32 * 128 + 16 * ks), b1 = *(const GAS f32x4*)(ky + (size_t)b * 32 * 128 + 16 * ks + 4);
            bf[b] = __builtin_bit_cast(bf16x8, (v4u){pkbf2(b0.x, b0.y), pkbf2(b0.z, b0.w), pkbf2(b1.x, b1.y), pkbf2(b1.z, b1.w)}); }
#pragma unroll
        for (int a = 0; a < 2; ++a)
#pragma unroll
            for (int b = 0; b < 2; ++b) acc[a][b] = __builtin_amdgcn_mfma_f32_32x32x16_bf16(af[a], bf[b], acc[a][b], 0, 0, 0);
    }
#pragma unroll
    for (int a = 0; a < 2; ++a)
#pragma unroll
        for (int b = 0; b < 2; ++b) {
            unsigned char* dst = (unsigned char*)(F.ws + W8_EFF) + (size_t)l * 2048 * 1024 + (size_t)(128 * hh + 64 * jb + 32 * b + r32) * 1024 + 64 * kb + 32 * a + 4 * h;
#pragma unroll
            for (int q = 0; q < 4; ++q) *(GAS unsigned*)(dst + 8 * q) = pk4_fp8(acc[a][b][4 * q] * W8_SCALE, acc[a][b][4 * q + 1] * W8_SCALE, acc[a][b][4 * q + 2] * W8_SCALE, acc[a][b][4 * q + 3] * W8_SCALE); }
}
__device__ __forceinline__ void p0_prologue(Frame& F) {
#ifndef PROBE_PRO
#define PROBE_PRO 0
#endif
    for (int rp = 0; rp < (PROBE_PRO == 4 ? 2 : 1); ++rp) {
    cvt_stream_dual(F, F.A->in[0 + F.z], (bf16*)(F.ws + WS_H), (unsigned char*)(F.ws + WS_H8), (size_t)TOK * DM);
    cvt_stream(F, F.A->in[1 + F.z], (bf16*)(F.ws + WS_PB), (size_t)DEPTH * TOK * 256); }
    LAS float* scr = (LAS float*)(F.lds + F.wave * 8704);
    const int gw = F.vcu * NWAVES + F.wave, NGW = F.G * NWAVES;
    constexpr int I_SQ = 16 * 32, I_GLU = 16 * 64, I_PW = 4 * 32;
    constexpr int NITEMS = 2 * I_SQ + 2 * I_GLU + I_GLU + 2 * I_SQ + 2 * I_SQ + 4 * I_SQ + 4 * I_PW;
    for (int rp = 0; rp < (PROBE_PRO == 2 ? 2 : 1); ++rp)
    for (int it = gw; it < NITEMS; it += NGW) {
        int r = it;
        if (r < 2 * I_SQ) { const int l = r / I_SQ; p0_transpose_item(F.A->in[6 + F.z] + (size_t)l * 1024 * 1024, 1024, 1024, nullptr, 0, scr, r % I_SQ, F.lane, (unsigned char*)(F.ws + W8_IN) + (size_t)l * 1024 * 1024); continue; } r -= 2 * I_SQ;
        if (r < 2 * I_GLU) { const int l = r / I_GLU; p0_transpose_item(F.A->in[15 + F.z] + (size_t)l * 1024 * 2048, 1024, 2048, nullptr, 1, scr, r % I_GLU, F.lane, (unsigned char*)(F.ws + W8_GLU) + (size_t)l * 2048 * 1024); continue; } r -= 2 * I_GLU;
        if (r < I_GLU) { p0_transpose_item(F.A->in[18 + F.z], 1024, 2048, nullptr, 0, scr, r, F.lane, (unsigned char*)(F.ws + W8_KV)); continue; } r -= I_GLU;
        if (r < 2 * I_SQ) { const int l = r / I_SQ; p0_transpose_item(F.A->in[19 + F.z] + (size_t)l * 1024 * 1024, 1024, 1024, nullptr, 0, scr, r % I_SQ, F.lane, (unsigned char*)(F.ws + W8_SQ) + (size_t)l * 1024 * 1024); continue; } r -= 2 * I_SQ;
        if (r < 2 * I_SQ) { const int l = r / I_SQ; p0_transpose_item(F.A->in[20 + F.z] + (size_t)l * 1024 * 1024, 1024, 1024, nullptr, 0, scr, r % I_SQ, F.lane, (unsigned char*)(F.ws + W8_SO) + (size_t)l * 1024 * 1024); continue; } r -= 2 * I_SQ;
        if (r < 4 * I_SQ) { const int l = r / I_SQ; p0_transpose_item(F.A->in[27 + F.z] + (size_t)l * 1024 * 1024, 1024, 1024, nullptr, 0, scr, r % I_SQ, F.lane, (unsigned char*)(F.ws + W8_PG) + (size_t)l * 1024 * 1024); continue; } r -= 4 * I_SQ;
        { const int l = r / I_PW; p0_transpose_item(F.A->in[26 + F.z] + (size_t)l * 256 * 1024, 256, 1024, (bf16*)(F.ws + WS_W_PW) + (size_t)l * 1024 * 256, 0, scr, r % I_PW, F.lane); }
    }
    for (int rp = 0; rp < (PROBE_PRO == 3 ? 2 : 1); ++rp)
    for (int it = gw; it < 2048; it += NGW) p0_weff_item(F, it);
}

__device__ __forceinline__ void ln_rows(Frame& F, const bf16* X, const float* g, const float* bb, bf16* O, unsigned char* O8 = nullptr) {
    const int gw = F.vcu * NWAVES + F.wave, NGW = F.G * NWAVES;
    float gg[16], bv[16];
    { const f32x4 a = *(const GAS f32x4*)(g + 8 * F.lane), b = *(const GAS f32x4*)(g + 8 * F.lane + 4), c = *(const GAS f32x4*)(g + 512 + 8 * F.lane), d = *(const GAS f32x4*)(g + 512 + 8 * F.lane + 4);
      gg[0] = a.x; gg[1] = a.y; gg[2] = a.z; gg[3] = a.w; gg[4] = b.x; gg[5] = b.y; gg[6] = b.z; gg[7] = b.w; gg[8] = c.x; gg[9] = c.y; gg[10] = c.z; gg[11] = c.w; gg[12] = d.x; gg[13] = d.y; gg[14] = d.z; gg[15] = d.w; }
    { const f32x4 a = *(const GAS f32x4*)(bb + 8 * F.lane), b = *(const GAS f32x4*)(bb + 8 * F.lane + 4), c = *(const GAS f32x4*)(bb + 512 + 8 * F.lane), d = *(const GAS f32x4*)(bb + 512 + 8 * F.lane + 4);
      bv[0] = a.x; bv[1] = a.y; bv[2] = a.z; bv[3] = a.w; bv[4] = b.x; bv[5] = b.y; bv[6] = b.z; bv[7] = b.w; bv[8] = c.x; bv[9] = c.y; bv[10] = c.z; bv[11] = c.w; bv[12] = d.x; bv[13] = d.y; bv[14] = d.z; bv[15] = d.w; }
    for (int m = gw; m < TOK; m += NGW) {
        const v4u xa = *(const GAS v4u*)(X + (size_t)m * DM + 8 * F.lane), xb = *(const GAS v4u*)(X + (size_t)m * DM + 512 + 8 * F.lane);
        float x[16] = {bf_lo(xa.x), bf_hi(xa.x), bf_lo(xa.y), bf_hi(xa.y), bf_lo(xa.z), bf_hi(xa.z), bf_lo(xa.w), bf_hi(xa.w), bf_lo(xb.x), bf_hi(xb.x), bf_lo(xb.y), bf_hi(xb.y), bf_lo(xb.z), bf_hi(xb.z), bf_lo(xb.w), bf_hi(xb.w)};
        float s = 0.f;
#pragma unroll
        for (int i = 0; i < 16; ++i) s += x[i];
        const float mean = wave_sum_dpp(s) * (1.f / DM); float q = 0.f;
#pragma unroll
        for (int i = 0; i < 16; ++i) { x[i] -= mean; q += x[i] * x[i]; }
        const float rstd = 1.0f / sqrtf(wave_sum_dpp(q) * (1.f / DM) + LN_EPS);
#pragma unroll
        for (int i = 0; i < 16; ++i) x[i] = x[i] * rstd * gg[i] + bv[i];
        v4u oa, ob; oa.x = pk2(x[0], x[1]); oa.y = pk2(x[2], x[3]); oa.z = pk2(x[4], x[5]); oa.w = pk2(x[6], x[7]); ob.x = pk2(x[8], x[9]); ob.y = pk2(x[10], x[11]); ob.z = pk2(x[12], x[13]); ob.w = pk2(x[14], x[15]);
        if (O) { *(GAS v4u*)(O + (size_t)m * DM + 8 * F.lane) = oa; *(GAS v4u*)(O + (size_t)m * DM + 512 + 8 * F.lane) = ob; }
        if (O8) { *(GAS v2u*)(O8 + (size_t)m * DM + 8 * F.lane) = (v2u){pk4_fp8(x[0], x[1], x[2], x[3]), pk4_fp8(x[4], x[5], x[6], x[7])};
                  *(GAS v2u*)(O8 + (size_t)m * DM + 512 + 8 * F.lane) = (v2u){pk4_fp8(x[8], x[9], x[10], x[11]), pk4_fp8(x[12], x[13], x[14], x[15])}; }
    }
}
struct TabCvt { const float* su; const float* sv; unsigned char* du; unsigned char* dv; int c, cf, stride, n; };
__device__ __forceinline__ void tabcvt_issue(TabCvt& T, int lane, f32x4 (&cv)[4]) {
    const bool live = T.c < T.n;
    if (live) { const int half = T.n >> 1; const float* src = (T.c < half ? T.su + (size_t)T.c * 1024 : T.sv + (size_t)(T.c - half) * 1024) + 16 * lane;
#pragma unroll
        for (int q = 0; q < 4; ++q) cv[q] = *(const GAS f32x4*)(src + 4 * q); }
    T.c += T.stride;
}
__device__ __forceinline__ unsigned i4q(float v) { float t = __builtin_fminf(__builtin_fmaxf(v * PEER_SU, -7.f), 7.f) + 12582912.0f; asm volatile("" : "+v"(t)); return __builtin_bit_cast(unsigned, t) & 15u; }
__device__ __forceinline__ unsigned pack8_i4(const f32x4& a, const f32x4& b) {
    return i4q(a.x) | (i4q(a.y) << 4) | (i4q(a.z) << 8) | (i4q(a.w) << 12) | (i4q(b.x) << 16) | (i4q(b.y) << 20) | (i4q(b.z) << 24) | (i4q(b.w) << 28);
}
__device__ __forceinline__ void tabcvt_finish(TabCvt& T, int lane, const f32x4 (&cv)[4]) {
    const bool live = T.cf < T.n;
    if (live) { const int half = T.n >> 1;
        unsigned w0 = 0u, w1 = 0u;
        if (T.cf < half) { w0 = pack8_i4(cv[0], cv[1]); w1 = pack8_i4(cv[2], cv[3]); }
        else { const float sc = PEER_SV;
            w0 = __builtin_amdgcn_cvt_scalef32_pk_fp4_f32(w0, cv[0].x * sc, cv[0].y * sc, 1.0f, 0); w0 = __builtin_amdgcn_cvt_scalef32_pk_fp4_f32(w0, cv[0].z * sc, cv[0].w * sc, 1.0f, 1);
            w0 = __builtin_amdgcn_cvt_scalef32_pk_fp4_f32(w0, cv[1].x * sc, cv[1].y * sc, 1.0f, 2); w0 = __builtin_amdgcn_cvt_scalef32_pk_fp4_f32(w0, cv[1].z * sc, cv[1].w * sc, 1.0f, 3);
            w1 = __builtin_amdgcn_cvt_scalef32_pk_fp4_f32(w1, cv[2].x * sc, cv[2].y * sc, 1.0f, 0); w1 = __builtin_amdgcn_cvt_scalef32_pk_fp4_f32(w1, cv[2].z * sc, cv[2].w * sc, 1.0f, 1);
            w1 = __builtin_amdgcn_cvt_scalef32_pk_fp4_f32(w1, cv[3].x * sc, cv[3].y * sc, 1.0f, 2); w1 = __builtin_amdgcn_cvt_scalef32_pk_fp4_f32(w1, cv[3].z * sc, cv[3].w * sc, 1.0f, 3); }
        unsigned char* dst = (T.cf < half ? T.du + (size_t)T.cf * 512 : T.dv + (size_t)(T.cf - half) * 512) + 8 * lane;
        *(GAS v2u*)dst = (v2u){w0, w1}; }
    T.cf += T.stride;
}
template <bool PASS1> __device__ __forceinline__ void ssm_pass(const bf16* U, bf16* Y, LAS unsigned char* stl, const float* dskip, size_t tok0, int g, int lane, int n, int hh, int i_row,
                                                                  const float (&a_re)[2], const float (&a_im)[2], const bf16x8 (&Bf)[4], const LAS unsigned char* CFL, float (&s_re)[2], float (&s_im)[2]) {
    const int c0 = 16 * g + 4 * hh;
    bf16x8 ua_n = *(const GAS bf16x8*)(U + tok0 * DM + 16 * g + 8 * hh);
    v2u u0_n = {}, u1_n = {};
    if (PASS1) { u0_n = *(const GAS v2u*)(U + tok0 * DM + c0); u1_n = *(const GAS v2u*)(U + tok0 * DM + c0 + 8); }
#pragma unroll 1
    for (int tile = 0; tile < 16; ++tile) {
        const size_t tok = tok0 + tile * 16;
        const bf16x8 ua = ua_n; const v2u u0 = u0_n, u1 = u1_n;
        { const size_t tokn = tok0 + ((tile + 1) & 15) * 16;
          ua_n = *(const GAS bf16x8*)(U + tokn * DM + 16 * g + 8 * hh);
          if (PASS1) { u0_n = *(const GAS v2u*)(U + tokn * DM + c0); u1_n = *(const GAS v2u*)(U + tokn * DM + c0 + 8); } }
        f32x16 acc[4];
#pragma unroll
        for (int nb = 0; nb < 4; ++nb) { f32x16 z = {}; acc[nb] = __builtin_amdgcn_mfma_f32_32x32x16_bf16(ua, Bf[nb], z, 0, 0, 0); }
#pragma unroll
        for (int pb = 0; pb < 2; ++pb) {
#pragma unroll
            for (int r = 0; r < 16; ++r) {
                float t0 = fmaf(-a_im[pb], s_im[pb], acc[2 * pb][r]); asm volatile("" : "+v"(t0));
                float t1 = fmaf(a_im[pb], s_re[pb], acc[2 * pb + 1][r]); asm volatile("" : "+v"(t1));
                float nre = fmaf(a_re[pb], s_re[pb], t0); asm volatile("" : "+v"(nre));
                float nim = fmaf(a_re[pb], s_im[pb], t1); asm volatile("" : "+v"(nim));
                s_re[pb] = nre; s_im[pb] = nim;
                if (PASS1) { const int irow = (r & 3) + 8 * (r >> 2) + 4 * hh; *(LAS unsigned*)(stl + irow * 272 + (32 * pb + n) * 4) = cvt_pk_bf16(nre, nim); }
            }
        }
        if (PASS1) {
            LDS_WAIT();
            f32x16 yv = {};
#pragma unroll
            for (int ks = 0; ks < 8; ++ks) { const bf16x8 sb = *(const LAS bf16x8*)(stl + i_row * 272 + (16 * ks + 8 * hh) * 2); const bf16x8 cf = *(const LAS bf16x8*)(CFL + (ks * 64 + lane) * 16); yv = __builtin_amdgcn_mfma_f32_32x32x16_bf16(cf, sb, yv, 0, 0, 0); }
            const f32x4 d0 = *(const GAS f32x4*)(dskip + c0), d1 = *(const GAS f32x4*)(dskip + c0 + 8);
            float o[8];
            o[0] = gelu_tanh(yv[0] + d0.x * bf_lo(u0.x)); o[1] = gelu_tanh(yv[1] + d0.y * bf_hi(u0.x)); o[2] = gelu_tanh(yv[2] + d0.z * bf_lo(u0.y)); o[3] = gelu_tanh(yv[3] + d0.w * bf_hi(u0.y));
            o[4] = gelu_tanh(yv[4] + d1.x * bf_lo(u1.x)); o[5] = gelu_tanh(yv[5] + d1.y * bf_hi(u1.x)); o[6] = gelu_tanh(yv[6] + d1.z * bf_lo(u1.y)); o[7] = gelu_tanh(yv[7] + d1.w * bf_hi(u1.y));
            *(GAS unsigned*)((unsigned char*)Y + tok * DM + c0) = pk4_fp8(o[0], o[1], o[2], o[3]);
            *(GAS unsigned*)((unsigned char*)Y + tok * DM + c0 + 8) = pk4_fp8(o[4], o[5], o[6], o[7]);
            LDS_WAIT();
        }
    }
}
__device__ __forceinline__ void ssm_phase(Frame& F, int layer) {
    if (layer == 0) {
        TabCvt TC; TC.su = F.A->in[24 + F.z]; TC.sv = F.A->in[25 + F.z]; TC.du = (unsigned char*)(F.ws + WS_TABU); TC.dv = (unsigned char*)(F.ws + WS_TABV);
        TC.c = F.vcu * NWAVES + F.wave; TC.cf = TC.c; TC.stride = F.G * NWAVES; TC.n = 2 * 16384;
        f32x4 cvA[4], cvB[4];
        tabcvt_issue(TC, F.lane, cvA);
        while (TC.cf < TC.n) { tabcvt_issue(TC, F.lane, cvB); tabcvt_finish(TC, F.lane, cvA); tabcvt_issue(TC, F.lane, cvA); tabcvt_finish(TC, F.lane, cvB); }
    }
    const bf16* U = (const bf16*)(F.ws + WS_U); bf16* Y = (bf16*)(F.ws + WS_Y);
    const int lane = F.lane, n = lane & 31, hh = lane >> 5, wave = F.wave;
    LAS unsigned char* stl = F.lds + wave * 8704;
    LAS float* E = (LAS float*)(F.lds + 8 * 8704);
    for (int bg = F.vcu; bg < BATCH * 64; bg += F.G) {
        const int b = bg >> 6, g = bg & 63, lg = layer * 64 + g;
        const float dt = expf(F.A->in[9 + F.z][lg]);
        float a_re[2], a_im[2]; bf16x8 Bf[4];
#pragma unroll
        for (int pb = 0; pb < 2; ++pb) {
            const int p = 32 * pb + n;
            const float lre = F.A->in[7 + F.z][lg * 64 + p], lim = F.A->in[8 + F.z][lg * 64 + p];
            const float mag = expf(lre * dt); float sn, cs; sincosf(lim * dt, &sn, &cs);
            a_re[pb] = mag * cs; a_im[pb] = mag * sn;
            const float nr = a_re[pb] - 1.0f, ni = a_im[pb], den = 1.0f / (lre * lre + lim * lim);
            const float cr = (nr * lre + ni * lim) * den, ci = (ni * lre - nr * lim) * den;
            const float* br = F.A->in[10 + F.z] + ((size_t)lg * 64 + p) * 16 + 8 * hh; const float* bi = F.A->in[11 + F.z] + ((size_t)lg * 64 + p) * 16 + 8 * hh;
            const f32x4 br0 = *(const GAS f32x4*)br, br1 = *(const GAS f32x4*)(br + 4), bi0 = *(const GAS f32x4*)bi, bi1 = *(const GAS f32x4*)(bi + 4);
            const float rr[8] = {br0.x, br0.y, br0.z, br0.w, br1.x, br1.y, br1.z, br1.w}, ii[8] = {bi0.x, bi0.y, bi0.z, bi0.w, bi1.x, bi1.y, bi1.z, bi1.w};
            unsigned wre[4], wim[4];
#pragma unroll
            for (int j = 0; j < 4; ++j) { const float r0 = rr[2 * j], i0 = ii[2 * j], r1 = rr[2 * j + 1], i1 = ii[2 * j + 1];
                wre[j] = pk2(cr * r0 - ci * i0, cr * r1 - ci * i1); wim[j] = pk2(cr * i0 + ci * r0, cr * i1 + ci * r1); }
            Bf[2 * pb] = __builtin_bit_cast(bf16x8, (v4u){wre[0], wre[1], wre[2], wre[3]});
            Bf[2 * pb + 1] = __builtin_bit_cast(bf16x8, (v4u){wim[0], wim[1], wim[2], wim[3]});
        }
        LAS unsigned char* CFL = F.lds + 8 * 8704 + 8192;
        if (wave == 0) { const int cr_ = n & 15; const float zm = (n < 16) ? 1.0f : 0.0f;
          const float* cre = F.A->in[12 + F.z] + ((size_t)lg * 16 + cr_) * 64 + 4 * hh; const float* cim = F.A->in[13 + F.z] + ((size_t)lg * 16 + cr_) * 64 + 4 * hh;
          f32x4 cr4[8], ci4[8];
#pragma unroll
          for (int ks = 0; ks < 8; ++ks) { cr4[ks] = *(const GAS f32x4*)(cre + 8 * ks); ci4[ks] = *(const GAS f32x4*)(cim + 8 * ks); }
#pragma unroll
          for (int ks = 0; ks < 8; ++ks) { const f32x4 a = cr4[ks] * zm, c = ci4[ks] * (-zm);
              *(LAS v4u*)(CFL + (ks * 64 + lane) * 16) = (v4u){pk2(a.x, c.x), pk2(a.y, c.y), pk2(a.z, c.z), pk2(a.w, c.w)}; } }
        const int seg_own = 2 * wave + hh;
        const int i_row = n, seg_ld = 2 * wave + ((i_row >> 2) & 1), tau_ld = (i_row & 3) + 4 * (i_row >> 3);
        const size_t tok0 = (size_t)b * SEQ + seg_ld * 256 + tau_ld;
        const float* dskip = F.A->in[14 + F.z] + layer * 1024;
        float s_re[2] = {0.f, 0.f}, s_im[2] = {0.f, 0.f};
        ssm_pass<false>(U, Y, stl, dskip, tok0, g, lane, n, hh, i_row, a_re, a_im, Bf, CFL, s_re, s_im);
#pragma unroll
        for (int pb = 0; pb < 2; ++pb) { E[(seg_own * 64 + 32 * pb + n) * 2] = s_re[pb]; E[(seg_own * 64 + 32 * pb + n) * 2 + 1] = s_im[pb]; }
        LDS_WAIT(); __syncthreads();
#pragma unroll
        for (int pb = 0; pb < 2; ++pb) {
            float Ar = a_re[pb], Ai = a_im[pb];
#pragma unroll
            for (int q = 0; q < 8; ++q) { float t = Ar * Ar - Ai * Ai; asm volatile("" : "+v"(t)); Ai = 2.0f * Ar * Ai; asm volatile("" : "+v"(Ai)); Ar = t; }
            float sr = 0.f, si = 0.f;
            for (int j = 0; j < 15; ++j) {
                const float er = E[(j * 64 + 32 * pb + n) * 2], ei = E[(j * 64 + 32 * pb + n) * 2 + 1];
                float tr = Ar * sr - Ai * si + er; asm volatile("" : "+v"(tr)); float ti = Ar * si + Ai * sr + ei; asm volatile("" : "+v"(ti));
                if (j < seg_own) { sr = tr; si = ti; }
            }
            s_re[pb] = sr; s_im[pb] = si;
        }
        __syncthreads();
        ssm_pass<true>(U, Y, stl, dskip, tok0, g, lane, n, hh, i_row, a_re, a_im, Bf, CFL, s_re, s_im);
        __syncthreads();
    }
}

__device__ __forceinline__ void attn_wave_unit(Frame& F, int b, int hd, int qt) {
    const unsigned char* Q = (const unsigned char*)(F.ws + WS_U); const unsigned char* K = (const unsigned char*)(F.ws + WS_KB); const bf16* Vt = (const bf16*)(F.ws + WS_VT); bf16* O = (bf16*)(F.ws + WS_Y);
    constexpr float QK_SC = 0.125f * 1.4426950408889634f;
    constexpr float ATT_EXIT = 28.0f;
    const int lane = F.lane, n = lane & 31, hh = lane >> 5;
    const size_t qrow = (size_t)b * SEQ + 32 * qt + n;
    long qf[4];
#pragma unroll
    for (int ks = 0; ks < 4; ++ks) qf[ks] = *(const GAS long*)(Q + qrow * DM + 64 * hd + 16 * ks + 8 * hh);
    f32x16 o[2]; o[0] = f32x16{}; o[1] = f32x16{};
    float racc = 0.f;
    const int qrel = 32 * qt, myq = qrel + n;
    const int keyi = (n & 3) + 4 * (n >> 3) + 16 * ((n >> 2) & 1);
    const unsigned char* kbase = K + ((size_t)b * SEQ + keyi) * DM + 64 * hd + 8 * hh;
    const bf16* vbase = Vt + (size_t)(64 * hd + n) * TOK + (size_t)b * SEQ + 16 * hh;
    int T = (qrel + 30) >> 6;
    long kf[2][4];
#pragma unroll
    for (int u = 0; u < 2; ++u)
#pragma unroll
        for (int ks = 0; ks < 4; ++ks) kf[u][ks] = *(const GAS long*)(kbase + (size_t)(64 * T + 32 * u) * DM + 16 * ks);
    for (; T >= 0; --T) {
        const int k0 = 64 * T;
        f32x16 s0 = {}, s1 = {};
#pragma unroll
        for (int ks = 0; ks < 4; ++ks) { s0 = __builtin_amdgcn_mfma_f32_32x32x16_fp8_fp8(kf[0][ks], qf[ks], s0, 0, 0, 0); s1 = __builtin_amdgcn_mfma_f32_32x32x16_fp8_fp8(kf[1][ks], qf[ks], s1, 0, 0, 0); }
        bf16x8 vf[2][2][2];
#pragma unroll
        for (int u = 0; u < 2; ++u)
#pragma unroll
            for (int sx = 0; sx < 2; ++sx)
#pragma unroll
                for (int db = 0; db < 2; ++db) vf[u][sx][db] = *(const GAS bf16x8*)(vbase + (size_t)(32 * db) * TOK + k0 + 32 * u + 8 * sx);
        { const int Tn = T > 0 ? T - 1 : 0;
#pragma unroll
          for (int u = 0; u < 2; ++u)
#pragma unroll
              for (int ks = 0; ks < 4; ++ks) kf[u][ks] = *(const GAS long*)(kbase + (size_t)(64 * Tn + 32 * u) * DM + 16 * ks); }
        const bool need_mask = (k0 + 63 >= qrel);
        float sp[2][16], z[2][16];
#pragma unroll
        for (int r = 0; r < 16; ++r) { const float za = fminf(s0[r] * QK_SC, 60.0f), zb = fminf(s1[r] * QK_SC, 60.0f); z[0][r] = za; z[1][r] = zb;
            sp[0][r] = __builtin_amdgcn_logf(1.0f + __builtin_amdgcn_exp2f(za)); sp[1][r] = __builtin_amdgcn_logf(1.0f + __builtin_amdgcn_exp2f(zb)); }
        if (need_mask) {
#pragma unroll
            for (int u = 0; u < 2; ++u)
#pragma unroll
                for (int r = 0; r < 16; ++r) { const int key = k0 + 32 * u + 16 * hh + r; if (key >= myq) { sp[u][r] = 0.f; z[u][r] = -1e30f; } }
        }
        float T0 = 0.f, T1 = 0.f;
#pragma unroll
        for (int r = 0; r < 16; ++r) { T0 += sp[0][r]; T1 += sp[1][r]; }
        const float oT0 = __shfl_xor(T0, 32), oT1 = __shfl_xor(T1, 32);
        const float off1 = racc + (hh ? 0.f : oT1);
        const float off0 = racc + T1 + oT1 + (hh ? 0.f : oT0);
        racc += T0 + T1 + oT0 + oT1;
        unsigned pw[2][8];
        { float run = off1;
#pragma unroll
          for (int r = 15; r >= 0; --r) { run += sp[1][r]; z[1][r] = __builtin_amdgcn_exp2f(z[1][r] - run); }
          run = off0;
#pragma unroll
          for (int r = 15; r >= 0; --r) { run += sp[0][r]; z[0][r] = __builtin_amdgcn_exp2f(z[0][r] - run); } }
#pragma unroll
        for (int u = 0; u < 2; ++u)
#pragma unroll
            for (int q = 0; q < 8; ++q) pw[u][q] = cvt_pk_bf16(z[u][2 * q], z[u][2 * q + 1]);
#pragma unroll
        for (int u = 0; u < 2; ++u)
#pragma unroll
            for (int sx = 0; sx < 2; ++sx) { const bf16x8 af = __builtin_bit_cast(bf16x8, (v4u){pw[u][4 * sx], pw[u][4 * sx + 1], pw[u][4 * sx + 2], pw[u][4 * sx + 3]});
#pragma unroll
                for (int db = 0; db < 2; ++db) o[db] = __builtin_amdgcn_mfma_f32_32x32x16_bf16(af, vf[u][sx][db], o[db], 0, 0, 0); }
        if (__all(racc >= ATT_EXIT)) break;
    }
#pragma unroll
    for (int db = 0; db < 2; ++db)
#pragma unroll
        for (int r = 0; r < 16; ++r) { const int qr = (r & 3) + 8 * (r >> 2) + 4 * hh;
            ((unsigned char*)O)[((size_t)b * SEQ + 32 * qt + qr) * DM + 64 * hd + 32 * db + n] = (unsigned char)(pk4_fp8(o[db][r], 0.f, 0.f, 0.f) & 0xffu); }
}
__device__ __forceinline__ void attn_phase(Frame& F) {
    const int gw = F.vcu * NWAVES + F.wave, NGW = F.G * NWAVES;
#pragma unroll 1
    for (int uidx = gw; uidx < 64 * 128; uidx += NGW) { const int bh = uidx >> 7; attn_wave_unit(F, bh >> 4, bh & 15, uidx & 127); }
}

typedef float f32x2 __attribute__((ext_vector_type(2)));
typedef _Float16 h16x2 __attribute__((ext_vector_type(2)));
template <int K, class T> __device__ __forceinline__ T xcomb(T a, T b, int lane) {
    const bool hi = (lane >> K) & 1; const T keep = hi ? b : a, send = hi ? a : b;
    return keep + __shfl_xor(send, 1 << K);
}
__device__ __forceinline__ void fp4x16_to_f32(const v2u& r, f32x2 (&f)[8]) {
    const unsigned w0 = r.x, w1 = r.y;
    f[0] = __builtin_amdgcn_cvt_scalef32_pk_f32_fp4(w0, 1.0f, 0); f[1] = __builtin_amdgcn_cvt_scalef32_pk_f32_fp4(w0, 1.0f, 1);
    f[2] = __builtin_amdgcn_cvt_scalef32_pk_f32_fp4(w0, 1.0f, 2); f[3] = __builtin_amdgcn_cvt_scalef32_pk_f32_fp4(w0, 1.0f, 3);
    f[4] = __builtin_amdgcn_cvt_scalef32_pk_f32_fp4(w1, 1.0f, 0); f[5] = __builtin_amdgcn_cvt_scalef32_pk_f32_fp4(w1, 1.0f, 1);
    f[6] = __builtin_amdgcn_cvt_scalef32_pk_f32_fp4(w1, 1.0f, 2); f[7] = __builtin_amdgcn_cvt_scalef32_pk_f32_fp4(w1, 1.0f, 3);
}
typedef unsigned bl_v2u __attribute__((__vector_size__(8)));
__device__ __forceinline__ void peer_load8(__amdgpu_buffer_rsrc_t tab, int idv, int e0, int lane, v2u (&R)[8]) {
    int so[8];
    __builtin_amdgcn_s_setprio(1);
#pragma unroll
    for (int i = 0; i < 8; ++i) so[i] = __builtin_amdgcn_readlane(idv, e0 + i) << 9;
    __builtin_amdgcn_sched_barrier(0);
#pragma unroll
    for (int i = 0; i < 8; ++i) { const bl_v2u t = __builtin_amdgcn_raw_buffer_load_b64(tab, 8 * lane, so[i], 0); R[i] = (v2u){t[0], t[1]}; }
    __builtin_amdgcn_s_setprio(0);
    __builtin_amdgcn_sched_barrier(0);
}
template <int K> __device__ __forceinline__ int xcomb_dpp(int a, int b, int lane) {
    const bool hi = (lane >> K) & 1; const int keep = hi ? b : a, send = hi ? a : b; int recv;
    if (K == 0) recv = __builtin_amdgcn_update_dpp(0, send, 0xB1, 0xF, 0xF, true);
    else if (K == 1) recv = __builtin_amdgcn_update_dpp(0, send, 0x4E, 0xF, 0xF, true);
    else { recv = __builtin_amdgcn_update_dpp(0, send, 0x104, 0xF, 0x5, true);
           recv = __builtin_amdgcn_update_dpp(recv, send, 0x114, 0xF, 0xA, true); }
    return keep + recv;
}
__device__ __forceinline__ float peer_dot8(const v2u (&R)[8], const v2u& xhi, const v2u& xlo, int lane) {
    int p[8];
#pragma unroll
    for (int i = 0; i < 8; i += 2) {
        int h0 = __builtin_amdgcn_sdot8((int)R[i].x, (int)xhi.x, 0, false), h1 = __builtin_amdgcn_sdot8((int)R[i + 1].x, (int)xhi.x, 0, false);
        int l0 = __builtin_amdgcn_sdot8((int)R[i].x, (int)xlo.x, 0, false), l1 = __builtin_amdgcn_sdot8((int)R[i + 1].x, (int)xlo.x, 0, false);
        h0 = __builtin_amdgcn_sdot8((int)R[i].y, (int)xhi.y, h0, false); h1 = __builtin_amdgcn_sdot8((int)R[i + 1].y, (int)xhi.y, h1, false);
        l0 = __builtin_amdgcn_sdot8((int)R[i].y, (int)xlo.y, l0, false); l1 = __builtin_amdgcn_sdot8((int)R[i + 1].y, (int)xlo.y, l1, false);
        p[i] = (h0 << 4) + l0; p[i + 1] = (h1 << 4) + l1; __builtin_amdgcn_sched_barrier(0); }
    int q[4];
#pragma unroll
    for (int i = 0; i < 4; ++i) q[i] = xcomb_dpp<0>(p[2 * i], p[2 * i + 1], lane);
    const int r0 = xcomb_dpp<1>(q[0], q[1], lane), r1 = xcomb_dpp<1>(q[2], q[3], lane);
    int v = xcomb_dpp<2>(r0, r1, lane);
    v += __builtin_amdgcn_update_dpp(0, v, 0x128, 0xF, 0xF, true);
    { const auto t = __builtin_amdgcn_permlane16_swap((unsigned)v, (unsigned)v, false, false); v = (int)(t[0] + t[1]); }
    { const auto t = __builtin_amdgcn_permlane32_swap((unsigned)v, (unsigned)v, false, false); v = (int)(t[0] + t[1]); }
    return (float)v;
}
__device__ __forceinline__ void peer_fma8(const v2u (&R)[8], unsigned wvh, int e0, h16x2 (&o)[8]) {
#pragma unroll
    for (int i = 0; i < 8; ++i) { const unsigned wt = (unsigned)__builtin_amdgcn_readlane((int)wvh, e0 + i); const h16x2 w2 = __builtin_bit_cast(h16x2, wt);
        const unsigned w0 = R[i].x, w1 = R[i].y; h16x2 f[8];
        f[0] = __builtin_amdgcn_cvt_scalef32_pk_f16_fp4(w0, 1.0f, 0); f[1] = __builtin_amdgcn_cvt_scalef32_pk_f16_fp4(w0, 1.0f, 1);
        f[2] = __builtin_amdgcn_cvt_scalef32_pk_f16_fp4(w0, 1.0f, 2); f[3] = __builtin_amdgcn_cvt_scalef32_pk_f16_fp4(w0, 1.0f, 3);
        f[4] = __builtin_amdgcn_cvt_scalef32_pk_f16_fp4(w1, 1.0f, 0); f[5] = __builtin_amdgcn_cvt_scalef32_pk_f16_fp4(w1, 1.0f, 1);
        f[6] = __builtin_amdgcn_cvt_scalef32_pk_f16_fp4(w1, 1.0f, 2); f[7] = __builtin_amdgcn_cvt_scalef32_pk_f16_fp4(w1, 1.0f, 3);
#pragma unroll
        for (int k = 0; k < 8; ++k) o[k] = __builtin_elementwise_fma(w2, f[k], o[k]);
        __builtin_amdgcn_sched_barrier(0); }
}
__device__ __forceinline__ void peer_phase(Frame& F, int layer) {
    const bf16* H1 = (const bf16*)(F.ws + WS_H1); bf16* H2 = (bf16*)(F.ws + WS_H2);
    const __amdgpu_buffer_rsrc_t TU = __builtin_amdgcn_make_buffer_rsrc((void*)(F.ws + WS_TABU + (size_t)layer * 16384 * 512), (short)0, 16384 * 512, 0x00020000);
    const __amdgpu_buffer_rsrc_t TV = __builtin_amdgcn_make_buffer_rsrc((void*)(F.ws + WS_TABV + (size_t)layer * 16384 * 512), (short)0, 16384 * 512, 0x00020000);
    const int* IDX = (const int*)(F.ws + WS_IDX); const float* GATE = (const float*)(F.ws + WS_GATE);
    const float* g = F.A->in[4 + F.z] + layer * 1024; const float* bb = F.A->in[5 + F.z] + layer * 1024;
    const int lane = F.lane, gw = F.vcu * NWAVES + F.wave, NGW = F.G * NWAVES;
    v2u B0[8], B1[8], B2[8], B3[8];
    TabCvt TC; { const size_t lo = (size_t)(layer + 1) * 16384 * 1024;
        TC.su = F.A->in[24 + F.z] + lo; TC.sv = F.A->in[25 + F.z] + lo; TC.du = (unsigned char*)(F.ws + WS_TABU) + lo / 2; TC.dv = (unsigned char*)(F.ws + WS_TABV) + lo / 2;
        TC.c = gw; TC.cf = gw; TC.stride = NGW; TC.n = (layer + 1 < DEPTH) ? 2 * 16384 : 0; }
    f32x4 cvA[4], cvB[4];
    int id0 = 0, id1 = 0;
    if (gw < TOK) { id0 = IDX[(size_t)gw * 128 + lane]; id1 = IDX[(size_t)gw * 128 + 64 + lane];
        peer_load8(TU, id0, 0, lane, B0); peer_load8(TU, id0, 8, lane, B1); peer_load8(TU, id0, 16, lane, B2); }
    tabcvt_issue(TC, lane, cvA); tabcvt_issue(TC, lane, cvB);
    for (int t = gw; t < TOK; t += NGW) {
        const int tn = (t + NGW < TOK) ? t + NGW : t;
        const int nid0 = IDX[(size_t)tn * 128 + lane], nid1 = IDX[(size_t)tn * 128 + 64 + lane];
        const float g0 = GATE[(size_t)t * 128 + lane], g1 = GATE[(size_t)t * 128 + 64 + lane];
        const v4u xa = *(const GAS v4u*)(H1 + (size_t)t * DM + 16 * lane), xb = *(const GAS v4u*)(H1 + (size_t)t * DM + 16 * lane + 8);
        f32x2 x[8] = {{bf_lo(xa.x), bf_hi(xa.x)}, {bf_lo(xa.y), bf_hi(xa.y)}, {bf_lo(xa.z), bf_hi(xa.z)}, {bf_lo(xa.w), bf_hi(xa.w)}, {bf_lo(xb.x), bf_hi(xb.x)}, {bf_lo(xb.y), bf_hi(xb.y)}, {bf_lo(xb.z), bf_hi(xb.z)}, {bf_lo(xb.w), bf_hi(xb.w)}};
        v2u xqh = {0u, 0u}, xql = {0u, 0u};
#pragma unroll
        for (int i = 0; i < 16; ++i) { const float xv = (i & 1) ? x[i >> 1].y : x[i >> 1].x;
            float qf = __builtin_fminf(__builtin_fmaxf(xv * 16.f, -120.f), 119.f) + 12582912.0f; asm volatile("" : "+v"(qf)); const unsigned q = __builtin_bit_cast(unsigned, qf);
            const unsigned lo = q & 15u, hi = ((q + 8u) >> 4) & 15u;
            if (i < 8) { xql.x |= lo << (4 * i); xqh.x |= hi << (4 * i); } else { xql.y |= lo << (4 * (i - 8)); xqh.y |= hi << (4 * (i - 8)); } }
#define PEER_LOADB(buf, b) do { const int b_ = (b); if (b_ < 32) peer_load8((b_ & 16) ? TV : TU, (b_ & 8) ? id1 : id0, 8 * (b_ & 7), lane, buf); else peer_load8(TU, nid0, 8 * (b_ & 7), lane, buf); } while (0)
#define PEER_DOTB(buf, b) do { const int b_ = (b); const float r_ = peer_dot8(buf, xqh, xql, lane); const bool mine_ = (lane >> 3) == (b_ & 7); if (b_ & 8) act1 = mine_ ? r_ : act1; else act0 = mine_ ? r_ : act0; } while (0)
#define PEER_FMAB(buf, b) do { const int b_ = (b); peer_fma8(buf, (b_ & 8) ? w1h : w0h, 8 * (b_ & 7), o); } while (0)
        float act0 = 0.f, act1 = 0.f;
#pragma unroll 1
        for (int j = 0; j < 16; j += 4) {
            PEER_LOADB(B3, j + 3); PEER_DOTB(B0, j);
            PEER_LOADB(B0, j + 4); PEER_DOTB(B1, j + 1);
            PEER_LOADB(B1, j + 5); PEER_DOTB(B2, j + 2);
            PEER_LOADB(B2, j + 6); PEER_DOTB(B3, j + 3);
        }
        const float w0 = g0 * gelu_tanh(act0 * (1.0f / (16.f * PEER_SU))) * (1.0f / PEER_SV), w1 = g1 * gelu_tanh(act1 * (1.0f / (16.f * PEER_SU))) * (1.0f / PEER_SV);
        unsigned w0h, w1h; { const _Float16 a = (_Float16)w0, b = (_Float16)w1; const h16x2 pa = {a, a}, pb = {b, b}; w0h = __builtin_bit_cast(unsigned, pa); w1h = __builtin_bit_cast(unsigned, pb); }
        h16x2 o[8];
#pragma unroll
        for (int i = 0; i < 8; ++i) o[i] = (h16x2){(_Float16)0.f, (_Float16)0.f};
#pragma unroll 1
        for (int j = 16; j < 32; j += 4) {
            PEER_LOADB(B3, j + 3); PEER_FMAB(B0, j);
            PEER_LOADB(B0, j + 4); PEER_FMAB(B1, j + 1);
            PEER_LOADB(B1, j + 5); PEER_FMAB(B2, j + 2);
            PEER_LOADB(B2, j + 6); PEER_FMAB(B3, j + 3);
        }
#undef PEER_LOADB
#undef PEER_DOTB
#undef PEER_FMAB
        id0 = nid0; id1 = nid1;
        tabcvt_finish(TC, lane, cvA); tabcvt_finish(TC, lane, cvB);
        tabcvt_issue(TC, lane, cvA); tabcvt_issue(TC, lane, cvB);
        float y[16]; float sm = 0.f;
#pragma unroll
        for (int i = 0; i < 8; ++i) { y[2 * i] = pg8::ALPHA_F * x[i].x + (float)o[i].x; y[2 * i + 1] = pg8::ALPHA_F * x[i].y + (float)o[i].y; sm += y[2 * i] + y[2 * i + 1]; }
        const float mean = wave_sum_dpp(sm) * (1.f / DM); float q = 0.f;
#pragma unroll
        for (int i = 0; i < 16; ++i) { y[i] -= mean; q += y[i] * y[i]; }
        const float rstd = 1.0f / sqrtf(wave_sum_dpp(q) * (1.f / DM) + LN_EPS);
#pragma unroll
        for (int c = 0; c < 4; ++c) { const f32x4 gv = *(const GAS f32x4*)(g + 16 * lane + 4 * c), bv = *(const GAS f32x4*)(bb + 16 * lane + 4 * c);
            y[4 * c] = y[4 * c] * rstd * gv.x + bv.x; y[4 * c + 1] = y[4 * c + 1] * rstd * gv.y + bv.y; y[4 * c + 2] = y[4 * c + 2] * rstd * gv.z + bv.z; y[4 * c + 3] = y[4 * c + 3] * rstd * gv.w + bv.w; }
        v4u oa, ob; oa.x = pk2(y[0], y[1]); oa.y = pk2(y[2], y[3]); oa.z = pk2(y[4], y[5]); oa.w = pk2(y[6], y[7]); ob.x = pk2(y[8], y[9]); ob.y = pk2(y[10], y[11]); ob.z = pk2(y[12], y[13]); ob.w = pk2(y[14], y[15]);
        *(GAS v4u*)(H2 + (size_t)t * DM + 16 * lane) = oa; *(GAS v4u*)(H2 + (size_t)t * DM + 16 * lane + 8) = ob;
        *(GAS v4u*)((unsigned char*)(F.ws + WS_H28) + (size_t)t * DM + 16 * lane) = (v4u){pk4_fp8(y[0], y[1], y[2], y[3]), pk4_fp8(y[4], y[5], y[6], y[7]), pk4_fp8(y[8], y[9], y[10], y[11]), pk4_fp8(y[12], y[13], y[14], y[15])};
    }
    tabcvt_finish(TC, lane, cvA); tabcvt_finish(TC, lane, cvB);
    while (TC.cf < TC.n) { tabcvt_issue(TC, lane, cvA); tabcvt_finish(TC, lane, cvA); }
}

template <class Epi> __device__ __forceinline__ void run_gemm(Frame& F, const bf16* A, const bf16* Bt, int M, int N, int K, const Epi& E, int pw = 0) {
    pg8::Gemm g{A, Bt, M, N, K}; pg8::StaticOrder S; S.init(M, N, F.G, pw ? F.vcu : F.bx); S.pw = pw; if (pw) S.nwg = 1024;
    int t = F.tid; asm volatile("" : "+v"(t));
    pg8::gemm_phase<Epi, pg8::StaticOrder, true, true>(F.lds, g, S, E, t);
}

template <class Epi> __device__ __forceinline__ void run_gemm8(Frame& F, const unsigned char* A8, const unsigned char* Bt8, int M, int N, int Kbytes, const Epi& E) {
    pg8::Gemm g{(const bf16*)A8, (const bf16*)Bt8, M, N, Kbytes / 2 + F.z  }; pg8::StaticOrder S; S.init(M, N, F.G, F.bx);
    int t = F.tid; asm volatile("" : "+v"(t));
    pg8::gemm_phase<Epi, pg8::StaticOrder, true, true, true>(F.lds, g, S, E, t);
}

__global__ void __launch_bounds__(NWAVES * 64, 2) mega_fwd(Args args) {
    extern __shared__ __attribute__((aligned(16))) unsigned char lds[];
    Frame F;
    F.lds = (LAS unsigned char*)lds;
    F.tid = threadIdx.x; F.lane = F.tid & 63; F.wave = 0; F.G = gridDim.x; F.bx = blockIdx.x; F.vcu = 0;
    F.A = &args; F.z = 0; F.out = args.out; F.ws = args.ws;
    const int wave_s = __builtin_amdgcn_readfirstlane((int)threadIdx.x >> 6);
    volatile LAS unsigned* MISC = (volatile LAS unsigned*)(F.lds + MISC_OFF);
    if (F.tid < 64) MISC[F.tid] = 0u;
    __syncthreads();
    XcdBarrier bar; bar.bar = (unsigned*)(F.ws + WS_CTL) + CW_BAR; bar.x = 0; bar.st = nullptr;
    if (args.use_bar) bar = xcd_barrier_post((unsigned*)(F.ws + WS_CTL) + CW_BAR, MISC + 8);

    for (int pc = args.ph_lo; pc < args.ph_hi; ++pc) {
        { int z = 0; asm volatile("" : "+s"(z)); int t = wave_s * 64 + (int)__builtin_amdgcn_mbcnt_hi(~0u, __builtin_amdgcn_mbcnt_lo(~0u, (unsigned)z)); asm volatile("" : "+v"(t));
          F.z = z; F.ws = args.ws + z; F.tid = t; F.lane = t & 63; F.wave = __builtin_amdgcn_readfirstlane(t >> 6);
          F.G = (int)gridDim.x + z; F.bx = (int)blockIdx.x + z; F.vcu = (F.G % 8 == 0) ? (F.bx % 8) * (F.G / 8) + F.bx / 8 : F.bx; }
        bf16* const H = (bf16*)(F.ws + WS_H); bf16* const U = (bf16*)(F.ws + WS_U); bf16* const Y = (bf16*)(F.ws + WS_Y); bf16* const X1 = (bf16*)(F.ws + WS_X1);
        bf16* const H1 = (bf16*)(F.ws + WS_H1); bf16* const H2 = (bf16*)(F.ws + WS_H2); bf16* const KB = (bf16*)(F.ws + WS_KB); bf16* const VT = (bf16*)(F.ws + WS_VT); bf16* const HKV = (bf16*)(F.ws + WS_HKV);
        const int ty = args.ph_type[pc], la = args.ph_arg[pc];
#ifndef PHMASK
#define PHMASK 0xFFFF
#endif
#define EN(x) ((PHMASK >> (x)) & 1)
        switch (ty) {
        case P_PROLOGUE: if (EN(P_PROLOGUE)) p0_prologue(F); break;
        case P_STORE: if (EN(P_STORE)) {
            const int njobs = (la == 0) ? 2 : (la == 2) ? 3 : 1;
            for (int j = 0; j < njobs; ++j) {
                const bf16* A; const bf16* Bt; int M = TOK, N = 1024, K = 1024, ldc = 1024, pw = 0; bf16* O; float sc = 1.0f;
                if (la == 0 && j == 0) { A = (const bf16*)(F.ws + WS_PB); Bt = (const bf16*)(F.ws + WS_W_PW); K = 256; O = (bf16*)(F.ws + WS_PW); pw = 1; }
                else if (la == 0) { A = H; Bt = (const bf16*)(F.ws + WS_W_IN); O = U; }
                else if (la == 1) { A = H; Bt = (const bf16*)(F.ws + WS_W_IN) + (size_t)1024 * 1024; O = U; }
                else if (la == 2 && j == 1) { A = HKV; Bt = (const bf16*)(F.ws + WS_W_KV); O = KB; }
                else if (la == 2 && j == 2) { A = (const bf16*)(F.ws + WS_W_KV) + (size_t)1024 * 1024; Bt = HKV; M = 1024; N = TOK; ldc = TOK; O = VT; }
                else { A = H; Bt = (const bf16*)(F.ws + WS_W_SQ) + (size_t)(la - 2) * 1024 * 1024; O = U; sc = 0.125f * 1.4426950408889634f; }
                if (!pw) {
                    const unsigned char* A8; const unsigned char* B8;
                    if (la <= 1) { A8 = (const unsigned char*)(F.ws + WS_H8); B8 = (const unsigned char*)(F.ws + W8_IN) + (size_t)la * 1024 * 1024; }
                    else if (la == 2 && j == 1) { A8 = (const unsigned char*)(F.ws + WS_HKV); B8 = (const unsigned char*)(F.ws + W8_KV); }
                    else if (la == 2 && j == 2) { A8 = (const unsigned char*)(F.ws + W8_KV) + (size_t)1024 * 1024; B8 = (const unsigned char*)(F.ws + WS_HKV); }
                    else { A8 = (const unsigned char*)(F.ws + WS_H8); B8 = (const unsigned char*)(F.ws + W8_SQ) + (size_t)(la - 2) * 1024 * 1024; }
                    const int f8o = (la >= 2 && j != 2) ? 1 : 0;
                    pg8::EpiStore E{O, ldc, (f8o ? 1.0f : sc) * (1.0f / W8_SCALE), -1, f8o};
                    run_gemm8(F, A8, B8, M, N, 1024, E);
                } else {
                    pg8::EpiStore E{O, ldc, sc, pw ? 3 : -1, pw ? 1 : 0};
                    run_gemm(F, A, Bt, M, N, K, E, pw);
                }
            }
        } break;
        case P_SSM: if (EN(P_SSM)) ssm_phase(F, la); break;
        case P_GLU: if (EN(P_GLU)) { pg8::EpiGlu E{H, X1}; run_gemm8(F, (const unsigned char*)Y, (const unsigned char*)(F.ws + W8_GLU) + (size_t)la * 2048 * 1024, TOK, 2048, 1024, E); } break;
        case P_LNMIX: if (EN(P_LNMIX)) ln_rows(F, X1, F.A->in[2 + F.z] + la * 1024, F.A->in[3 + F.z] + la * 1024, H1, (unsigned char*)(F.ws + WS_H18)); break;
        case P_TOPK: if (EN(P_TOPK)) {
            pg8::EpiTopk E{(int*)(F.ws + WS_IDX), (float*)(F.ws + WS_GATE)};
            pg8::Gemm g{(const bf16*)(F.ws + WS_H18), (const bf16*)((const unsigned char*)(F.ws + W8_EFF) + (size_t)la * 2048 * 1024), TOK, 2048, 512 + F.z};
            for (int r = 0; r < 2; ++r) { pg8::OneUnitOrder S; S.base.init(TOK, 2048, F.G, F.bx); S.round = r;
                int t = F.tid; asm volatile("" : "+v"(t)); pg8::gemm_phase<pg8::EpiTopk, pg8::OneUnitOrder, false, true, true>(F.lds, g, S, E, t); }
        } break;
        case P_PEER: if (EN(P_PEER)) peer_phase(F, la); break;
        case P_PLE: if (EN(P_PLE)) { pg8::EpiPle E{H2, (const unsigned char*)(F.ws + WS_PW) + (size_t)la * TOK * 1024, H, (la == DEPTH - 1) ? F.out : nullptr, (unsigned char*)(F.ws + WS_H8)};
            run_gemm8(F, (const unsigned char*)(F.ws + WS_H28), (const unsigned char*)(F.ws + W8_PG) + (size_t)la * 1024 * 1024, TOK, 1024, 1024, E); } break;
        case P_LNKV: if (EN(P_LNKV)) ln_rows(F, H, F.A->in[16 + F.z], F.A->in[17 + F.z], nullptr, (unsigned char*)HKV); break;
        case P_ATTN: if (EN(P_ATTN)) attn_phase(F); break;
        case P_RES: if (EN(P_RES)) { pg8::EpiRes E{H, X1}; run_gemm8(F, (const unsigned char*)Y, (const unsigned char*)(F.ws + W8_SO) + (size_t)(la - 2) * 1024 * 1024, TOK, 1024, 1024, E); } break;
        default: break;
        }
        if (pc + 1 < args.ph_hi) xcd_barrier(bar);
    }
}

#ifndef N_LAUNCH_MODE
#define N_LAUNCH_MODE 1
#endif
extern "C" void kernel_launch(void* const* d_in, const int* in_sizes, int n_in, void* d_out, int out_size, void* d_ws, size_t ws_size, hipStream_t stream) {
    static int grid = 0;
    if (grid == 0) {
        if (n_in != 28 || out_size != TOK * DM || ws_size < WS_END) { fprintf(stderr, "kernel_launch: unexpected shapes/workspace (n_in %d, out %d, ws %zu)\n", n_in, out_size, ws_size); grid = -1; return; }
        int dev = 0, cus = 0;
        if (hipGetDevice(&dev) != hipSuccess || hipDeviceGetAttribute(&cus, hipDeviceAttributeMultiprocessorCount, dev) != hipSuccess) { grid = -1; return; }
        if (hipFuncSetAttribute((const void*)mega_fwd, hipFuncAttributeMaxDynamicSharedMemorySize, LDS_BYTES) != hipSuccess) { fprintf(stderr, "kernel_launch: hipFuncSetAttribute failed\n"); grid = -1; return; }
        (void)hipGetLastError();
        grid = cus;
    }
    if (grid < 0) return;
    hipMemsetAsync((char*)d_ws + WS_CTL, 0, CTL_ZERO_BYTES, stream);
    Args a{};
    for (int i = 0; i < 28; ++i) a.in[i] = (const float*)d_in[i];
    a.out = (float*)d_out; a.ws = (unsigned char*)d_ws;
    int n = 0;
#ifndef REP_TYPE
#define REP_TYPE -1
#endif
    auto add = [&](int t, int l) { for (int r = 0; r < ((t == REP_TYPE) ? 2 : 1); ++r) { a.ph_type[n] = (unsigned char)t; a.ph_arg[n] = (unsigned char)l; ++n; } };
    add(P_PROLOGUE, 0); add(P_STORE, 0);
    for (int l = 0; l < DEPTH; ++l) {
        if (l < 2) { if (l == 1) add(P_STORE, 1); add(P_SSM, l); add(P_GLU, l); }
        else { if (l == 2) add(P_LNKV, 0); add(P_STORE, l); add(P_ATTN, l); add(P_RES, l); }
        add(P_LNMIX, l); add(P_TOPK, l); add(P_PEER, l); add(P_PLE, l);
    }
    a.nph = n;
    if (N_LAUNCH_MODE == 1) {
        a.ph_lo = 0; a.ph_hi = n; a.use_bar = 1;
        hipLaunchKernelGGL(mega_fwd, dim3(grid), dim3(NWAVES * 64), LDS_BYTES, stream, a);
    } else {
        a.use_bar = 0;
        for (int i = 0; i < n; ++i) { a.ph_lo = i; a.ph_hi = i + 1; hipLaunchKernelGGL(mega_fwd, dim3(grid), dim3(NWAVES * 64), LDS_BYTES, stream, a); }
    }
}
```

```cpp
#include <hip/hip_runtime.h>
#include <cstdio>
#include <cstdint>
#include <cmath>
namespace pg8 {
#define PG8_LAS __attribute__((address_space(3)))
typedef unsigned short bf16_t;
typedef short bf16x8 __attribute__((ext_vector_type(8)));
typedef float f32x4 __attribute__((ext_vector_type(4)));
typedef unsigned u32x4 __attribute__((ext_vector_type(4)));
constexpr int BM = 256, BK = 64, HALF = 128, HTB = HALF * BK * 2  , STAGE_BYTES = 8 * HTB, NXCD = 8, WGM = 8;

__host__ __device__ __forceinline__ int lds_byte(int r, int c) { const int st = (r >> 4) * 2 + (c >> 5), rr = r & 15, cc = c & 31, ob = rr * 64 + cc * 2; return st * 1024 + (ob ^ (((ob >> 9) & 1) << 5)); }
__host__ __device__ __forceinline__ void stage_rc(int b, int& R, int& C) { const int st = b / 1024, sb = b % 1024, swz = sb ^ (((sb >> 9) & 1) << 5); R = (st >> 1) * 16 + swz / 64; C = (st & 1) * 32 + (swz % 64) / 2; }
__host__ __device__ __forceinline__ int perm32(int rho) { const int n = rho >> 4, i = rho & 15; return 8 * (i >> 2) + 4 * n + (i & 3); }

struct Unit { int pm, pn; };
struct Gemm { const bf16_t* A; const bf16_t* Bt; int M, N, K; };

struct StaticOrder {
    int nM, nN, nwg, G, c;
    __host__ __device__ void init(int M, int N, int G_, int c_) { nM = M / BM; nN = N / BM; nwg = nM * nN; G = G_; c = c_; pw = 0; }
    int pw;
    __host__ __device__ bool next(int i, Unit& u) const {
        const long L = (long)i * G + c; if (L >= nwg) return false;
        if (pw) { const int l = (int)L >> 8, rem = (int)L & 255; u.pm = l * 64 + (rem >> 2); u.pn = l * 4 + (rem & 3); return true; }
        int wgid = (int)L; { const int q = nwg / NXCD, r = nwg % NXCD, xcd = wgid % NXCD, off = wgid / NXCD; wgid = (xcd < r ? xcd * (q + 1) : r * (q + 1) + (xcd - r) * q) + off; }
        const int nig = WGM * nN, gid = wgid / nig, fm = gid * WGM, gsz = (nM - fm) < WGM ? (nM - fm) : WGM;
        u.pm = fm + ((wgid % nig) % gsz); u.pn = (wgid % nig) / gsz; return true;
    }
    __device__ __forceinline__ void a_ready(const Unit&) const {}
    __device__ __forceinline__ void done(const Unit&) const {}
};

typedef float f32x2c_t __attribute__((ext_vector_type(2))); typedef __bf16 bf16x2c_t __attribute__((ext_vector_type(2)));
__device__ __forceinline__ unsigned cvt_pk_bf16(float lo, float hi) { f32x2c_t v = {lo, hi}; bf16x2c_t b = __builtin_convertvector(v, bf16x2c_t); return __builtin_bit_cast(unsigned, b); }
typedef float f32x2 __attribute__((ext_vector_type(2)));
typedef int v8i32_t __attribute__((ext_vector_type(8)));
typedef unsigned u32x8_t __attribute__((ext_vector_type(8)));
template <bool F8> struct Frag { bf16x8 k[2]; };
template <> struct Frag<true> { v8i32_t v; };
template <class Epi, class Sched, bool ALIGN_EPI = false, bool SP2 = false, bool F8 = false>
__device__ __forceinline__ void gemm_phase(PG8_LAS unsigned char* lds, const Gemm g, const Sched& S, const Epi& E, const int tid) {
    const int wid = __builtin_amdgcn_readfirstlane(tid >> 6), lane = tid & 63, wr = wid >> 2, wc = wid & 3, fr = lane & 15, fq = lane >> 4;
    const int K = g.K, nt = K / BK;
    unsigned voffA[1], voffB[1];
    { int R, C; stage_rc(tid * 16, R, C); const int Rb = Epi::PERM ? ((R & ~31) + perm32(R & 31)) : R;
        voffA[0] = (unsigned)(R * K + C) * 2u; voffB[0] = (unsigned)(Rb * K + C) * 2u; }
    const size_t r64 = (size_t)128 * K;
    const size_t kstep = (size_t)(BK * 2);
    const size_t hstep = (size_t)HALF * K * 2;
    const size_t tstep = 2 * hstep;
    const unsigned ldsw = (unsigned)wid * 1024u;
    const int aoff = lds_byte(wr * 64 + fr, F8 ? fq * 16 : fq * 8), boff = lds_byte(wc * 32 + fr, F8 ? fq * 16 : fq * 8);
#define PG8_SA(b, h) (((b) * 2 + (h)) * HTB)
#define PG8_SB(b, h) ((4 + (b) * 2 + (h)) * HTB)
#define PG8_STAGE(bufoff, gbase, voff) do { _Pragma("unroll") for (int _i = 0; _i < 2; ++_i) \
        __builtin_amdgcn_global_load_lds((const unsigned*)((const char*)(gbase) + _i * r64 + (voff)[0]), (PG8_LAS unsigned*)(lds + (bufoff) + ldsw + _i * 8192), 16, 0, 0); } while (0)
#define PG8_LDF(d, addr) do { if constexpr (F8) { const u32x4 lo_ = *(const PG8_LAS u32x4*)(addr), hi_ = *(const PG8_LAS u32x4*)((addr) + 16); d.v = __builtin_bit_cast(v8i32_t, (u32x8_t){lo_[0], lo_[1], lo_[2], lo_[3], hi_[0], hi_[1], hi_[2], hi_[3]}); } \
        else { d.k[0] = *(const PG8_LAS bf16x8*)(addr); d.k[1] = *(const PG8_LAS bf16x8*)((addr) + 1024); } } while (0)
#define PG8_LDA(dst, b, h) do { _Pragma("unroll") for (int m = 0; m < 4; ++m) PG8_LDF(dst[m], lds + PG8_SA(b, h) + aoff + m * 2048); } while (0)
#define PG8_LDB(dst, b, h) do { _Pragma("unroll") for (int n = 0; n < 2; ++n) PG8_LDF(dst[n], lds + PG8_SB(b, h) + boff + n * 2048); } while (0)
#define PG8_MMA(ai, bj, At, Bt) do { __builtin_amdgcn_s_setprio(1); _Pragma("unroll") for (int m = 0; m < 4; ++m) _Pragma("unroll") for (int n = 0; n < 2; ++n) { \
        if constexpr (F8) asm volatile("v_mfma_f32_16x16x128_f8f6f4 %0, %1, %2, %0" : "+v"(acc[ai][bj][m][n]) : "v"(Bt[n].v), "v"(At[m].v));   \
        else { _Pragma("unroll") for (int k = 0; k < 2; ++k) acc[ai][bj][m][n] = __builtin_amdgcn_mfma_f32_16x16x32_bf16(Bt[n].k[k], At[m].k[k], acc[ai][bj][m][n], 0, 0, 0); } } __builtin_amdgcn_s_setprio(0); } while (0)
#define PG8_WAIT_V(n) asm volatile("s_waitcnt vmcnt(" #n ")" ::: "memory")
#define PG8_WAIT_L(n) asm volatile("s_waitcnt lgkmcnt(" #n ")" ::: "memory")
#define PG8_BAR __builtin_amdgcn_s_barrier()
#define PG8_SCHED __builtin_amdgcn_sched_barrier(0)
    Unit cur, nxt; int ui = 0;
    if (!S.next(0, cur)) return;
    f32x4 acc[2][2][4][2];
#pragma unroll
    for (int a = 0; a < 2; ++a)
#pragma unroll
        for (int b = 0; b < 2; ++b)
#pragma unroll
            for (int m = 0; m < 4; ++m)
#pragma unroll
                for (int n = 0; n < 2; ++n) acc[a][b][m][n] = (f32x4){0.f, 0.f, 0.f, 0.f};
    Frag<F8> At[4], B0[2], B1[2];
    const char* cA = (const char*)g.A + (size_t)cur.pm * tstep; const char* cB = (const char*)g.Bt + (size_t)cur.pn * tstep;
    S.a_ready(cur);
    if constexpr (SP2) {
        PG8_STAGE(PG8_SB(0, 0), cB, voffB); PG8_STAGE(PG8_SB(0, 1), cB + hstep, voffB); PG8_STAGE(PG8_SA(0, 0), cA, voffA); PG8_STAGE(PG8_SA(0, 1), cA + hstep, voffA);
        if (wr == 1) PG8_BAR;
        PG8_WAIT_V(2); PG8_BAR;
        PG8_STAGE(PG8_SB(1, 0), cB + kstep, voffB); PG8_STAGE(PG8_SA(1, 0), cA + kstep, voffA); PG8_STAGE(PG8_SB(1, 1), cB + hstep + kstep, voffB);
        PG8_WAIT_V(6); PG8_BAR;
    } else {
        PG8_STAGE(PG8_SB(0, 0), cB, voffB); PG8_STAGE(PG8_SA(0, 0), cA, voffA); PG8_STAGE(PG8_SB(0, 1), cB + hstep, voffB); PG8_STAGE(PG8_SA(0, 1), cA + hstep, voffA);
        if (wr == 1) PG8_BAR;
        PG8_WAIT_V(4); PG8_BAR;
        PG8_STAGE(PG8_SB(1, 0), cB + kstep, voffB); PG8_STAGE(PG8_SA(1, 0), cA + kstep, voffA); PG8_STAGE(PG8_SB(1, 1), cB + hstep + kstep, voffB);
        PG8_WAIT_V(6); PG8_BAR;
    }
    for (;;) {
        const bool has_next = S.next(ui + 1, nxt);
        const char* nA = has_next ? (const char*)g.A + (size_t)nxt.pm * tstep : cA; const char* nB = has_next ? (const char*)g.Bt + (size_t)nxt.pn * tstep : cB;
#pragma unroll 1
        for (int t = 0; t < nt; t += 2) {
            const bool last = (t == nt - 2);
            const char* a1 = cA + (size_t)(t + 1) * kstep;
            const char* a2 = last ? nA : cA + (size_t)(t + 2) * kstep; const char* b2 = last ? nB : cB + (size_t)(t + 2) * kstep;
            const char* a3 = a2 + kstep; const char* b3 = b2 + kstep;
            if (last && has_next) S.a_ready(nxt);
            if constexpr (SP2) {
            PG8_LDB(B0, 0, 0); PG8_LDB(B1, 0, 1); PG8_SCHED; PG8_LDA(At, 0, 0); PG8_STAGE(PG8_SA(1, 1), a1 + hstep, voffA);
            PG8_WAIT_V(8); PG8_WAIT_L(0); PG8_BAR; PG8_MMA(0, 0, At, B0); PG8_MMA(0, 1, At, B1); PG8_BAR; PG8_SCHED;
            PG8_LDA(At, 0, 1); PG8_STAGE(PG8_SB(0, 0), b2, voffB); PG8_STAGE(PG8_SB(0, 1), b2 + hstep, voffB); PG8_STAGE(PG8_SA(0, 0), a2, voffA);
            PG8_WAIT_V(8); PG8_WAIT_L(0); PG8_BAR; PG8_MMA(1, 0, At, B0); PG8_MMA(1, 1, At, B1); PG8_BAR; PG8_SCHED;
            PG8_LDB(B0, 1, 0); PG8_LDB(B1, 1, 1); PG8_SCHED; PG8_LDA(At, 1, 0); PG8_STAGE(PG8_SA(0, 1), a2 + hstep, voffA);
            PG8_WAIT_V(8); PG8_WAIT_L(0); PG8_BAR; PG8_MMA(0, 0, At, B0); PG8_MMA(0, 1, At, B1); PG8_BAR; PG8_SCHED;
            PG8_LDA(At, 1, 1); PG8_STAGE(PG8_SB(1, 0), b3, voffB); PG8_STAGE(PG8_SB(1, 1), b3 + hstep, voffB); PG8_STAGE(PG8_SA(1, 0), a3, voffA);
            PG8_WAIT_V(8); PG8_WAIT_L(0); PG8_BAR; PG8_MMA(1, 0, At, B0); PG8_MMA(1, 1, At, B1); PG8_BAR; PG8_SCHED;
            } else {
            PG8_LDB(B0, 0, 0); PG8_SCHED; PG8_LDA(At, 0, 0); PG8_STAGE(PG8_SA(1, 1), a1 + hstep, voffA);
            PG8_WAIT_L(8); PG8_BAR; PG8_WAIT_L(0); PG8_MMA(0, 0, At, B0); PG8_BAR; PG8_SCHED;
            PG8_LDB(B1, 0, 1); PG8_STAGE(PG8_SB(0, 0), b2, voffB);
            PG8_BAR; PG8_WAIT_L(0); PG8_MMA(0, 1, At, B1); PG8_BAR;
            PG8_LDA(At, 0, 1); PG8_STAGE(PG8_SA(0, 0), a2, voffA);
            PG8_BAR; PG8_WAIT_L(0); PG8_MMA(1, 0, At, B0); PG8_BAR; PG8_SCHED;
            PG8_STAGE(PG8_SB(0, 1), b2 + hstep, voffB);
            PG8_WAIT_V(6); PG8_BAR; PG8_MMA(1, 1, At, B1); PG8_BAR;
            PG8_LDB(B0, 1, 0); PG8_SCHED; PG8_LDA(At, 1, 0); PG8_STAGE(PG8_SA(0, 1), a2 + hstep, voffA);
            PG8_WAIT_L(8); PG8_BAR; PG8_WAIT_L(0); PG8_MMA(0, 0, At, B0); PG8_BAR; PG8_SCHED;
            PG8_LDB(B1, 1, 1); PG8_STAGE(PG8_SB(1, 0), b3, voffB);
            PG8_BAR; PG8_WAIT_L(0); PG8_MMA(0, 1, At, B1); PG8_BAR;
            PG8_LDA(At, 1, 1); PG8_STAGE(PG8_SA(1, 0), a3, voffA);
            PG8_BAR; PG8_WAIT_L(0); PG8_MMA(1, 0, At, B0); PG8_BAR; PG8_SCHED;
            PG8_STAGE(PG8_SB(1, 1), b3 + hstep, voffB);
            PG8_WAIT_V(6); PG8_BAR; PG8_MMA(1, 1, At, B1); PG8_BAR;
            }
        }
        if constexpr (F8) asm volatile("s_nop 15\n\ts_nop 15" ::: "memory");
        if constexpr (ALIGN_EPI) { if (wr == 0) PG8_BAR; }
        if constexpr (!Epi::AFTER_DRAIN) { E(acc, cur, wr, wc, fr, fq); S.done(cur); }
        if (!has_next) break;
#pragma unroll
        for (int a = 0; a < 2; ++a)
#pragma unroll
            for (int b = 0; b < 2; ++b)
#pragma unroll
                for (int m = 0; m < 4; ++m)
#pragma unroll
                    for (int n = 0; n < 2; ++n) acc[a][b][m][n] = (f32x4){0.f, 0.f, 0.f, 0.f};
        cur = nxt; cA = nA; cB = nB; ++ui;
        if constexpr (ALIGN_EPI) { if (wr == 1) PG8_BAR; }
    }
    PG8_WAIT_V(0);
    if constexpr (!ALIGN_EPI) { if (wr == 0) PG8_BAR; }
    PG8_BAR;
    if constexpr (Epi::AFTER_DRAIN) { E.fused(acc, cur, wr, wc, fr, fq, lds, wid, lane); S.done(cur); }
#undef PG8_SA
#undef PG8_SB
#undef PG8_STAGE
#undef PG8_LDA
#undef PG8_LDB
#undef PG8_MMA
#undef PG8_LDF
#undef PG8_WAIT_V
#undef PG8_WAIT_L
#undef PG8_BAR
#undef PG8_SCHED
}
}
namespace pg8 {
__device__ __forceinline__ float bf_lo(unsigned w) { return __uint_as_float(w << 16); }
__device__ __forceinline__ float bf_hi(unsigned w) { return __uint_as_float(w & 0xffff0000u); }
__device__ __forceinline__ float fast_sigmoid(float x) { return __builtin_amdgcn_rcpf(1.0f + __builtin_amdgcn_exp2f(-1.4426950408889634f * x)); }
__device__ __forceinline__ float gelu_tanh(float x) { const float t = x * (1.5957691216057308f + 0.07135481627260025f * x * x); return x * __builtin_amdgcn_rcpf(1.0f + __builtin_amdgcn_exp2f(-1.4426950408889634f * t)); }
constexpr float ALPHA_F = 1.681792830507429f;
constexpr float WSC = 1.0f / 32.0f;

struct EpiStore {
    static constexpr bool PERM = true, AFTER_DRAIN = false;
    bf16_t* O; int ldc; float scale; int pnmask; int f8out;
    __device__ __forceinline__ void operator()(const f32x4 (&acc)[2][2][4][2], const Unit& u, int wr, int wc, int fr, int fq) const {
        const int row0 = u.pm * BM + wr * 64 + fr, col0 = (u.pn & pnmask) * BM + wc * 32 + 8 * fq;
#pragma unroll
        for (int ai = 0; ai < 2; ++ai)
#pragma unroll
            for (int m = 0; m < 4; ++m) { bf16_t* rowp = O + (size_t)(row0 + ai * HALF + m * 16) * ldc + col0;
#pragma unroll
                for (int bj = 0; bj < 2; ++bj) { const f32x4 v0 = acc[ai][bj][m][0] * scale, v1 = acc[ai][bj][m][1] * scale;
                    if (f8out) {
                        int w0 = 0, w1 = 0; w0 = __builtin_amdgcn_cvt_pk_fp8_f32(v0[0], v0[1], w0, false); w0 = __builtin_amdgcn_cvt_pk_fp8_f32(v0[2], v0[3], w0, true);
                        w1 = __builtin_amdgcn_cvt_pk_fp8_f32(v1[0], v1[1], w1, false); w1 = __builtin_amdgcn_cvt_pk_fp8_f32(v1[2], v1[3], w1, true);
                        *(unsigned long long*)((unsigned char*)O + (size_t)(row0 + ai * HALF + m * 16) * ldc + col0 + bj * HALF) = (unsigned long long)(unsigned)w0 | ((unsigned long long)(unsigned)w1 << 32);
                    } else {
                    u32x4 w; w.x = cvt_pk_bf16(v0[0], v0[1]); w.y = cvt_pk_bf16(v0[2], v0[3]); w.z = cvt_pk_bf16(v1[0], v1[1]); w.w = cvt_pk_bf16(v1[2], v1[3]);
                    *(u32x4*)(rowp + bj * HALF) = w; } } }
    }
};
struct EpiGlu {
    static constexpr bool PERM = true, AFTER_DRAIN = false;
    const bf16_t* Hin; bf16_t* X1;
    __device__ __forceinline__ void operator()(const f32x4 (&acc)[2][2][4][2], const Unit& u, int wr, int wc, int fr, int fq) const {
        const int row0 = u.pm * BM + wr * 64 + fr, col0 = u.pn * HALF + wc * 32 + 8 * fq;
        u32x4 hvv[2][4];
#pragma unroll
        for (int ai = 0; ai < 2; ++ai)
#pragma unroll
            for (int m = 0; m < 4; ++m) hvv[ai][m] = *(const u32x4*)(Hin + (size_t)(row0 + ai * HALF + m * 16) * 1024 + col0);
#pragma unroll
        for (int ai = 0; ai < 2; ++ai)
#pragma unroll
            for (int m = 0; m < 4; ++m) { const size_t off = (size_t)(row0 + ai * HALF + m * 16) * 1024 + col0;
                const u32x4 hv = hvv[ai][m];
                const f32x4 v0 = acc[ai][0][m][0] * WSC, v1 = acc[ai][0][m][1] * WSC, g0 = acc[ai][1][m][0] * WSC, g1 = acc[ai][1][m][1] * WSC;
                float o[8];
                o[0] = ALPHA_F * bf_lo(hv.x) + v0[0] * fast_sigmoid(g0[0]); o[1] = ALPHA_F * bf_hi(hv.x) + v0[1] * fast_sigmoid(g0[1]);
                o[2] = ALPHA_F * bf_lo(hv.y) + v0[2] * fast_sigmoid(g0[2]); o[3] = ALPHA_F * bf_hi(hv.y) + v0[3] * fast_sigmoid(g0[3]);
                o[4] = ALPHA_F * bf_lo(hv.z) + v1[0] * fast_sigmoid(g1[0]); o[5] = ALPHA_F * bf_hi(hv.z) + v1[1] * fast_sigmoid(g1[1]);
                o[6] = ALPHA_F * bf_lo(hv.w) + v1[2] * fast_sigmoid(g1[2]); o[7] = ALPHA_F * bf_hi(hv.w) + v1[3] * fast_sigmoid(g1[3]);
                u32x4 w; w.x = cvt_pk_bf16(o[0], o[1]); w.y = cvt_pk_bf16(o[2], o[3]); w.z = cvt_pk_bf16(o[4], o[5]); w.w = cvt_pk_bf16(o[6], o[7]);
                *(u32x4*)(X1 + off) = w; }
    }
};
struct EpiRes {
    static constexpr bool PERM = true, AFTER_DRAIN = false;
    const bf16_t* Hin; bf16_t* X1;
    __device__ __forceinline__ void operator()(const f32x4 (&acc)[2][2][4][2], const Unit& u, int wr, int wc, int fr, int fq) const {
        const int row0 = u.pm * BM + wr * 64 + fr, col0 = u.pn * BM + wc * 32 + 8 * fq;
        u32x4 hvv[2][4][2];
#pragma unroll
        for (int ai = 0; ai < 2; ++ai)
#pragma unroll
            for (int m = 0; m < 4; ++m)
#pragma unroll
                for (int bj = 0; bj < 2; ++bj) hvv[ai][m][bj] = *(const u32x4*)(Hin + (size_t)(row0 + ai * HALF + m * 16) * 1024 + col0 + bj * HALF);
#pragma unroll
        for (int ai = 0; ai < 2; ++ai)
#pragma unroll
            for (int m = 0; m < 4; ++m)
#pragma unroll
                for (int bj = 0; bj < 2; ++bj) { const size_t off = (size_t)(row0 + ai * HALF + m * 16) * 1024 + col0 + bj * HALF;
                    const u32x4 hv = hvv[ai][m][bj]; const f32x4 v0 = acc[ai][bj][m][0] * WSC, v1 = acc[ai][bj][m][1] * WSC;
                    u32x4 w; w.x = cvt_pk_bf16(ALPHA_F * bf_lo(hv.x) + v0[0], ALPHA_F * bf_hi(hv.x) + v0[1]); w.y = cvt_pk_bf16(ALPHA_F * bf_lo(hv.y) + v0[2], ALPHA_F * bf_hi(hv.y) + v0[3]);
                    w.z = cvt_pk_bf16(ALPHA_F * bf_lo(hv.z) + v1[0], ALPHA_F * bf_hi(hv.z) + v1[1]); w.w = cvt_pk_bf16(ALPHA_F * bf_lo(hv.w) + v1[2], ALPHA_F * bf_hi(hv.w) + v1[3]);
                    *(u32x4*)(X1 + off) = w; }
    }
};
struct EpiPle {
    static constexpr bool PERM = true, AFTER_DRAIN = false;
    const bf16_t* H2; const unsigned char* PW; bf16_t* Hout; float* Fout; unsigned char* H8out;
    __device__ __forceinline__ void operator()(const f32x4 (&acc)[2][2][4][2], const Unit& u, int wr, int wc, int fr, int fq) const {
        const int row0 = u.pm * BM + wr * 64 + fr, col0 = u.pn * BM + wc * 32 + 8 * fq;
#pragma unroll
        for (int ai = 0; ai < 2; ++ai) {
            u32x4 hvv[4][2]; unsigned long long pvv[4][2];
#pragma unroll
            for (int m = 0; m < 4; ++m)
#pragma unroll
                for (int bj = 0; bj < 2; ++bj) { const size_t off = (size_t)(row0 + ai * HALF + m * 16) * 1024 + col0 + bj * HALF; hvv[m][bj] = *(const u32x4*)(H2 + off); pvv[m][bj] = *(const unsigned long long*)(PW + off); }
#pragma unroll
            for (int m = 0; m < 4; ++m)
#pragma unroll
                for (int bj = 0; bj < 2; ++bj) { const size_t off = (size_t)(row0 + ai * HALF + m * 16) * 1024 + col0 + bj * HALF;
                    const u32x4 hv = hvv[m][bj]; const int pl = (int)(unsigned)pvv[m][bj], ph = (int)(unsigned)(pvv[m][bj] >> 32); const f32x4 v0 = acc[ai][bj][m][0] * WSC, v1 = acc[ai][bj][m][1] * WSC;
                    const auto p01 = __builtin_amdgcn_cvt_pk_f32_fp8(pl, false), p23 = __builtin_amdgcn_cvt_pk_f32_fp8(pl, true), p45 = __builtin_amdgcn_cvt_pk_f32_fp8(ph, false), p67 = __builtin_amdgcn_cvt_pk_f32_fp8(ph, true);
                    float o[8];
                    o[0] = bf_lo(hv.x) + fast_sigmoid(v0[0]) * p01[0]; o[1] = bf_hi(hv.x) + fast_sigmoid(v0[1]) * p01[1];
                    o[2] = bf_lo(hv.y) + fast_sigmoid(v0[2]) * p23[0]; o[3] = bf_hi(hv.y) + fast_sigmoid(v0[3]) * p23[1];
                    o[4] = bf_lo(hv.z) + fast_sigmoid(v1[0]) * p45[0]; o[5] = bf_hi(hv.z) + fast_sigmoid(v1[1]) * p45[1];
                    o[6] = bf_lo(hv.w) + fast_sigmoid(v1[2]) * p67[0]; o[7] = bf_hi(hv.w) + fast_sigmoid(v1[3]) * p67[1];
                    if (Fout) { *(f32x4*)(Fout + off) = (f32x4){o[0], o[1], o[2], o[3]}; *(f32x4*)(Fout + off + 4) = (f32x4){o[4], o[5], o[6], o[7]}; }
                    else { u32x4 w; w.x = cvt_pk_bf16(o[0], o[1]); w.y = cvt_pk_bf16(o[2], o[3]); w.z = cvt_pk_bf16(o[4], o[5]); w.w = cvt_pk_bf16(o[6], o[7]); *(u32x4*)(Hout + off) = w;
                        int w0 = 0, w1 = 0; w0 = __builtin_amdgcn_cvt_pk_fp8_f32(o[0], o[1], w0, false); w0 = __builtin_amdgcn_cvt_pk_fp8_f32(o[2], o[3], w0, true); w1 = __builtin_amdgcn_cvt_pk_fp8_f32(o[4], o[5], w1, false); w1 = __builtin_amdgcn_cvt_pk_fp8_f32(o[6], o[7], w1, true);
                        *(unsigned long long*)(H8out + off) = (unsigned long long)(unsigned)w0 | ((unsigned long long)(unsigned)w1 << 32); } }
        }
    }
};

__device__ __forceinline__ int imax_(int a, int b) { return a > b ? a : b; }
__device__ __forceinline__ int imin_(int a, int b) { return a < b ? a : b; }
__device__ __forceinline__ float csum(float a, float b) { float s = a + b; asm volatile("" : "+v"(s)); return s; }
__device__ __forceinline__ int f2key(float v) { int s = __float_as_int(v); return s ^ ((s >> 31) & 0x7fffffff); }
__device__ __forceinline__ float key2f(int k) { return __int_as_float(k ^ ((k >> 31) & 0x7fffffff)); }
template <bool DESC> __device__ __forceinline__ void bitonic_sort16(int (&x)[16]) {
#pragma unroll
    for (int k = 2; k <= 16; k <<= 1)
#pragma unroll
        for (int j = k >> 1; j > 0; j >>= 1)
#pragma unroll
            for (int i = 0; i < 16; ++i) { const int l = i ^ j; if (l > i) { const bool up = ((i & k) == 0) || (k == 16); const bool asc = DESC ? !up : up;
                const int lo = imin_(x[i], x[l]), hi = imax_(x[i], x[l]); x[i] = asc ? lo : hi; x[l] = asc ? hi : lo; } }
}
__device__ __forceinline__ void bitonic_merge_desc16(int (&x)[16]) {
#pragma unroll
    for (int j = 8; j > 0; j >>= 1)
#pragma unroll
        for (int i = 0; i < 16; ++i) { const int l = i ^ j; if (l > i) { const int lo = imin_(x[i], x[l]), hi = imax_(x[i], x[l]); x[i] = hi; x[l] = lo; } }
}
__device__ __forceinline__ void topk_absorb16(int (&L)[16], int (&N)[16]) {
    bitonic_sort16<false>(N);
#pragma unroll
    for (int i = 0; i < 16; ++i) L[i] = imax_(L[i], N[i]);
    bitonic_merge_desc16(L);
}
__device__ __forceinline__ void topk_insert1(int (&L)[16], int v) {
#pragma unroll
    for (int i = 0; i < 16; ++i) { const int hi = imax_(L[i], v); v = imin_(L[i], v); L[i] = hi; }
}

template <bool DESC> __device__ __forceinline__ void bitonic_sort16f(float (&x)[16]) {
#pragma unroll
    for (int k = 2; k <= 16; k <<= 1)
#pragma unroll
        for (int j = k >> 1; j > 0; j >>= 1)
#pragma unroll
            for (int i = 0; i < 16; ++i) { const int l = i ^ j; if (l > i) { const bool up = ((i & k) == 0) || (k == 16); const bool asc = DESC ? !up : up;
                const float lo = __builtin_fminf(x[i], x[l]), hi = __builtin_fmaxf(x[i], x[l]); x[i] = asc ? lo : hi; x[l] = asc ? hi : lo; } }
}
__device__ __forceinline__ void bitonic_merge_desc16f(float (&x)[16]) {
#pragma unroll
    for (int j = 8; j > 0; j >>= 1)
#pragma unroll
        for (int i = 0; i < 16; ++i) { const int l = i ^ j; if (l > i) { const float lo = __builtin_fminf(x[i], x[l]), hi = __builtin_fmaxf(x[i], x[l]); x[i] = hi; x[l] = lo; } }
}
__device__ __forceinline__ void topk_absorb16f(float (&L)[16], float (&N)[16]) {
    bitonic_sort16f<false>(N);
#pragma unroll
    for (int i = 0; i < 16; ++i) L[i] = __builtin_fmaxf(L[i], N[i]);
    bitonic_merge_desc16f(L);
}

__device__ __forceinline__ void topk_insert1f(float (&L)[16], float v) {
#pragma unroll
    for (int i = 0; i < 16; ++i) { const float hi = __builtin_fmaxf(L[i], v); v = __builtin_fminf(L[i], v); L[i] = hi; }
}
struct EpiTopk {
    static constexpr bool PERM = true, AFTER_DRAIN = true;
    int* IDX; float* GATE;
    __device__ __forceinline__ void fused(f32x4 (&acc)[2][2][4][2], const Unit& u, int wr, int wc, int fr, int fq, PG8_LAS unsigned char* lds, int wid, int lane) const {
        const int tid = wid * 64 + lane;
        PG8_LAS float* S = (PG8_LAS float*)lds;
        PG8_LAS int* X = (PG8_LAS int*)lds;
        const int row = tid & 255, part = tid >> 8;
        int KK[2][16];
#pragma unroll
        for (int bj = 0; bj < 2; ++bj) {
#pragma unroll
            for (int ai = 0; ai < 2; ++ai)
#pragma unroll
                for (int m = 0; m < 4; ++m)
#pragma unroll
                    for (int n = 0; n < 2; ++n) *(PG8_LAS f32x4*)(S + (ai * HALF + wr * 64 + m * 16 + fr) * 132 + wc * 32 + 8 * fq + 4 * n) = acc[ai][bj][m][n] * WSC;
            asm volatile("s_waitcnt lgkmcnt(0)" ::: "memory"); __builtin_amdgcn_s_barrier(); asm volatile("" ::: "memory");
            float L[16];
#pragma unroll
            for (int c = 0; c < 4; ++c) {
                float N[16];
#pragma unroll
                for (int i = 0; i < 4; ++i) { const f32x4 v = *(const PG8_LAS f32x4*)(S + row * 132 + 64 * part + 16 * c + 4 * i);
#pragma unroll
                    for (int e = 0; e < 4; ++e) N[4 * i + e] = __int_as_float((__float_as_int(v[e]) & ~127) | (127 - (64 * part + 16 * c + 4 * i + e))); }
                if (c == 0) { bitonic_sort16f<true>(N);
#pragma unroll
                    for (int i = 0; i < 16; ++i) L[i] = N[i]; }
                else topk_absorb16f(L, N);
            }
            asm volatile("s_waitcnt lgkmcnt(0)" ::: "memory"); __builtin_amdgcn_s_barrier(); asm volatile("" ::: "memory");
#pragma unroll
            for (int i = 0; i < 4; ++i) *(PG8_LAS u32x4*)(X + tid * 20 + 4 * i) = (u32x4){(unsigned)__float_as_int(L[4 * i]), (unsigned)__float_as_int(L[4 * i + 1]), (unsigned)__float_as_int(L[4 * i + 2]), (unsigned)__float_as_int(L[4 * i + 3])};
            asm volatile("s_waitcnt lgkmcnt(0)" ::: "memory"); __builtin_amdgcn_s_barrier(); asm volatile("" ::: "memory");
            { float P[16]; const int pt = tid ^ 256;
#pragma unroll
              for (int i = 0; i < 4; ++i) { const u32x4 v = *(const PG8_LAS u32x4*)(X + pt * 20 + 4 * i); P[4 * i] = __int_as_float((int)v.x); P[4 * i + 1] = __int_as_float((int)v.y); P[4 * i + 2] = __int_as_float((int)v.z); P[4 * i + 3] = __int_as_float((int)v.w); }
#pragma unroll
              for (int i = 0; i < 16; ++i) L[i] = __builtin_fmaxf(L[i], P[15 - i]);
              bitonic_merge_desc16f(L); }
#pragma unroll
            for (int i = 0; i < 16; ++i) KK[bj][i] = __float_as_int(L[i]);
            asm volatile("s_waitcnt lgkmcnt(0)" ::: "memory"); __builtin_amdgcn_s_barrier(); asm volatile("" ::: "memory");
        }
        float v1[16], v2[16];
#pragma unroll
        for (int i = 0; i < 16; ++i) { v1[i] = __int_as_float(KK[0][i] & ~127); v2[i] = __int_as_float(KK[1][i] & ~127); }
#define CKEY(a, b) __int_as_float((__float_as_int(csum(v1[a], v2[b])) & ~255) | (255 - (((a) << 4) | (b))))
        float L[16];
#pragma unroll
        for (int b = 0; b < 16; ++b) L[b] = CKEY(0, b);
        { float N[16] = {CKEY(1, 0), CKEY(1, 1), CKEY(1, 2), CKEY(1, 3), CKEY(1, 4), CKEY(1, 5), CKEY(1, 6), CKEY(1, 7), CKEY(2, 0), CKEY(2, 1), CKEY(2, 2), CKEY(2, 3), CKEY(2, 4), CKEY(4, 0), CKEY(4, 1), CKEY(4, 2)};
          topk_absorb16f(L, N); }
        { float N[16] = {CKEY(3, 0), CKEY(3, 1), CKEY(3, 2), CKEY(3, 3), CKEY(5, 0), CKEY(5, 1), CKEY(6, 0), CKEY(6, 1), CKEY(7, 0), CKEY(7, 1), CKEY(8, 0), CKEY(9, 0), CKEY(10, 0), CKEY(11, 0), CKEY(12, 0), CKEY(13, 0)};
          topk_absorb16f(L, N); }
        topk_insert1f(L, CKEY(14, 0)); topk_insert1f(L, CKEY(15, 0));
#undef CKEY
#pragma unroll
        for (int i = 0; i < 4; ++i) { *(PG8_LAS u32x4*)(X + tid * 36 + 4 * i) = (u32x4){(unsigned)KK[0][4 * i], (unsigned)KK[0][4 * i + 1], (unsigned)KK[0][4 * i + 2], (unsigned)KK[0][4 * i + 3]};
                                      *(PG8_LAS u32x4*)(X + tid * 36 + 16 + 4 * i) = (u32x4){(unsigned)KK[1][4 * i], (unsigned)KK[1][4 * i + 1], (unsigned)KK[1][4 * i + 2], (unsigned)KK[1][4 * i + 3]}; }
        asm volatile("s_waitcnt lgkmcnt(0)" ::: "memory");
        float sc[16]; int ex[16];
#pragma unroll
        for (int i = 0; i < 16; ++i) { const int code = 255 - (__float_as_int(L[i]) & 255); const int ka = X[tid * 36 + (code >> 4)], kb = X[tid * 36 + 16 + (code & 15)];
            sc[i] = __int_as_float(ka & ~127) + __int_as_float(kb & ~127); ex[i] = (127 - (ka & 127)) * 128 + (127 - (kb & 127)); }
        float mx = sc[0];
#pragma unroll
        for (int i = 1; i < 16; ++i) mx = fmaxf(mx, sc[i]);
        float den = 0.f;
#pragma unroll
        for (int i = 0; i < 16; ++i) { sc[i] = __builtin_amdgcn_exp2f((sc[i] - mx) * 1.4426950408889634f); den += sc[i]; }
        const float rden = 1.0f / den;
        const size_t o = ((size_t)(u.pm * BM + row) * 8 + u.pn) * 16;
        if (part == 0) {
#pragma unroll
            for (int i = 0; i < 4; ++i) *(u32x4*)(IDX + o + 4 * i) = (u32x4){(unsigned)ex[4 * i], (unsigned)ex[4 * i + 1], (unsigned)ex[4 * i + 2], (unsigned)ex[4 * i + 3]};
        } else {
#pragma unroll
            for (int i = 0; i < 4; ++i) *(f32x4*)(GATE + o + 4 * i) = (f32x4){sc[4 * i] * rden, sc[4 * i + 1] * rden, sc[4 * i + 2] * rden, sc[4 * i + 3] * rden};
        }
        asm volatile("s_waitcnt lgkmcnt(0)" ::: "memory"); __builtin_amdgcn_s_barrier(); asm volatile("" ::: "memory");
    }
};
struct OneUnitOrder {
    StaticOrder base; int round;
    __device__ __forceinline__ bool next(int i, Unit& u) const { return i == 0 && base.next(round, u); }
    __device__ __forceinline__ void a_ready(const Unit&) const {}
    __device__ __forceinline__ void done(const Unit&) const {}
};
}
constexpr int NWAVES = 8;
constexpr int BATCH = 4, SEQ = 4096, DM = 1024, TOK = BATCH * SEQ, DEPTH = 4;
constexpr float LN_EPS = 1e-5f;
constexpr size_t MiB = 1u << 20;
constexpr size_t WS_CTL = 0, CTL_ZERO_BYTES = 32 * 1024;
constexpr size_t WS_W_IN = 2 * MiB;
constexpr size_t WS_W_GLU = 6 * MiB;
constexpr size_t WS_W_KV = 14 * MiB;
constexpr size_t WS_W_SQ = 18 * MiB;
constexpr size_t WS_W_SO = 22 * MiB;
constexpr size_t WS_W_EFF = 26 * MiB;
constexpr size_t WS_W_PG = 42 * MiB;
constexpr size_t WS_W_PW = 50 * MiB;
constexpr size_t WS_PB = 52 * MiB;
constexpr size_t WS_IDX = 84 * MiB;
constexpr size_t WS_GATE = 92 * MiB;
constexpr size_t WS_TABU = 100 * MiB;
constexpr size_t WS_TABV = 228 * MiB;
constexpr size_t WS_PW = 356 * MiB;
constexpr size_t WS_H = 484 * MiB, WS_U = 516 * MiB, WS_Y = 548 * MiB, WS_X1 = 580 * MiB, WS_H1 = 612 * MiB, WS_H2 = 644 * MiB, WS_KB = 676 * MiB, WS_VT = 708 * MiB, WS_HKV = 740 * MiB;
constexpr size_t WS_H8 = 772 * MiB, WS_H28 = 788 * MiB;
constexpr size_t WS_W8 = 804 * MiB;
constexpr size_t W8_IN = WS_W8, W8_GLU = WS_W8 + 2 * MiB, W8_KV = WS_W8 + 6 * MiB, W8_SQ = WS_W8 + 8 * MiB, W8_SO = WS_W8 + 10 * MiB, W8_PG = WS_W8 + 12 * MiB;
constexpr float W8_SCALE = 32.0f;
constexpr size_t WS_H18 = 820 * MiB;
constexpr size_t W8_EFF = 836 * MiB;
constexpr size_t WS_END = 844 * MiB;
constexpr int CW_BAR = 4096;
constexpr float PEER_SU = 91.0f, PEER_SV = 4.75f;

constexpr int LDS_BYTES = 163840;
constexpr int RING_BYTES = 131072;
constexpr int MISC_OFF = 163840 - 256;

#define GAS __attribute__((address_space(1)))
#define LAS __attribute__((address_space(3)))
typedef unsigned short bf16;
typedef unsigned v4u __attribute__((ext_vector_type(4)));
typedef unsigned v2u __attribute__((ext_vector_type(2)));
typedef float f32x4 __attribute__((ext_vector_type(4)));
typedef float f32x16 __attribute__((ext_vector_type(16)));
typedef short bf16x8 __attribute__((ext_vector_type(8)));
typedef __bf16 bf16x2_t __attribute__((ext_vector_type(2)));
#define LDS_WAIT() asm volatile("s_waitcnt lgkmcnt(0)" ::: "memory")
#define VM_WAIT() asm volatile("s_waitcnt vmcnt(0)" ::: "memory")
using pg8::cvt_pk_bf16; using pg8::bf_lo; using pg8::bf_hi; using pg8::gelu_tanh;

#define XB_TMO      128
#define XB_XCNT(j)  (256  + 64 * (j))
#define XB_XSUB(j)  (1280 + 64 * (j))
#define XB_XGEN(j)  (2304 + 64 * (j))
#define XB_TOP      3328
#define XB_TOPGEN   3392
#define XCD_BAR_WORDS 3456
#define XB_SPIN_CAP (1u << 24)
__device__ __forceinline__ unsigned xb_ld(unsigned* p)              { return __hip_atomic_load(p, __ATOMIC_RELAXED, __HIP_MEMORY_SCOPE_AGENT); }
__device__ __forceinline__ unsigned xb_add(unsigned* p, unsigned v) { return __hip_atomic_fetch_add(p, v, __ATOMIC_RELAXED, __HIP_MEMORY_SCOPE_AGENT); }
__device__ __forceinline__ unsigned xb_xcc_id() { return (unsigned)__builtin_amdgcn_s_getreg((3 << 11) | 20) & 0xFu; }
#define XB_SPIN(cond, bar) do { unsigned _sp = 0; while (cond) { __builtin_amdgcn_s_sleep(1); \
    if ((++_sp & 255u) == 0u) { if (xb_ld(&(bar)[XB_TMO])) break; if (_sp > XB_SPIN_CAP) { atomicAdd(&(bar)[XB_TMO], 1u); break; } } } } while (0)
struct XcdBarrier { unsigned* bar; unsigned x; volatile LAS unsigned* st; };
__device__ __forceinline__ XcdBarrier xcd_barrier_post(unsigned* bar, volatile LAS unsigned* st) {
    XcdBarrier b; b.bar = bar; b.x = xb_xcc_id(); b.st = st;
    if (threadIdx.x == 0) (void)xb_add(&bar[XB_XCNT(b.x)], 1u);
    return b;
}
__device__ __forceinline__ void xcd_barrier_complete(unsigned* bar, unsigned x, unsigned& nloc, unsigned& nx) {
    const unsigned G = gridDim.x * gridDim.y * gridDim.z;
    unsigned sum, cnt, mine, sp = 0u;
    for (;;) {
        sum = 0u; cnt = 0u; mine = 0u;
#pragma unroll 1
        for (unsigned j = 0; j < 16; ++j) { const unsigned c = xb_ld(&bar[XB_XCNT(j)]); sum += c; cnt += (c > 0u) ? 1u : 0u; mine = (j == x) ? c : mine; }
        if (sum == G) break;
        __builtin_amdgcn_s_sleep(1);
        if ((++sp & 255u) == 0u) { if (xb_ld(&bar[XB_TMO])) break; if (sp > XB_SPIN_CAP) { atomicAdd(&bar[XB_TMO], 1u); break; } }
    }
    nloc = mine > 0u ? mine : 1u; nx = cnt > 0u ? cnt : 1u;
}
__device__ __forceinline__ void xcd_barrier(const XcdBarrier& b) {
    asm volatile("s_waitcnt vmcnt(0)" ::: "memory");
    __syncthreads();
    if (threadIdx.x == 0) {
        unsigned* bar = b.bar;
        __builtin_amdgcn_s_waitcnt(0);
        unsigned nloc = b.st[0], nx = b.st[1];
        if (nloc == 0u) { xcd_barrier_complete(bar, b.x, nloc, nx); b.st[0] = nloc; b.st[1] = nx; }
        const unsigned old = xb_add(&bar[XB_XSUB(b.x)], 1u);
        const unsigned gen = old / nloc;
        if (old + 1u == (gen + 1u) * nloc) {
            __builtin_amdgcn_fence(__ATOMIC_RELEASE, "agent");
            asm volatile("s_waitcnt vmcnt(0)" ::: "memory");
            const unsigned og = xb_add(&bar[XB_TOP], 1u);
            const unsigned tg = og / nx;
            if (og + 1u == (tg + 1u) * nx) xb_add(&bar[XB_TOPGEN], 1u);
            else XB_SPIN(xb_ld(&bar[XB_TOPGEN]) == tg, bar);
            __builtin_amdgcn_fence(__ATOMIC_ACQUIRE, "agent");
            xb_add(&bar[XB_XGEN(b.x)], 1u);
            asm volatile("s_waitcnt vmcnt(0)" ::: "memory");
        } else {
            XB_SPIN(xb_ld(&bar[XB_XGEN(b.x)]) == gen, bar);
            __builtin_amdgcn_fence(__ATOMIC_ACQUIRE, "agent");
            asm volatile("s_waitcnt vmcnt(0)" ::: "memory");
        }
    }
    __syncthreads();
}

enum PhaseType { P_PROLOGUE = 0, P_STORE = 1, P_SSM = 2, P_GLU = 3, P_LNMIX = 4, P_TOPK = 5, P_PEER = 6, P_PLE = 7, P_LNKV = 8, P_ATTN = 9, P_RES = 10 };
constexpr int MAX_PH = 48;
struct Args { const float* in[28]; float* out; unsigned char* ws; int ph_lo, ph_hi, use_bar, nph; unsigned char ph_type[MAX_PH]; unsigned char ph_arg[MAX_PH]; };
struct Frame {
    LAS unsigned char* lds;
    int tid, lane, wave, vcu, G, z, bx;
    const struct Args* A;
    float* out; unsigned char* ws;
};
__device__ __forceinline__ float wave_sum(float v) {
#pragma unroll
    for (int o = 1; o < 64; o <<= 1) v += __shfl_xor(v, o);
    return v;
}
template <int CTRL, int BANK> __device__ __forceinline__ float dpp_movf(float old, float v) {
    return __builtin_bit_cast(float, __builtin_amdgcn_update_dpp(__builtin_bit_cast(int, old), __builtin_bit_cast(int, v), CTRL, 0xF, BANK, true));
}
__device__ __forceinline__ float wave_sum_dpp(float v) {
    v += dpp_movf<0xB1, 0xF>(0.f, v);
    v += dpp_movf<0x4E, 0xF>(0.f, v);
    { float r = dpp_movf<0x104, 0x5>(0.f, v); r = dpp_movf<0x114, 0xA>(r, v); v += r; }
    v += dpp_movf<0x128, 0xF>(0.f, v);
    { const auto t = __builtin_amdgcn_permlane16_swap(__builtin_bit_cast(unsigned, v), __builtin_bit_cast(unsigned, v), false, false); const unsigned ta = t[0], tb = t[1]; v = __builtin_bit_cast(float, ta) + __builtin_bit_cast(float, tb); }
    { const auto t = __builtin_amdgcn_permlane32_swap(__builtin_bit_cast(unsigned, v), __builtin_bit_cast(unsigned, v), false, false); const unsigned ta = t[0], tb = t[1]; v = __builtin_bit_cast(float, ta) + __builtin_bit_cast(float, tb); }
    return v;
}
__device__ __forceinline__ unsigned f2bf(float f) { unsigned u = __builtin_bit_cast(unsigned, f); return (u + 0x7fffu + ((u >> 16) & 1u)) >> 16; }
__device__ __forceinline__ unsigned pk2(float lo, float hi) { return f2bf(lo) | (f2bf(hi) << 16); }

__device__ __forceinline__ unsigned pk4_fp8(float a, float b, float c, float d) { int w = 0; w = __builtin_amdgcn_cvt_pk_fp8_f32(a, b, w, false); w = __builtin_amdgcn_cvt_pk_fp8_f32(c, d, w, true); return (unsigned)w; }
__device__ __forceinline__ void p0_transpose_item(const float* W, int K, int N, bf16* WT, int glu, LAS float* scr, int item, int lane, unsigned char* WT8 = nullptr) {
    const int nblk = N / 32, kb = item / nblk, nb = item % nblk, k0 = 64 * kb, n0 = 32 * nb;
    int r0 = n0;
    if (glu) { const int bj = n0 >> 10, rem = n0 & 1023; r0 = 256 * (rem >> 7) + 128 * bj + (rem & 127); }
#pragma unroll 8
    for (int i = 0; i < 32; ++i) { const int kk = 2 * i + (lane >> 5); scr[kk * 33 + (lane & 31)] = W[(size_t)(k0 + kk) * N + n0 + (lane & 31)]; }
    LDS_WAIT(); asm volatile("" ::: "memory");
    const int c = lane & 7;
#pragma unroll
    for (int j = 0; j < 4; ++j) { const int n = (lane >> 3) + 8 * j; const LAS float* s = scr + (8 * c) * 33 + n;
        v4u o; o.x = pk2(s[0 * 33], s[1 * 33]); o.y = pk2(s[2 * 33], s[3 * 33]); o.z = pk2(s[4 * 33], s[5 * 33]); o.w = pk2(s[6 * 33], s[7 * 33]);
        if (WT) *(GAS v4u*)(WT + (size_t)(r0 + n) * K + k0 + 8 * c) = o;
        if (WT8) *(GAS v2u*)(WT8 + (size_t)(r0 + n) * K + k0 + 8 * c) = (v2u){pk4_fp8(s[0 * 33] * W8_SCALE, s[1 * 33] * W8_SCALE, s[2 * 33] * W8_SCALE, s[3 * 33] * W8_SCALE), pk4_fp8(s[4 * 33] * W8_SCALE, s[5 * 33] * W8_SCALE, s[6 * 33] * W8_SCALE, s[7 * 33] * W8_SCALE)}; }
    LDS_WAIT(); asm volatile("" ::: "memory");
}
__device__ __forceinline__ void cvt_stream_dual(Frame& F, const float* src, bf16* dst, unsigned char* dst8, size_t n) {
    const size_t nthr = (size_t)F.G * 512, gt = (size_t)F.bx * 512 + F.tid;
    for (size_t i = gt; i < n / 8; i += nthr) {
        const f32x4 a = *(const GAS f32x4*)(src + i * 8), b = *(const GAS f32x4*)(src + i * 8 + 4);
        v4u o; o.x = pk2(a.x, a.y); o.y = pk2(a.z, a.w); o.z = pk2(b.x, b.y); o.w = pk2(b.z, b.w);
        *(GAS v4u*)(dst + i * 8) = o;
        *(GAS v2u*)(dst8 + i * 8) = (v2u){pk4_fp8(a.x, a.y, a.z, a.w), pk4_fp8(b.x, b.y, b.z, b.w)};
    }
}
__device__ __forceinline__ void cvt_stream(Frame& F, const float* src, bf16* dst, size_t n) {
    const size_t nthr = (size_t)F.G * 512, gt = (size_t)F.bx * 512 + F.tid;
    for (size_t i = gt; i < n / 8; i += nthr) {
        const f32x4 a = *(const GAS f32x4*)(src + i * 8), b = *(const GAS f32x4*)(src + i * 8 + 4);
        v4u o; o.x = pk2(a.x, a.y); o.y = pk2(a.z, a.w); o.z = pk2(b.x, b.y); o.w = pk2(b.z, b.w);
        *(GAS v4u*)(dst + i * 8) = o;
    }
}
__device__ __forceinline__ void cvt_stream_fp4(Frame& F, const float* src, unsigned char* dst, size_t n, float scale) {
    const size_t nthr = (size_t)F.G * 512, gt = (size_t)F.bx * 512 + F.tid;
    for (size_t i = gt; i < n / 32; i += nthr) {
        unsigned w[4];
#pragma unroll
        for (int q = 0; q < 4; ++q) {
            const f32x4 a = *(const GAS f32x4*)(src + i * 32 + 8 * q) * scale, b = *(const GAS f32x4*)(src + i * 32 + 8 * q + 4) * scale;
            unsigned t = 0u;
            t = __builtin_amdgcn_cvt_scalef32_pk_fp4_f32(t, a.x, a.y, 1.0f, 0); t = __builtin_amdgcn_cvt_scalef32_pk_fp4_f32(t, a.z, a.w, 1.0f, 1);
            t = __builtin_amdgcn_cvt_scalef32_pk_fp4_f32(t, b.x, b.y, 1.0f, 2); t = __builtin_amdgcn_cvt_scalef32_pk_fp4_f32(t, b.z, b.w, 1.0f, 3);
            w[q] = t;
        }
        *(GAS v4u*)(dst + i * 16) = (v4u){w[0], w[1], w[2], w[3]};
    }
}
__device__ __forceinline__ unsigned pkbf2(float lo, float hi) { return cvt_pk_bf16(lo, hi); }
__device__ __forceinline__ void p0_weff_item(Frame& F, int item) {
    const int jb = item & 1, kb = (item >> 1) & 15, hh = (item >> 5) & 15, l = item >> 9;
    const int lane = F.lane, r32 = lane & 31, h = lane >> 5;
    const float* wq = F.A->in[21 + F.z] + (size_t)l * 1024 * 2048 + (size_t)(64 * kb + r32) * 2048 + 128 * hh + 8 * h;
    const float* ky = F.A->in[22 + (hh & 1) + F.z] + (size_t)l * 128 * 128 + (size_t)(64 * jb + r32) * 128 + 8 * h;
    f32x16 acc[2][2] = {};
#pragma unroll
    for (int ks = 0; ks < 8; ++ks) {
        bf16x8 af[2], bf[2];
#pragma unroll
        for (int a = 0; a < 2; ++a) { const f32x4 a0 = *(const GAS f32x4*)(wq + (size_t)a * 32 * 2048 + 16 * ks), a1 = *(const GAS f32x4*)(wq + (size_t)a * 32 * 2048 + 16 * ks + 4);
            af[a] = __builtin_bit_cast(bf16x8, (v4u){pkbf2(a0.x, a0.y), pkbf2(a0.z, a0.w), pkbf2(a1.x, a1.y), pkbf2(a1.z, a1.w)}); }
#pragma unroll
        for (int b = 0; b < 2; ++b) { const f32x4 b0 = *(const GAS f32x4*)(ky + (size_t)b * 32 * 128 + 16 * ks), b1 = *(const GAS f32x4*)(ky + (size_t)b * 32 * 128 + 16 * ks + 4);
            bf[b] = __builtin_bit_cast(bf16x8, (v4u){pkbf2(b0.x, b0.y), pkbf2(b0.z, b0.w), pkbf2(b1.x, b1.y), pkbf2(b1.z, b1.w)}); }
#pragma unroll
        for (int a = 0; a < 2; ++a)
#pragma unroll
            for (int b = 0; b < 2; ++b) acc[a][b] = __builtin_amdgcn_mfma_f32_32x32x16_bf16(af[a], bf[b], acc[a][b], 0, 0, 0);
    }
#pragma unroll
    for (int a = 0; a < 2; ++a)
#pragma unroll
        for (int b = 0; b < 2; ++b) {
            unsigned char* dst = (unsigned char*)(F.ws + W8_EFF) + (size_t)l * 2048 * 1024 + (size_t)(128 * hh + 64 * jb + 32 * b + r32) * 1024 + 64 * kb + 32 * a + 4 * h;
#pragma unroll
            for (int q = 0; q < 4; ++q) *(GAS unsigned*)(dst + 8 * q) = pk4_fp8(acc[a][b][4 * q] * W8_SCALE, acc[a][b][4 * q + 1] * W8_SCALE, acc[a][b][4 * q + 2] * W8_SCALE, acc[a][b][4 * q + 3] * W8_SCALE); }
}
__device__ __forceinline__ void p0_prologue(Frame& F) {
#ifndef PROBE_PRO
#define PROBE_PRO 0
#endif
    for (int rp = 0; rp < (PROBE_PRO == 4 ? 2 : 1); ++rp) {
    cvt_stream_dual(F, F.A->in[0 + F.z], (bf16*)(F.ws + WS_H), (unsigned char*)(F.ws + WS_H8), (size_t)TOK * DM);
    cvt_stream(F, F.A->in[1 + F.z], (bf16*)(F.ws + WS_PB), (size_t)DEPTH * TOK * 256); }
    LAS float* scr = (LAS float*)(F.lds + F.wave * 8704);
    const int gw = F.vcu * NWAVES + F.wave, NGW = F.G * NWAVES;
    constexpr int I_SQ = 16 * 32, I_GLU = 16 * 64, I_PW = 4 * 32;
    constexpr int NITEMS = 2 * I_SQ + 2 * I_GLU + I_GLU + 2 * I_SQ + 2 * I_SQ + 4 * I_SQ + 4 * I_PW;
    for (int rp = 0; rp < (PROBE_PRO == 2 ? 2 : 1); ++rp)
    for (int it = gw; it < NITEMS; it += NGW) {
        int r = it;
        if (r < 2 * I_SQ) { const int l = r / I_SQ; p0_transpose_item(F.A->in[6 + F.z] + (size_t)l * 1024 * 1024, 1024, 1024, nullptr, 0, scr, r % I_SQ, F.lane, (unsigned char*)(F.ws + W8_IN) + (size_t)l * 1024 * 1024); continue; } r -= 2 * I_SQ;
        if (r < 2 * I_GLU) { const int l = r / I_GLU; p0_transpose_item(F.A->in[15 + F.z] + (size_t)l * 1024 * 2048, 1024, 2048, nullptr, 1, scr, r % I_GLU, F.lane, (unsigned char*)(F.ws + W8_GLU) + (size_t)l * 2048 * 1024); continue; } r -= 2 * I_GLU;
        if (r < I_GLU) { p0_transpose_item(F.A->in[18 + F.z], 1024, 2048, nullptr, 0, scr, r, F.lane, (unsigned char*)(F.ws + W8_KV)); continue; } r -= I_GLU;
        if (r < 2 * I_SQ) { const int l = r / I_SQ; p0_transpose_item(F.A->in[19 + F.z] + (size_t)l * 1024 * 1024, 1024, 1024, nullptr, 0, scr, r % I_SQ, F.lane, (unsigned char*)(F.ws + W8_SQ) + (size_t)l * 1024 * 1024); continue; } r -= 2 * I_SQ;
        if (r < 2 * I_SQ) { const int l = r / I_SQ; p0_transpose_item(F.A->in[20 + F.z] + (size_t)l * 1024 * 1024, 1024, 1024, nullptr, 0, scr, r % I_SQ, F.lane, (unsigned char*)(F.ws + W8_SO) + (size_t)l * 1024 * 1024); continue; } r -= 2 * I_SQ;
        if (r < 4 * I_SQ) { const int l = r / I_SQ; p0_transpose_item(F.A->in[27 + F.z] + (size_t)l * 1024 * 1024, 1024, 1024, nullptr, 0, scr, r % I_SQ, F.lane, (unsigned char*)(F.ws + W8_PG) + (size_t)l * 1024 * 1024); continue; } r -= 4 * I_SQ;
        { const int l = r / I_PW; p0_transpose_item(F.A->in[26 + F.z] + (size_t)l * 256 * 1024, 256, 1024, (bf16*)(F.ws + WS_W_PW) + (size_t)l * 1024 * 256, 0, scr, r % I_PW, F.lane); }
    }
    for (int rp = 0; rp < (PROBE_PRO == 3 ? 2 : 1); ++rp)
    for (int it = gw; it < 2048; it += NGW) p0_weff_item(F, it);
}

__device__ __forceinline__ void ln_rows(Frame& F, const bf16* X, const float* g, const float* bb, bf16* O, unsigned char* O8 = nullptr) {
    const int gw = F.vcu * NWAVES + F.wave, NGW = F.G * NWAVES;
    float gg[16], bv[16];
    { const f32x4 a = *(const GAS f32x4*)(g + 8 * F.lane), b = *(const GAS f32x4*)(g + 8 * F.lane + 4), c = *(const GAS f32x4*)(g + 512 + 8 * F.lane), d = *(const GAS f32x4*)(g + 512 + 8 * F.lane + 4);
      gg[0] = a.x; gg[1] = a.y; gg[2] = a.z; gg[3] = a.w; gg[4] = b.x; gg[5] = b.y; gg[6] = b.z; gg[7] = b.w; gg[8] = c.x; gg[9] = c.y; gg[10] = c.z; gg[11] = c.w; gg[12] = d.x; gg[13] = d.y; gg[14] = d.z; gg[15] = d.w; }
    { const f32x4 a = *(const GAS f32x4*)(bb + 8 * F.lane), b = *(const GAS f32x4*)(bb + 8 * F.lane + 4), c = *(const GAS f32x4*)(bb + 512 + 8 * F.lane), d = *(const GAS f32x4*)(bb + 512 + 8 * F.lane + 4);
      bv[0] = a.x; bv[1] = a.y; bv[2] = a.z; bv[3] = a.w; bv[4] = b.x; bv[5] = b.y; bv[6] = b.z; bv[7] = b.w; bv[8] = c.x; bv[9] = c.y; bv[10] = c.z; bv[11] = c.w; bv[12] = d.x; bv[13] = d.y; bv[14] = d.z; bv[15] = d.w; }
    for (int m = gw; m < TOK; m += NGW) {
        const v4u xa = *(const GAS v4u*)(X + (size_t)m * DM + 8 * F.lane), xb = *(const GAS v4u*)(X + (size_t)m * DM + 512 + 8 * F.lane);
        float x[16] = {bf_lo(xa.x), bf_hi(xa.x), bf_lo(xa.y), bf_hi(xa.y), bf_lo(xa.z), bf_hi(xa.z), bf_lo(xa.w), bf_hi(xa.w), bf_lo(xb.x), bf_hi(xb.x), bf_lo(xb.y), bf_hi(xb.y), bf_lo(xb.z), bf_hi(xb.z), bf_lo(xb.w), bf_hi(xb.w)};
        float s = 0.f;
#pragma unroll
        for (int i = 0; i < 16; ++i) s += x[i];
        const float mean = wave_sum_dpp(s) * (1.f / DM); float q = 0.f;
#pragma unroll
        for (int i = 0; i < 16; ++i) { x[i] -= mean; q += x[i] * x[i]; }
        const float rstd = 1.0f / sqrtf(wave_sum_dpp(q) * (1.f / DM) + LN_EPS);
#pragma unroll
        for (int i = 0; i < 16; ++i) x[i] = x[i] * rstd * gg[i] + bv[i];
        v4u oa, ob; oa.x = pk2(x[0], x[1]); oa.y = pk2(x[2], x[3]); oa.z = pk2(x[4], x[5]); oa.w = pk2(x[6], x[7]); ob.x = pk2(x[8], x[9]); ob.y = pk2(x[10], x[11]); ob.z = pk2(x[12], x[13]); ob.w = pk2(x[14], x[15]);
        if (O) { *(GAS v4u*)(O + (size_t)m * DM + 8 * F.lane) = oa; *(GAS v4u*)(O + (size_t)m * DM + 512 + 8 * F.lane) = ob; }
        if (O8) { *(GAS v2u*)(O8 + (size_t)m * DM + 8 * F.lane) = (v2u){pk4_fp8(x[0], x[1], x[2], x[3]), pk4_fp8(x[4], x[5], x[6], x[7])};
                  *(GAS v2u*)(O8 + (size_t)m * DM + 512 + 8 * F.lane) = (v2u){pk4_fp8(x[8], x[9], x[10], x[11]), pk4_fp8(x[12], x[13], x[14], x[15])}; }
    }
}
struct TabCvt { const float* su; const float* sv; unsigned char* du; unsigned char* dv; int c, cf, stride, n; };
__device__ __forceinline__ void tabcvt_issue(TabCvt& T, int lane, f32x4 (&cv)[4]) {
    const bool live = T.c < T.n;
    if (live) { const int half = T.n >> 1; const float* src = (T.c < half ? T.su + (size_t)T.c * 1024 : T.sv + (size_t)(T.c - half) * 1024) + 16 * lane;
#pragma unroll
        for (int q = 0; q < 4; ++q) cv[q] = *(const GAS f32x4*)(src + 4 * q); }
    T.c += T.stride;
}
__device__ __forceinline__ unsigned i4q(float v) { float t = __builtin_fminf(__builtin_fmaxf(v * PEER_SU, -7.f), 7.f) + 12582912.0f; asm volatile("" : "+v"(t)); return __builtin_bit_cast(unsigned, t) & 15u; }
__device__ __forceinline__ unsigned pack8_i4(const f32x4& a, const f32x4& b) {
    return i4q(a.x) | (i4q(a.y) << 4) | (i4q(a.z) << 8) | (i4q(a.w) << 12) | (i4q(b.x) << 16) | (i4q(b.y) << 20) | (i4q(b.z) << 24) | (i4q(b.w) << 28);
}
__device__ __forceinline__ void tabcvt_finish(TabCvt& T, int lane, const f32x4 (&cv)[4]) {
    const bool live = T.cf < T.n;
    if (live) { const int half = T.n >> 1;
        unsigned w0 = 0u, w1 = 0u;
        if (T.cf < half) { w0 = pack8_i4(cv[0], cv[1]); w1 = pack8_i4(cv[2], cv[3]); }
        else { const float sc = PEER_SV;
            w0 = __builtin_amdgcn_cvt_scalef32_pk_fp4_f32(w0, cv[0].x * sc, cv[0].y * sc, 1.0f, 0); w0 = __builtin_amdgcn_cvt_scalef32_pk_fp4_f32(w0, cv[0].z * sc, cv[0].w * sc, 1.0f, 1);
            w0 = __builtin_amdgcn_cvt_scalef32_pk_fp4_f32(w0, cv[1].x * sc, cv[1].y * sc, 1.0f, 2); w0 = __builtin_amdgcn_cvt_scalef32_pk_fp4_f32(w0, cv[1].z * sc, cv[1].w * sc, 1.0f, 3);
            w1 = __builtin_amdgcn_cvt_scalef32_pk_fp4_f32(w1, cv[2].x * sc, cv[2].y * sc, 1.0f, 0); w1 = __builtin_amdgcn_cvt_scalef32_pk_fp4_f32(w1, cv[2].z * sc, cv[2].w * sc, 1.0f, 1);
            w1 = __builtin_amdgcn_cvt_scalef32_pk_fp4_f32(w1, cv[3].x * sc, cv[3].y * sc, 1.0f, 2); w1 = __builtin_amdgcn_cvt_scalef32_pk_fp4_f32(w1, cv[3].z * sc, cv[3].w * sc, 1.0f, 3); }
        unsigned char* dst = (T.cf < half ? T.du + (size_t)T.cf * 512 : T.dv + (size_t)(T.cf - half) * 512) + 8 * lane;
        *(GAS v2u*)dst = (v2u){w0, w1}; }
    T.cf += T.stride;
}
template <bool PASS1> __device__ __forceinline__ void ssm_pass(const bf16* U, bf16* Y, LAS unsigned char* stl, const float* dskip, size_t tok0, int g, int lane, int n, int hh, int i_row,
                                                                  const float (&a_re)[2], const float (&a_im)[2], const bf16x8 (&Bf)[4], const LAS unsigned char* CFL, float (&s_re)[2], float (&s_im)[2]) {
    const int c0 = 16 * g + 4 * hh;
    bf16x8 ua_n = *(const GAS bf16x8*)(U + tok0 * DM + 16 * g + 8 * hh);
    v2u u0_n = {}, u1_n = {};
    if (PASS1) { u0_n = *(const GAS v2u*)(U + tok0 * DM + c0); u1_n = *(const GAS v2u*)(U + tok0 * DM + c0 + 8); }
#pragma unroll 1
    for (int tile = 0; tile < 16; ++tile) {
        const size_t tok = tok0 + tile * 16;
        const bf16x8 ua = ua_n; const v2u u0 = u0_n, u1 = u1_n;
        { const size_t tokn = tok0 + ((tile + 1) & 15) * 16;
          ua_n = *(const GAS bf16x8*)(U + tokn * DM + 16 * g + 8 * hh);
          if (PASS1) { u0_n = *(const GAS v2u*)(U + tokn * DM + c0); u1_n = *(const GAS v2u*)(U + tokn * DM + c0 + 8); } }
        f32x16 acc[4];
#pragma unroll
        for (int nb = 0; nb < 4; ++nb) { f32x16 z = {}; acc[nb] = __builtin_amdgcn_mfma_f32_32x32x16_bf16(ua, Bf[nb], z, 0, 0, 0); }
#pragma unroll
        for (int pb = 0; pb < 2; ++pb) {
#pragma unroll
            for (int r = 0; r < 16; ++r) {
                float t0 = fmaf(-a_im[pb], s_im[pb], acc[2 * pb][r]); asm volatile("" : "+v"(t0));
                float t1 = fmaf(a_im[pb], s_re[pb], acc[2 * pb + 1][r]); asm volatile("" : "+v"(t1));
                float nre = fmaf(a_re[pb], s_re[pb], t0); asm volatile("" : "+v"(nre));
                float nim = fmaf(a_re[pb], s_im[pb], t1); asm volatile("" : "+v"(nim));
                s_re[pb] = nre; s_im[pb] = nim;
                if (PASS1) { const int irow = (r & 3) + 8 * (r >> 2) + 4 * hh; *(LAS unsigned*)(stl + irow * 272 + (32 * pb + n) * 4) = cvt_pk_bf16(nre, nim); }
            }
        }
        if (PASS1) {
            LDS_WAIT();
            f32x16 yv = {};
#pragma unroll
            for (int ks = 0; ks < 8; ++ks) { const bf16x8 sb = *(const LAS bf16x8*)(stl + i_row * 272 + (16 * ks + 8 * hh) * 2); const bf16x8 cf = *(const LAS bf16x8*)(CFL + (ks * 64 + lane) * 16); yv = __builtin_amdgcn_mfma_f32_32x32x16_bf16(cf, sb, yv, 0, 0, 0); }
            const f32x4 d0 = *(const GAS f32x4*)(dskip + c0), d1 = *(const GAS f32x4*)(dskip + c0 + 8);
            float o[8];
            o[0] = gelu_tanh(yv[0] + d0.x * bf_lo(u0.x)); o[1] = gelu_tanh(yv[1] + d0.y * bf_hi(u0.x)); o[2] = gelu_tanh(yv[2] + d0.z * bf_lo(u0.y)); o[3] = gelu_tanh(yv[3] + d0.w * bf_hi(u0.y));
            o[4] = gelu_tanh(yv[4] + d1.x * bf_lo(u1.x)); o[5] = gelu_tanh(yv[5] + d1.y * bf_hi(u1.x)); o[6] = gelu_tanh(yv[6] + d1.z * bf_lo(u1.y)); o[7] = gelu_tanh(yv[7] + d1.w * bf_hi(u1.y));
            *(GAS unsigned*)((unsigned char*)Y + tok * DM + c0) = pk4_fp8(o[0], o[1], o[2], o[3]);
            *(GAS unsigned*)((unsigned char*)Y + tok * DM + c0 + 8) = pk4_fp8(o[4], o[5], o[6], o[7]);
            LDS_WAIT();
        }
    }
}
__device__ __forceinline__ void ssm_phase(Frame& F, int layer) {
    if (layer == 0) {
        TabCvt TC; TC.su = F.A->in[24 + F.z]; TC.sv = F.A->in[25 + F.z]; TC.du = (unsigned char*)(F.ws + WS_TABU); TC.dv = (unsigned char*)(F.ws + WS_TABV);
        TC.c = F.vcu * NWAVES + F.wave; TC.cf = TC.c; TC.stride = F.G * NWAVES; TC.n = 2 * 16384;
        f32x4 cvA[4], cvB[4];
        tabcvt_issue(TC, F.lane, cvA);
        while (TC.cf < TC.n) { tabcvt_issue(TC, F.lane, cvB); tabcvt_finish(TC, F.lane, cvA); tabcvt_issue(TC, F.lane, cvA); tabcvt_finish(TC, F.lane, cvB); }
    }
    const bf16* U = (const bf16*)(F.ws + WS_U); bf16* Y = (bf16*)(F.ws + WS_Y);
    const int lane = F.lane, n = lane & 31, hh = lane >> 5, wave = F.wave;
    LAS unsigned char* stl = F.lds + wave * 8704;
    LAS float* E = (LAS float*)(F.lds + 8 * 8704);
    for (int bg = F.vcu; bg < BATCH * 64; bg += F.G) {
        const int b = bg >> 6, g = bg & 63, lg = layer * 64 + g;
        const float dt = expf(F.A->in[9 + F.z][lg]);
        float a_re[2], a_im[2]; bf16x8 Bf[4];
#pragma unroll
        for (int pb = 0; pb < 2; ++pb) {
            const int p = 32 * pb + n;
            const float lre = F.A->in[7 + F.z][lg * 64 + p], lim = F.A->in[8 + F.z][lg * 64 + p];
            const float mag = expf(lre * dt); float sn, cs; sincosf(lim * dt, &sn, &cs);
            a_re[pb] = mag * cs; a_im[pb] = mag * sn;
            const float nr = a_re[pb] - 1.0f, ni = a_im[pb], den = 1.0f / (lre * lre + lim * lim);
            const float cr = (nr * lre + ni * lim) * den, ci = (ni * lre - nr * lim) * den;
            const float* br = F.A->in[10 + F.z] + ((size_t)lg * 64 + p) * 16 + 8 * hh; const float* bi = F.A->in[11 + F.z] + ((size_t)lg * 64 + p) * 16 + 8 * hh;
            const f32x4 br0 = *(const GAS f32x4*)br, br1 = *(const GAS f32x4*)(br + 4), bi0 = *(const GAS f32x4*)bi, bi1 = *(const GAS f32x4*)(bi + 4);
            const float rr[8] = {br0.x, br0.y, br0.z, br0.w, br1.x, br1.y, br1.z, br1.w}, ii[8] = {bi0.x, bi0.y, bi0.z, bi0.w, bi1.x, bi1.y, bi1.z, bi1.w};
            unsigned wre[4], wim[4];
#pragma unroll
            for (int j = 0; j < 4; ++j) { const float r0 = rr[2 * j], i0 = ii[2 * j], r1 = rr[2 * j + 1], i1 = ii[2 * j + 1];
                wre[j] = pk2(cr * r0 - ci * i0, cr * r1 - ci * i1); wim[j] = pk2(cr * i0 + ci * r0, cr * i1 + ci * r1); }
            Bf[2 * pb] = __builtin_bit_cast(bf16x8, (v4u){wre[0], wre[1], wre[2], wre[3]});
            Bf[2 * pb + 1] = __builtin_bit_cast(bf16x8, (v4u){wim[0], wim[1], wim[2], wim[3]});
        }
        LAS unsigned char* CFL = F.lds + 8 * 8704 + 8192;
        if (wave == 0) { const int cr_ = n & 15; const float zm = (n < 16) ? 1.0f : 0.0f;
          const float* cre = F.A->in[12 + F.z] + ((size_t)lg * 16 + cr_) * 64 + 4 * hh; const float* cim = F.A->in[13 + F.z] + ((size_t)lg * 16 + cr_) * 64 + 4 * hh;
          f32x4 cr4[8], ci4[8];
#pragma unroll
          for (int ks = 0; ks < 8; ++ks) { cr4[ks] = *(const GAS f32x4*)(cre + 8 * ks); ci4[ks] = *(const GAS f32x4*)(cim + 8 * ks); }
#pragma unroll
          for (int ks = 0; ks < 8; ++ks) { const f32x4 a = cr4[ks] * zm, c = ci4[ks] * (-zm);
              *(LAS v4u*)(CFL + (ks * 64 + lane) * 16) = (v4u){pk2(a.x, c.x), pk2(a.y, c.y), pk2(a.z, c.z), pk2(a.w, c.w)}; } }
        const int seg_own = 2 * wave + hh;
        const int i_row = n, seg_ld = 2 * wave + ((i_row >> 2) & 1), tau_ld = (i_row & 3) + 4 * (i_row >> 3);
        const size_t tok0 = (size_t)b * SEQ + seg_ld * 256 + tau_ld;
        const float* dskip = F.A->in[14 + F.z] + layer * 1024;
        float s_re[2] = {0.f, 0.f}, s_im[2] = {0.f, 0.f};
        ssm_pass<false>(U, Y, stl, dskip, tok0, g, lane, n, hh, i_row, a_re, a_im, Bf, CFL, s_re, s_im);
#pragma unroll
        for (int pb = 0; pb < 2; ++pb) { E[(seg_own * 64 + 32 * pb + n) * 2] = s_re[pb]; E[(seg_own * 64 + 32 * pb + n) * 2 + 1] = s_im[pb]; }
        LDS_WAIT(); __syncthreads();
#pragma unroll
        for (int pb = 0; pb < 2; ++pb) {
            float Ar = a_re[pb], Ai = a_im[pb];
#pragma unroll
            for (int q = 0; q < 8; ++q) { float t = Ar * Ar - Ai * Ai; asm volatile("" : "+v"(t)); Ai = 2.0f * Ar * Ai; asm volatile("" : "+v"(Ai)); Ar = t; }
            float sr = 0.f, si = 0.f;
            for (int j = 0; j < 15; ++j) {
                const float er = E[(j * 64 + 32 * pb + n) * 2], ei = E[(j * 64 + 32 * pb + n) * 2 + 1];
                float tr = Ar * sr - Ai * si + er; asm volatile("" : "+v"(tr)); float ti = Ar * si + Ai * sr + ei; asm volatile("" : "+v"(ti));
                if (j < seg_own) { sr = tr; si = ti; }
            }
            s_re[pb] = sr; s_im[pb] = si;
        }
        __syncthreads();
        ssm_pass<true>(U, Y, stl, dskip, tok0, g, lane, n, hh, i_row, a_re, a_im, Bf, CFL, s_re, s_im);
        __syncthreads();
    }
}

__device__ __forceinline__ void attn_wave_unit(Frame& F, int b, int hd, int qt) {
    const unsigned char* Q = (const unsigned char*)(F.ws + WS_U); const unsigned char* K = (const unsigned char*)(F.ws + WS_KB); const unsigned char* Vt = (const unsigned char*)(F.ws + WS_VT); bf16* O = (bf16*)(F.ws + WS_Y);
    constexpr float QK_SC = 0.125f * 1.4426950408889634f;
    constexpr float ATT_EXIT = 28.0f;
    const int lane = F.lane, n = lane & 31, hh = lane >> 5;
    const size_t qrow = (size_t)b * SEQ + 32 * qt + n;
    long qf[4];
#pragma unroll
    for (int ks = 0; ks < 4; ++ks) qf[ks] = *(const GAS long*)(Q + qrow * DM + 64 * hd + 16 * ks + 8 * hh);
    f32x16 o[2]; o[0] = f32x16{}; o[1] = f32x16{};
    float racc = 0.f;
    const int qrel = 32 * qt, myq = qrel + n;
    const int keyi = (n & 3) + 4 * (n >> 3) + 16 * ((n >> 2) & 1);
    const unsigned char* kbase = K + ((size_t)b * SEQ + keyi) * DM + 64 * hd + 8 * hh;
    const unsigned char* vbase = Vt + (size_t)(64 * hd + n) * TOK + (size_t)b * SEQ + 16 * hh;
    int T = (qrel + 30) >> 6;
    long kf[2][4];
#pragma unroll
    for (int u = 0; u < 2; ++u)
#pragma unroll
        for (int ks = 0; ks < 4; ++ks) kf[u][ks] = *(const GAS long*)(kbase + (size_t)(64 * T + 32 * u) * DM + 16 * ks);
    for (; T >= 0; --T) {
        const int k0 = 64 * T;
        f32x16 s0 = {}, s1 = {};
#pragma unroll
        for (int ks = 0; ks < 4; ++ks) { s0 = __builtin_amdgcn_mfma_f32_32x32x16_fp8_fp8(kf[0][ks], qf[ks], s0, 0, 0, 0); s1 = __builtin_amdgcn_mfma_f32_32x32x16_fp8_fp8(kf[1][ks], qf[ks], s1, 0, 0, 0); }
        long vf[2][2][2];
#pragma unroll
        for (int u = 0; u < 2; ++u)
#pragma unroll
            for (int sx = 0; sx < 2; ++sx)
#pragma unroll
                for (int db = 0; db < 2; ++db) vf[u][sx][db] = *(const GAS long*)(vbase + (size_t)(32 * db) * TOK + k0 + 32 * u + 8 * sx);
        { const int Tn = T > 0 ? T - 1 : 0;
#pragma unroll
          for (int u = 0; u < 2; ++u)
#pragma unroll
              for (int ks = 0; ks < 4; ++ks) kf[u][ks] = *(const GAS long*)(kbase + (size_t)(64 * Tn + 32 * u) * DM + 16 * ks); }
        const bool need_mask = (k0 + 63 >= qrel);
        float sp[2][16], z[2][16];
#pragma unroll
        for (int r = 0; r < 16; ++r) { const float za = fminf(s0[r] * QK_SC, 60.0f), zb = fminf(s1[r] * QK_SC, 60.0f); z[0][r] = za; z[1][r] = zb;
            sp[0][r] = __builtin_amdgcn_logf(1.0f + __builtin_amdgcn_exp2f(za)); sp[1][r] = __builtin_amdgcn_logf(1.0f + __builtin_amdgcn_exp2f(zb)); }
        if (need_mask) {
#pragma unroll
            for (int u = 0; u < 2; ++u)
#pragma unroll
                for (int r = 0; r < 16; ++r) { const int key = k0 + 32 * u + 16 * hh + r; if (key >= myq) { sp[u][r] = 0.f; z[u][r] = -1e30f; } }
        }
        float T0 = 0.f, T1 = 0.f;
#pragma unroll
        for (int r = 0; r < 16; ++r) { T0 += sp[0][r]; T1 += sp[1][r]; }
        const float oT0 = __shfl_xor(T0, 32), oT1 = __shfl_xor(T1, 32);
        const float off1 = racc + (hh ? 0.f : oT1);
        const float off0 = racc + T1 + oT1 + (hh ? 0.f : oT0);
        racc += T0 + T1 + oT0 + oT1;
        unsigned pw[2][4];
        { float run = off1;
#pragma unroll
          for (int r = 15; r >= 0; --r) { run += sp[1][r]; z[1][r] = __builtin_amdgcn_exp2f(z[1][r] - run); }
          run = off0;
#pragma unroll
          for (int r = 15; r >= 0; --r) { run += sp[0][r]; z[0][r] = __builtin_amdgcn_exp2f(z[0][r] - run); } }
#pragma unroll
        for (int u = 0; u < 2; ++u)
#pragma unroll
            for (int q = 0; q < 4; ++q) pw[u][q] = pk4_fp8(z[u][4 * q], z[u][4 * q + 1], z[u][4 * q + 2], z[u][4 * q + 3]);
#pragma unroll
        for (int u = 0; u < 2; ++u)
#pragma unroll
            for (int sx = 0; sx < 2; ++sx) { const long af = (long)(((unsigned long long)pw[u][2 * sx + 1] << 32) | (unsigned long long)pw[u][2 * sx]);
#pragma unroll
                for (int db = 0; db < 2; ++db) o[db] = __builtin_amdgcn_mfma_f32_32x32x16_fp8_fp8(af, vf[u][sx][db], o[db], 0, 0, 0); }
        if (__all(racc >= ATT_EXIT)) break;
    }
#pragma unroll
    for (int db = 0; db < 2; ++db)
#pragma unroll
        for (int r = 0; r < 16; ++r) { const int qr = (r & 3) + 8 * (r >> 2) + 4 * hh;
            ((unsigned char*)O)[((size_t)b * SEQ + 32 * qt + qr) * DM + 64 * hd + 32 * db + n] = (unsigned char)(pk4_fp8(o[db][r], 0.f, 0.f, 0.f) & 0xffu); }
}
__device__ __forceinline__ void attn_phase(Frame& F) {
    const int gw = F.vcu * NWAVES + F.wave, NGW = F.G * NWAVES;
#pragma unroll 1
    for (int uidx = gw; uidx < 64 * 128; uidx += NGW) { const int bh = uidx >> 7; attn_wave_unit(F, bh >> 4, bh & 15, uidx & 127); }
}

typedef float f32x2 __attribute__((ext_vector_type(2)));
typedef _Float16 h16x2 __attribute__((ext_vector_type(2)));
template <int K, class T> __device__ __forceinline__ T xcomb(T a, T b, int lane) {
    const bool hi = (lane >> K) & 1; const T keep = hi ? b : a, send = hi ? a : b;
    return keep + __shfl_xor(send, 1 << K);
}
__device__ __forceinline__ void fp4x16_to_f32(const v2u& r, f32x2 (&f)[8]) {
    const unsigned w0 = r.x, w1 = r.y;
    f[0] = __builtin_amdgcn_cvt_scalef32_pk_f32_fp4(w0, 1.0f, 0); f[1] = __builtin_amdgcn_cvt_scalef32_pk_f32_fp4(w0, 1.0f, 1);
    f[2] = __builtin_amdgcn_cvt_scalef32_pk_f32_fp4(w0, 1.0f, 2); f[3] = __builtin_amdgcn_cvt_scalef32_pk_f32_fp4(w0, 1.0f, 3);
    f[4] = __builtin_amdgcn_cvt_scalef32_pk_f32_fp4(w1, 1.0f, 0); f[5] = __builtin_amdgcn_cvt_scalef32_pk_f32_fp4(w1, 1.0f, 1);
    f[6] = __builtin_amdgcn_cvt_scalef32_pk_f32_fp4(w1, 1.0f, 2); f[7] = __builtin_amdgcn_cvt_scalef32_pk_f32_fp4(w1, 1.0f, 3);
}
typedef unsigned bl_v2u __attribute__((__vector_size__(8)));
__device__ __forceinline__ void peer_load8(__amdgpu_buffer_rsrc_t tab, int idv, int e0, int lane, v2u (&R)[8]) {
    int so[8];
    __builtin_amdgcn_s_setprio(1);
#pragma unroll
    for (int i = 0; i < 8; ++i) so[i] = __builtin_amdgcn_readlane(idv, e0 + i) << 9;
    __builtin_amdgcn_sched_barrier(0);
#pragma unroll
    for (int i = 0; i < 8; ++i) { const bl_v2u t = __builtin_amdgcn_raw_buffer_load_b64(tab, 8 * lane, so[i], 0); R[i] = (v2u){t[0], t[1]}; }
    __builtin_amdgcn_s_setprio(0);
    __builtin_amdgcn_sched_barrier(0);
}
template <int K> __device__ __forceinline__ int xcomb_dpp(int a, int b, int lane) {
    const bool hi = (lane >> K) & 1; const int keep = hi ? b : a, send = hi ? a : b; int recv;
    if (K == 0) recv = __builtin_amdgcn_update_dpp(0, send, 0xB1, 0xF, 0xF, true);
    else if (K == 1) recv = __builtin_amdgcn_update_dpp(0, send, 0x4E, 0xF, 0xF, true);
    else { recv = __builtin_amdgcn_update_dpp(0, send, 0x104, 0xF, 0x5, true);
           recv = __builtin_amdgcn_update_dpp(recv, send, 0x114, 0xF, 0xA, true); }
    return keep + recv;
}
__device__ __forceinline__ float peer_dot8(const v2u (&R)[8], const v2u& xhi, const v2u& xlo, int lane) {
    int p[8];
#pragma unroll
    for (int i = 0; i < 8; i += 2) {
        int h0 = __builtin_amdgcn_sdot8((int)R[i].x, (int)xhi.x, 0, false), h1 = __builtin_amdgcn_sdot8((int)R[i + 1].x, (int)xhi.x, 0, false);
        int l0 = __builtin_amdgcn_sdot8((int)R[i].x, (int)xlo.x, 0, false), l1 = __builtin_amdgcn_sdot8((int)R[i + 1].x, (int)xlo.x, 0, false);
        h0 = __builtin_amdgcn_sdot8((int)R[i].y, (int)xhi.y, h0, false); h1 = __builtin_amdgcn_sdot8((int)R[i + 1].y, (int)xhi.y, h1, false);
        l0 = __builtin_amdgcn_sdot8((int)R[i].y, (int)xlo.y, l0, false); l1 = __builtin_amdgcn_sdot8((int)R[i + 1].y, (int)xlo.y, l1, false);
        p[i] = (h0 << 4) + l0; p[i + 1] = (h1 << 4) + l1; __builtin_amdgcn_sched_barrier(0); }
    int q[4];
#pragma unroll
    for (int i = 0; i < 4; ++i) q[i] = xcomb_dpp<0>(p[2 * i], p[2 * i + 1], lane);
    const int r0 = xcomb_dpp<1>(q[0], q[1], lane), r1 = xcomb_dpp<1>(q[2], q[3], lane);
    int v = xcomb_dpp<2>(r0, r1, lane);
    v += __builtin_amdgcn_update_dpp(0, v, 0x128, 0xF, 0xF, true);
    { const auto t = __builtin_amdgcn_permlane16_swap((unsigned)v, (unsigned)v, false, false); v = (int)(t[0] + t[1]); }
    { const auto t = __builtin_amdgcn_permlane32_swap((unsigned)v, (unsigned)v, false, false); v = (int)(t[0] + t[1]); }
    return (float)v;
}
__device__ __forceinline__ void peer_fma8(const v2u (&R)[8], unsigned wvh, int e0, h16x2 (&o)[8]) {
#pragma unroll
    for (int i = 0; i < 8; ++i) { const unsigned wt = (unsigned)__builtin_amdgcn_readlane((int)wvh, e0 + i); const h16x2 w2 = __builtin_bit_cast(h16x2, wt);
        const unsigned w0 = R[i].x, w1 = R[i].y; h16x2 f[8];
        f[0] = __builtin_amdgcn_cvt_scalef32_pk_f16_fp4(w0, 1.0f, 0); f[1] = __builtin_amdgcn_cvt_scalef32_pk_f16_fp4(w0, 1.0f, 1);
        f[2] = __builtin_amdgcn_cvt_scalef32_pk_f16_fp4(w0, 1.0f, 2); f[3] = __builtin_amdgcn_cvt_scalef32_pk_f16_fp4(w0, 1.0f, 3);
        f[4] = __builtin_amdgcn_cvt_scalef32_pk_f16_fp4(w1, 1.0f, 0); f[5] = __builtin_amdgcn_cvt_scalef32_pk_f16_fp4(w1, 1.0f, 1);
        f[6] = __builtin_amdgcn_cvt_scalef32_pk_f16_fp4(w1, 1.0f, 2); f[7] = __builtin_amdgcn_cvt_scalef32_pk_f16_fp4(w1, 1.0f, 3);
#pragma unroll
        for (int k = 0; k < 8; ++k) o[k] = __builtin_elementwise_fma(w2, f[k], o[k]);
        __builtin_amdgcn_sched_barrier(0); }
}
__device__ __forceinline__ void peer_phase(Frame& F, int layer) {
    const bf16* H1 = (const bf16*)(F.ws + WS_H1); bf16* H2 = (bf16*)(F.ws + WS_H2);
    const __amdgpu_buffer_rsrc_t TU = __builtin_amdgcn_make_buffer_rsrc((void*)(F.ws + WS_TABU + (size_t)layer * 16384 * 512), (short)0, 16384 * 512, 0x00020000);
    const __amdgpu_buffer_rsrc_t TV = __builtin_amdgcn_make_buffer_rsrc((void*)(F.ws + WS_TABV + (size_t)layer * 16384 * 512), (short)0, 16384 * 512, 0x00020000);
    const int* IDX = (const int*)(F.ws + WS_IDX); const float* GATE = (const float*)(F.ws + WS_GATE);
    const float* g = F.A->in[4 + F.z] + layer * 1024; const float* bb = F.A->in[5 + F.z] + layer * 1024;
    const int lane = F.lane, gw = F.vcu * NWAVES + F.wave, NGW = F.G * NWAVES;
    v2u B0[8], B1[8], B2[8], B3[8];
    TabCvt TC; { const size_t lo = (size_t)(layer + 1) * 16384 * 1024;
        TC.su = F.A->in[24 + F.z] + lo; TC.sv = F.A->in[25 + F.z] + lo; TC.du = (unsigned char*)(F.ws + WS_TABU) + lo / 2; TC.dv = (unsigned char*)(F.ws + WS_TABV) + lo / 2;
        TC.c = gw; TC.cf = gw; TC.stride = NGW; TC.n = (layer + 1 < DEPTH) ? 2 * 16384 : 0; }
    f32x4 cvA[4], cvB[4];
    int id0 = 0, id1 = 0;
    if (gw < TOK) { id0 = IDX[(size_t)gw * 128 + lane]; id1 = IDX[(size_t)gw * 128 + 64 + lane];
        peer_load8(TU, id0, 0, lane, B0); peer_load8(TU, id0, 8, lane, B1); peer_load8(TU, id0, 16, lane, B2); }
    tabcvt_issue(TC, lane, cvA); tabcvt_issue(TC, lane, cvB);
    for (int t = gw; t < TOK; t += NGW) {
        const int tn = (t + NGW < TOK) ? t + NGW : t;
        const int nid0 = IDX[(size_t)tn * 128 + lane], nid1 = IDX[(size_t)tn * 128 + 64 + lane];
        const float g0 = GATE[(size_t)t * 128 + lane], g1 = GATE[(size_t)t * 128 + 64 + lane];
        const v4u xa = *(const GAS v4u*)(H1 + (size_t)t * DM + 16 * lane), xb = *(const GAS v4u*)(H1 + (size_t)t * DM + 16 * lane + 8);
        f32x2 x[8] = {{bf_lo(xa.x), bf_hi(xa.x)}, {bf_lo(xa.y), bf_hi(xa.y)}, {bf_lo(xa.z), bf_hi(xa.z)}, {bf_lo(xa.w), bf_hi(xa.w)}, {bf_lo(xb.x), bf_hi(xb.x)}, {bf_lo(xb.y), bf_hi(xb.y)}, {bf_lo(xb.z), bf_hi(xb.z)}, {bf_lo(xb.w), bf_hi(xb.w)}};
        v2u xqh = {0u, 0u}, xql = {0u, 0u};
#pragma unroll
        for (int i = 0; i < 16; ++i) { const float xv = (i & 1) ? x[i >> 1].y : x[i >> 1].x;
            float qf = __builtin_fminf(__builtin_fmaxf(xv * 16.f, -120.f), 119.f) + 12582912.0f; asm volatile("" : "+v"(qf)); const unsigned q = __builtin_bit_cast(unsigned, qf);
            const unsigned lo = q & 15u, hi = ((q + 8u) >> 4) & 15u;
            if (i < 8) { xql.x |= lo << (4 * i); xqh.x |= hi << (4 * i); } else { xql.y |= lo << (4 * (i - 8)); xqh.y |= hi << (4 * (i - 8)); } }
#define PEER_LOADB(buf, b) do { const int b_ = (b); if (b_ < 32) peer_load8((b_ & 16) ? TV : TU, (b_ & 8) ? id1 : id0, 8 * (b_ & 7), lane, buf); else peer_load8(TU, nid0, 8 * (b_ & 7), lane, buf); } while (0)
#define PEER_DOTB(buf, b) do { const int b_ = (b); const float r_ = peer_dot8(buf, xqh, xql, lane); const bool mine_ = (lane >> 3) == (b_ & 7); if (b_ & 8) act1 = mine_ ? r_ : act1; else act0 = mine_ ? r_ : act0; } while (0)
#define PEER_FMAB(buf, b) do { const int b_ = (b); peer_fma8(buf, (b_ & 8) ? w1h : w0h, 8 * (b_ & 7), o); } while (0)
        float act0 = 0.f, act1 = 0.f;
#pragma unroll 1
        for (int j = 0; j < 16; j += 4) {
            PEER_LOADB(B3, j + 3); PEER_DOTB(B0, j);
            PEER_LOADB(B0, j + 4); PEER_DOTB(B1, j + 1);
            PEER_LOADB(B1, j + 5); PEER_DOTB(B2, j + 2);
            PEER_LOADB(B2, j + 6); PEER_DOTB(B3, j + 3);
        }
        const float w0 = g0 * gelu_tanh(act0 * (1.0f / (16.f * PEER_SU))) * (1.0f / PEER_SV), w1 = g1 * gelu_tanh(act1 * (1.0f / (16.f * PEER_SU))) * (1.0f / PEER_SV);
        unsigned w0h, w1h; { const _Float16 a = (_Float16)w0, b = (_Float16)w1; const h16x2 pa = {a, a}, pb = {b, b}; w0h = __builtin_bit_cast(unsigned, pa); w1h = __builtin_bit_cast(unsigned, pb); }
        h16x2 o[8];
#pragma unroll
        for (int i = 0; i < 8; ++i) o[i] = (h16x2){(_Float16)0.f, (_Float16)0.f};
#pragma unroll 1
        for (int j = 16; j < 32; j += 4) {
            PEER_LOADB(B3, j + 3); PEER_FMAB(B0, j);
            PEER_LOADB(B0, j + 4); PEER_FMAB(B1, j + 1);
            PEER_LOADB(B1, j + 5); PEER_FMAB(B2, j + 2);
            PEER_LOADB(B2, j + 6); PEER_FMAB(B3, j + 3);
        }
#undef PEER_LOADB
#undef PEER_DOTB
#undef PEER_FMAB
        id0 = nid0; id1 = nid1;
        tabcvt_finish(TC, lane, cvA); tabcvt_finish(TC, lane, cvB);
        tabcvt_issue(TC, lane, cvA); tabcvt_issue(TC, lane, cvB);
        float y[16]; float sm = 0.f;
#pragma unroll
        for (int i = 0; i < 8; ++i) { y[2 * i] = pg8::ALPHA_F * x[i].x + (float)o[i].x; y[2 * i + 1] = pg8::ALPHA_F * x[i].y + (float)o[i].y; sm += y[2 * i] + y[2 * i + 1]; }
        const float mean = wave_sum_dpp(sm) * (1.f / DM); float q = 0.f;
#pragma unroll
        for (int i = 0; i < 16; ++i) { y[i] -= mean; q += y[i] * y[i]; }
        const float rstd = 1.0f / sqrtf(wave_sum_dpp(q) * (1.f / DM) + LN_EPS);
#pragma unroll
        for (int c = 0; c < 4; ++c) { const f32x4 gv = *(const GAS f32x4*)(g + 16 * lane + 4 * c), bv = *(const GAS f32x4*)(bb + 16 * lane + 4 * c);
            y[4 * c] = y[4 * c] * rstd * gv.x + bv.x; y[4 * c + 1] = y[4 * c + 1] * rstd * gv.y + bv.y; y[4 * c + 2] = y[4 * c + 2] * rstd * gv.z + bv.z; y[4 * c + 3] = y[4 * c + 3] * rstd * gv.w + bv.w; }
        v4u oa, ob; oa.x = pk2(y[0], y[1]); oa.y = pk2(y[2], y[3]); oa.z = pk2(y[4], y[5]); oa.w = pk2(y[6], y[7]); ob.x = pk2(y[8], y[9]); ob.y = pk2(y[10], y[11]); ob.z = pk2(y[12], y[13]); ob.w = pk2(y[14], y[15]);
        *(GAS v4u*)(H2 + (size_t)t * DM + 16 * lane) = oa; *(GAS v4u*)(H2 + (size_t)t * DM + 16 * lane + 8) = ob;
        *(GAS v4u*)((unsigned char*)(F.ws + WS_H28) + (size_t)t * DM + 16 * lane) = (v4u){pk4_fp8(y[0], y[1], y[2], y[3]), pk4_fp8(y[4], y[5], y[6], y[7]), pk4_fp8(y[8], y[9], y[10], y[11]), pk4_fp8(y[12], y[13], y[14], y[15])};
    }
    tabcvt_finish(TC, lane, cvA); tabcvt_finish(TC, lane, cvB);
    while (TC.cf < TC.n) { tabcvt_issue(TC, lane, cvA); tabcvt_finish(TC, lane, cvA); }
}

template <class Epi> __device__ __forceinline__ void run_gemm(Frame& F, const bf16* A, const bf16* Bt, int M, int N, int K, const Epi& E, int pw = 0) {
    pg8::Gemm g{A, Bt, M, N, K}; pg8::StaticOrder S; S.init(M, N, F.G, pw ? F.vcu : F.bx); S.pw = pw; if (pw) S.nwg = 1024;
    int t = F.tid; asm volatile("" : "+v"(t));
    pg8::gemm_phase<Epi, pg8::StaticOrder, true, true>(F.lds, g, S, E, t);
}

template <class Epi> __device__ __forceinline__ void run_gemm8(Frame& F, const unsigned char* A8, const unsigned char* Bt8, int M, int N, int Kbytes, const Epi& E) {
    pg8::Gemm g{(const bf16*)A8, (const bf16*)Bt8, M, N, Kbytes / 2 + F.z  }; pg8::StaticOrder S; S.init(M, N, F.G, F.bx);
    int t = F.tid; asm volatile("" : "+v"(t));
    pg8::gemm_phase<Epi, pg8::StaticOrder, true, true, true>(F.lds, g, S, E, t);
}

__global__ void __launch_bounds__(NWAVES * 64, 2) mega_fwd(Args args) {
    extern __shared__ __attribute__((aligned(16))) unsigned char lds[];
    Frame F;
    F.lds = (LAS unsigned char*)lds;
    F.tid = threadIdx.x; F.lane = F.tid & 63; F.wave = 0; F.G = gridDim.x; F.bx = blockIdx.x; F.vcu = 0;
    F.A = &args; F.z = 0; F.out = args.out; F.ws = args.ws;
    const int wave_s = __builtin_amdgcn_readfirstlane((int)threadIdx.x >> 6);
    volatile LAS unsigned* MISC = (volatile LAS unsigned*)(F.lds + MISC_OFF);
    if (F.tid < 64) MISC[F.tid] = 0u;
    __syncthreads();
    XcdBarrier bar; bar.bar = (unsigned*)(F.ws + WS_CTL) + CW_BAR; bar.x = 0; bar.st = nullptr;
    if (args.use_bar) bar = xcd_barrier_post((unsigned*)(F.ws + WS_CTL) + CW_BAR, MISC + 8);

    for (int pc = args.ph_lo; pc < args.ph_hi; ++pc) {
        { int z = 0; asm volatile("" : "+s"(z)); int t = wave_s * 64 + (int)__builtin_amdgcn_mbcnt_hi(~0u, __builtin_amdgcn_mbcnt_lo(~0u, (unsigned)z)); asm volatile("" : "+v"(t));
          F.z = z; F.ws = args.ws + z; F.tid = t; F.lane = t & 63; F.wave = __builtin_amdgcn_readfirstlane(t >> 6);
          F.G = (int)gridDim.x + z; F.bx = (int)blockIdx.x + z; F.vcu = (F.G % 8 == 0) ? (F.bx % 8) * (F.G / 8) + F.bx / 8 : F.bx; }
        bf16* const H = (bf16*)(F.ws + WS_H); bf16* const U = (bf16*)(F.ws + WS_U); bf16* const Y = (bf16*)(F.ws + WS_Y); bf16* const X1 = (bf16*)(F.ws + WS_X1);
        bf16* const H1 = (bf16*)(F.ws + WS_H1); bf16* const H2 = (bf16*)(F.ws + WS_H2); bf16* const KB = (bf16*)(F.ws + WS_KB); bf16* const VT = (bf16*)(F.ws + WS_VT); bf16* const HKV = (bf16*)(F.ws + WS_HKV);
        const int ty = args.ph_type[pc], la = args.ph_arg[pc];
#ifndef PHMASK
#define PHMASK 0xFFFF
#endif
#define EN(x) ((PHMASK >> (x)) & 1)
        switch (ty) {
        case P_PROLOGUE: if (EN(P_PROLOGUE)) p0_prologue(F); break;
        case P_STORE: if (EN(P_STORE)) {
            const int njobs = (la == 0) ? 2 : (la == 2) ? 3 : 1;
            for (int j = 0; j < njobs; ++j) {
                const bf16* A; const bf16* Bt; int M = TOK, N = 1024, K = 1024, ldc = 1024, pw = 0; bf16* O; float sc = 1.0f;
                if (la == 0 && j == 0) { A = (const bf16*)(F.ws + WS_PB); Bt = (const bf16*)(F.ws + WS_W_PW); K = 256; O = (bf16*)(F.ws + WS_PW); pw = 1; }
                else if (la == 0) { A = H; Bt = (const bf16*)(F.ws + WS_W_IN); O = U; }
                else if (la == 1) { A = H; Bt = (const bf16*)(F.ws + WS_W_IN) + (size_t)1024 * 1024; O = U; }
                else if (la == 2 && j == 1) { A = HKV; Bt = (const bf16*)(F.ws + WS_W_KV); O = KB; }
                else if (la == 2 && j == 2) { A = (const bf16*)(F.ws + WS_W_KV) + (size_t)1024 * 1024; Bt = HKV; M = 1024; N = TOK; ldc = TOK; O = VT; }
                else { A = H; Bt = (const bf16*)(F.ws + WS_W_SQ) + (size_t)(la - 2) * 1024 * 1024; O = U; sc = 0.125f * 1.4426950408889634f; }
                if (!pw) {
                    const unsigned char* A8; const unsigned char* B8;
                    if (la <= 1) { A8 = (const unsigned char*)(F.ws + WS_H8); B8 = (const unsigned char*)(F.ws + W8_IN) + (size_t)la * 1024 * 1024; }
                    else if (la == 2 && j == 1) { A8 = (const unsigned char*)(F.ws + WS_HKV); B8 = (const unsigned char*)(F.ws + W8_KV); }
                    else if (la == 2 && j == 2) { A8 = (const unsigned char*)(F.ws + W8_KV) + (size_t)1024 * 1024; B8 = (const unsigned char*)(F.ws + WS_HKV); }
                    else { A8 = (const unsigned char*)(F.ws + WS_H8); B8 = (const unsigned char*)(F.ws + W8_SQ) + (size_t)(la - 2) * 1024 * 1024; }
                    const int f8o = (la >= 2) ? 1 : 0;
                    pg8::EpiStore E{O, ldc, (f8o ? 1.0f : sc) * (1.0f / W8_SCALE), -1, f8o};
                    run_gemm8(F, A8, B8, M, N, 1024, E);
                } else {
                    pg8::EpiStore E{O, ldc, sc, pw ? 3 : -1, pw ? 1 : 0};
                    run_gemm(F, A, Bt, M, N, K, E, pw);
                }
            }
        } break;
        case P_SSM: if (EN(P_SSM)) ssm_phase(F, la); break;
        case P_GLU: if (EN(P_GLU)) { pg8::EpiGlu E{H, X1}; run_gemm8(F, (const unsigned char*)Y, (const unsigned char*)(F.ws + W8_GLU) + (size_t)la * 2048 * 1024, TOK, 2048, 1024, E); } break;
        case P_LNMIX: if (EN(P_LNMIX)) ln_rows(F, X1, F.A->in[2 + F.z] + la * 1024, F.A->in[3 + F.z] + la * 1024, H1, (unsigned char*)(F.ws + WS_H18)); break;
        case P_TOPK: if (EN(P_TOPK)) {
            pg8::EpiTopk E{(int*)(F.ws + WS_IDX), (float*)(F.ws + WS_GATE)};
            pg8::Gemm g{(const bf16*)(F.ws + WS_H18), (const bf16*)((const unsigned char*)(F.ws + W8_EFF) + (size_t)la * 2048 * 1024), TOK, 2048, 512 + F.z};
            for (int r = 0; r < 2; ++r) { pg8::OneUnitOrder S; S.base.init(TOK, 2048, F.G, F.bx); S.round = r;
                int t = F.tid; asm volatile("" : "+v"(t)); pg8::gemm_phase<pg8::EpiTopk, pg8::OneUnitOrder, false, true, true>(F.lds, g, S, E, t); }
        } break;
        case P_PEER: if (EN(P_PEER)) peer_phase(F, la); break;
        case P_PLE: if (EN(P_PLE)) { pg8::EpiPle E{H2, (const unsigned char*)(F.ws + WS_PW) + (size_t)la * TOK * 1024, H, (la == DEPTH - 1) ? F.out : nullptr, (unsigned char*)(F.ws + WS_H8)};
            run_gemm8(F, (const unsigned char*)(F.ws + WS_H28), (const unsigned char*)(F.ws + W8_PG) + (size_t)la * 1024 * 1024, TOK, 1024, 1024, E); } break;
        case P_LNKV: if (EN(P_LNKV)) ln_rows(F, H, F.A->in[16 + F.z], F.A->in[17 + F.z], nullptr, (unsigned char*)HKV); break;
        case P_ATTN: if (EN(P_ATTN)) attn_phase(F); break;
        case P_RES: if (EN(P_RES)) { pg8::EpiRes E{H, X1}; run_gemm8(F, (const unsigned char*)Y, (const unsigned char*)(F.ws + W8_SO) + (size_t)(la - 2) * 1024 * 1024, TOK, 1024, 1024, E); } break;
        default: break;
        }
        if (pc + 1 < args.ph_hi) xcd_barrier(bar);
    }
}

#ifndef N_LAUNCH_MODE
#define N_LAUNCH_MODE 1
#endif
extern "C" void kernel_launch(void* const* d_in, const int* in_sizes, int n_in, void* d_out, int out_size, void* d_ws, size_t ws_size, hipStream_t stream) {
    static int grid = 0;
    if (grid == 0) {
        if (n_in != 28 || out_size != TOK * DM || ws_size < WS_END) { fprintf(stderr, "kernel_launch: unexpected shapes/workspace (n_in %d, out %d, ws %zu)\n", n_in, out_size, ws_size); grid = -1; return; }
        int dev = 0, cus = 0;
        if (hipGetDevice(&dev) != hipSuccess || hipDeviceGetAttribute(&cus, hipDeviceAttributeMultiprocessorCount, dev) != hipSuccess) { grid = -1; return; }
        if (hipFuncSetAttribute((const void*)mega_fwd, hipFuncAttributeMaxDynamicSharedMemorySize, LDS_BYTES) != hipSuccess) { fprintf(stderr, "kernel_launch: hipFuncSetAttribute failed\n"); grid = -1; return; }
        (void)hipGetLastError();
        grid = cus;
    }
    if (grid < 0) return;
    hipMemsetAsync((char*)d_ws + WS_CTL, 0, CTL_ZERO_BYTES, stream);
    Args a{};
    for (int i = 0; i < 28; ++i) a.in[i] = (const float*)d_in[i];
    a.out = (float*)d_out; a.ws = (unsigned char*)d_ws;
    int n = 0;
#ifndef REP_TYPE
#define REP_TYPE -1
#endif
    auto add = [&](int t, int l) { for (int r = 0; r < ((t == REP_TYPE) ? 2 : 1); ++r) { a.ph_type[n] = (unsigned char)t; a.ph_arg[n] = (unsigned char)l; ++n; } };
    add(P_PROLOGUE, 0); add(P_STORE, 0);
    for (int l = 0; l < DEPTH; ++l) {
        if (l < 2) { if (l == 1) add(P_STORE, 1); add(P_SSM, l); add(P_GLU, l); }
        else { if (l == 2) add(P_LNKV, 0); add(P_STORE, l); add(P_ATTN, l); add(P_RES, l); }
        add(P_LNMIX, l); add(P_TOPK, l); add(P_PEER, l); add(P_PLE, l);
    }
    a.nph = n;
    if (N_LAUNCH_MODE == 1) {
        a.ph_lo = 0; a.ph_hi = n; a.use_bar = 1;
        hipLaunchKernelGGL(mega_fwd, dim3(grid), dim3(NWAVES * 64), LDS_BYTES, stream, a);
    } else {
        a.use_bar = 0;
        for (int i = 0; i < n; ++i) { a.ph_lo = i; a.ph_hi = i + 1; hipLaunchKernelGGL(mega_fwd, dim3(grid), dim3(NWAVES * 64), LDS_BYTES, stream, a); }
    }
}
```

```cpp
#include <hip/hip_runtime.h>
#include <cstdio>
#include <cstdint>
#include <cmath>
namespace pg8 {
#define PG8_LAS __attribute__((address_space(3)))
typedef unsigned short bf16_t;
typedef short bf16x8 __attribute__((ext_vector_type(8)));
typedef float f32x4 __attribute__((ext_vector_type(4)));
typedef unsigned u32x4 __attribute__((ext_vector_type(4)));
constexpr int BM = 256, BK = 64, HALF = 128, HTB = HALF * BK * 2  , STAGE_BYTES = 8 * HTB, NXCD = 8, WGM = 8;

__host__ __device__ __forceinline__ int lds_byte(int r, int c) { const int st = (r >> 4) * 2 + (c >> 5), rr = r & 15, cc = c & 31, ob = rr * 64 + cc * 2; return st * 1024 + (ob ^ (((ob >> 9) & 1) << 5)); }
__host__ __device__ __forceinline__ void stage_rc(int b, int& R, int& C) { const int st = b / 1024, sb = b % 1024, swz = sb ^ (((sb >> 9) & 1) << 5); R = (st >> 1) * 16 + swz / 64; C = (st & 1) * 32 + (swz % 64) / 2; }
__host__ __device__ __forceinline__ int perm32(int rho) { const int n = rho >> 4, i = rho & 15; return 8 * (i >> 2) + 4 * n + (i & 3); }

struct Unit { int pm, pn; };
struct Gemm { const bf16_t* A; const bf16_t* Bt; int M, N, K; };

struct StaticOrder {
    int nM, nN, nwg, G, c;
    __host__ __device__ void init(int M, int N, int G_, int c_) { nM = M / BM; nN = N / BM; nwg = nM * nN; G = G_; c = c_; pw = 0; }
    int pw;
    __host__ __device__ bool next(int i, Unit& u) const {
        const long L = (long)i * G + c; if (L >= nwg) return false;
        if (pw) { const int l = (int)L >> 8, rem = (int)L & 255; u.pm = l * 64 + (rem >> 2); u.pn = l * 4 + (rem & 3); return true; }
        int wgid = (int)L; { const int q = nwg / NXCD, r = nwg % NXCD, xcd = wgid % NXCD, off = wgid / NXCD; wgid = (xcd < r ? xcd * (q + 1) : r * (q + 1) + (xcd - r) * q) + off; }
        const int nig = WGM * nN, gid = wgid / nig, fm = gid * WGM, gsz = (nM - fm) < WGM ? (nM - fm) : WGM;
        u.pm = fm + ((wgid % nig) % gsz); u.pn = (wgid % nig) / gsz; return true;
    }
    __device__ __forceinline__ void a_ready(const Unit&) const {}
    __device__ __forceinline__ void done(const Unit&) const {}
};

typedef float f32x2c_t __attribute__((ext_vector_type(2))); typedef __bf16 bf16x2c_t __attribute__((ext_vector_type(2)));
__device__ __forceinline__ unsigned cvt_pk_bf16(float lo, float hi) { f32x2c_t v = {lo, hi}; bf16x2c_t b = __builtin_convertvector(v, bf16x2c_t); return __builtin_bit_cast(unsigned, b); }
typedef float f32x2 __attribute__((ext_vector_type(2)));
typedef int v8i32_t __attribute__((ext_vector_type(8)));
typedef unsigned u32x8_t __attribute__((ext_vector_type(8)));
template <bool F8> struct Frag { bf16x8 k[2]; };
template <> struct Frag<true> { v8i32_t v; };
template <class Epi, class Sched, bool ALIGN_EPI = false, bool SP2 = false, bool F8 = false>
__device__ __forceinline__ void gemm_phase(PG8_LAS unsigned char* lds, const Gemm g, const Sched& S, const Epi& E, const int tid) {
    const int wid = __builtin_amdgcn_readfirstlane(tid >> 6), lane = tid & 63, wr = wid >> 2, wc = wid & 3, fr = lane & 15, fq = lane >> 4;
    const int K = g.K, nt = K / BK;
    unsigned voffA[1], voffB[1];
    { int R, C; stage_rc(tid * 16, R, C); const int Rb = Epi::PERM ? ((R & ~31) + perm32(R & 31)) : R;
        voffA[0] = (unsigned)(R * K + C) * 2u; voffB[0] = (unsigned)(Rb * K + C) * 2u; }
    const size_t r64 = (size_t)128 * K;
    const size_t kstep = (size_t)(BK * 2);
    const size_t hstep = (size_t)HALF * K * 2;
    const size_t tstep = 2 * hstep;
    const unsigned ldsw = (unsigned)wid * 1024u;
    const int aoff = lds_byte(wr * 64 + fr, F8 ? fq * 16 : fq * 8), boff = lds_byte(wc * 32 + fr, F8 ? fq * 16 : fq * 8);
#define PG8_SA(b, h) (((b) * 2 + (h)) * HTB)
#define PG8_SB(b, h) ((4 + (b) * 2 + (h)) * HTB)
#define PG8_STAGE(bufoff, gbase, voff) do { _Pragma("unroll") for (int _i = 0; _i < 2; ++_i) \
        __builtin_amdgcn_global_load_lds((const unsigned*)((const char*)(gbase) + _i * r64 + (voff)[0]), (PG8_LAS unsigned*)(lds + (bufoff) + ldsw + _i * 8192), 16, 0, 0); } while (0)
#define PG8_LDF(d, addr) do { if constexpr (F8) { const u32x4 lo_ = *(const PG8_LAS u32x4*)(addr), hi_ = *(const PG8_LAS u32x4*)((addr) + 16); d.v = __builtin_bit_cast(v8i32_t, (u32x8_t){lo_[0], lo_[1], lo_[2], lo_[3], hi_[0], hi_[1], hi_[2], hi_[3]}); } \
        else { d.k[0] = *(const PG8_LAS bf16x8*)(addr); d.k[1] = *(const PG8_LAS bf16x8*)((addr) + 1024); } } while (0)
#define PG8_LDA(dst, b, h) do { _Pragma("unroll") for (int m = 0; m < 4; ++m) PG8_LDF(dst[m], lds + PG8_SA(b, h) + aoff + m * 2048); } while (0)
#define PG8_LDB(dst, b, h) do { _Pragma("unroll") for (int n = 0; n < 2; ++n) PG8_LDF(dst[n], lds + PG8_SB(b, h) + boff + n * 2048); } while (0)
#define PG8_MMA(ai, bj, At, Bt) do { __builtin_amdgcn_s_setprio(1); _Pragma("unroll") for (int m = 0; m < 4; ++m) _Pragma("unroll") for (int n = 0; n < 2; ++n) { \
        if constexpr (F8) asm volatile("v_mfma_f32_16x16x128_f8f6f4 %0, %1, %2, %0" : "+v"(acc[ai][bj][m][n]) : "v"(Bt[n].v), "v"(At[m].v));   \
        else { _Pragma("unroll") for (int k = 0; k < 2; ++k) acc[ai][bj][m][n] = __builtin_amdgcn_mfma_f32_16x16x32_bf16(Bt[n].k[k], At[m].k[k], acc[ai][bj][m][n], 0, 0, 0); } } __builtin_amdgcn_s_setprio(0); } while (0)
#define PG8_WAIT_V(n) asm volatile("s_waitcnt vmcnt(" #n ")" ::: "memory")
#define PG8_WAIT_L(n) asm volatile("s_waitcnt lgkmcnt(" #n ")" ::: "memory")
#define PG8_BAR __builtin_amdgcn_s_barrier()
#define PG8_SCHED __builtin_amdgcn_sched_barrier(0)
    Unit cur, nxt; int ui = 0;
    if (!S.next(0, cur)) return;
    f32x4 acc[2][2][4][2];
#pragma unroll
    for (int a = 0; a < 2; ++a)
#pragma unroll
        for (int b = 0; b < 2; ++b)
#pragma unroll
            for (int m = 0; m < 4; ++m)
#pragma unroll
                for (int n = 0; n < 2; ++n) acc[a][b][m][n] = (f32x4){0.f, 0.f, 0.f, 0.f};
    Frag<F8> At[4], B0[2], B1[2];
    const char* cA = (const char*)g.A + (size_t)cur.pm * tstep; const char* cB = (const char*)g.Bt + (size_t)cur.pn * tstep;
    S.a_ready(cur);
    if constexpr (SP2) {
        PG8_STAGE(PG8_SB(0, 0), cB, voffB); PG8_STAGE(PG8_SB(0, 1), cB + hstep, voffB); PG8_STAGE(PG8_SA(0, 0), cA, voffA); PG8_STAGE(PG8_SA(0, 1), cA + hstep, voffA);
        if (wr == 1) PG8_BAR;
        PG8_WAIT_V(2); PG8_BAR;
        PG8_STAGE(PG8_SB(1, 0), cB + kstep, voffB); PG8_STAGE(PG8_SA(1, 0), cA + kstep, voffA); PG8_STAGE(PG8_SB(1, 1), cB + hstep + kstep, voffB);
        PG8_WAIT_V(6); PG8_BAR;
    } else {
        PG8_STAGE(PG8_SB(0, 0), cB, voffB); PG8_STAGE(PG8_SA(0, 0), cA, voffA); PG8_STAGE(PG8_SB(0, 1), cB + hstep, voffB); PG8_STAGE(PG8_SA(0, 1), cA + hstep, voffA);
        if (wr == 1) PG8_BAR;
        PG8_WAIT_V(4); PG8_BAR;
        PG8_STAGE(PG8_SB(1, 0), cB + kstep, voffB); PG8_STAGE(PG8_SA(1, 0), cA + kstep, voffA); PG8_STAGE(PG8_SB(1, 1), cB + hstep + kstep, voffB);
        PG8_WAIT_V(6); PG8_BAR;
    }
    for (;;) {
        const bool has_next = S.next(ui + 1, nxt);
        const char* nA = has_next ? (const char*)g.A + (size_t)nxt.pm * tstep : cA; const char* nB = has_next ? (const char*)g.Bt + (size_t)nxt.pn * tstep : cB;
#pragma unroll 1
        for (int t = 0; t < nt; t += 2) {
            const bool last = (t == nt - 2);
            const char* a1 = cA + (size_t)(t + 1) * kstep;
            const char* a2 = last ? nA : cA + (size_t)(t + 2) * kstep; const char* b2 = last ? nB : cB + (size_t)(t + 2) * kstep;
            const char* a3 = a2 + kstep; const char* b3 = b2 + kstep;
            if (last && has_next) S.a_ready(nxt);
            if constexpr (SP2) {
            PG8_LDB(B0, 0, 0); PG8_LDB(B1, 0, 1); PG8_SCHED; PG8_LDA(At, 0, 0); PG8_STAGE(PG8_SA(1, 1), a1 + hstep, voffA);
            PG8_WAIT_V(8); PG8_WAIT_L(0); PG8_BAR; PG8_MMA(0, 0, At, B0); PG8_MMA(0, 1, At, B1); PG8_BAR; PG8_SCHED;
            PG8_LDA(At, 0, 1); PG8_STAGE(PG8_SB(0, 0), b2, voffB); PG8_STAGE(PG8_SB(0, 1), b2 + hstep, voffB); PG8_STAGE(PG8_SA(0, 0), a2, voffA);
            PG8_WAIT_V(8); PG8_WAIT_L(0); PG8_BAR; PG8_MMA(1, 0, At, B0); PG8_MMA(1, 1, At, B1); PG8_BAR; PG8_SCHED;
            PG8_LDB(B0, 1, 0); PG8_LDB(B1, 1, 1); PG8_SCHED; PG8_LDA(At, 1, 0); PG8_STAGE(PG8_SA(0, 1), a2 + hstep, voffA);
            PG8_WAIT_V(8); PG8_WAIT_L(0); PG8_BAR; PG8_MMA(0, 0, At, B0); PG8_MMA(0, 1, At, B1); PG8_BAR; PG8_SCHED;
            PG8_LDA(At, 1, 1); PG8_STAGE(PG8_SB(1, 0), b3, voffB); PG8_STAGE(PG8_SB(1, 1), b3 + hstep, voffB); PG8_STAGE(PG8_SA(1, 0), a3, voffA);
            PG8_WAIT_V(8); PG8_WAIT_L(0); PG8_BAR; PG8_MMA(1, 0, At, B0); PG8_MMA(1, 1, At, B1); PG8_BAR; PG8_SCHED;
            } else {
            PG8_LDB(B0, 0, 0); PG8_SCHED; PG8_LDA(At, 0, 0); PG8_STAGE(PG8_SA(1, 1), a1 + hstep, voffA);
            PG8_WAIT_L(8); PG8_BAR; PG8_WAIT_L(0); PG8_MMA(0, 0, At, B0); PG8_BAR; PG8_SCHED;
            PG8_LDB(B1, 0, 1); PG8_STAGE(PG8_SB(0, 0), b2, voffB);
            PG8_BAR; PG8_WAIT_L(0); PG8_MMA(0, 1, At, B1); PG8_BAR;
            PG8_LDA(At, 0, 1); PG8_STAGE(PG8_SA(0, 0), a2, voffA);
            PG8_BAR; PG8_WAIT_L(0); PG8_MMA(1, 0, At, B0); PG8_BAR; PG8_SCHED;
            PG8_STAGE(PG8_SB(0, 1), b2 + hstep, voffB);
            PG8_WAIT_V(6); PG8_BAR; PG8_MMA(1, 1, At, B1); PG8_BAR;
            PG8_LDB(B0, 1, 0); PG8_SCHED; PG8_LDA(At, 1, 0); PG8_STAGE(PG8_SA(0, 1), a2 + hstep, voffA);
            PG8_WAIT_L(8); PG8_BAR; PG8_WAIT_L(0); PG8_MMA(0, 0, At, B0); PG8_BAR; PG8_SCHED;
            PG8_LDB(B1, 1, 1); PG8_STAGE(PG8_SB(1, 0), b3, voffB);
            PG8_BAR; PG8_WAIT_L(0); PG8_MMA(0, 1, At, B1); PG8_BAR;
            PG8_LDA(At, 1, 1); PG8_STAGE(PG8_SA(1, 0), a3, voffA);
            PG8_BAR; PG8_WAIT_L(0); PG8_MMA(1, 0, At, B0); PG8_BAR; PG8_SCHED;
            PG8_STAGE(PG8_SB(1, 1), b3 + hstep, voffB);
            PG8_WAIT_V(6); PG8_BAR; PG8_MMA(1, 1, At, B1); PG8_BAR;
            }
        }
        if constexpr (F8) asm volatile("s_nop 15\n\ts_nop 15" ::: "memory");
        if constexpr (ALIGN_EPI) { if (wr == 0) PG8_BAR; }
        if constexpr (!Epi::AFTER_DRAIN) { E(acc, cur, wr, wc, fr, fq); S.done(cur); }
        if (!has_next) break;
#pragma unroll
        for (int a = 0; a < 2; ++a)
#pragma unroll
            for (int b = 0; b < 2; ++b)
#pragma unroll
                for (int m = 0; m < 4; ++m)
#pragma unroll
                    for (int n = 0; n < 2; ++n) acc[a][b][m][n] = (f32x4){0.f, 0.f, 0.f, 0.f};
        cur = nxt; cA = nA; cB = nB; ++ui;
        if constexpr (ALIGN_EPI) { if (wr == 1) PG8_BAR; }
    }
    PG8_WAIT_V(0);
    if constexpr (!ALIGN_EPI) { if (wr == 0) PG8_BAR; }
    PG8_BAR;
    if constexpr (Epi::AFTER_DRAIN) { E.fused(acc, cur, wr, wc, fr, fq, lds, wid, lane); S.done(cur); }
#undef PG8_SA
#undef PG8_SB
#undef PG8_STAGE
#undef PG8_LDA
#undef PG8_LDB
#undef PG8_MMA
#undef PG8_LDF
#undef PG8_WAIT_V
#undef PG8_WAIT_L
#undef PG8_BAR
#undef PG8_SCHED
}
}
namespace pg8 {
__device__ __forceinline__ float bf_lo(unsigned w) { return __uint_as_float(w << 16); }
__device__ __forceinline__ float bf_hi(unsigned w) { return __uint_as_float(w & 0xffff0000u); }
__device__ __forceinline__ float fast_sigmoid(float x) { return __builtin_amdgcn_rcpf(1.0f + __builtin_amdgcn_exp2f(-1.4426950408889634f * x)); }
__device__ __forceinline__ float gelu_tanh(float x) { const float t = x * (1.5957691216057308f + 0.07135481627260025f * x * x); return x * __builtin_amdgcn_rcpf(1.0f + __builtin_amdgcn_exp2f(-1.4426950408889634f * t)); }
constexpr float ALPHA_F = 1.681792830507429f;
constexpr float WSC = 1.0f / 32.0f;

struct EpiStore {
    static constexpr bool PERM = true, AFTER_DRAIN = false;
    bf16_t* O; int ldc; float scale; int pnmask; int f8out;
    __device__ __forceinline__ void operator()(const f32x4 (&acc)[2][2][4][2], const Unit& u, int wr, int wc, int fr, int fq) const {
        const int row0 = u.pm * BM + wr * 64 + fr, col0 = (u.pn & pnmask) * BM + wc * 32 + 8 * fq;
#pragma unroll
        for (int ai = 0; ai < 2; ++ai)
#pragma unroll
            for (int m = 0; m < 4; ++m) { bf16_t* rowp = O + (size_t)(row0 + ai * HALF + m * 16) * ldc + col0;
#pragma unroll
                for (int bj = 0; bj < 2; ++bj) { const f32x4 v0 = acc[ai][bj][m][0] * scale, v1 = acc[ai][bj][m][1] * scale;
                    if (f8out) {
                        int w0 = 0, w1 = 0; w0 = __builtin_amdgcn_cvt_pk_fp8_f32(v0[0], v0[1], w0, false); w0 = __builtin_amdgcn_cvt_pk_fp8_f32(v0[2], v0[3], w0, true);
                        w1 = __builtin_amdgcn_cvt_pk_fp8_f32(v1[0], v1[1], w1, false); w1 = __builtin_amdgcn_cvt_pk_fp8_f32(v1[2], v1[3], w1, true);
                        *(unsigned long long*)((unsigned char*)O + (size_t)(row0 + ai * HALF + m * 16) * ldc + col0 + bj * HALF) = (unsigned long long)(unsigned)w0 | ((unsigned long long)(unsigned)w1 << 32);
                    } else {
                    u32x4 w; w.x = cvt_pk_bf16(v0[0], v0[1]); w.y = cvt_pk_bf16(v0[2], v0[3]); w.z = cvt_pk_bf16(v1[0], v1[1]); w.w = cvt_pk_bf16(v1[2], v1[3]);
                    *(u32x4*)(rowp + bj * HALF) = w; } } }
    }
};
struct EpiGlu {
    static constexpr bool PERM = true, AFTER_DRAIN = false;
    const bf16_t* Hin; bf16_t* X1;
    __device__ __forceinline__ void operator()(const f32x4 (&acc)[2][2][4][2], const Unit& u, int wr, int wc, int fr, int fq) const {
        const int row0 = u.pm * BM + wr * 64 + fr, col0 = u.pn * HALF + wc * 32 + 8 * fq;
        u32x4 hvv[2][4];
#pragma unroll
        for (int ai = 0; ai < 2; ++ai)
#pragma unroll
            for (int m = 0; m < 4; ++m) hvv[ai][m] = *(const u32x4*)(Hin + (size_t)(row0 + ai * HALF + m * 16) * 1024 + col0);
#pragma unroll
        for (int ai = 0; ai < 2; ++ai)
#pragma unroll
            for (int m = 0; m < 4; ++m) { const size_t off = (size_t)(row0 + ai * HALF + m * 16) * 1024 + col0;
                const u32x4 hv = hvv[ai][m];
                const f32x4 v0 = acc[ai][0][m][0] * WSC, v1 = acc[ai][0][m][1] * WSC, g0 = acc[ai][1][m][0] * WSC, g1 = acc[ai][1][m][1] * WSC;
                float o[8];
                o[0] = ALPHA_F * bf_lo(hv.x) + v0[0] * fast_sigmoid(g0[0]); o[1] = ALPHA_F * bf_hi(hv.x) + v0[1] * fast_sigmoid(g0[1]);
                o[2] = ALPHA_F * bf_lo(hv.y) + v0[2] * fast_sigmoid(g0[2]); o[3] = ALPHA_F * bf_hi(hv.y) + v0[3] * fast_sigmoid(g0[3]);
                o[4] = ALPHA_F * bf_lo(hv.z) + v1[0] * fast_sigmoid(g1[0]); o[5] = ALPHA_F * bf_hi(hv.z) + v1[1] * fast_sigmoid(g1[1]);
                o[6] = ALPHA_F * bf_lo(hv.w) + v1[2] * fast_sigmoid(g1[2]); o[7] = ALPHA_F * bf_hi(hv.w) + v1[3] * fast_sigmoid(g1[3]);
                u32x4 w; w.x = cvt_pk_bf16(o[0], o[1]); w.y = cvt_pk_bf16(o[2], o[3]); w.z = cvt_pk_bf16(o[4], o[5]); w.w = cvt_pk_bf16(o[6], o[7]);
                *(u32x4*)(X1 + off) = w; }
    }
};
struct EpiRes {
    static constexpr bool PERM = true, AFTER_DRAIN = false;
    const bf16_t* Hin; bf16_t* X1;
    __device__ __forceinline__ void operator()(const f32x4 (&acc)[2][2][4][2], const Unit& u, int wr, int wc, int fr, int fq) const {
        const int row0 = u.pm * BM + wr * 64 + fr, col0 = u.pn * BM + wc * 32 + 8 * fq;
        u32x4 hvv[2][4][2];
#pragma unroll
        for (int ai = 0; ai < 2; ++ai)
#pragma unroll
            for (int m = 0; m < 4; ++m)
#pragma unroll
                for (int bj = 0; bj < 2; ++bj) hvv[ai][m][bj] = *(const u32x4*)(Hin + (size_t)(row0 + ai * HALF + m * 16) * 1024 + col0 + bj * HALF);
#pragma unroll
        for (int ai = 0; ai < 2; ++ai)
#pragma unroll
            for (int m = 0; m < 4; ++m)
#pragma unroll
                for (int bj = 0; bj < 2; ++bj) { const size_t off = (size_t)(row0 + ai * HALF + m * 16) * 1024 + col0 + bj * HALF;
                    const u32x4 hv = hvv[ai][m][bj]; const f32x4 v0 = acc[ai][bj][m][0] * WSC, v1 = acc[ai][bj][m][1] * WSC;
                    u32x4 w; w.x = cvt_pk_bf16(ALPHA_F * bf_lo(hv.x) + v0[0], ALPHA_F * bf_hi(hv.x) + v0[1]); w.y = cvt_pk_bf16(ALPHA_F * bf_lo(hv.y) + v0[2], ALPHA_F * bf_hi(hv.y) + v0[3]);
                    w.z = cvt_pk_bf16(ALPHA_F * bf_lo(hv.z) + v1[0], ALPHA_F * bf_hi(hv.z) + v1[1]); w.w = cvt_pk_bf16(ALPHA_F * bf_lo(hv.w) + v1[2], ALPHA_F * bf_hi(hv.w) + v1[3]);
                    *(u32x4*)(X1 + off) = w; }
    }
};
struct EpiPle {
    static constexpr bool PERM = true, AFTER_DRAIN = false;
    const bf16_t* H2; const unsigned char* PW; bf16_t* Hout; float* Fout; unsigned char* H8out;
    __device__ __forceinline__ void operator()(const f32x4 (&acc)[2][2][4][2], const Unit& u, int wr, int wc, int fr, int fq) const {
        const int row0 = u.pm * BM + wr * 64 + fr, col0 = u.pn * BM + wc * 32 + 8 * fq;
#pragma unroll
        for (int ai = 0; ai < 2; ++ai) {
            u32x4 hvv[4][2]; unsigned long long pvv[4][2];
#pragma unroll
            for (int m = 0; m < 4; ++m)
#pragma unroll
                for (int bj = 0; bj < 2; ++bj) { const size_t off = (size_t)(row0 + ai * HALF + m * 16) * 1024 + col0 + bj * HALF; hvv[m][bj] = *(const u32x4*)(H2 + off); pvv[m][bj] = *(const unsigned long long*)(PW + off); }
#pragma unroll
            for (int m = 0; m < 4; ++m)
#pragma unroll
                for (int bj = 0; bj < 2; ++bj) { const size_t off = (size_t)(row0 + ai * HALF + m * 16) * 1024 + col0 + bj * HALF;
                    const u32x4 hv = hvv[m][bj]; const int pl = (int)(unsigned)pvv[m][bj], ph = (int)(unsigned)(pvv[m][bj] >> 32); const f32x4 v0 = acc[ai][bj][m][0] * WSC, v1 = acc[ai][bj][m][1] * WSC;
                    const auto p01 = __builtin_amdgcn_cvt_pk_f32_fp8(pl, false), p23 = __builtin_amdgcn_cvt_pk_f32_fp8(pl, true), p45 = __builtin_amdgcn_cvt_pk_f32_fp8(ph, false), p67 = __builtin_amdgcn_cvt_pk_f32_fp8(ph, true);
                    float o[8];
                    o[0] = bf_lo(hv.x) + fast_sigmoid(v0[0]) * p01[0]; o[1] = bf_hi(hv.x) + fast_sigmoid(v0[1]) * p01[1];
                    o[2] = bf_lo(hv.y) + fast_sigmoid(v0[2]) * p23[0]; o[3] = bf_hi(hv.y) + fast_sigmoid(v0[3]) * p23[1];
                    o[4] = bf_lo(hv.z) + fast_sigmoid(v1[0]) * p45[0]; o[5] = bf_hi(hv.z) + fast_sigmoid(v1[1]) * p45[1];
                    o[6] = bf_lo(hv.w) + fast_sigmoid(v1[2]) * p67[0]; o[7] = bf_hi(hv.w) + fast_sigmoid(v1[3]) * p67[1];
                    if (Fout) { *(f32x4*)(Fout + off) = (f32x4){o[0], o[1], o[2], o[3]}; *(f32x4*)(Fout + off + 4) = (f32x4){o[4], o[5], o[6], o[7]}; }
                    else { u32x4 w; w.x = cvt_pk_bf16(o[0], o[1]); w.y = cvt_pk_bf16(o[2], o[3]); w.z = cvt_pk_bf16(o[4], o[5]); w.w = cvt_pk_bf16(o[6], o[7]); *(u32x4*)(Hout + off) = w;
                        int w0 = 0, w1 = 0; w0 = __builtin_amdgcn_cvt_pk_fp8_f32(o[0], o[1], w0, false); w0 = __builtin_amdgcn_cvt_pk_fp8_f32(o[2], o[3], w0, true); w1 = __builtin_amdgcn_cvt_pk_fp8_f32(o[4], o[5], w1, false); w1 = __builtin_amdgcn_cvt_pk_fp8_f32(o[6], o[7], w1, true);
                        *(unsigned long long*)(H8out + off) = (unsigned long long)(unsigned)w0 | ((unsigned long long)(unsigned)w1 << 32); } }
        }
    }
};

__device__ __forceinline__ int imax_(int a, int b) { return a > b ? a : b; }
__device__ __forceinline__ int imin_(int a, int b) { return a < b ? a : b; }
__device__ __forceinline__ float csum(float a, float b) { float s = a + b; asm volatile("" : "+v"(s)); return s; }
__device__ __forceinline__ int f2key(float v) { int s = __float_as_int(v); return s ^ ((s >> 31) & 0x7fffffff); }
__device__ __forceinline__ float key2f(int k) { return __int_as_float(k ^ ((k >> 31) & 0x7fffffff)); }
template <bool DESC> __device__ __forceinline__ void bitonic_sort16(int (&x)[16]) {
#pragma unroll
    for (int k = 2; k <= 16; k <<= 1)
#pragma unroll
        for (int j = k >> 1; j > 0; j >>= 1)
#pragma unroll
            for (int i = 0; i < 16; ++i) { const int l = i ^ j; if (l > i) { const bool up = ((i & k) == 0) || (k == 16); const bool asc = DESC ? !up : up;
                const int lo = imin_(x[i], x[l]), hi = imax_(x[i], x[l]); x[i] = asc ? lo : hi; x[l] = asc ? hi : lo; } }
}
__device__ __forceinline__ void bitonic_merge_desc16(int (&x)[16]) {
#pragma unroll
    for (int j = 8; j > 0; j >>= 1)
#pragma unroll
        for (int i = 0; i < 16; ++i) { const int l = i ^ j; if (l > i) { const int lo = imin_(x[i], x[l]), hi = imax_(x[i], x[l]); x[i] = hi; x[l] = lo; } }
}
__device__ __forceinline__ void topk_absorb16(int (&L)[16], int (&N)[16]) {
    bitonic_sort16<false>(N);
#pragma unroll
    for (int i = 0; i < 16; ++i) L[i] = imax_(L[i], N[i]);
    bitonic_merge_desc16(L);
}
__device__ __forceinline__ void topk_insert1(int (&L)[16], int v) {
#pragma unroll
    for (int i = 0; i < 16; ++i) { const int hi = imax_(L[i], v); v = imin_(L[i], v); L[i] = hi; }
}

template <bool DESC> __device__ __forceinline__ void bitonic_sort16f(float (&x)[16]) {
#pragma unroll
    for (int k = 2; k <= 16; k <<= 1)
#pragma unroll
        for (int j = k >> 1; j > 0; j >>= 1)
#pragma unroll
            for (int i = 0; i < 16; ++i) { const int l = i ^ j; if (l > i) { const bool up = ((i & k) == 0) || (k == 16); const bool asc = DESC ? !up : up;
                const float lo = __builtin_fminf(x[i], x[l]), hi = __builtin_fmaxf(x[i], x[l]); x[i] = asc ? lo : hi; x[l] = asc ? hi : lo; } }
}
__device__ __forceinline__ void bitonic_merge_desc16f(float (&x)[16]) {
#pragma unroll
    for (int j = 8; j > 0; j >>= 1)
#pragma unroll
        for (int i = 0; i < 16; ++i) { const int l = i ^ j; if (l > i) { const float lo = __builtin_fminf(x[i], x[l]), hi = __builtin_fmaxf(x[i], x[l]); x[i] = hi; x[l] = lo; } }
}
__device__ __forceinline__ void topk_absorb16f(float (&L)[16], float (&N)[16]) {
    bitonic_sort16f<false>(N);
#pragma unroll
    for (int i = 0; i < 16; ++i) L[i] = __builtin_fmaxf(L[i], N[i]);
    bitonic_merge_desc16f(L);
}

__device__ __forceinline__ void topk_insert1f(float (&L)[16], float v) {
#pragma unroll
    for (int i = 0; i < 16; ++i) { const float hi = __builtin_fmaxf(L[i], v); v = __builtin_fminf(L[i], v); L[i] = hi; }
}
struct EpiTopk {
    static constexpr bool PERM = true, AFTER_DRAIN = true;
    int* IDX; float* GATE;
    __device__ __forceinline__ void fused(f32x4 (&acc)[2][2][4][2], const Unit& u, int wr, int wc, int fr, int fq, PG8_LAS unsigned char* lds, int wid, int lane) const {
        const int tid = wid * 64 + lane;
        PG8_LAS float* S = (PG8_LAS float*)lds;
        PG8_LAS int* X = (PG8_LAS int*)lds;
        const int row = tid & 255, part = tid >> 8;
        int KK[2][16];
#pragma unroll
        for (int bj = 0; bj < 2; ++bj) {
#pragma unroll
            for (int ai = 0; ai < 2; ++ai)
#pragma unroll
                for (int m = 0; m < 4; ++m)
#pragma unroll
                    for (int n = 0; n < 2; ++n) *(PG8_LAS f32x4*)(S + (ai * HALF + wr * 64 + m * 16 + fr) * 132 + wc * 32 + 8 * fq + 4 * n) = acc[ai][bj][m][n] * WSC;
            asm volatile("s_waitcnt lgkmcnt(0)" ::: "memory"); __builtin_amdgcn_s_barrier(); asm volatile("" ::: "memory");
            float L[16];
#pragma unroll
            for (int c = 0; c < 4; ++c) {
                float N[16];
#pragma unroll
                for (int i = 0; i < 4; ++i) { const f32x4 v = *(const PG8_LAS f32x4*)(S + row * 132 + 64 * part + 16 * c + 4 * i);
#pragma unroll
                    for (int e = 0; e < 4; ++e) N[4 * i + e] = __int_as_float((__float_as_int(v[e]) & ~127) | (127 - (64 * part + 16 * c + 4 * i + e))); }
                if (c == 0) { bitonic_sort16f<true>(N);
#pragma unroll
                    for (int i = 0; i < 16; ++i) L[i] = N[i]; }
                else topk_absorb16f(L, N);
            }
            asm volatile("s_waitcnt lgkmcnt(0)" ::: "memory"); __builtin_amdgcn_s_barrier(); asm volatile("" ::: "memory");
#pragma unroll
            for (int i = 0; i < 4; ++i) *(PG8_LAS u32x4*)(X + tid * 20 + 4 * i) = (u32x4){(unsigned)__float_as_int(L[4 * i]), (unsigned)__float_as_int(L[4 * i + 1]), (unsigned)__float_as_int(L[4 * i + 2]), (unsigned)__float_as_int(L[4 * i + 3])};
            asm volatile("s_waitcnt lgkmcnt(0)" ::: "memory"); __builtin_amdgcn_s_barrier(); asm volatile("" ::: "memory");
            { float P[16]; const int pt = tid ^ 256;
#pragma unroll
              for (int i = 0; i < 4; ++i) { const u32x4 v = *(const PG8_LAS u32x4*)(X + pt * 20 + 4 * i); P[4 * i] = __int_as_float((int)v.x); P[4 * i + 1] = __int_as_float((int)v.y); P[4 * i + 2] = __int_as_float((int)v.z); P[4 * i + 3] = __int_as_float((int)v.w); }
#pragma unroll
              for (int i = 0; i < 16; ++i) L[i] = __builtin_fmaxf(L[i], P[15 - i]);
              bitonic_merge_desc16f(L); }
#pragma unroll
            for (int i = 0; i < 16; ++i) KK[bj][i] = __float_as_int(L[i]);
            asm volatile("s_waitcnt lgkmcnt(0)" ::: "memory"); __builtin_amdgcn_s_barrier(); asm volatile("" ::: "memory");
        }
        float v1[16], v2[16];
#pragma unroll
        for (int i = 0; i < 16; ++i) { v1[i] = __int_as_float(KK[0][i] & ~127); v2[i] = __int_as_float(KK[1][i] & ~127); }
#define CKEY(a, b) __int_as_float((__float_as_int(csum(v1[a], v2[b])) & ~255) | (255 - (((a) << 4) | (b))))
        float L[16];
#pragma unroll
        for (int b = 0; b < 16; ++b) L[b] = CKEY(0, b);
        { float N[16] = {CKEY(1, 0), CKEY(1, 1), CKEY(1, 2), CKEY(1, 3), CKEY(1, 4), CKEY(1, 5), CKEY(1, 6), CKEY(1, 7), CKEY(2, 0), CKEY(2, 1), CKEY(2, 2), CKEY(2, 3), CKEY(2, 4), CKEY(4, 0), CKEY(4, 1), CKEY(4, 2)};
          topk_absorb16f(L, N); }
        { float N[16] = {CKEY(3, 0), CKEY(3, 1), CKEY(3, 2), CKEY(3, 3), CKEY(5, 0), CKEY(5, 1), CKEY(6, 0), CKEY(6, 1), CKEY(7, 0), CKEY(7, 1), CKEY(8, 0), CKEY(9, 0), CKEY(10, 0), CKEY(11, 0), CKEY(12, 0), CKEY(13, 0)};
          topk_absorb16f(L, N); }
        topk_insert1f(L, CKEY(14, 0)); topk_insert1f(L, CKEY(15, 0));
#undef CKEY
#pragma unroll
        for (int i = 0; i < 4; ++i) { *(PG8_LAS u32x4*)(X + tid * 36 + 4 * i) = (u32x4){(unsigned)KK[0][4 * i], (unsigned)KK[0][4 * i + 1], (unsigned)KK[0][4 * i + 2], (unsigned)KK[0][4 * i + 3]};
                                      *(PG8_LAS u32x4*)(X + tid * 36 + 16 + 4 * i) = (u32x4){(unsigned)KK[1][4 * i], (unsigned)KK[1][4 * i + 1], (unsigned)KK[1][4 * i + 2], (unsigned)KK[1][4 * i + 3]}; }
        asm volatile("s_waitcnt lgkmcnt(0)" ::: "memory");
        float sc[16]; int ex[16];
#pragma unroll
        for (int i = 0; i < 16; ++i) { const int code = 255 - (__float_as_int(L[i]) & 255); const int ka = X[tid * 36 + (code >> 4)], kb = X[tid * 36 + 16 + (code & 15)];
            sc[i] = __int_as_float(ka & ~127) + __int_as_float(kb & ~127); ex[i] = (127 - (ka & 127)) * 128 + (127 - (kb & 127)); }
        float mx = sc[0];
#pragma unroll
        for (int i = 1; i < 16; ++i) mx = fmaxf(mx, sc[i]);
        float den = 0.f;
#pragma unroll
        for (int i = 0; i < 16; ++i) { sc[i] = __builtin_amdgcn_exp2f((sc[i] - mx) * 1.4426950408889634f); den += sc[i]; }
        const float rden = 1.0f / den;
        const size_t o = ((size_t)(u.pm * BM + row) * 8 + u.pn) * 16;
        if (part == 0) {
#pragma unroll
            for (int i = 0; i < 4; ++i) *(u32x4*)(IDX + o + 4 * i) = (u32x4){(unsigned)ex[4 * i], (unsigned)ex[4 * i + 1], (unsigned)ex[4 * i + 2], (unsigned)ex[4 * i + 3]};
        } else {
#pragma unroll
            for (int i = 0; i < 4; ++i) *(f32x4*)(GATE + o + 4 * i) = (f32x4){sc[4 * i] * rden, sc[4 * i + 1] * rden, sc[4 * i + 2] * rden, sc[4 * i + 3] * rden};
        }
        asm volatile("s_waitcnt lgkmcnt(0)" ::: "memory"); __builtin_amdgcn_s_barrier(); asm volatile("" ::: "memory");
    }
};
struct OneUnitOrder {
    StaticOrder base; int round;
    __device__ __forceinline__ bool next(int i, Unit& u) const { return i == 0 && base.next(round, u); }
    __device__ __forceinline__ void a_ready(const Unit&) const {}
    __device__ __forceinline__ void done(const Unit&) const {}
};
}
constexpr int NWAVES = 8;
constexpr int BATCH = 4, SEQ = 4096, DM = 1024, TOK = BATCH * SEQ, DEPTH = 4;
constexpr float LN_EPS = 1e-5f;
constexpr size_t MiB = 1u << 20;
constexpr size_t WS_CTL = 0, CTL_ZERO_BYTES = 32 * 1024;
constexpr size_t WS_W_IN = 2 * MiB;
constexpr size_t WS_W_GLU = 6 * MiB;
constexpr size_t WS_W_KV = 14 * MiB;
constexpr size_t WS_W_SQ = 18 * MiB;
constexpr size_t WS_W_SO = 22 * MiB;
constexpr size_t WS_W_EFF = 26 * MiB;
constexpr size_t WS_W_PG = 42 * MiB;
constexpr size_t WS_W_PW = 50 * MiB;
constexpr size_t WS_PB = 52 * MiB;
constexpr size_t WS_IDX = 84 * MiB;
constexpr size_t WS_GATE = 92 * MiB;
constexpr size_t WS_TABU = 100 * MiB;
constexpr size_t WS_TABV = 228 * MiB;
constexpr size_t WS_PW = 356 * MiB;
constexpr size_t WS_H = 484 * MiB, WS_U = 516 * MiB, WS_Y = 548 * MiB, WS_X1 = 580 * MiB, WS_H1 = 612 * MiB, WS_H2 = 644 * MiB, WS_KB = 676 * MiB, WS_VT = 708 * MiB, WS_HKV = 740 * MiB;
constexpr size_t WS_H8 = 772 * MiB, WS_H28 = 788 * MiB;
constexpr size_t WS_W8 = 804 * MiB;
constexpr size_t W8_IN = WS_W8, W8_GLU = WS_W8 + 2 * MiB, W8_KV = WS_W8 + 6 * MiB, W8_SQ = WS_W8 + 8 * MiB, W8_SO = WS_W8 + 10 * MiB, W8_PG = WS_W8 + 12 * MiB;
constexpr float W8_SCALE = 32.0f;
constexpr size_t WS_H18 = 820 * MiB;
constexpr size_t W8_EFF = 836 * MiB;
constexpr size_t WS_END = 844 * MiB;
constexpr int CW_BAR = 4096;
constexpr float PEER_SU = 91.0f, PEER_SV = 4.75f;

constexpr int LDS_BYTES = 163840;
constexpr int RING_BYTES = 131072;
constexpr int MISC_OFF = 163840 - 256;

#define GAS __attribute__((address_space(1)))
#define LAS __attribute__((address_space(3)))
typedef unsigned short bf16;
typedef unsigned v4u __attribute__((ext_vector_type(4)));
typedef unsigned v2u __attribute__((ext_vector_type(2)));
typedef float f32x4 __attribute__((ext_vector_type(4)));
typedef float f32x16 __attribute__((ext_vector_type(16)));
typedef short bf16x8 __attribute__((ext_vector_type(8)));
typedef __bf16 bf16x2_t __attribute__((ext_vector_type(2)));
#define LDS_WAIT() asm volatile("s_waitcnt lgkmcnt(0)" ::: "memory")
#define VM_WAIT() asm volatile("s_waitcnt vmcnt(0)" ::: "memory")
using pg8::cvt_pk_bf16; using pg8::bf_lo; using pg8::bf_hi; using pg8::gelu_tanh;

#define XB_TMO      128
#define XB_XCNT(j)  (256  + 64 * (j))
#define XB_XSUB(j)  (1280 + 64 * (j))
#define XB_XGEN(j)  (2304 + 64 * (j))
#define XB_TOP      3328
#define XB_TOPGEN   3392
#define XCD_BAR_WORDS 3456
#define XB_SPIN_CAP (1u << 24)
__device__ __forceinline__ unsigned xb_ld(unsigned* p)              { return __hip_atomic_load(p, __ATOMIC_RELAXED, __HIP_MEMORY_SCOPE_AGENT); }
__device__ __forceinline__ unsigned xb_add(unsigned* p, unsigned v) { return __hip_atomic_fetch_add(p, v, __ATOMIC_RELAXED, __HIP_MEMORY_SCOPE_AGENT); }
__device__ __forceinline__ unsigned xb_xcc_id() { return (unsigned)__builtin_amdgcn_s_getreg((3 << 11) | 20) & 0xFu; }
#define XB_SPIN(cond, bar) do { unsigned _sp = 0; while (cond) { __builtin_amdgcn_s_sleep(1); \
    if ((++_sp & 255u) == 0u) { if (xb_ld(&(bar)[XB_TMO])) break; if (_sp > XB_SPIN_CAP) { atomicAdd(&(bar)[XB_TMO], 1u); break; } } } } while (0)
struct XcdBarrier { unsigned* bar; unsigned x; volatile LAS unsigned* st; };
__device__ __forceinline__ XcdBarrier xcd_barrier_post(unsigned* bar, volatile LAS unsigned* st) {
    XcdBarrier b; b.bar = bar; b.x = xb_xcc_id(); b.st = st;
    if (threadIdx.x == 0) (void)xb_add(&bar[XB_XCNT(b.x)], 1u);
    return b;
}
__device__ __forceinline__ void xcd_barrier_complete(unsigned* bar, unsigned x, unsigned& nloc, unsigned& nx) {
    const unsigned G = gridDim.x * gridDim.y * gridDim.z;
    unsigned sum, cnt, mine, sp = 0u;
    for (;;) {
        sum = 0u; cnt = 0u; mine = 0u;
#pragma unroll 1
        for (unsigned j = 0; j < 16; ++j) { const unsigned c = xb_ld(&bar[XB_XCNT(j)]); sum += c; cnt += (c > 0u) ? 1u : 0u; mine = (j == x) ? c : mine; }
        if (sum == G) break;
        __builtin_amdgcn_s_sleep(1);
        if ((++sp & 255u) == 0u) { if (xb_ld(&bar[XB_TMO])) break; if (sp > XB_SPIN_CAP) { atomicAdd(&bar[XB_TMO], 1u); break; } }
    }
    nloc = mine > 0u ? mine : 1u; nx = cnt > 0u ? cnt : 1u;
}
__device__ __forceinline__ void xcd_barrier(const XcdBarrier& b) {
    asm volatile("s_waitcnt vmcnt(0)" ::: "memory");
    __syncthreads();
    if (threadIdx.x == 0) {
        unsigned* bar = b.bar;
        __builtin_amdgcn_s_waitcnt(0);
        unsigned nloc = b.st[0], nx = b.st[1];
        if (nloc == 0u) { xcd_barrier_complete(bar, b.x, nloc, nx); b.st[0] = nloc; b.st[1] = nx; }
        const unsigned old = xb_add(&bar[XB_XSUB(b.x)], 1u);
        const unsigned gen = old / nloc;
        if (old + 1u == (gen + 1u) * nloc) {
            __builtin_amdgcn_fence(__ATOMIC_RELEASE, "agent");
            asm volatile("s_waitcnt vmcnt(0)" ::: "memory");
            const unsigned og = xb_add(&bar[XB_TOP], 1u);
            const unsigned tg = og / nx;
            if (og + 1u == (tg + 1u) * nx) xb_add(&bar[XB_TOPGEN], 1u);
            else XB_SPIN(xb_ld(&bar[XB_TOPGEN]) == tg, bar);
            __builtin_amdgcn_fence(__ATOMIC_ACQUIRE, "agent");
            xb_add(&bar[XB_XGEN(b.x)], 1u);
            asm volatile("s_waitcnt vmcnt(0)" ::: "memory");
        } else {
            XB_SPIN(xb_ld(&bar[XB_XGEN(b.x)]) == gen, bar);
            __builtin_amdgcn_fence(__ATOMIC_ACQUIRE, "agent");
            asm volatile("s_waitcnt vmcnt(0)" ::: "memory");
        }
    }
    __syncthreads();
}

enum PhaseType { P_PROLOGUE = 0, P_STORE = 1, P_SSM = 2, P_GLU = 3, P_LNMIX = 4, P_TOPK = 5, P_PEER = 6, P_PLE = 7, P_LNKV = 8, P_ATTN = 9, P_RES = 10 };
constexpr int MAX_PH = 48;
struct Args { const float* in[28]; float* out; unsigned char* ws; int ph_lo, ph_hi, use_bar, nph; unsigned char ph_type[MAX_PH]; unsigned char ph_arg[MAX_PH]; };
struct Frame {
    LAS unsigned char* lds;
    int tid, lane, wave, vcu, G, z, bx;
    const struct Args* A;
    float* out; unsigned char* ws;
};
__device__ __forceinline__ float wave_sum(float v) {
#pragma unroll
    for (int o = 1; o < 64; o <<= 1) v += __shfl_xor(v, o);
    return v;
}
template <int CTRL, int BANK> __device__ __forceinline__ float dpp_movf(float old, float v) {
    return __builtin_bit_cast(float, __builtin_amdgcn_update_dpp(__builtin_bit_cast(int, old), __builtin_bit_cast(int, v), CTRL, 0xF, BANK, true));
}
__device__ __forceinline__ float wave_sum_dpp(float v) {
    v += dpp_movf<0xB1, 0xF>(0.f, v);
    v += dpp_movf<0x4E, 0xF>(0.f, v);
    { float r = dpp_movf<0x104, 0x5>(0.f, v); r = dpp_movf<0x114, 0xA>(r, v); v += r; }
    v += dpp_movf<0x128, 0xF>(0.f, v);
    { const auto t = __builtin_amdgcn_permlane16_swap(__builtin_bit_cast(unsigned, v), __builtin_bit_cast(unsigned, v), false, false); const unsigned ta = t[0], tb = t[1]; v = __builtin_bit_cast(float, ta) + __builtin_bit_cast(float, tb); }
    { const auto t = __builtin_amdgcn_permlane32_swap(__builtin_bit_cast(unsigned, v), __builtin_bit_cast(unsigned, v), false, false); const unsigned ta = t[0], tb = t[1]; v = __builtin_bit_cast(float, ta) + __builtin_bit_cast(float, tb); }
    return v;
}
__device__ __forceinline__ unsigned f2bf(float f) { unsigned u = __builtin_bit_cast(unsigned, f); return (u + 0x7fffu + ((u >> 16) & 1u)) >> 16; }
__device__ __forceinline__ unsigned pk2(float lo, float hi) { return f2bf(lo) | (f2bf(hi) << 16); }

__device__ __forceinline__ unsigned pk4_fp8(float a, float b, float c, float d) { int w = 0; w = __builtin_amdgcn_cvt_pk_fp8_f32(a, b, w, false); w = __builtin_amdgcn_cvt_pk_fp8_f32(c, d, w, true); return (unsigned)w; }
__device__ __forceinline__ void p0_transpose_item(const float* W, int K, int N, bf16* WT, int glu, LAS float* scr, int item, int lane, unsigned char* WT8 = nullptr) {
    const int nblk = N / 32, kb = item / nblk, nb = item % nblk, k0 = 64 * kb, n0 = 32 * nb;
    int r0 = n0;
    if (glu) { const int bj = n0 >> 10, rem = n0 & 1023; r0 = 256 * (rem >> 7) + 128 * bj + (rem & 127); }
#pragma unroll 8
    for (int i = 0; i < 32; ++i) { const int kk = 2 * i + (lane >> 5); scr[kk * 33 + (lane & 31)] = W[(size_t)(k0 + kk) * N + n0 + (lane & 31)]; }
    LDS_WAIT(); asm volatile("" ::: "memory");
    const int c = lane & 7;
#pragma unroll
    for (int j = 0; j < 4; ++j) { const int n = (lane >> 3) + 8 * j; const LAS float* s = scr + (8 * c) * 33 + n;
        v4u o; o.x = pk2(s[0 * 33], s[1 * 33]); o.y = pk2(s[2 * 33], s[3 * 33]); o.z = pk2(s[4 * 33], s[5 * 33]); o.w = pk2(s[6 * 33], s[7 * 33]);
        if (WT) *(GAS v4u*)(WT + (size_t)(r0 + n) * K + k0 + 8 * c) = o;
        if (WT8) *(GAS v2u*)(WT8 + (size_t)(r0 + n) * K + k0 + 8 * c) = (v2u){pk4_fp8(s[0 * 33] * W8_SCALE, s[1 * 33] * W8_SCALE, s[2 * 33] * W8_SCALE, s[3 * 33] * W8_SCALE), pk4_fp8(s[4 * 33] * W8_SCALE, s[5 * 33] * W8_SCALE, s[6 * 33] * W8_SCALE, s[7 * 33] * W8_SCALE)}; }
    LDS_WAIT(); asm volatile("" ::: "memory");
}
__device__ __forceinline__ void cvt_stream_dual(Frame& F, const float* src, bf16* dst, unsigned char* dst8, size_t n) {
    const size_t nthr = (size_t)F.G * 512, gt = (size_t)F.bx * 512 + F.tid;
    for (size_t i = gt; i < n / 8; i += nthr) {
        const f32x4 a = *(const GAS f32x4*)(src + i * 8), b = *(const GAS f32x4*)(src + i * 8 + 4);
        v4u o; o.x = pk2(a.x, a.y); o.y = pk2(a.z, a.w); o.z = pk2(b.x, b.y); o.w = pk2(b.z, b.w);
        *(GAS v4u*)(dst + i * 8) = o;
        *(GAS v2u*)(dst8 + i * 8) = (v2u){pk4_fp8(a.x, a.y, a.z, a.w), pk4_fp8(b.x, b.y, b.z, b.w)};
    }
}
__device__ __forceinline__ void cvt_stream(Frame& F, const float* src, bf16* dst, size_t n) {
    const size_t nthr = (size_t)F.G * 512, gt = (size_t)F.bx * 512 + F.tid;
    for (size_t i = gt; i < n / 8; i += nthr) {
        const f32x4 a = *(const GAS f32x4*)(src + i * 8), b = *(const GAS f32x4*)(src + i * 8 + 4);
        v4u o; o.x = pk2(a.x, a.y); o.y = pk2(a.z, a.w); o.z = pk2(b.x, b.y); o.w = pk2(b.z, b.w);
        *(GAS v4u*)(dst + i * 8) = o;
    }
}
__device__ __forceinline__ void cvt_stream_fp4(Frame& F, const float* src, unsigned char* dst, size_t n, float scale) {
    const size_t nthr = (size_t)F.G * 512, gt = (size_t)F.bx * 512 + F.tid;
    for (size_t i = gt; i < n / 32; i += nthr) {
        unsigned w[4];
#pragma unroll
        for (int q = 0; q < 4; ++q) {
            const f32x4 a = *(const GAS f32x4*)(src + i * 32 + 8 * q) * scale, b = *(const GAS f32x4*)(src + i * 32 + 8 * q + 4) * scale;
            unsigned t = 0u;
            t = __builtin_amdgcn_cvt_scalef32_pk_fp4_f32(t, a.x, a.y, 1.0f, 0); t = __builtin_amdgcn_cvt_scalef32_pk_fp4_f32(t, a.z, a.w, 1.0f, 1);
            t = __builtin_amdgcn_cvt_scalef32_pk_fp4_f32(t, b.x, b.y, 1.0f, 2); t = __builtin_amdgcn_cvt_scalef32_pk_fp4_f32(t, b.z, b.w, 1.0f, 3);
            w[q] = t;
        }
        *(GAS v4u*)(dst + i * 16) = (v4u){w[0], w[1], w[2], w[3]};
    }
}
__device__ __forceinline__ unsigned pkbf2(float lo, float hi) { return cvt_pk_bf16(lo, hi); }
__device__ __forceinline__ void p0_weff_item(Frame& F, int item) {
    const int jb = item & 1, kb = (item >> 1) & 15, hh = (item >> 5) & 15, l = item >> 9;
    const int lane = F.lane, r32 = lane & 31, h = lane >> 5;
    const float* wq = F.A->in[21 + F.z] + (size_t)l * 1024 * 2048 + (size_t)(64 * kb + r32) * 2048 + 128 * hh + 8 * h;
    const float* ky = F.A->in[22 + (hh & 1) + F.z] + (size_t)l * 128 * 128 + (size_t)(64 * jb + r32) * 128 + 8 * h;
    f32x16 acc[2][2] = {};
#pragma unroll
    for (int ks = 0; ks < 8; ++ks) {
        bf16x8 af[2], bf[2];
#pragma unroll
        for (int a = 0; a < 2; ++a) { const f32x4 a0 = *(const GAS f32x4*)(wq + (size_t)a * 32 * 2048 + 16 * ks), a1 = *(const GAS f32x4*)(wq + (size_t)a * 32 * 2048 + 16 * ks + 4);
            af[a] = __builtin_bit_cast(bf16x8, (v4u){pkbf2(a0.x, a0.y), pkbf2(a0.z, a0.w), pkbf2(a1.x, a1.y), pkbf2(a1.z, a1.w)}); }
#pragma unroll
        for (int b = 0; b < 2; ++b) { const f32x4 b0 = *(const GAS f32x4*)(ky + (size_t)b * 32 * 128 + 16 * ks), b1 = *(const GAS f32x4*)(ky + (size_t)b * 32 * 128 + 16 * ks + 4);
            bf[b] = __builtin_bit_cast(bf16x8, (v4u){pkbf2(b0.x, b0.y), pkbf2(b0.z, b0.w), pkbf2(b1.x, b1.y), pkbf2(b1.z, b1.w)}); }
#pragma unroll
        for (int a = 0; a < 2; ++a)
#pragma unroll
            for (int b = 0; b < 2; ++b) acc[a][b] = __builtin_amdgcn_mfma_f32_32x32x16_bf16(af[a], bf[b], acc[a][b], 0, 0, 0);
    }
#pragma unroll
    for (int a = 0; a < 2; ++a)
#pragma unroll
        for (int b = 0; b < 2; ++b) {
            unsigned char* dst = (unsigned char*)(F.ws + W8_EFF) + (size_t)l * 2048 * 1024 + (size_t)(128 * hh + 64 * jb + 32 * b + r32) * 1024 + 64 * kb + 32 * a + 4 * h;
#pragma unroll
            for (int q = 0; q < 4; ++q) *(GAS unsigned*)(dst + 8 * q) = pk4_fp8(acc[a][b][4 * q] * W8_SCALE, acc[a][b][4 * q + 1] * W8_SCALE, acc[a][b][4 * q + 2] * W8_SCALE, acc[a][b][4 * q + 3] * W8_SCALE); }
}
__device__ __forceinline__ void p0_prologue(Frame& F) {
#ifndef PROBE_PRO
#define PROBE_PRO 0
#endif
    for (int rp = 0; rp < (PROBE_PRO == 4 ? 2 : 1); ++rp) {
    cvt_stream_dual(F, F.A->in[0 + F.z], (bf16*)(F.ws + WS_H), (unsigned char*)(F.ws + WS_H8), (size_t)TOK * DM);
    cvt_stream(F, F.A->in[1 + F.z], (bf16*)(F.ws + WS_PB), (size_t)DEPTH * TOK * 256); }
    LAS float* scr = (LAS float*)(F.lds + F.wave * 8704);
    const int gw = F.vcu * NWAVES + F.wave, NGW = F.G * NWAVES;
    constexpr int I_SQ = 16 * 32, I_GLU = 16 * 64, I_PW = 4 * 32;
    constexpr int NITEMS = 2 * I_SQ + 2 * I_GLU + I_GLU + 2 * I_SQ + 2 * I_SQ + 4 * I_SQ + 4 * I_PW;
    for (int rp = 0; rp < (PROBE_PRO == 2 ? 2 : 1); ++rp)
    for (int it = gw; it < NITEMS; it += NGW) {
        int r = it;
        if (r < 2 * I_SQ) { const int l = r / I_SQ; p0_transpose_item(F.A->in[6 + F.z] + (size_t)l * 1024 * 1024, 1024, 1024, nullptr, 0, scr, r % I_SQ, F.lane, (unsigned char*)(F.ws + W8_IN) + (size_t)l * 1024 * 1024); continue; } r -= 2 * I_SQ;
        if (r < 2 * I_GLU) { const int l = r / I_GLU; p0_transpose_item(F.A->in[15 + F.z] + (size_t)l * 1024 * 2048, 1024, 2048, nullptr, 1, scr, r % I_GLU, F.lane, (unsigned char*)(F.ws + W8_GLU) + (size_t)l * 2048 * 1024); continue; } r -= 2 * I_GLU;
        if (r < I_GLU) { p0_transpose_item(F.A->in[18 + F.z], 1024, 2048, nullptr, 0, scr, r, F.lane, (unsigned char*)(F.ws + W8_KV)); continue; } r -= I_GLU;
        if (r < 2 * I_SQ) { const int l = r / I_SQ; p0_transpose_item(F.A->in[19 + F.z] + (size_t)l * 1024 * 1024, 1024, 1024, nullptr, 0, scr, r % I_SQ, F.lane, (unsigned char*)(F.ws + W8_SQ) + (size_t)l * 1024 * 1024); continue; } r -= 2 * I_SQ;
        if (r < 2 * I_SQ) { const int l = r / I_SQ; p0_transpose_item(F.A->in[20 + F.z] + (size_t)l * 1024 * 1024, 1024, 1024, nullptr, 0, scr, r % I_SQ, F.lane, (unsigned char*)(F.ws + W8_SO) + (size_t)l * 1024 * 1024); continue; } r -= 2 * I_SQ;
        if (r < 4 * I_SQ) { const int l = r / I_SQ; p0_transpose_item(F.A->in[27 + F.z] + (size_t)l * 1024 * 1024, 1024, 1024, nullptr, 0, scr, r % I_SQ, F.lane, (unsigned char*)(F.ws + W8_PG) + (size_t)l * 1024 * 1024); continue; } r -= 4 * I_SQ;
        { const int l = r / I_PW; p0_transpose_item(F.A->in[26 + F.z] + (size_t)l * 256 * 1024, 256, 1024, (bf16*)(F.ws + WS_W_PW) + (size_t)l * 1024 * 256, 0, scr, r % I_PW, F.lane); }
    }
    for (int rp = 0; rp < (PROBE_PRO == 3 ? 2 : 1); ++rp)
    for (int it = gw; it < 2048; it += NGW) p0_weff_item(F, it);
}

__device__ __forceinline__ void ln_rows(Frame& F, const bf16* X, const float* g, const float* bb, bf16* O, unsigned char* O8 = nullptr) {
    const int gw = F.vcu * NWAVES + F.wave, NGW = F.G * NWAVES;
    float gg[16], bv[16];
    { const f32x4 a = *(const GAS f32x4*)(g + 8 * F.lane), b = *(const GAS f32x4*)(g + 8 * F.lane + 4), c = *(const GAS f32x4*)(g + 512 + 8 * F.lane), d = *(const GAS f32x4*)(g + 512 + 8 * F.lane + 4);
      gg[0] = a.x; gg[1] = a.y; gg[2] = a.z; gg[3] = a.w; gg[4] = b.x; gg[5] = b.y; gg[6] = b.z; gg[7] = b.w; gg[8] = c.x; gg[9] = c.y; gg[10] = c.z; gg[11] = c.w; gg[12] = d.x; gg[13] = d.y; gg[14] = d.z; gg[15] = d.w; }
    { const f32x4 a = *(const GAS f32x4*)(bb + 8 * F.lane), b = *(const GAS f32x4*)(bb + 8 * F.lane + 4), c = *(const GAS f32x4*)(bb + 512 + 8 * F.lane), d = *(const GAS f32x4*)(bb + 512 + 8 * F.lane + 4);
      bv[0] = a.x; bv[1] = a.y; bv[2] = a.z; bv[3] = a.w; bv[4] = b.x; bv[5] = b.y; bv[6] = b.z; bv[7] = b.w; bv[8] = c.x; bv[9] = c.y; bv[10] = c.z; bv[11] = c.w; bv[12] = d.x; bv[13] = d.y; bv[14] = d.z; bv[15] = d.w; }
    for (int m = gw; m < TOK; m += NGW) {
        const v4u xa = *(const GAS v4u*)(X + (size_t)m * DM + 8 * F.lane), xb = *(const GAS v4u*)(X + (size_t)m * DM + 512 + 8 * F.lane);
        float x[16] = {bf_lo(xa.x), bf_hi(xa.x), bf_lo(xa.y), bf_hi(xa.y), bf_lo(xa.z), bf_hi(xa.z), bf_lo(xa.w), bf_hi(xa.w), bf_lo(xb.x), bf_hi(xb.x), bf_lo(xb.y), bf_hi(xb.y), bf_lo(xb.z), bf_hi(xb.z), bf_lo(xb.w), bf_hi(xb.w)};
        float s = 0.f;
#pragma unroll
        for (int i = 0; i < 16; ++i) s += x[i];
        const float mean = wave_sum_dpp(s) * (1.f / DM); float q = 0.f;
#pragma unroll
        for (int i = 0; i < 16; ++i) { x[i] -= mean; q += x[i] * x[i]; }
        const float rstd = 1.0f / sqrtf(wave_sum_dpp(q) * (1.f / DM) + LN_EPS);
#pragma unroll
        for (int i = 0; i < 16; ++i) x[i] = x[i] * rstd * gg[i] + bv[i];
        v4u oa, ob; oa.x = pk2(x[0], x[1]); oa.y = pk2(x[2], x[3]); oa.z = pk2(x[4], x[5]); oa.w = pk2(x[6], x[7]); ob.x = pk2(x[8], x[9]); ob.y = pk2(x[10], x[11]); ob.z = pk2(x[12], x[13]); ob.w = pk2(x[14], x[15]);
        if (O) { *(GAS v4u*)(O + (size_t)m * DM + 8 * F.lane) = oa; *(GAS v4u*)(O + (size_t)m * DM + 512 + 8 * F.lane) = ob; }
        if (O8) { *(GAS v2u*)(O8 + (size_t)m * DM + 8 * F.lane) = (v2u){pk4_fp8(x[0], x[1], x[2], x[3]), pk4_fp8(x[4], x[5], x[6], x[7])};
                  *(GAS v2u*)(O8 + (size_t)m * DM + 512 + 8 * F.lane) = (v2u){pk4_fp8(x[8], x[9], x[10], x[11]), pk4_fp8(x[12], x[13], x[14], x[15])}; }
    }
}
struct TabCvt { const float* su; const float* sv; unsigned char* du; unsigned char* dv; int c, cf, stride, n; };
__device__ __forceinline__ void tabcvt_issue(TabCvt& T, int lane, f32x4 (&cv)[4]) {
    const bool live = T.c < T.n;
    if (live) { const int half = T.n >> 1; const float* src = (T.c < half ? T.su + (size_t)T.c * 1024 : T.sv + (size_t)(T.c - half) * 1024) + 16 * lane;
#pragma unroll
        for (int q = 0; q < 4; ++q) cv[q] = *(const GAS f32x4*)(src + 4 * q); }
    T.c += T.stride;
}
__device__ __forceinline__ unsigned i4q(float v) { float t = __builtin_fminf(__builtin_fmaxf(v * PEER_SU, -7.f), 7.f) + 12582912.0f; asm volatile("" : "+v"(t)); return __builtin_bit_cast(unsigned, t) & 15u; }
__device__ __forceinline__ unsigned pack8_i4(const f32x4& a, const f32x4& b) {
    return i4q(a.x) | (i4q(a.y) << 4) | (i4q(a.z) << 8) | (i4q(a.w) << 12) | (i4q(b.x) << 16) | (i4q(b.y) << 20) | (i4q(b.z) << 24) | (i4q(b.w) << 28);
}
__device__ __forceinline__ void tabcvt_finish(TabCvt& T, int lane, const f32x4 (&cv)[4]) {
    const bool live = T.cf < T.n;
    if (live) { const int half = T.n >> 1;
        unsigned w0 = 0u, w1 = 0u;
        if (T.cf < half) { w0 = pack8_i4(cv[0], cv[1]); w1 = pack8_i4(cv[2], cv[3]); }
        else { const float sc = PEER_SV;
            w0 = __builtin_amdgcn_cvt_scalef32_pk_fp4_f32(w0, cv[0].x * sc, cv[0].y * sc, 1.0f, 0); w0 = __builtin_amdgcn_cvt_scalef32_pk_fp4_f32(w0, cv[0].z * sc, cv[0].w * sc, 1.0f, 1);
            w0 = __builtin_amdgcn_cvt_scalef32_pk_fp4_f32(w0, cv[1].x * sc, cv[1].y * sc, 1.0f, 2); w0 = __builtin_amdgcn_cvt_scalef32_pk_fp4_f32(w0, cv[1].z * sc, cv[1].w * sc, 1.0f, 3);
            w1 = __builtin_amdgcn_cvt_scalef32_pk_fp4_f32(w1, cv[2].x * sc, cv[2].y * sc, 1.0f, 0); w1 = __builtin_amdgcn_cvt_scalef32_pk_fp4_f32(w1, cv[2].z * sc, cv[2].w * sc, 1.0f, 1);
            w1 = __builtin_amdgcn_cvt_scalef32_pk_fp4_f32(w1, cv[3].x * sc, cv[3].y * sc, 1.0f, 2); w1 = __builtin_amdgcn_cvt_scalef32_pk_fp4_f32(w1, cv[3].z * sc, cv[3].w * sc, 1.0f, 3); }
        unsigned char* dst = (T.cf < half ? T.du + (size_t)T.cf * 512 : T.dv + (size_t)(T.cf - half) * 512) + 8 * lane;
        *(GAS v2u*)dst = (v2u){w0, w1}; }
    T.cf += T.stride;
}
template <bool PASS1> __device__ __forceinline__ void ssm_pass(const bf16* U, bf16* Y, LAS unsigned char* stl, const float* dskip, size_t tok0, int g, int lane, int n, int hh, int i_row,
                                                                  const float (&a_re)[2], const float (&a_im)[2], const bf16x8 (&Bf)[4], const LAS unsigned char* CFL, float (&s_re)[2], float (&s_im)[2]) {
    const int c0 = 16 * g + 4 * hh;
    bf16x8 ua_n = *(const GAS bf16x8*)(U + tok0 * DM + 16 * g + 8 * hh);
    v2u u0_n = {}, u1_n = {};
    if (PASS1) { u0_n = *(const GAS v2u*)(U + tok0 * DM + c0); u1_n = *(const GAS v2u*)(U + tok0 * DM + c0 + 8); }
#pragma unroll 1
    for (int tile = 0; tile < 16; ++tile) {
        const size_t tok = tok0 + tile * 16;
        const bf16x8 ua = ua_n; const v2u u0 = u0_n, u1 = u1_n;
        { const size_t tokn = tok0 + ((tile + 1) & 15) * 16;
          ua_n = *(const GAS bf16x8*)(U + tokn * DM + 16 * g + 8 * hh);
          if (PASS1) { u0_n = *(const GAS v2u*)(U + tokn * DM + c0); u1_n = *(const GAS v2u*)(U + tokn * DM + c0 + 8); } }
        f32x16 acc[4];
#pragma unroll
        for (int nb = 0; nb < 4; ++nb) { f32x16 z = {}; acc[nb] = __builtin_amdgcn_mfma_f32_32x32x16_bf16(ua, Bf[nb], z, 0, 0, 0); }
#pragma unroll
        for (int pb = 0; pb < 2; ++pb) {
#pragma unroll
            for (int r = 0; r < 16; ++r) {
                float t0 = fmaf(-a_im[pb], s_im[pb], acc[2 * pb][r]); asm volatile("" : "+v"(t0));
                float t1 = fmaf(a_im[pb], s_re[pb], acc[2 * pb + 1][r]); asm volatile("" : "+v"(t1));
                float nre = fmaf(a_re[pb], s_re[pb], t0); asm volatile("" : "+v"(nre));
                float nim = fmaf(a_re[pb], s_im[pb], t1); asm volatile("" : "+v"(nim));
                s_re[pb] = nre; s_im[pb] = nim;
                if (PASS1) { const int irow = (r & 3) + 8 * (r >> 2) + 4 * hh; *(LAS unsigned*)(stl + irow * 272 + (32 * pb + n) * 4) = cvt_pk_bf16(nre, nim); }
            }
        }
        if (PASS1) {
            LDS_WAIT();
            f32x16 yv = {};
#pragma unroll
            for (int ks = 0; ks < 8; ++ks) { const bf16x8 sb = *(const LAS bf16x8*)(stl + i_row * 272 + (16 * ks + 8 * hh) * 2); const bf16x8 cf = *(const LAS bf16x8*)(CFL + (ks * 64 + lane) * 16); yv = __builtin_amdgcn_mfma_f32_32x32x16_bf16(cf, sb, yv, 0, 0, 0); }
            const f32x4 d0 = *(const GAS f32x4*)(dskip + c0), d1 = *(const GAS f32x4*)(dskip + c0 + 8);
            float o[8];
            o[0] = gelu_tanh(yv[0] + d0.x * bf_lo(u0.x)); o[1] = gelu_tanh(yv[1] + d0.y * bf_hi(u0.x)); o[2] = gelu_tanh(yv[2] + d0.z * bf_lo(u0.y)); o[3] = gelu_tanh(yv[3] + d0.w * bf_hi(u0.y));
            o[4] = gelu_tanh(yv[4] + d1.x * bf_lo(u1.x)); o[5] = gelu_tanh(yv[5] + d1.y * bf_hi(u1.x)); o[6] = gelu_tanh(yv[6] + d1.z * bf_lo(u1.y)); o[7] = gelu_tanh(yv[7] + d1.w * bf_hi(u1.y));
            *(GAS unsigned*)((unsigned char*)Y + tok * DM + c0) = pk4_fp8(o[0], o[1], o[2], o[3]);
            *(GAS unsigned*)((unsigned char*)Y + tok * DM + c0 + 8) = pk4_fp8(o[4], o[5], o[6], o[7]);
            LDS_WAIT();
        }
    }
}
__device__ __forceinline__ void ssm_phase(Frame& F, int layer) {
    if (layer == 0) {
        TabCvt TC; TC.su = F.A->in[24 + F.z]; TC.sv = F.A->in[25 + F.z]; TC.du = (unsigned char*)(F.ws + WS_TABU); TC.dv = (unsigned char*)(F.ws + WS_TABV);
        TC.c = F.vcu * NWAVES + F.wave; TC.cf = TC.c; TC.stride = F.G * NWAVES; TC.n = 2 * 16384;
        f32x4 cvA[4], cvB[4];
        tabcvt_issue(TC, F.lane, cvA);
        while (TC.cf < TC.n) { tabcvt_issue(TC, F.lane, cvB); tabcvt_finish(TC, F.lane, cvA); tabcvt_issue(TC, F.lane, cvA); tabcvt_finish(TC, F.lane, cvB); }
    }
    const bf16* U = (const bf16*)(F.ws + WS_U); bf16* Y = (bf16*)(F.ws + WS_Y);
    const int lane = F.lane, n = lane & 31, hh = lane >> 5, wave = F.wave;
    LAS unsigned char* stl = F.lds + wave * 8704;
    LAS float* E = (LAS float*)(F.lds + 8 * 8704);
    for (int bg = F.vcu; bg < BATCH * 64; bg += F.G) {
        const int b = bg >> 6, g = bg & 63, lg = layer * 64 + g;
        const float dt = expf(F.A->in[9 + F.z][lg]);
        float a_re[2], a_im[2]; bf16x8 Bf[4];
#pragma unroll
        for (int pb = 0; pb < 2; ++pb) {
            const int p = 32 * pb + n;
            const float lre = F.A->in[7 + F.z][lg * 64 + p], lim = F.A->in[8 + F.z][lg * 64 + p];
            const float mag = expf(lre * dt); float sn, cs; sincosf(lim * dt, &sn, &cs);
            a_re[pb] = mag * cs; a_im[pb] = mag * sn;
            const float nr = a_re[pb] - 1.0f, ni = a_im[pb], den = 1.0f / (lre * lre + lim * lim);
            const float cr = (nr * lre + ni * lim) * den, ci = (ni * lre - nr * lim) * den;
            const float* br = F.A->in[10 + F.z] + ((size_t)lg * 64 + p) * 16 + 8 * hh; const float* bi = F.A->in[11 + F.z] + ((size_t)lg * 64 + p) * 16 + 8 * hh;
            const f32x4 br0 = *(const GAS f32x4*)br, br1 = *(const GAS f32x4*)(br + 4), bi0 = *(const GAS f32x4*)bi, bi1 = *(const GAS f32x4*)(bi + 4);
            const float rr[8] = {br0.x, br0.y, br0.z, br0.w, br1.x, br1.y, br1.z, br1.w}, ii[8] = {bi0.x, bi0.y, bi0.z, bi0.w, bi1.x, bi1.y, bi1.z, bi1.w};
            unsigned wre[4], wim[4];
#pragma unroll
            for (int j = 0; j < 4; ++j) { const float r0 = rr[2 * j], i0 = ii[2 * j], r1 = rr[2 * j + 1], i1 = ii[2 * j + 1];
                wre[j] = pk2(cr * r0 - ci * i0, cr * r1 - ci * i1); wim[j] = pk2(cr * i0 + ci * r0, cr * i1 + ci * r1); }
            Bf[2 * pb] = __builtin_bit_cast(bf16x8, (v4u){wre[0], wre[1], wre[2], wre[3]});
            Bf[2 * pb + 1] = __builtin_bit_cast(bf16x8, (v4u){wim[0], wim[1], wim[2], wim[3]});
        }
        LAS unsigned char* CFL = F.lds + 8 * 8704 + 8192;
        if (wave == 0) { const int cr_ = n & 15; const float zm = (n < 16) ? 1.0f : 0.0f;
          const float* cre = F.A->in[12 + F.z] + ((size_t)lg * 16 + cr_) * 64 + 4 * hh; const float* cim = F.A->in[13 + F.z] + ((size_t)lg * 16 + cr_) * 64 + 4 * hh;
          f32x4 cr4[8], ci4[8];
#pragma unroll
          for (int ks = 0; ks < 8; ++ks) { cr4[ks] = *(const GAS f32x4*)(cre + 8 * ks); ci4[ks] = *(const GAS f32x4*)(cim + 8 * ks); }
#pragma unroll
          for (int ks = 0; ks < 8; ++ks) { const f32x4 a = cr4[ks] * zm, c = ci4[ks] * (-zm);
              *(LAS v4u*)(CFL + (ks * 64 + lane) * 16) = (v4u){pk2(a.x, c.x), pk2(a.y, c.y), pk2(a.z, c.z), pk2(a.w, c.w)}; } }
        const int seg_own = 2 * wave + hh;
        const int i_row = n, seg_ld = 2 * wave + ((i_row >> 2) & 1), tau_ld = (i_row & 3) + 4 * (i_row >> 3);
        const size_t tok0 = (size_t)b * SEQ + seg_ld * 256 + tau_ld;
        const float* dskip = F.A->in[14 + F.z] + layer * 1024;
        float s_re[2] = {0.f, 0.f}, s_im[2] = {0.f, 0.f};
        ssm_pass<false>(U, Y, stl, dskip, tok0, g, lane, n, hh, i_row, a_re, a_im, Bf, CFL, s_re, s_im);
#pragma unroll
        for (int pb = 0; pb < 2; ++pb) { E[(seg_own * 64 + 32 * pb + n) * 2] = s_re[pb]; E[(seg_own * 64 + 32 * pb + n) * 2 + 1] = s_im[pb]; }
        LDS_WAIT(); __syncthreads();
#pragma unroll
        for (int pb = 0; pb < 2; ++pb) {
            float Ar = a_re[pb], Ai = a_im[pb];
#pragma unroll
            for (int q = 0; q < 8; ++q) { float t = Ar * Ar - Ai * Ai; asm volatile("" : "+v"(t)); Ai = 2.0f * Ar * Ai; asm volatile("" : "+v"(Ai)); Ar = t; }
            float sr = 0.f, si = 0.f;
            for (int j = 0; j < 15; ++j) {
                const float er = E[(j * 64 + 32 * pb + n) * 2], ei = E[(j * 64 + 32 * pb + n) * 2 + 1];
                float tr = Ar * sr - Ai * si + er; asm volatile("" : "+v"(tr)); float ti = Ar * si + Ai * sr + ei; asm volatile("" : "+v"(ti));
                if (j < seg_own) { sr = tr; si = ti; }
            }
            s_re[pb] = sr; s_im[pb] = si;
        }
        __syncthreads();
        ssm_pass<true>(U, Y, stl, dskip, tok0, g, lane, n, hh, i_row, a_re, a_im, Bf, CFL, s_re, s_im);
        __syncthreads();
    }
}

typedef int av8i __attribute__((ext_vector_type(8)));
__device__ __forceinline__ av8i ld32B(const unsigned char* p0, const unsigned char* p1) {
    const v4u a = *(const GAS v4u*)p0, b = *(const GAS v4u*)p1; return (av8i){(int)a.x, (int)a.y, (int)a.z, (int)a.w, (int)b.x, (int)b.y, (int)b.z, (int)b.w}; }
__device__ __forceinline__ void attn_wave_unit(Frame& F, int b, int hd, int qt) {
    const unsigned char* Q = (const unsigned char*)(F.ws + WS_U); const unsigned char* K = (const unsigned char*)(F.ws + WS_KB); const unsigned char* Vt = (const unsigned char*)(F.ws + WS_VT); bf16* O = (bf16*)(F.ws + WS_Y);
    constexpr float QK_SC = 0.125f * 1.4426950408889634f;
    constexpr float ATT_EXIT = 28.0f;
    const int lane = F.lane, n = lane & 31, hh = lane >> 5;
    const size_t qrow = (size_t)b * SEQ + 32 * qt + n;
    const av8i qf = ld32B(Q + qrow * DM + 64 * hd + 32 * hh, Q + qrow * DM + 64 * hd + 32 * hh + 16);
    f32x16 o[2]; o[0] = f32x16{}; o[1] = f32x16{};
    float racc = 0.f;
    const int qrel = 32 * qt, myq = qrel + n;
    const int keyi = (n & 3) + 4 * (n >> 3) + 16 * ((n >> 2) & 1);
    const unsigned char* kbase = K + ((size_t)b * SEQ + keyi) * DM + 64 * hd + 32 * hh;
    const unsigned char* vbase = Vt + (size_t)(64 * hd + n) * TOK + (size_t)b * SEQ + 16 * hh;
    int T = (qrel + 30) >> 6;
    av8i kf[2];
#pragma unroll
    for (int u = 0; u < 2; ++u) { const unsigned char* kp = kbase + (size_t)(64 * T + 32 * u) * DM; kf[u] = ld32B(kp, kp + 16); }
    for (; T >= 0; --T) {
        const int k0 = 64 * T;
        const f32x16 zz = {};
        const f32x16 s0 = __builtin_amdgcn_mfma_scale_f32_32x32x64_f8f6f4(kf[0], qf, zz, 0, 0, 0, 0, 0, 0), s1 = __builtin_amdgcn_mfma_scale_f32_32x32x64_f8f6f4(kf[1], qf, zz, 0, 0, 0, 0, 0, 0);
        av8i vf[2];
#pragma unroll
        for (int db = 0; db < 2; ++db) { const unsigned char* vp = vbase + (size_t)(32 * db) * TOK + k0; vf[db] = ld32B(vp, vp + 32); }
        { const int Tn = T > 0 ? T - 1 : 0;
#pragma unroll
          for (int u = 0; u < 2; ++u) { const unsigned char* kp = kbase + (size_t)(64 * Tn + 32 * u) * DM; kf[u] = ld32B(kp, kp + 16); } }
        const bool need_mask = (k0 + 63 >= qrel);
        float sp[2][16], z[2][16];
#pragma unroll
        for (int r = 0; r < 16; ++r) { const float za = fminf(s0[r] * QK_SC, 60.0f), zb = fminf(s1[r] * QK_SC, 60.0f); z[0][r] = za; z[1][r] = zb;
            sp[0][r] = __builtin_amdgcn_logf(1.0f + __builtin_amdgcn_exp2f(za)); sp[1][r] = __builtin_amdgcn_logf(1.0f + __builtin_amdgcn_exp2f(zb)); }
        if (need_mask) {
#pragma unroll
            for (int u = 0; u < 2; ++u)
#pragma unroll
                for (int r = 0; r < 16; ++r) { const int key = k0 + 32 * u + 16 * hh + r; if (key >= myq) { sp[u][r] = 0.f; z[u][r] = -1e30f; } }
        }
        float T0 = 0.f, T1 = 0.f;
#pragma unroll
        for (int r = 0; r < 16; ++r) { T0 += sp[0][r]; T1 += sp[1][r]; }
        const float oT0 = __shfl_xor(T0, 32), oT1 = __shfl_xor(T1, 32);
        const float off1 = racc + (hh ? 0.f : oT1);
        const float off0 = racc + T1 + oT1 + (hh ? 0.f : oT0);
        racc += T0 + T1 + oT0 + oT1;
        unsigned pw[2][4];
        { float run = off1;
#pragma unroll
          for (int r = 15; r >= 0; --r) { run += sp[1][r]; z[1][r] = __builtin_amdgcn_exp2f(z[1][r] - run); }
          run = off0;
#pragma unroll
          for (int r = 15; r >= 0; --r) { run += sp[0][r]; z[0][r] = __builtin_amdgcn_exp2f(z[0][r] - run); } }
#pragma unroll
        for (int u = 0; u < 2; ++u)
#pragma unroll
            for (int q = 0; q < 4; ++q) pw[u][q] = pk4_fp8(z[u][4 * q], z[u][4 * q + 1], z[u][4 * q + 2], z[u][4 * q + 3]);
        { const av8i af = {(int)pw[0][0], (int)pw[0][1], (int)pw[0][2], (int)pw[0][3], (int)pw[1][0], (int)pw[1][1], (int)pw[1][2], (int)pw[1][3]};
#pragma unroll
          for (int db = 0; db < 2; ++db) o[db] = __builtin_amdgcn_mfma_scale_f32_32x32x64_f8f6f4(af, vf[db], o[db], 0, 0, 0, 0, 0, 0); }
        if (__all(racc >= ATT_EXIT)) break;
    }
#pragma unroll
    for (int db = 0; db < 2; ++db)
#pragma unroll
        for (int r = 0; r < 16; ++r) { const int qr = (r & 3) + 8 * (r >> 2) + 4 * hh;
            ((unsigned char*)O)[((size_t)b * SEQ + 32 * qt + qr) * DM + 64 * hd + 32 * db + n] = (unsigned char)(pk4_fp8(o[db][r], 0.f, 0.f, 0.f) & 0xffu); }
}
__device__ __forceinline__ void attn_phase(Frame& F) {
    const int gw = F.vcu * NWAVES + F.wave, NGW = F.G * NWAVES;
#pragma unroll 1
    for (int uidx = gw; uidx < 64 * 128; uidx += NGW) { const int bh = uidx >> 7; attn_wave_unit(F, bh >> 4, bh & 15, uidx & 127); }
}

typedef float f32x2 __attribute__((ext_vector_type(2)));
typedef _Float16 h16x2 __attribute__((ext_vector_type(2)));
template <int K, class T> __device__ __forceinline__ T xcomb(T a, T b, int lane) {
    const bool hi = (lane >> K) & 1; const T keep = hi ? b : a, send = hi ? a : b;
    return keep + __shfl_xor(send, 1 << K);
}
__device__ __forceinline__ void fp4x16_to_f32(const v2u& r, f32x2 (&f)[8]) {
    const unsigned w0 = r.x, w1 = r.y;
    f[0] = __builtin_amdgcn_cvt_scalef32_pk_f32_fp4(w0, 1.0f, 0); f[1] = __builtin_amdgcn_cvt_scalef32_pk_f32_fp4(w0, 1.0f, 1);
    f[2] = __builtin_amdgcn_cvt_scalef32_pk_f32_fp4(w0, 1.0f, 2); f[3] = __builtin_amdgcn_cvt_scalef32_pk_f32_fp4(w0, 1.0f, 3);
    f[4] = __builtin_amdgcn_cvt_scalef32_pk_f32_fp4(w1, 1.0f, 0); f[5] = __builtin_amdgcn_cvt_scalef32_pk_f32_fp4(w1, 1.0f, 1);
    f[6] = __builtin_amdgcn_cvt_scalef32_pk_f32_fp4(w1, 1.0f, 2); f[7] = __builtin_amdgcn_cvt_scalef32_pk_f32_fp4(w1, 1.0f, 3);
}
typedef unsigned bl_v2u __attribute__((__vector_size__(8)));
__device__ __forceinline__ void peer_load8(__amdgpu_buffer_rsrc_t tab, int idv, int e0, int lane, v2u (&R)[8]) {
    int so[8];
    __builtin_amdgcn_s_setprio(1);
#pragma unroll
    for (int i = 0; i < 8; ++i) so[i] = __builtin_amdgcn_readlane(idv, e0 + i) << 9;
    __builtin_amdgcn_sched_barrier(0);
#pragma unroll
    for (int i = 0; i < 8; ++i) { const bl_v2u t = __builtin_amdgcn_raw_buffer_load_b64(tab, 8 * lane, so[i], 0); R[i] = (v2u){t[0], t[1]}; }
    __builtin_amdgcn_s_setprio(0);
    __builtin_amdgcn_sched_barrier(0);
}
template <int K> __device__ __forceinline__ int xcomb_dpp(int a, int b, int lane) {
    const bool hi = (lane >> K) & 1; const int keep = hi ? b : a, send = hi ? a : b; int recv;
    if (K == 0) recv = __builtin_amdgcn_update_dpp(0, send, 0xB1, 0xF, 0xF, true);
    else if (K == 1) recv = __builtin_amdgcn_update_dpp(0, send, 0x4E, 0xF, 0xF, true);
    else { recv = __builtin_amdgcn_update_dpp(0, send, 0x104, 0xF, 0x5, true);
           recv = __builtin_amdgcn_update_dpp(recv, send, 0x114, 0xF, 0xA, true); }
    return keep + recv;
}
__device__ __forceinline__ float peer_dot8(const v2u (&R)[8], const v2u& xhi, const v2u& xlo, int lane) {
    int p[8];
#pragma unroll
    for (int i = 0; i < 8; i += 2) {
        int h0 = __builtin_amdgcn_sdot8((int)R[i].x, (int)xhi.x, 0, false), h1 = __builtin_amdgcn_sdot8((int)R[i + 1].x, (int)xhi.x, 0, false);
        int l0 = __builtin_amdgcn_sdot8((int)R[i].x, (int)xlo.x, 0, false), l1 = __builtin_amdgcn_sdot8((int)R[i + 1].x, (int)xlo.x, 0, false);
        h0 = __builtin_amdgcn_sdot8((int)R[i].y, (int)xhi.y, h0, false); h1 = __builtin_amdgcn_sdot8((int)R[i + 1].y, (int)xhi.y, h1, false);
        l0 = __builtin_amdgcn_sdot8((int)R[i].y, (int)xlo.y, l0, false); l1 = __builtin_amdgcn_sdot8((int)R[i + 1].y, (int)xlo.y, l1, false);
        p[i] = (h0 << 4) + l0; p[i + 1] = (h1 << 4) + l1; __builtin_amdgcn_sched_barrier(0); }
    int q[4];
#pragma unroll
    for (int i = 0; i < 4; ++i) q[i] = xcomb_dpp<0>(p[2 * i], p[2 * i + 1], lane);
    const int r0 = xcomb_dpp<1>(q[0], q[1], lane), r1 = xcomb_dpp<1>(q[2], q[3], lane);
    int v = xcomb_dpp<2>(r0, r1, lane);
    v += __builtin_amdgcn_update_dpp(0, v, 0x128, 0xF, 0xF, true);
    { const auto t = __builtin_amdgcn_permlane16_swap((unsigned)v, (unsigned)v, false, false); v = (int)(t[0] + t[1]); }
    { const auto t = __builtin_amdgcn_permlane32_swap((unsigned)v, (unsigned)v, false, false); v = (int)(t[0] + t[1]); }
    return (float)v;
}
__device__ __forceinline__ void peer_fma8(const v2u (&R)[8], unsigned wvh, int e0, h16x2 (&o)[8]) {
#pragma unroll
    for (int i = 0; i < 8; ++i) { const unsigned wt = (unsigned)__builtin_amdgcn_readlane((int)wvh, e0 + i); const h16x2 w2 = __builtin_bit_cast(h16x2, wt);
        const unsigned w0 = R[i].x, w1 = R[i].y; h16x2 f[8];
        f[0] = __builtin_amdgcn_cvt_scalef32_pk_f16_fp4(w0, 1.0f, 0); f[1] = __builtin_amdgcn_cvt_scalef32_pk_f16_fp4(w0, 1.0f, 1);
        f[2] = __builtin_amdgcn_cvt_scalef32_pk_f16_fp4(w0, 1.0f, 2); f[3] = __builtin_amdgcn_cvt_scalef32_pk_f16_fp4(w0, 1.0f, 3);
        f[4] = __builtin_amdgcn_cvt_scalef32_pk_f16_fp4(w1, 1.0f, 0); f[5] = __builtin_amdgcn_cvt_scalef32_pk_f16_fp4(w1, 1.0f, 1);
        f[6] = __builtin_amdgcn_cvt_scalef32_pk_f16_fp4(w1, 1.0f, 2); f[7] = __builtin_amdgcn_cvt_scalef32_pk_f16_fp4(w1, 1.0f, 3);
#pragma unroll
        for (int k = 0; k < 8; ++k) o[k] = __builtin_elementwise_fma(w2, f[k], o[k]);
        __builtin_amdgcn_sched_barrier(0); }
}
__device__ __forceinline__ void peer_phase(Frame& F, int layer) {
    const bf16* H1 = (const bf16*)(F.ws + WS_H1); bf16* H2 = (bf16*)(F.ws + WS_H2);
    const __amdgpu_buffer_rsrc_t TU = __builtin_amdgcn_make_buffer_rsrc((void*)(F.ws + WS_TABU + (size_t)layer * 16384 * 512), (short)0, 16384 * 512, 0x00020000);
    const __amdgpu_buffer_rsrc_t TV = __builtin_amdgcn_make_buffer_rsrc((void*)(F.ws + WS_TABV + (size_t)layer * 16384 * 512), (short)0, 16384 * 512, 0x00020000);
    const int* IDX = (const int*)(F.ws + WS_IDX); const float* GATE = (const float*)(F.ws + WS_GATE);
    const float* g = F.A->in[4 + F.z] + layer * 1024; const float* bb = F.A->in[5 + F.z] + layer * 1024;
    const int lane = F.lane, gw = F.vcu * NWAVES + F.wave, NGW = F.G * NWAVES;
    v2u B0[8], B1[8], B2[8], B3[8];
    TabCvt TC; { const size_t lo = (size_t)(layer + 1) * 16384 * 1024;
        TC.su = F.A->in[24 + F.z] + lo; TC.sv = F.A->in[25 + F.z] + lo; TC.du = (unsigned char*)(F.ws + WS_TABU) + lo / 2; TC.dv = (unsigned char*)(F.ws + WS_TABV) + lo / 2;
        TC.c = gw; TC.cf = gw; TC.stride = NGW; TC.n = (layer + 1 < DEPTH) ? 2 * 16384 : 0; }
    f32x4 cvA[4], cvB[4];
    int id0 = 0, id1 = 0;
    if (gw < TOK) { id0 = IDX[(size_t)gw * 128 + lane]; id1 = IDX[(size_t)gw * 128 + 64 + lane];
        peer_load8(TU, id0, 0, lane, B0); peer_load8(TU, id0, 8, lane, B1); peer_load8(TU, id0, 16, lane, B2); }
    tabcvt_issue(TC, lane, cvA); tabcvt_issue(TC, lane, cvB);
    for (int t = gw; t < TOK; t += NGW) {
        const int tn = (t + NGW < TOK) ? t + NGW : t;
        const int nid0 = IDX[(size_t)tn * 128 + lane], nid1 = IDX[(size_t)tn * 128 + 64 + lane];
        const float g0 = GATE[(size_t)t * 128 + lane], g1 = GATE[(size_t)t * 128 + 64 + lane];
        const v4u xa = *(const GAS v4u*)(H1 + (size_t)t * DM + 16 * lane), xb = *(const GAS v4u*)(H1 + (size_t)t * DM + 16 * lane + 8);
        f32x2 x[8] = {{bf_lo(xa.x), bf_hi(xa.x)}, {bf_lo(xa.y), bf_hi(xa.y)}, {bf_lo(xa.z), bf_hi(xa.z)}, {bf_lo(xa.w), bf_hi(xa.w)}, {bf_lo(xb.x), bf_hi(xb.x)}, {bf_lo(xb.y), bf_hi(xb.y)}, {bf_lo(xb.z), bf_hi(xb.z)}, {bf_lo(xb.w), bf_hi(xb.w)}};
        v2u xqh = {0u, 0u}, xql = {0u, 0u};
#pragma unroll
        for (int i = 0; i < 16; ++i) { const float xv = (i & 1) ? x[i >> 1].y : x[i >> 1].x;
            float qf = __builtin_fminf(__builtin_fmaxf(xv * 16.f, -120.f), 119.f) + 12582912.0f; asm volatile("" : "+v"(qf)); const unsigned q = __builtin_bit_cast(unsigned, qf);
            const unsigned lo = q & 15u, hi = ((q + 8u) >> 4) & 15u;
            if (i < 8) { xql.x |= lo << (4 * i); xqh.x |= hi << (4 * i); } else { xql.y |= lo << (4 * (i - 8)); xqh.y |= hi << (4 * (i - 8)); } }
#define PEER_LOADB(buf, b) do { const int b_ = (b); if (b_ < 32) peer_load8((b_ & 16) ? TV : TU, (b_ & 8) ? id1 : id0, 8 * (b_ & 7), lane, buf); else peer_load8(TU, nid0, 8 * (b_ & 7), lane, buf); } while (0)
#define PEER_DOTB(buf, b) do { const int b_ = (b); const float r_ = peer_dot8(buf, xqh, xql, lane); const bool mine_ = (lane >> 3) == (b_ & 7); if (b_ & 8) act1 = mine_ ? r_ : act1; else act0 = mine_ ? r_ : act0; } while (0)
#define PEER_FMAB(buf, b) do { const int b_ = (b); peer_fma8(buf, (b_ & 8) ? w1h : w0h, 8 * (b_ & 7), o); } while (0)
        float act0 = 0.f, act1 = 0.f;
#pragma unroll 1
        for (int j = 0; j < 16; j += 4) {
            PEER_LOADB(B3, j + 3); PEER_DOTB(B0, j);
            PEER_LOADB(B0, j + 4); PEER_DOTB(B1, j + 1);
            PEER_LOADB(B1, j + 5); PEER_DOTB(B2, j + 2);
            PEER_LOADB(B2, j + 6); PEER_DOTB(B3, j + 3);
        }
        const float w0 = g0 * gelu_tanh(act0 * (1.0f / (16.f * PEER_SU))) * (1.0f / PEER_SV), w1 = g1 * gelu_tanh(act1 * (1.0f / (16.f * PEER_SU))) * (1.0f / PEER_SV);
        unsigned w0h, w1h; { const _Float16 a = (_Float16)w0, b = (_Float16)w1; const h16x2 pa = {a, a}, pb = {b, b}; w0h = __builtin_bit_cast(unsigned, pa); w1h = __builtin_bit_cast(unsigned, pb); }
        h16x2 o[8];
#pragma unroll
        for (int i = 0; i < 8; ++i) o[i] = (h16x2){(_Float16)0.f, (_Float16)0.f};
#pragma unroll 1
        for (int j = 16; j < 32; j += 4) {
            PEER_LOADB(B3, j + 3); PEER_FMAB(B0, j);
            PEER_LOADB(B0, j + 4); PEER_FMAB(B1, j + 1);
            PEER_LOADB(B1, j + 5); PEER_FMAB(B2, j + 2);
            PEER_LOADB(B2, j + 6); PEER_FMAB(B3, j + 3);
        }
#undef PEER_LOADB
#undef PEER_DOTB
#undef PEER_FMAB
        id0 = nid0; id1 = nid1;
        tabcvt_finish(TC, lane, cvA); tabcvt_finish(TC, lane, cvB);
        tabcvt_issue(TC, lane, cvA); tabcvt_issue(TC, lane, cvB);
        float y[16]; float sm = 0.f;
#pragma unroll
        for (int i = 0; i < 8; ++i) { y[2 * i] = pg8::ALPHA_F * x[i].x + (float)o[i].x; y[2 * i + 1] = pg8::ALPHA_F * x[i].y + (float)o[i].y; sm += y[2 * i] + y[2 * i + 1]; }
        const float mean = wave_sum_dpp(sm) * (1.f / DM); float q = 0.f;
#pragma unroll
        for (int i = 0; i < 16; ++i) { y[i] -= mean; q += y[i] * y[i]; }
        const float rstd = 1.0f / sqrtf(wave_sum_dpp(q) * (1.f / DM) + LN_EPS);
#pragma unroll
        for (int c = 0; c < 4; ++c) { const f32x4 gv = *(const GAS f32x4*)(g + 16 * lane + 4 * c), bv = *(const GAS f32x4*)(bb + 16 * lane + 4 * c);
            y[4 * c] = y[4 * c] * rstd * gv.x + bv.x; y[4 * c + 1] = y[4 * c + 1] * rstd * gv.y + bv.y; y[4 * c + 2] = y[4 * c + 2] * rstd * gv.z + bv.z; y[4 * c + 3] = y[4 * c + 3] * rstd * gv.w + bv.w; }
        v4u oa, ob; oa.x = pk2(y[0], y[1]); oa.y = pk2(y[2], y[3]); oa.z = pk2(y[4], y[5]); oa.w = pk2(y[6], y[7]); ob.x = pk2(y[8], y[9]); ob.y = pk2(y[10], y[11]); ob.z = pk2(y[12], y[13]); ob.w = pk2(y[14], y[15]);
        *(GAS v4u*)(H2 + (size_t)t * DM + 16 * lane) = oa; *(GAS v4u*)(H2 + (size_t)t * DM + 16 * lane + 8) = ob;
        *(GAS v4u*)((unsigned char*)(F.ws + WS_H28) + (size_t)t * DM + 16 * lane) = (v4u){pk4_fp8(y[0], y[1], y[2], y[3]), pk4_fp8(y[4], y[5], y[6], y[7]), pk4_fp8(y[8], y[9], y[10], y[11]), pk4_fp8(y[12], y[13], y[14], y[15])};
    }
    tabcvt_finish(TC, lane, cvA); tabcvt_finish(TC, lane, cvB);
    while (TC.cf < TC.n) { tabcvt_issue(TC, lane, cvA); tabcvt_finish(TC, lane, cvA); }
}

template <class Epi> __device__ __forceinline__ void run_gemm(Frame& F, const bf16* A, const bf16* Bt, int M, int N, int K, const Epi& E, int pw = 0) {
    pg8::Gemm g{A, Bt, M, N, K}; pg8::StaticOrder S; S.init(M, N, F.G, pw ? F.vcu : F.bx); S.pw = pw; if (pw) S.nwg = 1024;
    int t = F.tid; asm volatile("" : "+v"(t));
    pg8::gemm_phase<Epi, pg8::StaticOrder, true, true>(F.lds, g, S, E, t);
}

template <class Epi> __device__ __forceinline__ void run_gemm8(Frame& F, const unsigned char* A8, const unsigned char* Bt8, int M, int N, int Kbytes, const Epi& E) {
    pg8::Gemm g{(const bf16*)A8, (const bf16*)Bt8, M, N, Kbytes / 2 + F.z  }; pg8::StaticOrder S; S.init(M, N, F.G, F.bx);
    int t = F.tid; asm volatile("" : "+v"(t));
    pg8::gemm_phase<Epi, pg8::StaticOrder, true, true, true>(F.lds, g, S, E, t);
}

__global__ void __launch_bounds__(NWAVES * 64, 2) mega_fwd(Args args) {
    extern __shared__ __attribute__((aligned(16))) unsigned char lds[];
    Frame F;
    F.lds = (LAS unsigned char*)lds;
    F.tid = threadIdx.x; F.lane = F.tid & 63; F.wave = 0; F.G = gridDim.x; F.bx = blockIdx.x; F.vcu = 0;
    F.A = &args; F.z = 0; F.out = args.out; F.ws = args.ws;
    const int wave_s = __builtin_amdgcn_readfirstlane((int)threadIdx.x >> 6);
    volatile LAS unsigned* MISC = (volatile LAS unsigned*)(F.lds + MISC_OFF);
    if (F.tid < 64) MISC[F.tid] = 0u;
    __syncthreads();
    XcdBarrier bar; bar.bar = (unsigned*)(F.ws + WS_CTL) + CW_BAR; bar.x = 0; bar.st = nullptr;
    if (args.use_bar) bar = xcd_barrier_post((unsigned*)(F.ws + WS_CTL) + CW_BAR, MISC + 8);

    for (int pc = args.ph_lo; pc < args.ph_hi; ++pc) {
        { int z = 0; asm volatile("" : "+s"(z)); int t = wave_s * 64 + (int)__builtin_amdgcn_mbcnt_hi(~0u, __builtin_amdgcn_mbcnt_lo(~0u, (unsigned)z)); asm volatile("" : "+v"(t));
          F.z = z; F.ws = args.ws + z; F.tid = t; F.lane = t & 63; F.wave = __builtin_amdgcn_readfirstlane(t >> 6);
          F.G = (int)gridDim.x + z; F.bx = (int)blockIdx.x + z; F.vcu = (F.G % 8 == 0) ? (F.bx % 8) * (F.G / 8) + F.bx / 8 : F.bx; }
        bf16* const H = (bf16*)(F.ws + WS_H); bf16* const U = (bf16*)(F.ws + WS_U); bf16* const Y = (bf16*)(F.ws + WS_Y); bf16* const X1 = (bf16*)(F.ws + WS_X1);
        bf16* const H1 = (bf16*)(F.ws + WS_H1); bf16* const H2 = (bf16*)(F.ws + WS_H2); bf16* const KB = (bf16*)(F.ws + WS_KB); bf16* const VT = (bf16*)(F.ws + WS_VT); bf16* const HKV = (bf16*)(F.ws + WS_HKV);
        const int ty = args.ph_type[pc], la = args.ph_arg[pc];
#ifndef PHMASK
#define PHMASK 0xFFFF
#endif
#define EN(x) ((PHMASK >> (x)) & 1)
        switch (ty) {
        case P_PROLOGUE: if (EN(P_PROLOGUE)) p0_prologue(F); break;
        case P_STORE: if (EN(P_STORE)) {
            const int njobs = (la == 0) ? 2 : (la == 2) ? 3 : 1;
            for (int j = 0; j < njobs; ++j) {
                const bf16* A; const bf16* Bt; int M = TOK, N = 1024, K = 1024, ldc = 1024, pw = 0; bf16* O; float sc = 1.0f;
                if (la == 0 && j == 0) { A = (const bf16*)(F.ws + WS_PB); Bt = (const bf16*)(F.ws + WS_W_PW); K = 256; O = (bf16*)(F.ws + WS_PW); pw = 1; }
                else if (la == 0) { A = H; Bt = (const bf16*)(F.ws + WS_W_IN); O = U; }
                else if (la == 1) { A = H; Bt = (const bf16*)(F.ws + WS_W_IN) + (size_t)1024 * 1024; O = U; }
                else if (la == 2 && j == 1) { A = HKV; Bt = (const bf16*)(F.ws + WS_W_KV); O = KB; }
                else if (la == 2 && j == 2) { A = (const bf16*)(F.ws + WS_W_KV) + (size_t)1024 * 1024; Bt = HKV; M = 1024; N = TOK; ldc = TOK; O = VT; }
                else { A = H; Bt = (const bf16*)(F.ws + WS_W_SQ) + (size_t)(la - 2) * 1024 * 1024; O = U; sc = 0.125f * 1.4426950408889634f; }
                if (!pw) {
                    const unsigned char* A8; const unsigned char* B8;
                    if (la <= 1) { A8 = (const unsigned char*)(F.ws + WS_H8); B8 = (const unsigned char*)(F.ws + W8_IN) + (size_t)la * 1024 * 1024; }
                    else if (la == 2 && j == 1) { A8 = (const unsigned char*)(F.ws + WS_HKV); B8 = (const unsigned char*)(F.ws + W8_KV); }
                    else if (la == 2 && j == 2) { A8 = (const unsigned char*)(F.ws + W8_KV) + (size_t)1024 * 1024; B8 = (const unsigned char*)(F.ws + WS_HKV); }
                    else { A8 = (const unsigned char*)(F.ws + WS_H8); B8 = (const unsigned char*)(F.ws + W8_SQ) + (size_t)(la - 2) * 1024 * 1024; }
                    const int f8o = (la >= 2) ? 1 : 0;
                    pg8::EpiStore E{O, ldc, (f8o ? 1.0f : sc) * (1.0f / W8_SCALE), -1, f8o};
                    run_gemm8(F, A8, B8, M, N, 1024, E);
                } else {
                    pg8::EpiStore E{O, ldc, sc, pw ? 3 : -1, pw ? 1 : 0};
                    run_gemm(F, A, Bt, M, N, K, E, pw);
                }
            }
        } break;
        case P_SSM: if (EN(P_SSM)) ssm_phase(F, la); break;
        case P_GLU: if (EN(P_GLU)) { pg8::EpiGlu E{H, X1}; run_gemm8(F, (const unsigned char*)Y, (const unsigned char*)(F.ws + W8_GLU) + (size_t)la * 2048 * 1024, TOK, 2048, 1024, E); } break;
        case P_LNMIX: if (EN(P_LNMIX)) ln_rows(F, X1, F.A->in[2 + F.z] + la * 1024, F.A->in[3 + F.z] + la * 1024, H1, (unsigned char*)(F.ws + WS_H18)); break;
        case P_TOPK: if (EN(P_TOPK)) {
            pg8::EpiTopk E{(int*)(F.ws + WS_IDX), (float*)(F.ws + WS_GATE)};
            pg8::Gemm g{(const bf16*)(F.ws + WS_H18), (const bf16*)((const unsigned char*)(F.ws + W8_EFF) + (size_t)la * 2048 * 1024), TOK, 2048, 512 + F.z};
            for (int r = 0; r < 2; ++r) { pg8::OneUnitOrder S; S.base.init(TOK, 2048, F.G, F.bx); S.round = r;
                int t = F.tid; asm volatile("" : "+v"(t)); pg8::gemm_phase<pg8::EpiTopk, pg8::OneUnitOrder, false, true, true>(F.lds, g, S, E, t); }
        } break;
        case P_PEER: if (EN(P_PEER)) peer_phase(F, la); break;
        case P_PLE: if (EN(P_PLE)) { pg8::EpiPle E{H2, (const unsigned char*)(F.ws + WS_PW) + (size_t)la * TOK * 1024, H, (la == DEPTH - 1) ? F.out : nullptr, (unsigned char*)(F.ws + WS_H8)};
            run_gemm8(F, (const unsigned char*)(F.ws + WS_H28), (const unsigned char*)(F.ws + W8_PG) + (size_t)la * 1024 * 1024, TOK, 1024, 1024, E); } break;
        case P_LNKV: if (EN(P_LNKV)) ln_rows(F, H, F.A->in[16 + F.z], F.A->in[17 + F.z], nullptr, (unsigned char*)HKV); break;
        case P_ATTN: if (EN(P_ATTN)) attn_phase(F); break;
        case P_RES: if (EN(P_RES)) { pg8::EpiRes E{H, X1}; run_gemm8(F, (const unsigned char*)Y, (const unsigned char*)(F.ws + W8_SO) + (size_t)(la - 2) * 1024 * 1024, TOK, 1024, 1024, E); } break;
        default: break;
        }
        if (pc + 1 < args.ph_hi) xcd_barrier(bar);
    }
}

#ifndef N_LAUNCH_MODE
#define N_LAUNCH_MODE 1
#endif
extern "C" void kernel_launch(void* const* d_in, const int* in_sizes, int n_in, void* d_out, int out_size, void* d_ws, size_t ws_size, hipStream_t stream) {
    static int grid = 0;
    if (grid == 0) {
        if (n_in != 28 || out_size != TOK * DM || ws_size < WS_END) { fprintf(stderr, "kernel_launch: unexpected shapes/workspace (n_in %d, out %d, ws %zu)\n", n_in, out_size, ws_size); grid = -1; return; }
        int dev = 0, cus = 0;
        if (hipGetDevice(&dev) != hipSuccess || hipDeviceGetAttribute(&cus, hipDeviceAttributeMultiprocessorCount, dev) != hipSuccess) { grid = -1; return; }
        if (hipFuncSetAttribute((const void*)mega_fwd, hipFuncAttributeMaxDynamicSharedMemorySize, LDS_BYTES) != hipSuccess) { fprintf(stderr, "kernel_launch: hipFuncSetAttribute failed\n"); grid = -1; return; }
        (void)hipGetLastError();
        grid = cus;
    }
    if (grid < 0) return;
    hipMemsetAsync((char*)d_ws + WS_CTL, 0, CTL_ZERO_BYTES, stream);
    Args a{};
    for (int i = 0; i < 28; ++i) a.in[i] = (const float*)d_in[i];
    a.out = (float*)d_out; a.ws = (unsigned char*)d_ws;
    int n = 0;
#ifndef REP_TYPE
#define REP_TYPE -1
#endif
    auto add = [&](int t, int l) { for (int r = 0; r < ((t == REP_TYPE) ? 2 : 1); ++r) { a.ph_type[n] = (unsigned char)t; a.ph_arg[n] = (unsigned char)l; ++n; } };
    add(P_PROLOGUE, 0); add(P_STORE, 0);
    for (int l = 0; l < DEPTH; ++l) {
        if (l < 2) { if (l == 1) add(P_STORE, 1); add(P_SSM, l); add(P_GLU, l); }
        else { if (l == 2) add(P_LNKV, 0); add(P_STORE, l); add(P_ATTN, l); add(P_RES, l); }
        add(P_LNMIX, l); add(P_TOPK, l); add(P_PEER, l); add(P_PLE, l);
    }
    a.nph = n;
    if (N_LAUNCH_MODE == 1) {
        a.ph_lo = 0; a.ph_hi = n; a.use_bar = 1;
        hipLaunchKernelGGL(mega_fwd, dim3(grid), dim3(NWAVES * 64), LDS_BYTES, stream, a);
    } else {
        a.use_bar = 0;
        for (int i = 0; i < n; ++i) { a.ph_lo = i; a.ph_hi = i + 1; hipLaunchKernelGGL(mega_fwd, dim3(grid), dim3(NWAVES * 64), LDS_BYTES, stream, a); }
    }
}
```

```cpp
#include <hip/hip_runtime.h>
#include <cstdio>
#include <cstdint>
#include <cmath>
namespace pg8 {
#define PG8_LAS __attribute__((address_space(3)))
typedef unsigned short bf16_t;
typedef short bf16x8 __attribute__((ext_vector_type(8)));
typedef float f32x4 __attribute__((ext_vector_type(4)));
typedef unsigned u32x4 __attribute__((ext_vector_type(4)));
constexpr int BM = 256, BK = 64, HALF = 128, HTB = HALF * BK * 2  , STAGE_BYTES = 8 * HTB, NXCD = 8, WGM = 8;

__host__ __device__ __forceinline__ int lds_byte(int r, int c) { const int st = (r >> 4) * 2 + (c >> 5), rr = r & 15, cc = c & 31, ob = rr * 64 + cc * 2; return st * 1024 + (ob ^ (((ob >> 9) & 1) << 5)); }
__host__ __device__ __forceinline__ void stage_rc(int b, int& R, int& C) { const int st = b / 1024, sb = b % 1024, swz = sb ^ (((sb >> 9) & 1) << 5); R = (st >> 1) * 16 + swz / 64; C = (st & 1) * 32 + (swz % 64) / 2; }
__host__ __device__ __forceinline__ int perm32(int rho) { const int n = rho >> 4, i = rho & 15; return 8 * (i >> 2) + 4 * n + (i & 3); }

struct Unit { int pm, pn; };
struct Gemm { const bf16_t* A; const bf16_t* Bt; int M, N, K; };

struct StaticOrder {
    int nM, nN, nwg, G, c;
    __host__ __device__ void init(int M, int N, int G_, int c_) { nM = M / BM; nN = N / BM; nwg = nM * nN; G = G_; c = c_; pw = 0; }
    int pw;
    __host__ __device__ bool next(int i, Unit& u) const {
        const long L = (long)i * G + c; if (L >= nwg) return false;
        if (pw) { const int l = (int)L >> 8, rem = (int)L & 255; u.pm = l * 64 + (rem >> 2); u.pn = l * 4 + (rem & 3); return true; }
        int wgid = (int)L; { const int q = nwg / NXCD, r = nwg % NXCD, xcd = wgid % NXCD, off = wgid / NXCD; wgid = (xcd < r ? xcd * (q + 1) : r * (q + 1) + (xcd - r) * q) + off; }
        const int nig = WGM * nN, gid = wgid / nig, fm = gid * WGM, gsz = (nM - fm) < WGM ? (nM - fm) : WGM;
        u.pm = fm + ((wgid % nig) % gsz); u.pn = (wgid % nig) / gsz; return true;
    }
    __device__ __forceinline__ void a_ready(const Unit&) const {}
    __device__ __forceinline__ void done(const Unit&) const {}
};

typedef float f32x2c_t __attribute__((ext_vector_type(2))); typedef __bf16 bf16x2c_t __attribute__((ext_vector_type(2)));
__device__ __forceinline__ unsigned cvt_pk_bf16(float lo, float hi) { f32x2c_t v = {lo, hi}; bf16x2c_t b = __builtin_convertvector(v, bf16x2c_t); return __builtin_bit_cast(unsigned, b); }
typedef float f32x2 __attribute__((ext_vector_type(2)));
typedef int v8i32_t __attribute__((ext_vector_type(8)));
typedef unsigned u32x8_t __attribute__((ext_vector_type(8)));
template <bool F8> struct Frag { bf16x8 k[2]; };
template <> struct Frag<true> { v8i32_t v; };
template <class Epi, class Sched, bool ALIGN_EPI = false, bool SP2 = false, bool F8 = false>
__device__ __forceinline__ void gemm_phase(PG8_LAS unsigned char* lds, const Gemm g, const Sched& S, const Epi& E, const int tid) {
    const int wid = __builtin_amdgcn_readfirstlane(tid >> 6), lane = tid & 63, wr = wid >> 2, wc = wid & 3, fr = lane & 15, fq = lane >> 4;
    const int K = g.K, nt = K / BK;
    unsigned voffA[1], voffB[1];
    { int R, C; stage_rc(tid * 16, R, C); const int Rb = Epi::PERM ? ((R & ~31) + perm32(R & 31)) : R;
        voffA[0] = (unsigned)(R * K + C) * 2u; voffB[0] = (unsigned)(Rb * K + C) * 2u; }
    const size_t r64 = (size_t)128 * K;
    const size_t kstep = (size_t)(BK * 2);
    const size_t hstep = (size_t)HALF * K * 2;
    const size_t tstep = 2 * hstep;
    const unsigned ldsw = (unsigned)wid * 1024u;
    const int aoff = lds_byte(wr * 64 + fr, F8 ? fq * 16 : fq * 8), boff = lds_byte(wc * 32 + fr, F8 ? fq * 16 : fq * 8);
#define PG8_SA(b, h) (((b) * 2 + (h)) * HTB)
#define PG8_SB(b, h) ((4 + (b) * 2 + (h)) * HTB)
#define PG8_STAGE(bufoff, gbase, voff) do { _Pragma("unroll") for (int _i = 0; _i < 2; ++_i) \
        __builtin_amdgcn_global_load_lds((const unsigned*)((const char*)(gbase) + _i * r64 + (voff)[0]), (PG8_LAS unsigned*)(lds + (bufoff) + ldsw + _i * 8192), 16, 0, 0); } while (0)
#define PG8_LDF(d, addr) do { if constexpr (F8) { const u32x4 lo_ = *(const PG8_LAS u32x4*)(addr), hi_ = *(const PG8_LAS u32x4*)((addr) + 16); d.v = __builtin_bit_cast(v8i32_t, (u32x8_t){lo_[0], lo_[1], lo_[2], lo_[3], hi_[0], hi_[1], hi_[2], hi_[3]}); } \
        else { d.k[0] = *(const PG8_LAS bf16x8*)(addr); d.k[1] = *(const PG8_LAS bf16x8*)((addr) + 1024); } } while (0)
#define PG8_LDA(dst, b, h) do { _Pragma("unroll") for (int m = 0; m < 4; ++m) PG8_LDF(dst[m], lds + PG8_SA(b, h) + aoff + m * 2048); } while (0)
#define PG8_LDB(dst, b, h) do { _Pragma("unroll") for (int n = 0; n < 2; ++n) PG8_LDF(dst[n], lds + PG8_SB(b, h) + boff + n * 2048); } while (0)
#define PG8_MMA(ai, bj, At, Bt) do { __builtin_amdgcn_s_setprio(1); _Pragma("unroll") for (int m = 0; m < 4; ++m) _Pragma("unroll") for (int n = 0; n < 2; ++n) { \
        if constexpr (F8) asm volatile("v_mfma_f32_16x16x128_f8f6f4 %0, %1, %2, %0" : "+v"(acc[ai][bj][m][n]) : "v"(Bt[n].v), "v"(At[m].v));   \
        else { _Pragma("unroll") for (int k = 0; k < 2; ++k) acc[ai][bj][m][n] = __builtin_amdgcn_mfma_f32_16x16x32_bf16(Bt[n].k[k], At[m].k[k], acc[ai][bj][m][n], 0, 0, 0); } } __builtin_amdgcn_s_setprio(0); } while (0)
#define PG8_WAIT_V(n) asm volatile("s_waitcnt vmcnt(" #n ")" ::: "memory")
#define PG8_WAIT_L(n) asm volatile("s_waitcnt lgkmcnt(" #n ")" ::: "memory")
#define PG8_BAR __builtin_amdgcn_s_barrier()
#define PG8_SCHED __builtin_amdgcn_sched_barrier(0)
    Unit cur, nxt; int ui = 0;
    if (!S.next(0, cur)) return;
    f32x4 acc[2][2][4][2];
#pragma unroll
    for (int a = 0; a < 2; ++a)
#pragma unroll
        for (int b = 0; b < 2; ++b)
#pragma unroll
            for (int m = 0; m < 4; ++m)
#pragma unroll
                for (int n = 0; n < 2; ++n) acc[a][b][m][n] = (f32x4){0.f, 0.f, 0.f, 0.f};
    Frag<F8> At[4], B0[2], B1[2];
    const char* cA = (const char*)g.A + (size_t)cur.pm * tstep; const char* cB = (const char*)g.Bt + (size_t)cur.pn * tstep;
    S.a_ready(cur);
    if constexpr (SP2) {
        PG8_STAGE(PG8_SB(0, 0), cB, voffB); PG8_STAGE(PG8_SB(0, 1), cB + hstep, voffB); PG8_STAGE(PG8_SA(0, 0), cA, voffA); PG8_STAGE(PG8_SA(0, 1), cA + hstep, voffA);
        if (wr == 1) PG8_BAR;
        PG8_WAIT_V(2); PG8_BAR;
        PG8_STAGE(PG8_SB(1, 0), cB + kstep, voffB); PG8_STAGE(PG8_SA(1, 0), cA + kstep, voffA); PG8_STAGE(PG8_SB(1, 1), cB + hstep + kstep, voffB);
        PG8_WAIT_V(6); PG8_BAR;
    } else {
        PG8_STAGE(PG8_SB(0, 0), cB, voffB); PG8_STAGE(PG8_SA(0, 0), cA, voffA); PG8_STAGE(PG8_SB(0, 1), cB + hstep, voffB); PG8_STAGE(PG8_SA(0, 1), cA + hstep, voffA);
        if (wr == 1) PG8_BAR;
        PG8_WAIT_V(4); PG8_BAR;
        PG8_STAGE(PG8_SB(1, 0), cB + kstep, voffB); PG8_STAGE(PG8_SA(1, 0), cA + kstep, voffA); PG8_STAGE(PG8_SB(1, 1), cB + hstep + kstep, voffB);
        PG8_WAIT_V(6); PG8_BAR;
    }
    for (;;) {
        const bool has_next = S.next(ui + 1, nxt);
        const char* nA = has_next ? (const char*)g.A + (size_t)nxt.pm * tstep : cA; const char* nB = has_next ? (const char*)g.Bt + (size_t)nxt.pn * tstep : cB;
#pragma unroll 1
        for (int t = 0; t < nt; t += 2) {
            const bool last = (t == nt - 2);
            const char* a1 = cA + (size_t)(t + 1) * kstep;
            const char* a2 = last ? nA : cA + (size_t)(t + 2) * kstep; const char* b2 = last ? nB : cB + (size_t)(t + 2) * kstep;
            const char* a3 = a2 + kstep; const char* b3 = b2 + kstep;
            if (last && has_next) S.a_ready(nxt);
            if constexpr (SP2) {
            PG8_LDB(B0, 0, 0); PG8_LDB(B1, 0, 1); PG8_SCHED; PG8_LDA(At, 0, 0); PG8_STAGE(PG8_SA(1, 1), a1 + hstep, voffA);
            PG8_WAIT_V(8); PG8_WAIT_L(0); PG8_BAR; PG8_MMA(0, 0, At, B0); PG8_MMA(0, 1, At, B1); PG8_BAR; PG8_SCHED;
            PG8_LDA(At, 0, 1); PG8_STAGE(PG8_SB(0, 0), b2, voffB); PG8_STAGE(PG8_SB(0, 1), b2 + hstep, voffB); PG8_STAGE(PG8_SA(0, 0), a2, voffA);
            PG8_WAIT_V(8); PG8_WAIT_L(0); PG8_BAR; PG8_MMA(1, 0, At, B0); PG8_MMA(1, 1, At, B1); PG8_BAR; PG8_SCHED;
            PG8_LDB(B0, 1, 0); PG8_LDB(B1, 1, 1); PG8_SCHED; PG8_LDA(At, 1, 0); PG8_STAGE(PG8_SA(0, 1), a2 + hstep, voffA);
            PG8_WAIT_V(8); PG8_WAIT_L(0); PG8_BAR; PG8_MMA(0, 0, At, B0); PG8_MMA(0, 1, At, B1); PG8_BAR; PG8_SCHED;
            PG8_LDA(At, 1, 1); PG8_STAGE(PG8_SB(1, 0), b3, voffB); PG8_STAGE(PG8_SB(1, 1), b3 + hstep, voffB); PG8_STAGE(PG8_SA(1, 0), a3, voffA);
            PG8_WAIT_V(8); PG8_WAIT_L(0); PG8_BAR; PG8_MMA(1, 0, At, B0); PG8_MMA(1, 1, At, B1); PG8_BAR; PG8_SCHED;
            } else {
            PG8_LDB(B0, 0, 0); PG8_SCHED; PG8_LDA(At, 0, 0); PG8_STAGE(PG8_SA(1, 1), a1 + hstep, voffA);
            PG8_WAIT_L(8); PG8_BAR; PG8_WAIT_L(0); PG8_MMA(0, 0, At, B0); PG8_BAR; PG8_SCHED;
            PG8_LDB(B1, 0, 1); PG8_STAGE(PG8_SB(0, 0), b2, voffB);
            PG8_BAR; PG8_WAIT_L(0); PG8_MMA(0, 1, At, B1); PG8_BAR;
            PG8_LDA(At, 0, 1); PG8_STAGE(PG8_SA(0, 0), a2, voffA);
            PG8_BAR; PG8_WAIT_L(0); PG8_MMA(1, 0, At, B0); PG8_BAR; PG8_SCHED;
            PG8_STAGE(PG8_SB(0, 1), b2 + hstep, voffB);
            PG8_WAIT_V(6); PG8_BAR; PG8_MMA(1, 1, At, B1); PG8_BAR;
            PG8_LDB(B0, 1, 0); PG8_SCHED; PG8_LDA(At, 1, 0); PG8_STAGE(PG8_SA(0, 1), a2 + hstep, voffA);
            PG8_WAIT_L(8); PG8_BAR; PG8_WAIT_L(0); PG8_MMA(0, 0, At, B0); PG8_BAR; PG8_SCHED;
            PG8_LDB(B1, 1, 1); PG8_STAGE(PG8_SB(1, 0), b3, voffB);
            PG8_BAR; PG8_WAIT_L(0); PG8_MMA(0, 1, At, B1); PG8_BAR;
            PG8_LDA(At, 1, 1); PG8_STAGE(PG8_SA(1, 0), a3, voffA);
            PG8_BAR; PG8_WAIT_L(0); PG8_MMA(1, 0, At, B0); PG8_BAR; PG8_SCHED;
            PG8_STAGE(PG8_SB(1, 1), b3 + hstep, voffB);
            PG8_WAIT_V(6); PG8_BAR; PG8_MMA(1, 1, At, B1); PG8_BAR;
            }
        }
        if constexpr (F8) asm volatile("s_nop 15\n\ts_nop 15" ::: "memory");
        if constexpr (ALIGN_EPI) { if (wr == 0) PG8_BAR; }
        if constexpr (!Epi::AFTER_DRAIN) { E(acc, cur, wr, wc, fr, fq); S.done(cur); }
        if (!has_next) break;
#pragma unroll
        for (int a = 0; a < 2; ++a)
#pragma unroll
            for (int b = 0; b < 2; ++b)
#pragma unroll
                for (int m = 0; m < 4; ++m)
#pragma unroll
                    for (int n = 0; n < 2; ++n) acc[a][b][m][n] = (f32x4){0.f, 0.f, 0.f, 0.f};
        cur = nxt; cA = nA; cB = nB; ++ui;
        if constexpr (ALIGN_EPI) { if (wr == 1) PG8_BAR; }
    }
    PG8_WAIT_V(0);
    if constexpr (!ALIGN_EPI) { if (wr == 0) PG8_BAR; }
    PG8_BAR;
    if constexpr (Epi::AFTER_DRAIN) { E.fused(acc, cur, wr, wc, fr, fq, lds, wid, lane); S.done(cur); }
#undef PG8_SA
#undef PG8_SB
#undef PG8_STAGE
#undef PG8_LDA
#undef PG8_LDB
#undef PG8_MMA
#undef PG8_LDF
#undef PG8_WAIT_V
#undef PG8_WAIT_L
#undef PG8_BAR
#undef PG8_SCHED
}
}
namespace pg8 {
__device__ __forceinline__ float bf_lo(unsigned w) { return __uint_as_float(w << 16); }
__device__ __forceinline__ float bf_hi(unsigned w) { return __uint_as_float(w & 0xffff0000u); }
__device__ __forceinline__ float fast_sigmoid(float x) { return __builtin_amdgcn_rcpf(1.0f + __builtin_amdgcn_exp2f(-1.4426950408889634f * x)); }
__device__ __forceinline__ float gelu_tanh(float x) { const float t = x * (1.5957691216057308f + 0.07135481627260025f * x * x); return x * __builtin_amdgcn_rcpf(1.0f + __builtin_amdgcn_exp2f(-1.4426950408889634f * t)); }
constexpr float ALPHA_F = 1.681792830507429f;
constexpr float WSC = 1.0f / 32.0f;

struct EpiStore {
    static constexpr bool PERM = true, AFTER_DRAIN = false;
    bf16_t* O; int ldc; float scale; int pnmask; int f8out;
    __device__ __forceinline__ void operator()(const f32x4 (&acc)[2][2][4][2], const Unit& u, int wr, int wc, int fr, int fq) const {
        const int row0 = u.pm * BM + wr * 64 + fr, col0 = (u.pn & pnmask) * BM + wc * 32 + 8 * fq;
#pragma unroll
        for (int ai = 0; ai < 2; ++ai)
#pragma unroll
            for (int m = 0; m < 4; ++m) { bf16_t* rowp = O + (size_t)(row0 + ai * HALF + m * 16) * ldc + col0;
#pragma unroll
                for (int bj = 0; bj < 2; ++bj) { const f32x4 v0 = acc[ai][bj][m][0] * scale, v1 = acc[ai][bj][m][1] * scale;
                    if (f8out) {
                        int w0 = 0, w1 = 0; w0 = __builtin_amdgcn_cvt_pk_fp8_f32(v0[0], v0[1], w0, false); w0 = __builtin_amdgcn_cvt_pk_fp8_f32(v0[2], v0[3], w0, true);
                        w1 = __builtin_amdgcn_cvt_pk_fp8_f32(v1[0], v1[1], w1, false); w1 = __builtin_amdgcn_cvt_pk_fp8_f32(v1[2], v1[3], w1, true);
                        *(unsigned long long*)((unsigned char*)O + (size_t)(row0 + ai * HALF + m * 16) * ldc + col0 + bj * HALF) = (unsigned long long)(unsigned)w0 | ((unsigned long long)(unsigned)w1 << 32);
                    } else {
                    u32x4 w; w.x = cvt_pk_bf16(v0[0], v0[1]); w.y = cvt_pk_bf16(v0[2], v0[3]); w.z = cvt_pk_bf16(v1[0], v1[1]); w.w = cvt_pk_bf16(v1[2], v1[3]);
                    *(u32x4*)(rowp + bj * HALF) = w; } } }
    }
};
struct EpiGlu {
    static constexpr bool PERM = true, AFTER_DRAIN = false;
    const bf16_t* Hin; bf16_t* X1;
    __device__ __forceinline__ void operator()(const f32x4 (&acc)[2][2][4][2], const Unit& u, int wr, int wc, int fr, int fq) const {
        const int row0 = u.pm * BM + wr * 64 + fr, col0 = u.pn * HALF + wc * 32 + 8 * fq;
        u32x4 hvv[2][4];
#pragma unroll
        for (int ai = 0; ai < 2; ++ai)
#pragma unroll
            for (int m = 0; m < 4; ++m) hvv[ai][m] = *(const u32x4*)(Hin + (size_t)(row0 + ai * HALF + m * 16) * 1024 + col0);
#pragma unroll
        for (int ai = 0; ai < 2; ++ai)
#pragma unroll
            for (int m = 0; m < 4; ++m) { const size_t off = (size_t)(row0 + ai * HALF + m * 16) * 1024 + col0;
                const u32x4 hv = hvv[ai][m];
                const f32x4 v0 = acc[ai][0][m][0] * WSC, v1 = acc[ai][0][m][1] * WSC, g0 = acc[ai][1][m][0] * WSC, g1 = acc[ai][1][m][1] * WSC;
                float o[8];
                o[0] = ALPHA_F * bf_lo(hv.x) + v0[0] * fast_sigmoid(g0[0]); o[1] = ALPHA_F * bf_hi(hv.x) + v0[1] * fast_sigmoid(g0[1]);
                o[2] = ALPHA_F * bf_lo(hv.y) + v0[2] * fast_sigmoid(g0[2]); o[3] = ALPHA_F * bf_hi(hv.y) + v0[3] * fast_sigmoid(g0[3]);
                o[4] = ALPHA_F * bf_lo(hv.z) + v1[0] * fast_sigmoid(g1[0]); o[5] = ALPHA_F * bf_hi(hv.z) + v1[1] * fast_sigmoid(g1[1]);
                o[6] = ALPHA_F * bf_lo(hv.w) + v1[2] * fast_sigmoid(g1[2]); o[7] = ALPHA_F * bf_hi(hv.w) + v1[3] * fast_sigmoid(g1[3]);
                u32x4 w; w.x = cvt_pk_bf16(o[0], o[1]); w.y = cvt_pk_bf16(o[2], o[3]); w.z = cvt_pk_bf16(o[4], o[5]); w.w = cvt_pk_bf16(o[6], o[7]);
                *(u32x4*)(X1 + off) = w; }
    }
};
struct EpiRes {
    static constexpr bool PERM = true, AFTER_DRAIN = false;
    const bf16_t* Hin; bf16_t* X1;
    __device__ __forceinline__ void operator()(const f32x4 (&acc)[2][2][4][2], const Unit& u, int wr, int wc, int fr, int fq) const {
        const int row0 = u.pm * BM + wr * 64 + fr, col0 = u.pn * BM + wc * 32 + 8 * fq;
        u32x4 hvv[2][4][2];
#pragma unroll
        for (int ai = 0; ai < 2; ++ai)
#pragma unroll
            for (int m = 0; m < 4; ++m)
#pragma unroll
                for (int bj = 0; bj < 2; ++bj) hvv[ai][m][bj] = *(const u32x4*)(Hin + (size_t)(row0 + ai * HALF + m * 16) * 1024 + col0 + bj * HALF);
#pragma unroll
        for (int ai = 0; ai < 2; ++ai)
#pragma unroll
            for (int m = 0; m < 4; ++m)
#pragma unroll
                for (int bj = 0; bj < 2; ++bj) { const size_t off = (size_t)(row0 + ai * HALF + m * 16) * 1024 + col0 + bj * HALF;
                    const u32x4 hv = hvv[ai][m][bj]; const f32x4 v0 = acc[ai][bj][m][0] * WSC, v1 = acc[ai][bj][m][1] * WSC;
                    u32x4 w; w.x = cvt_pk_bf16(ALPHA_F * bf_lo(hv.x) + v0[0], ALPHA_F * bf_hi(hv.x) + v0[1]); w.y = cvt_pk_bf16(ALPHA_F * bf_lo(hv.y) + v0[2], ALPHA_F * bf_hi(hv.y) + v0[3]);
                    w.z = cvt_pk_bf16(ALPHA_F * bf_lo(hv.z) + v1[0], ALPHA_F * bf_hi(hv.z) + v1[1]); w.w = cvt_pk_bf16(ALPHA_F * bf_lo(hv.w) + v1[2], ALPHA_F * bf_hi(hv.w) + v1[3]);
                    *(u32x4*)(X1 + off) = w; }
    }
};
struct EpiPle {
    static constexpr bool PERM = true, AFTER_DRAIN = false;
    const bf16_t* H2; const unsigned char* PW; bf16_t* Hout; float* Fout; unsigned char* H8out;
    __device__ __forceinline__ void operator()(const f32x4 (&acc)[2][2][4][2], const Unit& u, int wr, int wc, int fr, int fq) const {
        const int row0 = u.pm * BM + wr * 64 + fr, col0 = u.pn * BM + wc * 32 + 8 * fq;
#pragma unroll
        for (int ai = 0; ai < 2; ++ai) {
            u32x4 hvv[4][2]; unsigned long long pvv[4][2];
#pragma unroll
            for (int m = 0; m < 4; ++m)
#pragma unroll
                for (int bj = 0; bj < 2; ++bj) { const size_t off = (size_t)(row0 + ai * HALF + m * 16) * 1024 + col0 + bj * HALF; hvv[m][bj] = *(const u32x4*)(H2 + off); pvv[m][bj] = *(const unsigned long long*)(PW + off); }
#pragma unroll
            for (int m = 0; m < 4; ++m)
#pragma unroll
                for (int bj = 0; bj < 2; ++bj) { const size_t off = (size_t)(row0 + ai * HALF + m * 16) * 1024 + col0 + bj * HALF;
                    const u32x4 hv = hvv[m][bj]; const int pl = (int)(unsigned)pvv[m][bj], ph = (int)(unsigned)(pvv[m][bj] >> 32); const f32x4 v0 = acc[ai][bj][m][0] * WSC, v1 = acc[ai][bj][m][1] * WSC;
                    const auto p01 = __builtin_amdgcn_cvt_pk_f32_fp8(pl, false), p23 = __builtin_amdgcn_cvt_pk_f32_fp8(pl, true), p45 = __builtin_amdgcn_cvt_pk_f32_fp8(ph, false), p67 = __builtin_amdgcn_cvt_pk_f32_fp8(ph, true);
                    float o[8];
                    o[0] = bf_lo(hv.x) + fast_sigmoid(v0[0]) * p01[0]; o[1] = bf_hi(hv.x) + fast_sigmoid(v0[1]) * p01[1];
                    o[2] = bf_lo(hv.y) + fast_sigmoid(v0[2]) * p23[0]; o[3] = bf_hi(hv.y) + fast_sigmoid(v0[3]) * p23[1];
                    o[4] = bf_lo(hv.z) + fast_sigmoid(v1[0]) * p45[0]; o[5] = bf_hi(hv.z) + fast_sigmoid(v1[1]) * p45[1];
                    o[6] = bf_lo(hv.w) + fast_sigmoid(v1[2]) * p67[0]; o[7] = bf_hi(hv.w) + fast_sigmoid(v1[3]) * p67[1];
                    if (Fout) { *(f32x4*)(Fout + off) = (f32x4){o[0], o[1], o[2], o[3]}; *(f32x4*)(Fout + off + 4) = (f32x4){o[4], o[5], o[6], o[7]}; }
                    else { u32x4 w; w.x = cvt_pk_bf16(o[0], o[1]); w.y = cvt_pk_bf16(o[2], o[3]); w.z = cvt_pk_bf16(o[4], o[5]); w.w = cvt_pk_bf16(o[6], o[7]); *(u32x4*)(Hout + off) = w;
                        int w0 = 0, w1 = 0; w0 = __builtin_amdgcn_cvt_pk_fp8_f32(o[0], o[1], w0, false); w0 = __builtin_amdgcn_cvt_pk_fp8_f32(o[2], o[3], w0, true); w1 = __builtin_amdgcn_cvt_pk_fp8_f32(o[4], o[5], w1, false); w1 = __builtin_amdgcn_cvt_pk_fp8_f32(o[6], o[7], w1, true);
                        *(unsigned long long*)(H8out + off) = (unsigned long long)(unsigned)w0 | ((unsigned long long)(unsigned)w1 << 32); } }
        }
    }
};

__device__ __forceinline__ int imax_(int a, int b) { return a > b ? a : b; }
__device__ __forceinline__ int imin_(int a, int b) { return a < b ? a : b; }
__device__ __forceinline__ float csum(float a, float b) { float s = a + b; asm volatile("" : "+v"(s)); return s; }
__device__ __forceinline__ int f2key(float v) { int s = __float_as_int(v); return s ^ ((s >> 31) & 0x7fffffff); }
__device__ __forceinline__ float key2f(int k) { return __int_as_float(k ^ ((k >> 31) & 0x7fffffff)); }
template <bool DESC> __device__ __forceinline__ void bitonic_sort16(int (&x)[16]) {
#pragma unroll
    for (int k = 2; k <= 16; k <<= 1)
#pragma unroll
        for (int j = k >> 1; j > 0; j >>= 1)
#pragma unroll
            for (int i = 0; i < 16; ++i) { const int l = i ^ j; if (l > i) { const bool up = ((i & k) == 0) || (k == 16); const bool asc = DESC ? !up : up;
                const int lo = imin_(x[i], x[l]), hi = imax_(x[i], x[l]); x[i] = asc ? lo : hi; x[l] = asc ? hi : lo; } }
}
__device__ __forceinline__ void bitonic_merge_desc16(int (&x)[16]) {
#pragma unroll
    for (int j = 8; j > 0; j >>= 1)
#pragma unroll
        for (int i = 0; i < 16; ++i) { const int l = i ^ j; if (l > i) { const int lo = imin_(x[i], x[l]), hi = imax_(x[i], x[l]); x[i] = hi; x[l] = lo; } }
}
__device__ __forceinline__ void topk_absorb16(int (&L)[16], int (&N)[16]) {
    bitonic_sort16<false>(N);
#pragma unroll
    for (int i = 0; i < 16; ++i) L[i] = imax_(L[i], N[i]);
    bitonic_merge_desc16(L);
}
__device__ __forceinline__ void topk_insert1(int (&L)[16], int v) {
#pragma unroll
    for (int i = 0; i < 16; ++i) { const int hi = imax_(L[i], v); v = imin_(L[i], v); L[i] = hi; }
}

template <bool DESC> __device__ __forceinline__ void bitonic_sort16f(float (&x)[16]) {
#pragma unroll
    for (int k = 2; k <= 16; k <<= 1)
#pragma unroll
        for (int j = k >> 1; j > 0; j >>= 1)
#pragma unroll
            for (int i = 0; i < 16; ++i) { const int l = i ^ j; if (l > i) { const bool up = ((i & k) == 0) || (k == 16); const bool asc = DESC ? !up : up;
                const float lo = __builtin_fminf(x[i], x[l]), hi = __builtin_fmaxf(x[i], x[l]); x[i] = asc ? lo : hi; x[l] = asc ? hi : lo; } }
}
__device__ __forceinline__ void bitonic_merge_desc16f(float (&x)[16]) {
#pragma unroll
    for (int j = 8; j > 0; j >>= 1)
#pragma unroll
        for (int i = 0; i < 16; ++i) { const int l = i ^ j; if (l > i) { const float lo = __builtin_fminf(x[i], x[l]), hi = __builtin_fmaxf(x[i], x[l]); x[i] = hi; x[l] = lo; } }
}
__device__ __forceinline__ void topk_absorb16f(float (&L)[16], float (&N)[16]) {
    bitonic_sort16f<false>(N);
#pragma unroll
    for (int i = 0; i < 16; ++i) L[i] = __builtin_fmaxf(L[i], N[i]);
    bitonic_merge_desc16f(L);
}

__device__ __forceinline__ void topk_insert1f(float (&L)[16], float v) {
#pragma unroll
    for (int i = 0; i < 16; ++i) { const float hi = __builtin_fmaxf(L[i], v); v = __builtin_fminf(L[i], v); L[i] = hi; }
}
struct EpiTopk {
    static constexpr bool PERM = true, AFTER_DRAIN = true;
    int* IDX; float* GATE;
    __device__ __forceinline__ void fused(f32x4 (&acc)[2][2][4][2], const Unit& u, int wr, int wc, int fr, int fq, PG8_LAS unsigned char* lds, int wid, int lane) const {
        const int tid = wid * 64 + lane;
        PG8_LAS float* S = (PG8_LAS float*)lds;
        PG8_LAS int* X = (PG8_LAS int*)lds;
        const int row = tid & 255, part = tid >> 8;
        int KK[2][16];
#pragma unroll
        for (int bj = 0; bj < 2; ++bj) {
#pragma unroll
            for (int ai = 0; ai < 2; ++ai)
#pragma unroll
                for (int m = 0; m < 4; ++m)
#pragma unroll
                    for (int n = 0; n < 2; ++n) *(PG8_LAS f32x4*)(S + (ai * HALF + wr * 64 + m * 16 + fr) * 132 + wc * 32 + 8 * fq + 4 * n) = acc[ai][bj][m][n] * WSC;
            asm volatile("s_waitcnt lgkmcnt(0)" ::: "memory"); __builtin_amdgcn_s_barrier(); asm volatile("" ::: "memory");
            float L[16];
#pragma unroll
            for (int c = 0; c < 4; ++c) {
                float N[16];
#pragma unroll
                for (int i = 0; i < 4; ++i) { const f32x4 v = *(const PG8_LAS f32x4*)(S + row * 132 + 64 * part + 16 * c + 4 * i);
#pragma unroll
                    for (int e = 0; e < 4; ++e) N[4 * i + e] = __int_as_float((__float_as_int(v[e]) & ~127) | (127 - (64 * part + 16 * c + 4 * i + e))); }
                if (c == 0) { bitonic_sort16f<true>(N);
#pragma unroll
                    for (int i = 0; i < 16; ++i) L[i] = N[i]; }
                else topk_absorb16f(L, N);
            }
            asm volatile("s_waitcnt lgkmcnt(0)" ::: "memory"); __builtin_amdgcn_s_barrier(); asm volatile("" ::: "memory");
#pragma unroll
            for (int i = 0; i < 4; ++i) *(PG8_LAS u32x4*)(X + tid * 20 + 4 * i) = (u32x4){(unsigned)__float_as_int(L[4 * i]), (unsigned)__float_as_int(L[4 * i + 1]), (unsigned)__float_as_int(L[4 * i + 2]), (unsigned)__float_as_int(L[4 * i + 3])};
            asm volatile("s_waitcnt lgkmcnt(0)" ::: "memory"); __builtin_amdgcn_s_barrier(); asm volatile("" ::: "memory");
            { float P[16]; const int pt = tid ^ 256;
#pragma unroll
              for (int i = 0; i < 4; ++i) { const u32x4 v = *(const PG8_LAS u32x4*)(X + pt * 20 + 4 * i); P[4 * i] = __int_as_float((int)v.x); P[4 * i + 1] = __int_as_float((int)v.y); P[4 * i + 2] = __int_as_float((int)v.z); P[4 * i + 3] = __int_as_float((int)v.w); }
#pragma unroll
              for (int i = 0; i < 16; ++i) L[i] = __builtin_fmaxf(L[i], P[15 - i]);
              bitonic_merge_desc16f(L); }
#pragma unroll
            for (int i = 0; i < 16; ++i) KK[bj][i] = __float_as_int(L[i]);
            asm volatile("s_waitcnt lgkmcnt(0)" ::: "memory"); __builtin_amdgcn_s_barrier(); asm volatile("" ::: "memory");
        }
        float v1[16], v2[16];
#pragma unroll
        for (int i = 0; i < 16; ++i) { v1[i] = __int_as_float(KK[0][i] & ~127); v2[i] = __int_as_float(KK[1][i] & ~127); }
#define CKEY(a, b) __int_as_float((__float_as_int(csum(v1[a], v2[b])) & ~255) | (255 - (((a) << 4) | (b))))
        float L[16];
#pragma unroll
        for (int b = 0; b < 16; ++b) L[b] = CKEY(0, b);
        { float N[16] = {CKEY(1, 0), CKEY(1, 1), CKEY(1, 2), CKEY(1, 3), CKEY(1, 4), CKEY(1, 5), CKEY(1, 6), CKEY(1, 7), CKEY(2, 0), CKEY(2, 1), CKEY(2, 2), CKEY(2, 3), CKEY(2, 4), CKEY(4, 0), CKEY(4, 1), CKEY(4, 2)};
          topk_absorb16f(L, N); }
        { float N[16] = {CKEY(3, 0), CKEY(3, 1), CKEY(3, 2), CKEY(3, 3), CKEY(5, 0), CKEY(5, 1), CKEY(6, 0), CKEY(6, 1), CKEY(7, 0), CKEY(7, 1), CKEY(8, 0), CKEY(9, 0), CKEY(10, 0), CKEY(11, 0), CKEY(12, 0), CKEY(13, 0)};
          topk_absorb16f(L, N); }
        topk_insert1f(L, CKEY(14, 0)); topk_insert1f(L, CKEY(15, 0));
#undef CKEY
#pragma unroll
        for (int i = 0; i < 4; ++i) { *(PG8_LAS u32x4*)(X + tid * 36 + 4 * i) = (u32x4){(unsigned)KK[0][4 * i], (unsigned)KK[0][4 * i + 1], (unsigned)KK[0][4 * i + 2], (unsigned)KK[0][4 * i + 3]};
                                      *(PG8_LAS u32x4*)(X + tid * 36 + 16 + 4 * i) = (u32x4){(unsigned)KK[1][4 * i], (unsigned)KK[1][4 * i + 1], (unsigned)KK[1][4 * i + 2], (unsigned)KK[1][4 * i + 3]}; }
        asm volatile("s_waitcnt lgkmcnt(0)" ::: "memory");
        float sc[16]; int ex[16];
#pragma unroll
        for (int i = 0; i < 16; ++i) { const int code = 255 - (__float_as_int(L[i]) & 255); const int ka = X[tid * 36 + (code >> 4)], kb = X[tid * 36 + 16 + (code & 15)];
            sc[i] = __int_as_float(ka & ~127) + __int_as_float(kb & ~127); ex[i] = (127 - (ka & 127)) * 128 + (127 - (kb & 127)); }
        float mx = sc[0];
#pragma unroll
        for (int i = 1; i < 16; ++i) mx = fmaxf(mx, sc[i]);
        float den = 0.f;
#pragma unroll
        for (int i = 0; i < 16; ++i) { sc[i] = __builtin_amdgcn_exp2f((sc[i] - mx) * 1.4426950408889634f); den += sc[i]; }
        const float rden = 1.0f / den;
        const size_t o = ((size_t)(u.pm * BM + row) * 8 + u.pn) * 16;
        if (part == 0) {
#pragma unroll
            for (int i = 0; i < 4; ++i) *(u32x4*)(IDX + o + 4 * i) = (u32x4){(unsigned)ex[4 * i], (unsigned)ex[4 * i + 1], (unsigned)ex[4 * i + 2], (unsigned)ex[4 * i + 3]};
        } else {
#pragma unroll
            for (int i = 0; i < 4; ++i) *(f32x4*)(GATE + o + 4 * i) = (f32x4){sc[4 * i] * rden, sc[4 * i + 1] * rden, sc[4 * i + 2] * rden, sc[4 * i + 3] * rden};
        }
        asm volatile("s_waitcnt lgkmcnt(0)" ::: "memory"); __builtin_amdgcn_s_barrier(); asm volatile("" ::: "memory");
    }
};
struct OneUnitOrder {
    StaticOrder base; int round;
    __device__ __forceinline__ bool next(int i, Unit& u) const { return i == 0 && base.next(round, u); }
    __device__ __forceinline__ void a_ready(const Unit&) const {}
    __device__ __forceinline__ void done(const Unit&) const {}
};
}
constexpr int NWAVES = 8;
constexpr int BATCH = 4, SEQ = 4096, DM = 1024, TOK = BATCH * SEQ, DEPTH = 4;
constexpr float LN_EPS = 1e-5f;
constexpr size_t MiB = 1u << 20;
constexpr size_t WS_CTL = 0, CTL_ZERO_BYTES = 32 * 1024;
constexpr size_t WS_W_IN = 2 * MiB;
constexpr size_t WS_W_GLU = 6 * MiB;
constexpr size_t WS_W_KV = 14 * MiB;
constexpr size_t WS_W_SQ = 18 * MiB;
constexpr size_t WS_W_SO = 22 * MiB;
constexpr size_t WS_W_EFF = 26 * MiB;
constexpr size_t WS_W_PG = 42 * MiB;
constexpr size_t WS_W_PW = 50 * MiB;
constexpr size_t WS_PB = 52 * MiB;
constexpr size_t WS_IDX = 84 * MiB;
constexpr size_t WS_GATE = 92 * MiB;
constexpr size_t WS_TABU = 100 * MiB;
constexpr size_t WS_TABV = 228 * MiB;
constexpr size_t WS_PW = 356 * MiB;
constexpr size_t WS_H = 484 * MiB, WS_U = 516 * MiB, WS_Y = 548 * MiB, WS_X1 = 580 * MiB, WS_H1 = 612 * MiB, WS_H2 = 644 * MiB, WS_KB = 676 * MiB, WS_VT = 708 * MiB, WS_HKV = 740 * MiB;
constexpr size_t WS_H8 = 772 * MiB, WS_H28 = 788 * MiB;
constexpr size_t WS_W8 = 804 * MiB;
constexpr size_t W8_IN = WS_W8, W8_GLU = WS_W8 + 2 * MiB, W8_KV = WS_W8 + 6 * MiB, W8_SQ = WS_W8 + 8 * MiB, W8_SO = WS_W8 + 10 * MiB, W8_PG = WS_W8 + 12 * MiB;
constexpr float W8_SCALE = 32.0f;
constexpr size_t WS_H18 = 820 * MiB;
constexpr size_t W8_EFF = 836 * MiB;
constexpr size_t WS_STATS = 844 * MiB;
constexpr size_t WS_END = 845 * MiB;
constexpr int CW_BAR = 4096;
constexpr float PEER_SU = 91.0f, PEER_SV = 4.75f;

constexpr int LDS_BYTES = 163840;
constexpr int RING_BYTES = 131072;
constexpr int MISC_OFF = 163840 - 256;

#define GAS __attribute__((address_space(1)))
#define LAS __attribute__((address_space(3)))
typedef unsigned short bf16;
typedef unsigned v4u __attribute__((ext_vector_type(4)));
typedef unsigned v2u __attribute__((ext_vector_type(2)));
typedef float f32x4 __attribute__((ext_vector_type(4)));
typedef float f32x16 __attribute__((ext_vector_type(16)));
typedef short bf16x8 __attribute__((ext_vector_type(8)));
typedef __bf16 bf16x2_t __attribute__((ext_vector_type(2)));
#define LDS_WAIT() asm volatile("s_waitcnt lgkmcnt(0)" ::: "memory")
#define VM_WAIT() asm volatile("s_waitcnt vmcnt(0)" ::: "memory")
using pg8::cvt_pk_bf16; using pg8::bf_lo; using pg8::bf_hi; using pg8::gelu_tanh;

#define XB_TMO      128
#define XB_XCNT(j)  (256  + 64 * (j))
#define XB_XSUB(j)  (1280 + 64 * (j))
#define XB_XGEN(j)  (2304 + 64 * (j))
#define XB_TOP      3328
#define XB_TOPGEN   3392
#define XCD_BAR_WORDS 3456
#define XB_SPIN_CAP (1u << 24)
__device__ __forceinline__ unsigned xb_ld(unsigned* p)              { return __hip_atomic_load(p, __ATOMIC_RELAXED, __HIP_MEMORY_SCOPE_AGENT); }
__device__ __forceinline__ unsigned xb_add(unsigned* p, unsigned v) { return __hip_atomic_fetch_add(p, v, __ATOMIC_RELAXED, __HIP_MEMORY_SCOPE_AGENT); }
__device__ __forceinline__ unsigned xb_xcc_id() { return (unsigned)__builtin_amdgcn_s_getreg((3 << 11) | 20) & 0xFu; }
#define XB_SPIN(cond, bar) do { unsigned _sp = 0; while (cond) { __builtin_amdgcn_s_sleep(1); \
    if ((++_sp & 255u) == 0u) { if (xb_ld(&(bar)[XB_TMO])) break; if (_sp > XB_SPIN_CAP) { atomicAdd(&(bar)[XB_TMO], 1u); break; } } } } while (0)
struct XcdBarrier { unsigned* bar; unsigned x; volatile LAS unsigned* st; };
__device__ __forceinline__ XcdBarrier xcd_barrier_post(unsigned* bar, volatile LAS unsigned* st) {
    XcdBarrier b; b.bar = bar; b.x = xb_xcc_id(); b.st = st;
    if (threadIdx.x == 0) { st[2] = xb_add(&bar[XB_XCNT(b.x)], 1u); st[3] = b.x; }
    return b;
}
__device__ __forceinline__ void xcd_barrier_complete(unsigned* bar, unsigned x, unsigned& nloc, unsigned& nx, unsigned& even) {
    const unsigned G = gridDim.x * gridDim.y * gridDim.z;
    unsigned sum, cnt, mine, bad, sp = 0u;
    for (;;) {
        sum = 0u; cnt = 0u; mine = 0u; bad = 0u;
#pragma unroll 1
        for (unsigned j = 0; j < 16; ++j) { const unsigned c = xb_ld(&bar[XB_XCNT(j)]); sum += c; cnt += (c > 0u) ? 1u : 0u; mine = (j == x) ? c : mine; bad += (c != ((j < 8u) ? G / 8u : 0u)) ? 1u : 0u; }
        if (sum == G) break;
        __builtin_amdgcn_s_sleep(1);
        if ((++sp & 255u) == 0u) { if (xb_ld(&bar[XB_TMO])) break; if (sp > XB_SPIN_CAP) { atomicAdd(&bar[XB_TMO], 1u); break; } }
    }
    nloc = mine > 0u ? mine : 1u; nx = cnt > 0u ? cnt : 1u; even = (bad == 0u && G == 256u && sum == G) ? 1u : 0u;
}
__device__ __forceinline__ void xcd_barrier(const XcdBarrier& b, bool local = false, bool noacq = false) {
    asm volatile("s_waitcnt vmcnt(0)" ::: "memory");
    __syncthreads();
    if (threadIdx.x == 0) {
        unsigned* bar = b.bar;
        __builtin_amdgcn_s_waitcnt(0);
        unsigned nloc = b.st[0], nx = b.st[1];
        if (nloc == 0u) { unsigned even; xcd_barrier_complete(bar, b.x, nloc, nx, even); b.st[0] = nloc; b.st[1] = nx; b.st[4] = even; }
        const unsigned old = xb_add(&bar[XB_XSUB(b.x)], 1u);
        const unsigned gen = old / nloc;
        if (local) {
            if (old + 1u == (gen + 1u) * nloc) { if (!noacq) __builtin_amdgcn_fence(__ATOMIC_ACQUIRE, "agent"); xb_add(&bar[XB_XGEN(b.x)], 1u); }
            else { XB_SPIN(xb_ld(&bar[XB_XGEN(b.x)]) == gen, bar); if (!noacq) __builtin_amdgcn_fence(__ATOMIC_ACQUIRE, "agent"); }
            asm volatile("s_waitcnt vmcnt(0)" ::: "memory");
        } else if (old + 1u == (gen + 1u) * nloc) {
            __builtin_amdgcn_fence(__ATOMIC_RELEASE, "agent");
            asm volatile("s_waitcnt vmcnt(0)" ::: "memory");
            const unsigned og = xb_add(&bar[XB_TOP], 1u);
            const unsigned tg = og / nx;
            if (og + 1u == (tg + 1u) * nx) xb_add(&bar[XB_TOPGEN], 1u);
            else XB_SPIN(xb_ld(&bar[XB_TOPGEN]) == tg, bar);
            __builtin_amdgcn_fence(__ATOMIC_ACQUIRE, "agent");
            xb_add(&bar[XB_XGEN(b.x)], 1u);
            asm volatile("s_waitcnt vmcnt(0)" ::: "memory");
        } else {
            XB_SPIN(xb_ld(&bar[XB_XGEN(b.x)]) == gen, bar);
            __builtin_amdgcn_fence(__ATOMIC_ACQUIRE, "agent");
            asm volatile("s_waitcnt vmcnt(0)" ::: "memory");
        }
    }
    __syncthreads();
}

enum PhaseType { P_PROLOGUE = 0, P_STORE = 1, P_SSM = 2, P_GLU = 3, P_LNMIX = 4, P_TOPK = 5, P_PEER = 6, P_PLE = 7, P_LNKV = 8, P_ATTN = 9, P_RES = 10 };
constexpr int MAX_PH = 48;
struct Args { const float* in[28]; float* out; unsigned char* ws; int ph_lo, ph_hi, use_bar, nph; unsigned char ph_type[MAX_PH]; unsigned char ph_arg[MAX_PH]; };
struct Frame {
    LAS unsigned char* lds;
    int tid, lane, wave, vcu, G, z, bx;
    const struct Args* A;
    float* out; unsigned char* ws;
};
__device__ __forceinline__ float wave_sum(float v) {
#pragma unroll
    for (int o = 1; o < 64; o <<= 1) v += __shfl_xor(v, o);
    return v;
}
template <int CTRL, int BANK> __device__ __forceinline__ float dpp_movf(float old, float v) {
    return __builtin_bit_cast(float, __builtin_amdgcn_update_dpp(__builtin_bit_cast(int, old), __builtin_bit_cast(int, v), CTRL, 0xF, BANK, true));
}
__device__ __forceinline__ float wave_sum_dpp(float v) {
    v += dpp_movf<0xB1, 0xF>(0.f, v);
    v += dpp_movf<0x4E, 0xF>(0.f, v);
    { float r = dpp_movf<0x104, 0x5>(0.f, v); r = dpp_movf<0x114, 0xA>(r, v); v += r; }
    v += dpp_movf<0x128, 0xF>(0.f, v);
    { const auto t = __builtin_amdgcn_permlane16_swap(__builtin_bit_cast(unsigned, v), __builtin_bit_cast(unsigned, v), false, false); const unsigned ta = t[0], tb = t[1]; v = __builtin_bit_cast(float, ta) + __builtin_bit_cast(float, tb); }
    { const auto t = __builtin_amdgcn_permlane32_swap(__builtin_bit_cast(unsigned, v), __builtin_bit_cast(unsigned, v), false, false); const unsigned ta = t[0], tb = t[1]; v = __builtin_bit_cast(float, ta) + __builtin_bit_cast(float, tb); }
    return v;
}
__device__ __forceinline__ unsigned f2bf(float f) { unsigned u = __builtin_bit_cast(unsigned, f); return (u + 0x7fffu + ((u >> 16) & 1u)) >> 16; }
__device__ __forceinline__ unsigned pk2(float lo, float hi) { return f2bf(lo) | (f2bf(hi) << 16); }

__device__ __forceinline__ unsigned pk4_fp8(float a, float b, float c, float d) { int w = 0; w = __builtin_amdgcn_cvt_pk_fp8_f32(a, b, w, false); w = __builtin_amdgcn_cvt_pk_fp8_f32(c, d, w, true); return (unsigned)w; }
__device__ __forceinline__ void p0_transpose_item(const float* W, int K, int N, bf16* WT, int glu, LAS float* scr, int item, int lane, unsigned char* WT8 = nullptr) {
    const int nblk = N / 32, kb = item / nblk, nb = item % nblk, k0 = 64 * kb, n0 = 32 * nb;
    int r0 = n0;
    if (glu) { const int bj = n0 >> 10, rem = n0 & 1023; r0 = 256 * (rem >> 7) + 128 * bj + (rem & 127); }
    { float wv[32];
#pragma unroll
      for (int i = 0; i < 32; ++i) { const int kk = 2 * i + (lane >> 5); wv[i] = *(const GAS float*)(W + (size_t)(k0 + kk) * N + n0 + (lane & 31)); }
#pragma unroll
      for (int i = 0; i < 32; ++i) { const int kk = 2 * i + (lane >> 5); scr[kk * 33 + (lane & 31)] = wv[i]; } }
    LDS_WAIT(); asm volatile("" ::: "memory");
    const int c = lane & 7;
#pragma unroll
    for (int j = 0; j < 4; ++j) { const int n = (lane >> 3) + 8 * j; const LAS float* s = scr + (8 * c) * 33 + n;
        v4u o; o.x = pk2(s[0 * 33], s[1 * 33]); o.y = pk2(s[2 * 33], s[3 * 33]); o.z = pk2(s[4 * 33], s[5 * 33]); o.w = pk2(s[6 * 33], s[7 * 33]);
        if (WT) *(GAS v4u*)(WT + (size_t)(r0 + n) * K + k0 + 8 * c) = o;
        if (WT8) *(GAS v2u*)(WT8 + (size_t)(r0 + n) * K + k0 + 8 * c) = (v2u){pk4_fp8(s[0 * 33] * W8_SCALE, s[1 * 33] * W8_SCALE, s[2 * 33] * W8_SCALE, s[3 * 33] * W8_SCALE), pk4_fp8(s[4 * 33] * W8_SCALE, s[5 * 33] * W8_SCALE, s[6 * 33] * W8_SCALE, s[7 * 33] * W8_SCALE)}; }
    LDS_WAIT(); asm volatile("" ::: "memory");
}
__device__ __forceinline__ void cvt_stream_dual(Frame& F, const float* src, bf16* dst, unsigned char* dst8, size_t n) {
    const size_t nthr = (size_t)F.G * 512, gt = (size_t)F.bx * 512 + F.tid, ni = n / 8;
    for (size_t i = gt; i < ni; i += 4 * nthr) {
        f32x4 a[4], b[4];
#pragma unroll
        for (int k = 0; k < 4; ++k) { const size_t ik = i + k * nthr, ii = ik < ni ? ik : i; a[k] = *(const GAS f32x4*)(src + ii * 8); b[k] = *(const GAS f32x4*)(src + ii * 8 + 4); }
#pragma unroll
        for (int k = 0; k < 4; ++k) { const size_t ik = i + k * nthr;
            if (ik < ni) { v4u o; o.x = pk2(a[k].x, a[k].y); o.y = pk2(a[k].z, a[k].w); o.z = pk2(b[k].x, b[k].y); o.w = pk2(b[k].z, b[k].w);
                *(GAS v4u*)(dst + ik * 8) = o;
                *(GAS v2u*)(dst8 + ik * 8) = (v2u){pk4_fp8(a[k].x, a[k].y, a[k].z, a[k].w), pk4_fp8(b[k].x, b[k].y, b[k].z, b[k].w)}; } }
    }
}
__device__ __forceinline__ void cvt_stream(Frame& F, const float* src, bf16* dst, size_t n) {
    const size_t nthr = (size_t)F.G * 512, gt = (size_t)F.bx * 512 + F.tid, ni = n / 8;
    for (size_t i = gt; i < ni; i += 4 * nthr) {
        f32x4 a[4], b[4];
#pragma unroll
        for (int k = 0; k < 4; ++k) { const size_t ik = i + k * nthr, ii = ik < ni ? ik : i; a[k] = *(const GAS f32x4*)(src + ii * 8); b[k] = *(const GAS f32x4*)(src + ii * 8 + 4); }
#pragma unroll
        for (int k = 0; k < 4; ++k) { const size_t ik = i + k * nthr;
            if (ik < ni) { v4u o; o.x = pk2(a[k].x, a[k].y); o.y = pk2(a[k].z, a[k].w); o.z = pk2(b[k].x, b[k].y); o.w = pk2(b[k].z, b[k].w);
                *(GAS v4u*)(dst + ik * 8) = o; } }
    }
}
__device__ __forceinline__ void cvt_stream_fp4(Frame& F, const float* src, unsigned char* dst, size_t n, float scale) {
    const size_t nthr = (size_t)F.G * 512, gt = (size_t)F.bx * 512 + F.tid;
    for (size_t i = gt; i < n / 32; i += nthr) {
        unsigned w[4];
#pragma unroll
        for (int q = 0; q < 4; ++q) {
            const f32x4 a = *(const GAS f32x4*)(src + i * 32 + 8 * q) * scale, b = *(const GAS f32x4*)(src + i * 32 + 8 * q + 4) * scale;
            unsigned t = 0u;
            t = __builtin_amdgcn_cvt_scalef32_pk_fp4_f32(t, a.x, a.y, 1.0f, 0); t = __builtin_amdgcn_cvt_scalef32_pk_fp4_f32(t, a.z, a.w, 1.0f, 1);
            t = __builtin_amdgcn_cvt_scalef32_pk_fp4_f32(t, b.x, b.y, 1.0f, 2); t = __builtin_amdgcn_cvt_scalef32_pk_fp4_f32(t, b.z, b.w, 1.0f, 3);
            w[q] = t;
        }
        *(GAS v4u*)(dst + i * 16) = (v4u){w[0], w[1], w[2], w[3]};
    }
}
__device__ __forceinline__ unsigned pkbf2(float lo, float hi) { return cvt_pk_bf16(lo, hi); }
__device__ __forceinline__ void p0_weff_item(Frame& F, int item) {
    const int jb = item & 1, kb = (item >> 1) & 15, hh = (item >> 5) & 15, l = item >> 9;
    const int lane = F.lane, r32 = lane & 31, h = lane >> 5;
    const float* wq = F.A->in[21 + F.z] + (size_t)l * 1024 * 2048 + (size_t)(64 * kb + r32) * 2048 + 128 * hh + 8 * h;
    const float* ky = F.A->in[22 + (hh & 1) + F.z] + (size_t)l * 128 * 128 + (size_t)(64 * jb + r32) * 128 + 8 * h;
    f32x16 acc[2][2] = {};
#pragma unroll
    for (int ks = 0; ks < 8; ++ks) {
        bf16x8 af[2], bf[2];
#pragma unroll
        for (int a = 0; a < 2; ++a) { const f32x4 a0 = *(const GAS f32x4*)(wq + (size_t)a * 32 * 2048 + 16 * ks), a1 = *(const GAS f32x4*)(wq + (size_t)a * 32 * 2048 + 16 * ks + 4);
            af[a] = __builtin_bit_cast(bf16x8, (v4u){pkbf2(a0.x, a0.y), pkbf2(a0.z, a0.w), pkbf2(a1.x, a1.y), pkbf2(a1.z, a1.w)}); }
#pragma unroll
        for (int b = 0; b < 2; ++b) { const f32x4 b0 = *(const GAS f32x4*)(ky + (size_t)b * 32 * 128 + 16 * ks), b1 = *(const GAS f32x4*)(ky + (size_t)b * 32 * 128 + 16 * ks + 4);
            bf[b] = __builtin_bit_cast(bf16x8, (v4u){pkbf2(b0.x, b0.y), pkbf2(b0.z, b0.w), pkbf2(b1.x, b1.y), pkbf2(b1.z, b1.w)}); }
#pragma unroll
        for (int a = 0; a < 2; ++a)
#pragma unroll
            for (int b = 0; b < 2; ++b) acc[a][b] = __builtin_amdgcn_mfma_f32_32x32x16_bf16(af[a], bf[b], acc[a][b], 0, 0, 0);
    }
#pragma unroll
    for (int a = 0; a < 2; ++a)
#pragma unroll
        for (int b = 0; b < 2; ++b) {
            unsigned char* dst = (unsigned char*)(F.ws + W8_EFF) + (size_t)l * 2048 * 1024 + (size_t)(128 * hh + 64 * jb + 32 * b + r32) * 1024 + 64 * kb + 32 * a + 4 * h;
#pragma unroll
            for (int q = 0; q < 4; ++q) *(GAS unsigned*)(dst + 8 * q) = pk4_fp8(acc[a][b][4 * q] * W8_SCALE, acc[a][b][4 * q + 1] * W8_SCALE, acc[a][b][4 * q + 2] * W8_SCALE, acc[a][b][4 * q + 3] * W8_SCALE); }
}
__device__ __forceinline__ void p0_prologue(Frame& F) {
#ifndef PROBE_PRO
#define PROBE_PRO 0
#endif
    for (int rp = 0; rp < (PROBE_PRO == 4 ? 2 : 1); ++rp) {
    cvt_stream_dual(F, F.A->in[0 + F.z], (bf16*)(F.ws + WS_H), (unsigned char*)(F.ws + WS_H8), (size_t)TOK * DM);
    cvt_stream(F, F.A->in[1 + F.z], (bf16*)(F.ws + WS_PB), (size_t)DEPTH * TOK * 256); }
    LAS float* scr = (LAS float*)(F.lds + F.wave * 8704);
    const int gw = F.vcu * NWAVES + F.wave, NGW = F.G * NWAVES;
    constexpr int I_SQ = 16 * 32, I_GLU = 16 * 64, I_PW = 4 * 32;
    constexpr int NITEMS = 2 * I_SQ + 2 * I_GLU + I_GLU + 2 * I_SQ + 2 * I_SQ + 4 * I_SQ + 4 * I_PW;
    for (int rp = 0; rp < (PROBE_PRO == 2 ? 2 : 1); ++rp)
    for (int it = gw; it < NITEMS; it += NGW) {
        int r = it;
        if (r < 2 * I_SQ) { const int l = r / I_SQ; p0_transpose_item(F.A->in[6 + F.z] + (size_t)l * 1024 * 1024, 1024, 1024, nullptr, 0, scr, r % I_SQ, F.lane, (unsigned char*)(F.ws + W8_IN) + (size_t)l * 1024 * 1024); continue; } r -= 2 * I_SQ;
        if (r < 2 * I_GLU) { const int l = r / I_GLU; p0_transpose_item(F.A->in[15 + F.z] + (size_t)l * 1024 * 2048, 1024, 2048, nullptr, 1, scr, r % I_GLU, F.lane, (unsigned char*)(F.ws + W8_GLU) + (size_t)l * 2048 * 1024); continue; } r -= 2 * I_GLU;
        if (r < I_GLU) { p0_transpose_item(F.A->in[18 + F.z], 1024, 2048, nullptr, 0, scr, r, F.lane, (unsigned char*)(F.ws + W8_KV)); continue; } r -= I_GLU;
        if (r < 2 * I_SQ) { const int l = r / I_SQ; p0_transpose_item(F.A->in[19 + F.z] + (size_t)l * 1024 * 1024, 1024, 1024, nullptr, 0, scr, r % I_SQ, F.lane, (unsigned char*)(F.ws + W8_SQ) + (size_t)l * 1024 * 1024); continue; } r -= 2 * I_SQ;
        if (r < 2 * I_SQ) { const int l = r / I_SQ; p0_transpose_item(F.A->in[20 + F.z] + (size_t)l * 1024 * 1024, 1024, 1024, nullptr, 0, scr, r % I_SQ, F.lane, (unsigned char*)(F.ws + W8_SO) + (size_t)l * 1024 * 1024); continue; } r -= 2 * I_SQ;
        if (r < 4 * I_SQ) { const int l = r / I_SQ; p0_transpose_item(F.A->in[27 + F.z] + (size_t)l * 1024 * 1024, 1024, 1024, nullptr, 0, scr, r % I_SQ, F.lane, (unsigned char*)(F.ws + W8_PG) + (size_t)l * 1024 * 1024); continue; } r -= 4 * I_SQ;
        { const int l = r / I_PW; p0_transpose_item(F.A->in[26 + F.z] + (size_t)l * 256 * 1024, 256, 1024, (bf16*)(F.ws + WS_W_PW) + (size_t)l * 1024 * 256, 0, scr, r % I_PW, F.lane); }
    }
    for (int rp = 0; rp < (PROBE_PRO == 3 ? 2 : 1); ++rp)
    for (int it = gw; it < 2048; it += NGW) p0_weff_item(F, it);
}

typedef float f32x2g __attribute__((ext_vector_type(2)));
__device__ __forceinline__ void ln_rows(Frame& F, const bf16* X, const float* g, const float* bb, bf16* O, unsigned char* O8 = nullptr, float* ST = nullptr) {
    const int gw = F.vcu * NWAVES + F.wave, NGW = F.G * NWAVES;
    float gg[16], bv[16];
    { const f32x4 a = *(const GAS f32x4*)(g + 8 * F.lane), b = *(const GAS f32x4*)(g + 8 * F.lane + 4), c = *(const GAS f32x4*)(g + 512 + 8 * F.lane), d = *(const GAS f32x4*)(g + 512 + 8 * F.lane + 4);
      gg[0] = a.x; gg[1] = a.y; gg[2] = a.z; gg[3] = a.w; gg[4] = b.x; gg[5] = b.y; gg[6] = b.z; gg[7] = b.w; gg[8] = c.x; gg[9] = c.y; gg[10] = c.z; gg[11] = c.w; gg[12] = d.x; gg[13] = d.y; gg[14] = d.z; gg[15] = d.w; }
    { const f32x4 a = *(const GAS f32x4*)(bb + 8 * F.lane), b = *(const GAS f32x4*)(bb + 8 * F.lane + 4), c = *(const GAS f32x4*)(bb + 512 + 8 * F.lane), d = *(const GAS f32x4*)(bb + 512 + 8 * F.lane + 4);
      bv[0] = a.x; bv[1] = a.y; bv[2] = a.z; bv[3] = a.w; bv[4] = b.x; bv[5] = b.y; bv[6] = b.z; bv[7] = b.w; bv[8] = c.x; bv[9] = c.y; bv[10] = c.z; bv[11] = c.w; bv[12] = d.x; bv[13] = d.y; bv[14] = d.z; bv[15] = d.w; }
    const bool al = (F.G == 256);
    const int mbase = al ? (F.vcu >> 5) * 2048 + (F.vcu & 31) * 8 + F.wave : gw, mstep = al ? 256 : NGW, mend = al ? mbase + 2048 : TOK;
    for (int m = mbase; m < mend; m += mstep) {
        const v4u xa = *(const GAS v4u*)(X + (size_t)m * DM + 8 * F.lane), xb = *(const GAS v4u*)(X + (size_t)m * DM + 512 + 8 * F.lane);
        float x[16] = {bf_lo(xa.x), bf_hi(xa.x), bf_lo(xa.y), bf_hi(xa.y), bf_lo(xa.z), bf_hi(xa.z), bf_lo(xa.w), bf_hi(xa.w), bf_lo(xb.x), bf_hi(xb.x), bf_lo(xb.y), bf_hi(xb.y), bf_lo(xb.z), bf_hi(xb.z), bf_lo(xb.w), bf_hi(xb.w)};
        float s = 0.f;
#pragma unroll
        for (int i = 0; i < 16; ++i) s += x[i];
        const float mean = wave_sum_dpp(s) * (1.f / DM); float q = 0.f;
#pragma unroll
        for (int i = 0; i < 16; ++i) { x[i] -= mean; q += x[i] * x[i]; }
        const float rstd = 1.0f / sqrtf(wave_sum_dpp(q) * (1.f / DM) + LN_EPS);
        if (ST && F.lane == 0) *(GAS f32x2g*)(ST + 2 * (size_t)m) = (f32x2g){mean, rstd};
#pragma unroll
        for (int i = 0; i < 16; ++i) x[i] = x[i] * rstd * gg[i] + bv[i];
        v4u oa, ob; oa.x = pk2(x[0], x[1]); oa.y = pk2(x[2], x[3]); oa.z = pk2(x[4], x[5]); oa.w = pk2(x[6], x[7]); ob.x = pk2(x[8], x[9]); ob.y = pk2(x[10], x[11]); ob.z = pk2(x[12], x[13]); ob.w = pk2(x[14], x[15]);
        if (O) { *(GAS v4u*)(O + (size_t)m * DM + 8 * F.lane) = oa; *(GAS v4u*)(O + (size_t)m * DM + 512 + 8 * F.lane) = ob; }
        if (O8) { *(GAS v2u*)(O8 + (size_t)m * DM + 8 * F.lane) = (v2u){pk4_fp8(x[0], x[1], x[2], x[3]), pk4_fp8(x[4], x[5], x[6], x[7])};
                  *(GAS v2u*)(O8 + (size_t)m * DM + 512 + 8 * F.lane) = (v2u){pk4_fp8(x[8], x[9], x[10], x[11]), pk4_fp8(x[12], x[13], x[14], x[15])}; }
    }
}
struct TabCvt { const float* su; const float* sv; unsigned char* du; unsigned char* dv; int c, cf, stride, n; };
__device__ __forceinline__ void tabcvt_issue_always(TabCvt& T, int lane, f32x4 (&cv)[4]) {
    const int half = T.n >> 1, cc = T.c < T.n ? T.c : T.n - 1; const float* src = (cc < half ? T.su + (size_t)cc * 1024 : T.sv + (size_t)(cc - half) * 1024) + 16 * lane;
#pragma unroll
    for (int q = 0; q < 4; ++q) cv[q] = *(const GAS f32x4*)(src + 4 * q);
    T.c += T.stride;
}
__device__ __forceinline__ void tabcvt_issue(TabCvt& T, int lane, f32x4 (&cv)[4]) {
    const bool live = T.c < T.n;
    if (live) { const int half = T.n >> 1; const float* src = (T.c < half ? T.su + (size_t)T.c * 1024 : T.sv + (size_t)(T.c - half) * 1024) + 16 * lane;
#pragma unroll
        for (int q = 0; q < 4; ++q) cv[q] = *(const GAS f32x4*)(src + 4 * q); }
    T.c += T.stride;
}
__device__ __forceinline__ unsigned i4q(float v) { float t = __builtin_fminf(__builtin_fmaxf(v * PEER_SU, -7.f), 7.f) + 12582912.0f; asm volatile("" : "+v"(t)); return __builtin_bit_cast(unsigned, t) & 15u; }
__device__ __forceinline__ unsigned pack8_i4(const f32x4& a, const f32x4& b) {
    return i4q(a.x) | (i4q(a.y) << 4) | (i4q(a.z) << 8) | (i4q(a.w) << 12) | (i4q(b.x) << 16) | (i4q(b.y) << 20) | (i4q(b.z) << 24) | (i4q(b.w) << 28);
}
__device__ __forceinline__ void tabcvt_finish(TabCvt& T, int lane, const f32x4 (&cv)[4]) {
    const bool live = T.cf < T.n;
    if (live) { const int half = T.n >> 1;
        unsigned w0 = 0u, w1 = 0u;
        if (T.cf < half) { w0 = pack8_i4(cv[0], cv[1]); w1 = pack8_i4(cv[2], cv[3]); }
        else { const float sc = PEER_SV;
            w0 = __builtin_amdgcn_cvt_scalef32_pk_fp4_f32(w0, cv[0].x * sc, cv[0].y * sc, 1.0f, 0); w0 = __builtin_amdgcn_cvt_scalef32_pk_fp4_f32(w0, cv[0].z * sc, cv[0].w * sc, 1.0f, 1);
            w0 = __builtin_amdgcn_cvt_scalef32_pk_fp4_f32(w0, cv[1].x * sc, cv[1].y * sc, 1.0f, 2); w0 = __builtin_amdgcn_cvt_scalef32_pk_fp4_f32(w0, cv[1].z * sc, cv[1].w * sc, 1.0f, 3);
            w1 = __builtin_amdgcn_cvt_scalef32_pk_fp4_f32(w1, cv[2].x * sc, cv[2].y * sc, 1.0f, 0); w1 = __builtin_amdgcn_cvt_scalef32_pk_fp4_f32(w1, cv[2].z * sc, cv[2].w * sc, 1.0f, 1);
            w1 = __builtin_amdgcn_cvt_scalef32_pk_fp4_f32(w1, cv[3].x * sc, cv[3].y * sc, 1.0f, 2); w1 = __builtin_amdgcn_cvt_scalef32_pk_fp4_f32(w1, cv[3].z * sc, cv[3].w * sc, 1.0f, 3); }
        unsigned char* dst = (T.cf < half ? T.du + (size_t)T.cf * 512 : T.dv + (size_t)(T.cf - half) * 512) + 8 * lane;
        *(GAS v2u*)dst = (v2u){w0, w1}; }
    T.cf += T.stride;
}
struct SsmPre { v2u ua; };
template <bool PASS1, bool CVT> __device__ __forceinline__ void ssm_tile(const unsigned char* U8, bf16* Y, LAS unsigned char* stl, const f32x4& d0, const f32x4& d1, size_t tok0, int tile, int g, int lane, int n, int hh, int i_row,
                                                                  const float (&a_re)[2], const float (&a_im)[2], const bf16x8 (&Bf)[4], const LAS unsigned char* CFL, float (&s_re)[2], float (&s_im)[2],
                                                                  SsmPre& P, TabCvt& TC, f32x4 (&cv)[4], int& ci) {
    const int c0 = 16 * g + 4 * hh;
    const size_t tok = tok0 + tile * 16;
    bf16x8 ua; { const auto f0 = __builtin_amdgcn_cvt_pk_f32_fp8((int)P.ua.x, false), f1 = __builtin_amdgcn_cvt_pk_f32_fp8((int)P.ua.x, true), f2 = __builtin_amdgcn_cvt_pk_f32_fp8((int)P.ua.y, false), f3 = __builtin_amdgcn_cvt_pk_f32_fp8((int)P.ua.y, true);
        ua = __builtin_bit_cast(bf16x8, (v4u){cvt_pk_bf16(f0[0], f0[1]), cvt_pk_bf16(f1[0], f1[1]), cvt_pk_bf16(f2[0], f2[1]), cvt_pk_bf16(f3[0], f3[1])}); }
    unsigned u0 = 0u, u1 = 0u;
    if (PASS1) asm volatile("v_mov_b32 %0, %2\n\tv_mov_b32 %1, %3\n\ts_nop 1\n\tv_permlane32_swap_b32 %0, %1\n\ts_nop 1" : "=&v"(u0), "=&v"(u1) : "v"(P.ua.x), "v"(P.ua.y));
    { const size_t tokn = tok0 + ((tile + 2) & 15) * 16;
      P.ua = *(const GAS v2u*)(U8 + tokn * DM + 16 * g + 8 * hh); }
    f32x16 acc[4];
#pragma unroll
    for (int nb = 0; nb < 4; ++nb) { f32x16 z = {}; acc[nb] = __builtin_amdgcn_mfma_f32_32x32x16_bf16(ua, Bf[nb], z, 0, 0, 0); }
#pragma unroll
    for (int pb = 0; pb < 2; ++pb) {
#pragma unroll
        for (int r = 0; r < 16; ++r) {
            float t0 = fmaf(-a_im[pb], s_im[pb], acc[2 * pb][r]); asm volatile("" : "+v"(t0));
            float t1 = fmaf(a_im[pb], s_re[pb], acc[2 * pb + 1][r]); asm volatile("" : "+v"(t1));
            float nre = fmaf(a_re[pb], s_re[pb], t0); asm volatile("" : "+v"(nre));
            float nim = fmaf(a_re[pb], s_im[pb], t1); asm volatile("" : "+v"(nim));
            s_re[pb] = nre; s_im[pb] = nim;
            if (PASS1) { const int irow = (r & 3) + 8 * (r >> 2) + 4 * hh; *(LAS unsigned*)(stl + irow * 272 + (32 * pb + n) * 4) = cvt_pk_bf16(nre, nim); }
        }
    }
    if (PASS1) {
        LDS_WAIT();
        f32x16 yv = {};
#pragma unroll
        for (int ks = 0; ks < 8; ++ks) { const bf16x8 sb = *(const LAS bf16x8*)(stl + i_row * 272 + (16 * ks + 8 * hh) * 2); const bf16x8 cf = *(const LAS bf16x8*)(CFL + (ks * 64 + lane) * 16); yv = __builtin_amdgcn_mfma_f32_32x32x16_bf16(cf, sb, yv, 0, 0, 0); }
        float o[8];
        const auto ua0 = __builtin_amdgcn_cvt_pk_f32_fp8((int)u0, false), ua1 = __builtin_amdgcn_cvt_pk_f32_fp8((int)u0, true), ub0 = __builtin_amdgcn_cvt_pk_f32_fp8((int)u1, false), ub1 = __builtin_amdgcn_cvt_pk_f32_fp8((int)u1, true);
        o[0] = gelu_tanh(yv[0] + d0.x * ua0[0]); o[1] = gelu_tanh(yv[1] + d0.y * ua0[1]); o[2] = gelu_tanh(yv[2] + d0.z * ua1[0]); o[3] = gelu_tanh(yv[3] + d0.w * ua1[1]);
        o[4] = gelu_tanh(yv[4] + d1.x * ub0[0]); o[5] = gelu_tanh(yv[5] + d1.y * ub0[1]); o[6] = gelu_tanh(yv[6] + d1.z * ub1[0]); o[7] = gelu_tanh(yv[7] + d1.w * ub1[1]);
        *(GAS unsigned*)((unsigned char*)Y + tok * DM + c0) = pk4_fp8(o[0], o[1], o[2], o[3]);
        *(GAS unsigned*)((unsigned char*)Y + tok * DM + c0 + 8) = pk4_fp8(o[4], o[5], o[6], o[7]);
        LDS_WAIT();
    }
    if (CVT) { TC.cf = ci; tabcvt_finish(TC, lane, cv); ci = TC.c; tabcvt_issue_always(TC, lane, cv); }
}
template <bool PASS1, bool CVT> __device__ __forceinline__ void ssm_pass(const bf16* U, bf16* Y, LAS unsigned char* stl, const float* dskip, size_t tok0, int g, int lane, int n, int hh, int i_row,
                                                                  const float (&a_re)[2], const float (&a_im)[2], const bf16x8 (&Bf)[4], const LAS unsigned char* CFL, float (&s_re)[2], float (&s_im)[2], TabCvt& TC) {
    const int c0 = 16 * g + 4 * hh;
    const unsigned char* U8 = (const unsigned char*)U;
    SsmPre PA, PB;
    PA.ua = *(const GAS v2u*)(U8 + tok0 * DM + 16 * g + 8 * hh); PB.ua = *(const GAS v2u*)(U8 + (tok0 + 16) * DM + 16 * g + 8 * hh);
    f32x4 d0 = {}, d1 = {}; f32x4 cvA[4], cvB[4]; int iA = 0, iB = 0;
    if (PASS1) { d0 = *(const GAS f32x4*)(dskip + c0); d1 = *(const GAS f32x4*)(dskip + c0 + 8); }
    if (CVT) { __builtin_amdgcn_s_waitcnt(0x0F70);
               iA = TC.c; tabcvt_issue_always(TC, lane, cvA); if (PASS1) { iB = TC.c; tabcvt_issue_always(TC, lane, cvB); } }
#pragma unroll 1
    for (int tile = 0; tile < 16; tile += 4) {
        ssm_tile<PASS1, CVT>(U8, Y, stl, d0, d1, tok0, tile, g, lane, n, hh, i_row, a_re, a_im, Bf, CFL, s_re, s_im, PA, TC, cvA, iA);
        ssm_tile<PASS1, CVT && PASS1>(U8, Y, stl, d0, d1, tok0, tile + 1, g, lane, n, hh, i_row, a_re, a_im, Bf, CFL, s_re, s_im, PB, TC, cvB, iB);
        ssm_tile<PASS1, CVT && PASS1>(U8, Y, stl, d0, d1, tok0, tile + 2, g, lane, n, hh, i_row, a_re, a_im, Bf, CFL, s_re, s_im, PA, TC, cvA, iA);
        ssm_tile<PASS1, false>(U8, Y, stl, d0, d1, tok0, tile + 3, g, lane, n, hh, i_row, a_re, a_im, Bf, CFL, s_re, s_im, PB, TC, cvB, iB);
    }
    if (CVT) { TC.cf = iA; tabcvt_finish(TC, lane, cvA); if (PASS1) { TC.cf = iB; tabcvt_finish(TC, lane, cvB); } }
}
__device__ __forceinline__ void ssm_phase(Frame& F, int layer) {
    TabCvt TC; TC.su = F.A->in[24 + F.z]; TC.sv = F.A->in[25 + F.z]; TC.du = (unsigned char*)(F.ws + WS_TABU); TC.dv = (unsigned char*)(F.ws + WS_TABV);
    TC.c = F.vcu * NWAVES + F.wave; TC.cf = TC.c; TC.stride = F.G * NWAVES; TC.n = (layer == 0) ? 2 * 16384 : 0;
    const bf16* U = (const bf16*)(F.ws + WS_U); bf16* Y = (bf16*)(F.ws + WS_Y);
    const int lane = F.lane, n = lane & 31, hh = lane >> 5, wave = F.wave;
    LAS unsigned char* stl = F.lds + wave * 8704;
    LAS float* E = (LAS float*)(F.lds + 8 * 8704);
    for (int bg = F.vcu; bg < BATCH * 64; bg += F.G) {
        const int b = bg >> 6, g = bg & 63, lg = layer * 64 + g;
        const float dt = expf(F.A->in[9 + F.z][lg]);
        float a_re[2], a_im[2]; bf16x8 Bf[4];
#pragma unroll
        for (int pb = 0; pb < 2; ++pb) {
            const int p = 32 * pb + n;
            const float lre = F.A->in[7 + F.z][lg * 64 + p], lim = F.A->in[8 + F.z][lg * 64 + p];
            const float mag = expf(lre * dt); float sn, cs; sincosf(lim * dt, &sn, &cs);
            a_re[pb] = mag * cs; a_im[pb] = mag * sn;
            const float nr = a_re[pb] - 1.0f, ni = a_im[pb], den = 1.0f / (lre * lre + lim * lim);
            const float cr = (nr * lre + ni * lim) * den, ci = (ni * lre - nr * lim) * den;
            const float* br = F.A->in[10 + F.z] + ((size_t)lg * 64 + p) * 16 + 8 * hh; const float* bi = F.A->in[11 + F.z] + ((size_t)lg * 64 + p) * 16 + 8 * hh;
            const f32x4 br0 = *(const GAS f32x4*)br, br1 = *(const GAS f32x4*)(br + 4), bi0 = *(const GAS f32x4*)bi, bi1 = *(const GAS f32x4*)(bi + 4);
            const float rr[8] = {br0.x, br0.y, br0.z, br0.w, br1.x, br1.y, br1.z, br1.w}, ii[8] = {bi0.x, bi0.y, bi0.z, bi0.w, bi1.x, bi1.y, bi1.z, bi1.w};
            unsigned wre[4], wim[4];
#pragma unroll
            for (int j = 0; j < 4; ++j) { const float r0 = rr[2 * j], i0 = ii[2 * j], r1 = rr[2 * j + 1], i1 = ii[2 * j + 1];
                wre[j] = pk2(cr * r0 - ci * i0, cr * r1 - ci * i1); wim[j] = pk2(cr * i0 + ci * r0, cr * i1 + ci * r1); }
            Bf[2 * pb] = __builtin_bit_cast(bf16x8, (v4u){wre[0], wre[1], wre[2], wre[3]});
            Bf[2 * pb + 1] = __builtin_bit_cast(bf16x8, (v4u){wim[0], wim[1], wim[2], wim[3]});
        }
        LAS unsigned char* CFL = F.lds + 8 * 8704 + 8192;
        if (wave == 0) { const int cr_ = n & 15; const float zm = (n < 16) ? 1.0f : 0.0f;
          const float* cre = F.A->in[12 + F.z] + ((size_t)lg * 16 + cr_) * 64 + 4 * hh; const float* cim = F.A->in[13 + F.z] + ((size_t)lg * 16 + cr_) * 64 + 4 * hh;
          f32x4 cr4[8], ci4[8];
#pragma unroll
          for (int ks = 0; ks < 8; ++ks) { cr4[ks] = *(const GAS f32x4*)(cre + 8 * ks); ci4[ks] = *(const GAS f32x4*)(cim + 8 * ks); }
#pragma unroll
          for (int ks = 0; ks < 8; ++ks) { const f32x4 a = cr4[ks] * zm, c = ci4[ks] * (-zm);
              *(LAS v4u*)(CFL + (ks * 64 + lane) * 16) = (v4u){pk2(a.x, c.x), pk2(a.y, c.y), pk2(a.z, c.z), pk2(a.w, c.w)}; } }
        const int seg_own = 2 * wave + hh;
        const int i_row = n, seg_ld = 2 * wave + ((i_row >> 2) & 1), tau_ld = (i_row & 3) + 4 * (i_row >> 3);
        const size_t tok0 = (size_t)b * SEQ + seg_ld * 256 + tau_ld;
        const float* dskip = F.A->in[14 + F.z] + layer * 1024;
        float s_re[2] = {0.f, 0.f}, s_im[2] = {0.f, 0.f};
        if (layer == 0) ssm_pass<false, true>(U, Y, stl, dskip, tok0, g, lane, n, hh, i_row, a_re, a_im, Bf, CFL, s_re, s_im, TC);
        else ssm_pass<false, false>(U, Y, stl, dskip, tok0, g, lane, n, hh, i_row, a_re, a_im, Bf, CFL, s_re, s_im, TC);
#pragma unroll
        for (int pb = 0; pb < 2; ++pb) { E[(seg_own * 64 + 32 * pb + n) * 2] = s_re[pb]; E[(seg_own * 64 + 32 * pb + n) * 2 + 1] = s_im[pb]; }
        LDS_WAIT(); __syncthreads();
#pragma unroll
        for (int pb = 0; pb < 2; ++pb) {
            float Ar = a_re[pb], Ai = a_im[pb];
#pragma unroll
            for (int q = 0; q < 8; ++q) { float t = Ar * Ar - Ai * Ai; asm volatile("" : "+v"(t)); Ai = 2.0f * Ar * Ai; asm volatile("" : "+v"(Ai)); Ar = t; }
            float sr = 0.f, si = 0.f;
            for (int j = 0; j < 15; ++j) {
                const float er = E[(j * 64 + 32 * pb + n) * 2], ei = E[(j * 64 + 32 * pb + n) * 2 + 1];
                float tr = Ar * sr - Ai * si + er; asm volatile("" : "+v"(tr)); float ti = Ar * si + Ai * sr + ei; asm volatile("" : "+v"(ti));
                if (j < seg_own) { sr = tr; si = ti; }
            }
            s_re[pb] = sr; s_im[pb] = si;
        }
        __syncthreads();
        if (layer == 0) ssm_pass<true, true>(U, Y, stl, dskip, tok0, g, lane, n, hh, i_row, a_re, a_im, Bf, CFL, s_re, s_im, TC);
        else ssm_pass<true, false>(U, Y, stl, dskip, tok0, g, lane, n, hh, i_row, a_re, a_im, Bf, CFL, s_re, s_im, TC);
        __syncthreads();
    }
    { f32x4 cvT[4]; while (TC.c < TC.n) { TC.cf = TC.c; tabcvt_issue(TC, F.lane, cvT); tabcvt_finish(TC, F.lane, cvT); } }
}

typedef int av8i __attribute__((ext_vector_type(8)));
__device__ __forceinline__ av8i ld32B(const unsigned char* p0, const unsigned char* p1) {
    const v4u a = *(const GAS v4u*)p0, b = *(const GAS v4u*)p1; return (av8i){(int)a.x, (int)a.y, (int)a.z, (int)a.w, (int)b.x, (int)b.y, (int)b.z, (int)b.w}; }
__device__ __forceinline__ void attn_wave_unit(Frame& F, int b, int hd, int qt) {
    const unsigned char* Q = (const unsigned char*)(F.ws + WS_U); const unsigned char* K = (const unsigned char*)(F.ws + WS_KB); const unsigned char* Vt = (const unsigned char*)(F.ws + WS_VT); bf16* O = (bf16*)(F.ws + WS_Y);
    constexpr float QK_SC = 0.125f * 1.4426950408889634f;
    constexpr float ATT_EXIT = 28.0f;
    const int lane = F.lane, n = lane & 31, hh = lane >> 5;
    const size_t qrow = (size_t)b * SEQ + 32 * qt + n;
    const av8i qf = ld32B(Q + qrow * DM + 64 * hd + 32 * hh, Q + qrow * DM + 64 * hd + 32 * hh + 16);
    f32x16 o[2]; o[0] = f32x16{}; o[1] = f32x16{};
    float racc = 0.f;
    const int qrel = 32 * qt, myq = qrel + n;
    const int keyi = (n & 3) + 4 * (n >> 3) + 16 * ((n >> 2) & 1);
    const unsigned char* kbase = K + ((size_t)b * SEQ + keyi) * DM + 64 * hd + 32 * hh;
    const unsigned char* vbase = Vt + (size_t)(64 * hd + n) * TOK + (size_t)b * SEQ + 16 * hh;
    int T = (qrel + 30) >> 6;
    av8i kf[2];
#pragma unroll
    for (int u = 0; u < 2; ++u) { const unsigned char* kp = kbase + (size_t)(64 * T + 32 * u) * DM; kf[u] = ld32B(kp, kp + 16); }
    __builtin_amdgcn_s_waitcnt(0x0F70);
    for (; T >= 0; --T) {
        const int k0 = 64 * T;
        const f32x16 zz = {};
        const f32x16 s0 = __builtin_amdgcn_mfma_scale_f32_32x32x64_f8f6f4(kf[0], qf, zz, 0, 0, 0, 0, 0, 0), s1 = __builtin_amdgcn_mfma_scale_f32_32x32x64_f8f6f4(kf[1], qf, zz, 0, 0, 0, 0, 0, 0);
        av8i vf[2];
#pragma unroll
        for (int db = 0; db < 2; ++db) { const unsigned char* vp = vbase + (size_t)(32 * db) * TOK + k0; vf[db] = ld32B(vp, vp + 32); }
        { const int Tn = T > 0 ? T - 1 : 0;
#pragma unroll
          for (int u = 0; u < 2; ++u) { const unsigned char* kp = kbase + (size_t)(64 * Tn + 32 * u) * DM; kf[u] = ld32B(kp, kp + 16); } }
        const bool need_mask = (k0 + 63 >= qrel);
        float sp[2][16], z[2][16];
#pragma unroll
        for (int r = 0; r < 16; ++r) { const float za = fminf(s0[r] * QK_SC, 60.0f), zb = fminf(s1[r] * QK_SC, 60.0f); z[0][r] = za; z[1][r] = zb;
            sp[0][r] = __builtin_amdgcn_logf(1.0f + __builtin_amdgcn_exp2f(za)); sp[1][r] = __builtin_amdgcn_logf(1.0f + __builtin_amdgcn_exp2f(zb)); }
        if (need_mask) {
#pragma unroll
            for (int u = 0; u < 2; ++u)
#pragma unroll
                for (int r = 0; r < 16; ++r) { const int key = k0 + 32 * u + 16 * hh + r; if (key >= myq) { sp[u][r] = 0.f; z[u][r] = -1e30f; } }
        }
        float T0 = 0.f, T1 = 0.f;
#pragma unroll
        for (int r = 0; r < 16; ++r) { T0 += sp[0][r]; T1 += sp[1][r]; }
        float oT0, oT1;
        { const auto t = __builtin_amdgcn_permlane32_swap(__builtin_bit_cast(unsigned, T0), __builtin_bit_cast(unsigned, T0), false, false); const unsigned ta = t[0], tb = t[1]; oT0 = __builtin_bit_cast(float, hh ? ta : tb); }
        { const auto t = __builtin_amdgcn_permlane32_swap(__builtin_bit_cast(unsigned, T1), __builtin_bit_cast(unsigned, T1), false, false); const unsigned ta = t[0], tb = t[1]; oT1 = __builtin_bit_cast(float, hh ? ta : tb); }
        const float off1 = racc + (hh ? 0.f : oT1);
        const float off0 = racc + T1 + oT1 + (hh ? 0.f : oT0);
        racc += T0 + T1 + oT0 + oT1;
        unsigned pw[2][4];
        { float run = off1;
#pragma unroll
          for (int r = 15; r >= 0; --r) { run += sp[1][r]; z[1][r] = __builtin_amdgcn_exp2f(z[1][r] - run); }
          run = off0;
#pragma unroll
          for (int r = 15; r >= 0; --r) { run += sp[0][r]; z[0][r] = __builtin_amdgcn_exp2f(z[0][r] - run); } }
#pragma unroll
        for (int u = 0; u < 2; ++u)
#pragma unroll
            for (int q = 0; q < 4; ++q) pw[u][q] = pk4_fp8(z[u][4 * q], z[u][4 * q + 1], z[u][4 * q + 2], z[u][4 * q + 3]);
        { const av8i af = {(int)pw[0][0], (int)pw[0][1], (int)pw[0][2], (int)pw[0][3], (int)pw[1][0], (int)pw[1][1], (int)pw[1][2], (int)pw[1][3]};
#pragma unroll
          for (int db = 0; db < 2; ++db) o[db] = __builtin_amdgcn_mfma_scale_f32_32x32x64_f8f6f4(af, vf[db], o[db], 0, 0, 0, 0, 0, 0); }
        if (__all(racc >= ATT_EXIT)) break;
    }
#pragma unroll
    for (int db = 0; db < 2; ++db)
#pragma unroll
        for (int r = 0; r < 16; ++r) { const int qr = (r & 3) + 8 * (r >> 2) + 4 * hh;
            ((unsigned char*)O)[((size_t)b * SEQ + 32 * qt + qr) * DM + 64 * hd + 32 * db + n] = (unsigned char)(pk4_fp8(o[db][r], 0.f, 0.f, 0.f) & 0xffu); }
}
__device__ __forceinline__ void attn_phase(Frame& F) {
    const int gw = F.vcu * NWAVES + F.wave, NGW = F.G * NWAVES;
    if (F.G == 256) { const int x = F.vcu >> 5, j0 = (F.vcu & 31) * NWAVES + F.wave;
#pragma unroll 1
      for (int j = j0; j < 1024; j += 256) attn_wave_unit(F, x >> 1, j >> 6, 64 * (x & 1) + (j & 63)); }
    else {
#pragma unroll 1
      for (int uidx = gw; uidx < 64 * 128; uidx += NGW) { const int bh = uidx >> 7; attn_wave_unit(F, bh >> 4, bh & 15, uidx & 127); } }
}

typedef float f32x2 __attribute__((ext_vector_type(2)));
typedef _Float16 h16x2 __attribute__((ext_vector_type(2)));
template <int K, class T> __device__ __forceinline__ T xcomb(T a, T b, int lane) {
    const bool hi = (lane >> K) & 1; const T keep = hi ? b : a, send = hi ? a : b;
    return keep + __shfl_xor(send, 1 << K);
}
__device__ __forceinline__ void fp4x16_to_f32(const v2u& r, f32x2 (&f)[8]) {
    const unsigned w0 = r.x, w1 = r.y;
    f[0] = __builtin_amdgcn_cvt_scalef32_pk_f32_fp4(w0, 1.0f, 0); f[1] = __builtin_amdgcn_cvt_scalef32_pk_f32_fp4(w0, 1.0f, 1);
    f[2] = __builtin_amdgcn_cvt_scalef32_pk_f32_fp4(w0, 1.0f, 2); f[3] = __builtin_amdgcn_cvt_scalef32_pk_f32_fp4(w0, 1.0f, 3);
    f[4] = __builtin_amdgcn_cvt_scalef32_pk_f32_fp4(w1, 1.0f, 0); f[5] = __builtin_amdgcn_cvt_scalef32_pk_f32_fp4(w1, 1.0f, 1);
    f[6] = __builtin_amdgcn_cvt_scalef32_pk_f32_fp4(w1, 1.0f, 2); f[7] = __builtin_amdgcn_cvt_scalef32_pk_f32_fp4(w1, 1.0f, 3);
}
typedef unsigned bl_v2u __attribute__((__vector_size__(8)));
__device__ __forceinline__ int peer_pack_ids(int id) { const int o = __builtin_amdgcn_update_dpp(0, id, 0xB1, 0xf, 0xf, false); return (id & 0xffff) | (o << 16); }
__device__ __forceinline__ void peer_load8(__amdgpu_buffer_rsrc_t tab, int idv, int e0, int lane, v2u (&R)[8]) {
    int so[8];
#pragma unroll
    for (int m = 0; m < 4; ++m) { const unsigned pr = (unsigned)__builtin_amdgcn_readlane(idv, e0 + 2 * m); so[2 * m] = (int)((pr & 0xffffu) << 9); so[2 * m + 1] = (int)((pr >> 16) << 9); }
    __builtin_amdgcn_sched_barrier(0);
#pragma unroll
    for (int i = 0; i < 8; ++i) { const bl_v2u t = __builtin_amdgcn_raw_buffer_load_b64(tab, 8 * lane, so[i], 0); R[i] = (v2u){t[0], t[1]}; }
    __builtin_amdgcn_sched_barrier(0);
}
template <int K> __device__ __forceinline__ int xcomb_dpp(int a, int b, int lane) {
    const bool hi = (lane >> K) & 1; const int keep = hi ? b : a, send = hi ? a : b; int recv;
    if (K == 0) recv = __builtin_amdgcn_update_dpp(0, send, 0xB1, 0xF, 0xF, true);
    else if (K == 1) recv = __builtin_amdgcn_update_dpp(0, send, 0x4E, 0xF, 0xF, true);
    else { recv = __builtin_amdgcn_update_dpp(0, send, 0x104, 0xF, 0x5, true);
           recv = __builtin_amdgcn_update_dpp(recv, send, 0x114, 0xF, 0xA, true); }
    return keep + recv;
}
__device__ __forceinline__ float peer_dot8(const v2u (&R)[8], const v2u& xhi, const v2u& xlo, int lane) {
    int p[8];
#pragma unroll
    for (int i = 0; i < 8; i += 2) {
        int h0 = __builtin_amdgcn_sdot8((int)R[i].x, (int)xhi.x, 0, false), h1 = __builtin_amdgcn_sdot8((int)R[i + 1].x, (int)xhi.x, 0, false);
        int l0 = __builtin_amdgcn_sdot8((int)R[i].x, (int)xlo.x, 0, false), l1 = __builtin_amdgcn_sdot8((int)R[i + 1].x, (int)xlo.x, 0, false);
        h0 = __builtin_amdgcn_sdot8((int)R[i].y, (int)xhi.y, h0, false); h1 = __builtin_amdgcn_sdot8((int)R[i + 1].y, (int)xhi.y, h1, false);
        l0 = __builtin_amdgcn_sdot8((int)R[i].y, (int)xlo.y, l0, false); l1 = __builtin_amdgcn_sdot8((int)R[i + 1].y, (int)xlo.y, l1, false);
        p[i] = (h0 << 4) + l0; p[i + 1] = (h1 << 4) + l1; __builtin_amdgcn_sched_barrier(0); }
    int q[4];
#pragma unroll
    for (int i = 0; i < 4; ++i) q[i] = xcomb_dpp<0>(p[2 * i], p[2 * i + 1], lane);
    const int r0 = xcomb_dpp<1>(q[0], q[1], lane), r1 = xcomb_dpp<1>(q[2], q[3], lane);
    int v = xcomb_dpp<2>(r0, r1, lane);
    v += __builtin_amdgcn_update_dpp(0, v, 0x128, 0xF, 0xF, true);
    { const auto t = __builtin_amdgcn_permlane16_swap((unsigned)v, (unsigned)v, false, false); v = (int)(t[0] + t[1]); }
    { const auto t = __builtin_amdgcn_permlane32_swap((unsigned)v, (unsigned)v, false, false); v = (int)(t[0] + t[1]); }
    return (float)v;
}
__device__ __forceinline__ void peer_fma8(const v2u (&R)[8], const LAS unsigned* WLn, v4u (&wc)[2], h16x2 (&o)[8]) {
    const v4u wn0 = *(const LAS v4u*)WLn, wn1 = *(const LAS v4u*)(WLn + 4);
    const unsigned wtv[8] = {wc[0].x, wc[0].y, wc[0].z, wc[0].w, wc[1].x, wc[1].y, wc[1].z, wc[1].w};
#pragma unroll
    for (int i = 0; i < 8; ++i) { const unsigned wt = wtv[i]; const h16x2 w2 = __builtin_bit_cast(h16x2, wt);
        const unsigned w0 = R[i].x, w1 = R[i].y; h16x2 f[8];
        f[0] = __builtin_amdgcn_cvt_scalef32_pk_f16_fp4(w0, 1.0f, 0); f[1] = __builtin_amdgcn_cvt_scalef32_pk_f16_fp4(w0, 1.0f, 1);
        f[2] = __builtin_amdgcn_cvt_scalef32_pk_f16_fp4(w0, 1.0f, 2); f[3] = __builtin_amdgcn_cvt_scalef32_pk_f16_fp4(w0, 1.0f, 3);
        f[4] = __builtin_amdgcn_cvt_scalef32_pk_f16_fp4(w1, 1.0f, 0); f[5] = __builtin_amdgcn_cvt_scalef32_pk_f16_fp4(w1, 1.0f, 1);
        f[6] = __builtin_amdgcn_cvt_scalef32_pk_f16_fp4(w1, 1.0f, 2); f[7] = __builtin_amdgcn_cvt_scalef32_pk_f16_fp4(w1, 1.0f, 3);
#pragma unroll
        for (int k = 0; k < 8; ++k) o[k] = __builtin_elementwise_fma(w2, f[k], o[k]);
        __builtin_amdgcn_sched_barrier(0); }
    wc[0] = wn0; wc[1] = wn1;
}
__device__ __forceinline__ void peer_phase(Frame& F, int layer) {
    const bf16* X1 = (const bf16*)(F.ws + WS_X1); bf16* H2 = (bf16*)(F.ws + WS_H2); const float* ST = (const float*)(F.ws + WS_STATS);
    const __amdgpu_buffer_rsrc_t TU = __builtin_amdgcn_make_buffer_rsrc((void*)(F.ws + WS_TABU + (size_t)layer * 16384 * 512), (short)0, 16384 * 512, 0x00020000);
    const __amdgpu_buffer_rsrc_t TV = __builtin_amdgcn_make_buffer_rsrc((void*)(F.ws + WS_TABV + (size_t)layer * 16384 * 512), (short)0, 16384 * 512, 0x00020000);
    const int* IDX = (const int*)(F.ws + WS_IDX); const float* GATE = (const float*)(F.ws + WS_GATE);
    const float* g = F.A->in[4 + F.z] + layer * 1024; const float* bb = F.A->in[5 + F.z] + layer * 1024;
    const int lane = F.lane, gw = F.vcu * NWAVES + F.wave, NGW = F.G * NWAVES;
    v2u B0[8], B1[8], B2[8], B3[8];
    TabCvt TC; { const size_t lo = (size_t)(layer + 1) * 16384 * 1024;
        TC.su = F.A->in[24 + F.z] + lo; TC.sv = F.A->in[25 + F.z] + lo; TC.du = (unsigned char*)(F.ws + WS_TABU) + lo / 2; TC.dv = (unsigned char*)(F.ws + WS_TABV) + lo / 2;
        TC.c = gw; TC.cf = gw; TC.stride = NGW; TC.n = (layer + 1 < DEPTH) ? 2 * 16384 : 0; }
    f32x4 cvA[4], cvB[4];
    int id0 = 0, id1 = 0;
    LAS float* LG = (LAS float*)F.lds;
    { const int tt = F.tid; const float* gm = F.A->in[2 + F.z] + layer * 1024; const float* bm = F.A->in[3 + F.z] + layer * 1024;
      const f32x4 v = (tt < 256) ? *(const GAS f32x4*)(gm + 4 * tt) : *(const GAS f32x4*)(bm + 4 * (tt - 256)); *(LAS f32x4*)(LG + 4 * tt) = v; }
    LDS_WAIT(); __syncthreads();

    const bool al = (F.G == 256); const int t0 = al ? (F.vcu >> 5) * 2048 + (F.vcu & 31) * 8 + F.wave : gw, tstep = al ? 256 : NGW, tend = al ? t0 + 2048 : TOK;
    if (t0 < tend) { id0 = peer_pack_ids(IDX[(size_t)t0 * 128 + lane]); id1 = peer_pack_ids(IDX[(size_t)t0 * 128 + 64 + lane]);
        peer_load8(TU, id0, 0, lane, B0); peer_load8(TU, id0, 8, lane, B1); peer_load8(TU, id0, 16, lane, B2); }
    tabcvt_issue(TC, lane, cvA); tabcvt_issue(TC, lane, cvB);
    for (int t = t0; t < tend; t += tstep) {
        const int tn = (t + tstep < tend) ? t + tstep : t;
        const int nid0 = IDX[(size_t)tn * 128 + lane], nid1 = IDX[(size_t)tn * 128 + 64 + lane];
        const int nidp0 = peer_pack_ids(nid0);
        const float g0 = GATE[(size_t)t * 128 + lane], g1 = GATE[(size_t)t * 128 + 64 + lane];
        const v4u xa = *(const GAS v4u*)(X1 + (size_t)t * DM + 16 * lane), xb = *(const GAS v4u*)(X1 + (size_t)t * DM + 16 * lane + 8);
        const f32x2 mr = *(const GAS f32x2*)(ST + 2 * (size_t)t);
        f32x2 x[8] = {{bf_lo(xa.x), bf_hi(xa.x)}, {bf_lo(xa.y), bf_hi(xa.y)}, {bf_lo(xa.z), bf_hi(xa.z)}, {bf_lo(xa.w), bf_hi(xa.w)}, {bf_lo(xb.x), bf_hi(xb.x)}, {bf_lo(xb.y), bf_hi(xb.y)}, {bf_lo(xb.z), bf_hi(xb.z)}, {bf_lo(xb.w), bf_hi(xb.w)}};
#pragma unroll
        for (int c = 0; c < 4; ++c) { const f32x4 gv = *(const LAS f32x4*)(LG + 16 * lane + 4 * c), bv = *(const LAS f32x4*)(LG + 1024 + 16 * lane + 4 * c);
            x[2 * c].x = (x[2 * c].x - mr.x) * mr.y * gv.x + bv.x; x[2 * c].y = (x[2 * c].y - mr.x) * mr.y * gv.y + bv.y;
            x[2 * c + 1].x = (x[2 * c + 1].x - mr.x) * mr.y * gv.z + bv.z; x[2 * c + 1].y = (x[2 * c + 1].y - mr.x) * mr.y * gv.w + bv.w; }
        v2u xqh = {0u, 0u}, xql = {0u, 0u};
#pragma unroll
        for (int i = 0; i < 16; ++i) { const float xv = (i & 1) ? x[i >> 1].y : x[i >> 1].x;
            float qf = __builtin_fminf(__builtin_fmaxf(xv * 16.f, -120.f), 119.f) + 12582912.0f; asm volatile("" : "+v"(qf)); const unsigned q = __builtin_bit_cast(unsigned, qf);
            const unsigned lo = q & 15u, hi = ((q + 8u) >> 4) & 15u;
            if (i < 8) { xql.x |= lo << (4 * i); xqh.x |= hi << (4 * i); } else { xql.y |= lo << (4 * (i - 8)); xqh.y |= hi << (4 * (i - 8)); } }
#define PEER_LOADB(buf, b) do { const int b_ = (b); const bool nx_ = b_ >= 32; const int idv_ = nx_ ? nidp0 : ((b_ & 8) ? id1 : id0); peer_load8((!nx_ && (b_ & 16)) ? TV : TU, idv_, 8 * (b_ & 7), lane, buf); } while (0)
#define PEER_DOTB(buf, b) do { const int b_ = (b); const float r_ = peer_dot8(buf, xqh, xql, lane); const bool mine_ = (lane >> 3) == (b_ & 7); if (b_ & 8) act1 = mine_ ? r_ : act1; else act0 = mine_ ? r_ : act0; } while (0)
#define PEER_FMAB(buf, b) do { const int b_ = (b); peer_fma8(buf, WLw + 8 * ((b_ + 1) & 15), wcur, o); } while (0)
        float act0 = 0.f, act1 = 0.f;
#pragma unroll 1
        for (int j = 0; j < 16; j += 4) {
            PEER_LOADB(B3, j + 3); PEER_DOTB(B0, j);
            PEER_LOADB(B0, j + 4); PEER_DOTB(B1, j + 1);
            PEER_LOADB(B1, j + 5); PEER_DOTB(B2, j + 2);
            PEER_LOADB(B2, j + 6); PEER_DOTB(B3, j + 3);
        }
        const float w0 = g0 * gelu_tanh(act0 * (1.0f / (16.f * PEER_SU))) * (1.0f / PEER_SV), w1 = g1 * gelu_tanh(act1 * (1.0f / (16.f * PEER_SU))) * (1.0f / PEER_SV);
        unsigned w0h, w1h; { const _Float16 a = (_Float16)w0, b = (_Float16)w1; const h16x2 pa = {a, a}, pb = {b, b}; w0h = __builtin_bit_cast(unsigned, pa); w1h = __builtin_bit_cast(unsigned, pb); }
        LAS unsigned* WLw = (LAS unsigned*)(F.lds + 8192) + F.wave * 128;
        WLw[lane] = w0h; WLw[64 + lane] = w1h;
        v4u wcur[2] = {*(const LAS v4u*)WLw, *(const LAS v4u*)(WLw + 4)};
        h16x2 o[8];
#pragma unroll
        for (int i = 0; i < 8; ++i) o[i] = (h16x2){(_Float16)0.f, (_Float16)0.f};
#pragma unroll 1
        for (int j = 16; j < 32; j += 4) {
            PEER_LOADB(B3, j + 3); PEER_FMAB(B0, j);
            PEER_LOADB(B0, j + 4); PEER_FMAB(B1, j + 1);
            PEER_LOADB(B1, j + 5); PEER_FMAB(B2, j + 2);
            PEER_LOADB(B2, j + 6); PEER_FMAB(B3, j + 3);
        }
#undef PEER_LOADB
#undef PEER_DOTB
#undef PEER_FMAB
        id0 = nidp0; id1 = peer_pack_ids(nid1);
        tabcvt_finish(TC, lane, cvA); tabcvt_finish(TC, lane, cvB);
        tabcvt_issue(TC, lane, cvA); tabcvt_issue(TC, lane, cvB);
        float y[16]; float sm = 0.f;
#pragma unroll
        for (int i = 0; i < 8; ++i) { y[2 * i] = pg8::ALPHA_F * x[i].x + (float)o[i].x; y[2 * i + 1] = pg8::ALPHA_F * x[i].y + (float)o[i].y; sm += y[2 * i] + y[2 * i + 1]; }
        const float mean = wave_sum_dpp(sm) * (1.f / DM); float q = 0.f;
#pragma unroll
        for (int i = 0; i < 16; ++i) { y[i] -= mean; q += y[i] * y[i]; }
        const float rstd = 1.0f / sqrtf(wave_sum_dpp(q) * (1.f / DM) + LN_EPS);
#pragma unroll
        for (int c = 0; c < 4; ++c) { const f32x4 gv = *(const GAS f32x4*)(g + 16 * lane + 4 * c), bv = *(const GAS f32x4*)(bb + 16 * lane + 4 * c);
            y[4 * c] = y[4 * c] * rstd * gv.x + bv.x; y[4 * c + 1] = y[4 * c + 1] * rstd * gv.y + bv.y; y[4 * c + 2] = y[4 * c + 2] * rstd * gv.z + bv.z; y[4 * c + 3] = y[4 * c + 3] * rstd * gv.w + bv.w; }
        v4u oa, ob; oa.x = pk2(y[0], y[1]); oa.y = pk2(y[2], y[3]); oa.z = pk2(y[4], y[5]); oa.w = pk2(y[6], y[7]); ob.x = pk2(y[8], y[9]); ob.y = pk2(y[10], y[11]); ob.z = pk2(y[12], y[13]); ob.w = pk2(y[14], y[15]);
        *(GAS v4u*)(H2 + (size_t)t * DM + 16 * lane) = oa; *(GAS v4u*)(H2 + (size_t)t * DM + 16 * lane + 8) = ob;
        *(GAS v4u*)((unsigned char*)(F.ws + WS_H28) + (size_t)t * DM + 16 * lane) = (v4u){pk4_fp8(y[0], y[1], y[2], y[3]), pk4_fp8(y[4], y[5], y[6], y[7]), pk4_fp8(y[8], y[9], y[10], y[11]), pk4_fp8(y[12], y[13], y[14], y[15])};
    }
    tabcvt_finish(TC, lane, cvA); tabcvt_finish(TC, lane, cvB);
    while (TC.cf < TC.n) { tabcvt_issue(TC, lane, cvA); tabcvt_finish(TC, lane, cvA); }
}

template <class Epi> __device__ __forceinline__ void run_gemm(Frame& F, const bf16* A, const bf16* Bt, int M, int N, int K, const Epi& E, int pw = 0) {
    pg8::Gemm g{A, Bt, M, N, K}; pg8::StaticOrder S; S.init(M, N, F.G, pw ? F.vcu : F.bx); S.pw = pw; if (pw) S.nwg = 1024;
    int t = F.tid; asm volatile("" : "+v"(t));
    pg8::gemm_phase<Epi, pg8::StaticOrder, true, true>(F.lds, g, S, E, t);
}

template <class Epi> __device__ __forceinline__ void run_gemm8(Frame& F, const unsigned char* A8, const unsigned char* Bt8, int M, int N, int Kbytes, const Epi& E) {
    pg8::Gemm g{(const bf16*)A8, (const bf16*)Bt8, M, N, Kbytes / 2 + F.z  }; pg8::StaticOrder S; S.init(M, N, F.G, F.bx);
    int t = F.tid; asm volatile("" : "+v"(t));
    pg8::gemm_phase<Epi, pg8::StaticOrder, true, true, true>(F.lds, g, S, E, t);
}

__global__ void __launch_bounds__(NWAVES * 64, 2) mega_fwd(Args args) {
    extern __shared__ __attribute__((aligned(16))) unsigned char lds[];
    Frame F;
    F.lds = (LAS unsigned char*)lds;
    F.tid = threadIdx.x; F.lane = F.tid & 63; F.wave = 0; F.G = gridDim.x; F.bx = blockIdx.x; F.vcu = 0;
    F.A = &args; F.z = 0; F.out = args.out; F.ws = args.ws;
    const int wave_s = __builtin_amdgcn_readfirstlane((int)threadIdx.x >> 6);
    volatile LAS unsigned* MISC = (volatile LAS unsigned*)(F.lds + MISC_OFF);
    if (F.tid < 64) MISC[F.tid] = 0u;
    __syncthreads();
    XcdBarrier bar; bar.bar = (unsigned*)(F.ws + WS_CTL) + CW_BAR; bar.x = 0; bar.st = nullptr;
    if (args.use_bar) bar = xcd_barrier_post((unsigned*)(F.ws + WS_CTL) + CW_BAR, MISC + 8);

    for (int pc = args.ph_lo; pc < args.ph_hi; ++pc) {
        { int z = 0; asm volatile("" : "+s"(z)); int t = wave_s * 64 + (int)__builtin_amdgcn_mbcnt_hi(~0u, __builtin_amdgcn_mbcnt_lo(~0u, (unsigned)z)); asm volatile("" : "+v"(t));
          F.z = z; F.ws = args.ws + z; F.tid = t; F.lane = t & 63; F.wave = __builtin_amdgcn_readfirstlane(t >> 6);
          F.G = (int)gridDim.x + z; F.bx = (int)blockIdx.x + z; if (args.use_bar && MISC[12]) F.bx = (int)(MISC[10] * 8u + MISC[11]) + z;     F.vcu = (F.G % 8 == 0) ? (F.bx % 8) * (F.G / 8) + F.bx / 8 : F.bx; }
        bf16* const H = (bf16*)(F.ws + WS_H); bf16* const U = (bf16*)(F.ws + WS_U); bf16* const Y = (bf16*)(F.ws + WS_Y); bf16* const X1 = (bf16*)(F.ws + WS_X1);
        bf16* const H1 = (bf16*)(F.ws + WS_H1); bf16* const H2 = (bf16*)(F.ws + WS_H2); bf16* const KB = (bf16*)(F.ws + WS_KB); bf16* const VT = (bf16*)(F.ws + WS_VT); bf16* const HKV = (bf16*)(F.ws + WS_HKV);
        const int ty = args.ph_type[pc], la = args.ph_arg[pc] & 0x3f; const bool loc_ok = (args.ph_arg[pc] & 0x80) != 0, noacq = (args.ph_arg[pc] & 0x40) != 0;
#ifndef PHMASK
#define PHMASK 0xFFFF
#endif
#define EN(x) ((PHMASK >> (x)) & 1)
        switch (ty) {
        case P_PROLOGUE: if (EN(P_PROLOGUE)) p0_prologue(F); break;
        case P_STORE: if (EN(P_STORE)) {
            const int njobs = (la == 0) ? 2 : (la == 2) ? 3 : 1;
            for (int j = 0; j < njobs; ++j) {
                const bf16* A; const bf16* Bt; int M = TOK, N = 1024, K = 1024, ldc = 1024, pw = 0; bf16* O; float sc = 1.0f;
                if (la == 0 && j == 0) { A = (const bf16*)(F.ws + WS_PB); Bt = (const bf16*)(F.ws + WS_W_PW); K = 256; O = (bf16*)(F.ws + WS_PW); pw = 1; }
                else if (la == 0) { A = H; Bt = (const bf16*)(F.ws + WS_W_IN); O = U; }
                else if (la == 1) { A = H; Bt = (const bf16*)(F.ws + WS_W_IN) + (size_t)1024 * 1024; O = U; }
                else if (la == 2 && j == 1) { A = HKV; Bt = (const bf16*)(F.ws + WS_W_KV); O = KB; }
                else if (la == 2 && j == 2) { A = (const bf16*)(F.ws + WS_W_KV) + (size_t)1024 * 1024; Bt = HKV; M = 1024; N = TOK; ldc = TOK; O = VT; }
                else { A = H; Bt = (const bf16*)(F.ws + WS_W_SQ) + (size_t)(la - 2) * 1024 * 1024; O = U; sc = 0.125f * 1.4426950408889634f; }
                if (!pw) {
                    const unsigned char* A8; const unsigned char* B8;
                    if (la <= 1) { A8 = (const unsigned char*)(F.ws + WS_H8); B8 = (const unsigned char*)(F.ws + W8_IN) + (size_t)la * 1024 * 1024; }
                    else if (la == 2 && j == 1) { A8 = (const unsigned char*)(F.ws + WS_HKV); B8 = (const unsigned char*)(F.ws + W8_KV); }
                    else if (la == 2 && j == 2) { A8 = (const unsigned char*)(F.ws + W8_KV) + (size_t)1024 * 1024; B8 = (const unsigned char*)(F.ws + WS_HKV); }
                    else { A8 = (const unsigned char*)(F.ws + WS_H8); B8 = (const unsigned char*)(F.ws + W8_SQ) + (size_t)(la - 2) * 1024 * 1024; }
                    const int f8o = 1;
                    pg8::EpiStore E{O, ldc, 1.0f * (1.0f / W8_SCALE), -1, f8o};
                    run_gemm8(F, A8, B8, M, N, 1024, E);
                } else {
                    pg8::EpiStore E{O, ldc, sc, pw ? 3 : -1, pw ? 1 : 0};
                    run_gemm(F, A, Bt, M, N, K, E, pw);
                }
            }
        } break;
        case P_SSM: if (EN(P_SSM)) ssm_phase(F, la); break;
        case P_GLU: if (EN(P_GLU)) { pg8::EpiGlu E{H, X1}; run_gemm8(F, (const unsigned char*)Y, (const unsigned char*)(F.ws + W8_GLU) + (size_t)la * 2048 * 1024, TOK, 2048, 1024, E); } break;
        case P_LNMIX: if (EN(P_LNMIX)) ln_rows(F, X1, F.A->in[2 + F.z] + la * 1024, F.A->in[3 + F.z] + la * 1024, nullptr, (unsigned char*)(F.ws + WS_H18), (float*)(F.ws + WS_STATS)); break;
        case P_TOPK: if (EN(P_TOPK)) {
            pg8::EpiTopk E{(int*)(F.ws + WS_IDX), (float*)(F.ws + WS_GATE)};
            pg8::Gemm g{(const bf16*)(F.ws + WS_H18), (const bf16*)((const unsigned char*)(F.ws + W8_EFF) + (size_t)la * 2048 * 1024), TOK, 2048, 512 + F.z};
            for (int r = 0; r < 2; ++r) { pg8::OneUnitOrder S; S.base.init(TOK, 2048, F.G, F.bx); S.round = r;
                int t = F.tid; asm volatile("" : "+v"(t)); pg8::gemm_phase<pg8::EpiTopk, pg8::OneUnitOrder, false, true, true>(F.lds, g, S, E, t); }
        } break;
        case P_PEER: if (EN(P_PEER)) peer_phase(F, la); break;
        case P_PLE: if (EN(P_PLE)) { pg8::EpiPle E{H2, (const unsigned char*)(F.ws + WS_PW) + (size_t)la * TOK * 1024, H, (la == DEPTH - 1) ? F.out : nullptr, (unsigned char*)(F.ws + WS_H8)};
            run_gemm8(F, (const unsigned char*)(F.ws + WS_H28), (const unsigned char*)(F.ws + W8_PG) + (size_t)la * 1024 * 1024, TOK, 1024, 1024, E); } break;
        case P_LNKV: if (EN(P_LNKV)) ln_rows(F, H, F.A->in[16 + F.z], F.A->in[17 + F.z], nullptr, (unsigned char*)HKV); break;
        case P_ATTN: if (EN(P_ATTN)) attn_phase(F); break;
        case P_RES: if (EN(P_RES)) { pg8::EpiRes E{H, X1}; run_gemm8(F, (const unsigned char*)Y, (const unsigned char*)(F.ws + W8_SO) + (size_t)(la - 2) * 1024 * 1024, TOK, 1024, 1024, E); } break;
        default: break;
        }
        if (pc + 1 < args.ph_hi) xcd_barrier(bar, loc_ok && args.use_bar && MISC[12] != 0u, noacq);
    }
}

#ifndef N_LAUNCH_MODE
#define N_LAUNCH_MODE 1
#endif
extern "C" void kernel_launch(void* const* d_in, const int* in_sizes, int n_in, void* d_out, int out_size, void* d_ws, size_t ws_size, hipStream_t stream) {
    static int grid = 0;
    if (grid == 0) {
        if (n_in != 28 || out_size != TOK * DM || ws_size < WS_END) { fprintf(stderr, "kernel_launch: unexpected shapes/workspace (n_in %d, out %d, ws %zu)\n", n_in, out_size, ws_size); grid = -1; return; }
        int dev = 0, cus = 0;
        if (hipGetDevice(&dev) != hipSuccess || hipDeviceGetAttribute(&cus, hipDeviceAttributeMultiprocessorCount, dev) != hipSuccess) { grid = -1; return; }
        if (hipFuncSetAttribute((const void*)mega_fwd, hipFuncAttributeMaxDynamicSharedMemorySize, LDS_BYTES) != hipSuccess) { fprintf(stderr, "kernel_launch: hipFuncSetAttribute failed\n"); grid = -1; return; }
        (void)hipGetLastError();
        grid = cus;
    }
    if (grid < 0) return;
    hipMemsetAsync((char*)d_ws + WS_CTL, 0, CTL_ZERO_BYTES, stream);
    Args a{};
    for (int i = 0; i < 28; ++i) a.in[i] = (const float*)d_in[i];
    a.out = (float*)d_out; a.ws = (unsigned char*)d_ws;
    int n = 0;
#ifndef REP_TYPE
#define REP_TYPE -1
#endif
    auto add = [&](int t, int l, int loc = 0) { for (int r = 0; r < ((t == REP_TYPE) ? 2 : 1); ++r) { a.ph_type[n] = (unsigned char)t; a.ph_arg[n] = (unsigned char)(l | (loc && t != REP_TYPE ? 0x80 : 0) | (loc == 2 && t != REP_TYPE ? 0x40 : 0)); ++n; } };
    add(P_PROLOGUE, 0); add(P_STORE, 0);
    for (int l = 0; l < DEPTH; ++l) {
        if (l < 2) { if (l == 1) add(P_STORE, 1); add(P_SSM, l); add(P_GLU, l, 2); }
        else { if (l == 2) add(P_LNKV, 0, 2); add(P_STORE, l); add(P_ATTN, l, 2); add(P_RES, l, 2); }
        add(P_LNMIX, l, 2); add(P_TOPK, l, 2); add(P_PEER, l, 2); add(P_PLE, l, (l == 1) ? 1 : 2);
    }
    a.nph = n;
    if (N_LAUNCH_MODE == 1) {
        a.ph_lo = 0; a.ph_hi = n; a.use_bar = 1;
        hipLaunchKernelGGL(mega_fwd, dim3(grid), dim3(NWAVES * 64), LDS_BYTES, stream, a);
    } else {
        a.use_bar = 0;
        for (int i = 0; i < n; ++i) { a.ph_lo = i; a.ph_hi = i + 1; hipLaunchKernelGGL(mega_fwd, dim3(grid), dim3(NWAVES * 64), LDS_BYTES, stream, a); }
    }
}
```
